# Optimizing an MI355X kernel written in HIP

```python
import math
import numpy as np
import jax
import jax.numpy as jnp
from jax import lax

D_MODEL = 4096
BATCH = 2
SEQ = 4096
DEPTH = 1
DEC_BATCH = 16
DEC_SEQ = 32
PAST_LEN = 2048

CHUNK = 64
N_HEADS = 32
N_KV_HEADS = 8
HEAD_DIM = 128
ATTN_W = N_HEADS * HEAD_DIM
KV_W = N_KV_HEADS * HEAD_DIM
ROT_DIM = HEAD_DIM // 4
ROPE_THETA = 500000.0
IDX_HEADS = 32
IDX_DIM = 128
IDX_ROT_DIM = IDX_DIM // 4
TOPK_MAX = 256
Q_BLOCK = 128
LRU_W = D_MODEL
LRU_BLOCKS = 16
LRU_BW = LRU_W // LRU_BLOCKS
CONV_W = 4
LRU_C = 8.0
D_FF = -(-8 * D_MODEL // (3 * 256)) * 256
EPS = 1e-6
NEG = -1e30

IN_SIZES = (ATTN_W, KV_W, KV_W, IDX_HEADS * IDX_DIM, IDX_HEADS, IDX_DIM, LRU_W, LRU_W, D_MODEL, D_MODEL)
IN_SPLITS = tuple(int(s) for s in np.cumsum(IN_SIZES)[:-1])
IN_COLS = int(sum(IN_SIZES))

kernel_name = 'dsa_rglru_gated_hybrid_stream_step'


def rmsnorm(x, g):
    xf = x.astype(jnp.float32)
    y = xf * lax.rsqrt(jnp.mean(xf * xf, axis=-1, keepdims=True) + EPS) * g.astype(jnp.float32)
    return y.astype(x.dtype)


def rope_partial(x, pos, rot):
    half = rot // 2
    inv = ROPE_THETA ** (-jnp.arange(half, dtype=jnp.float32) * 2.0 / rot)
    ang = pos.astype(jnp.float32)[:, None] * inv[None, :]
    cos = jnp.cos(ang)[:, None, :]
    sin = jnp.sin(ang)[:, None, :]
    xf = x.astype(jnp.float32)
    x1 = xf[..., :half]
    x2 = xf[..., half:rot]
    out = jnp.concatenate([x1 * cos - x2 * sin, x2 * cos + x1 * sin, xf[..., rot:]], axis=-1)
    return out.astype(x.dtype)


def sparse_attend(q, iq, iw, q_pos, k_all, v_all, ik_all, k_pos, topk):
    f32 = jnp.float32
    B, Tq = q.shape[0], q.shape[1]
    s_idx = jnp.einsum('bthd,bsd->bths', iq.astype(f32), ik_all.astype(f32))
    s_idx = jnp.einsum('bths,bth->bts', jax.nn.relu(s_idx), iw.astype(f32))
    allowed = (k_pos[None, :] // CHUNK) <= (q_pos[:, None] // CHUNK)
    s_idx = jnp.where(allowed[None], s_idx, NEG)
    vals, sel = lax.top_k(s_idx, topk)
    valid = vals > 0.5 * NEG
    gather = jax.vmap(lambda kv, ix: kv[ix])
    k_sel = gather(k_all, sel)
    v_sel = gather(v_all, sel)
    qg = q.reshape(B, Tq, N_KV_HEADS, N_HEADS // N_KV_HEADS, HEAD_DIM).astype(f32)
    logits = jnp.einsum('btkgd,btskd->btkgs', qg, k_sel.astype(f32)) * (HEAD_DIM ** -0.5)
    logits = jnp.where(valid[:, :, None, None, :], logits, NEG)
    p = jax.nn.softmax(logits, axis=-1)
    o = jnp.einsum('btkgs,btskd->btkgd', p, v_sel.astype(f32))
    return o.reshape(B, Tq, ATTN_W).astype(q.dtype)


def rg_lru_branch(xl, conv0, h0, conv_w, conv_b, wa, ba, wx, bx, lam):
    f32 = jnp.float32
    B, T = xl.shape[0], xl.shape[1]
    xpad = jnp.concatenate([conv0.astype(xl.dtype), xl], axis=1)
    u = conv_b
    for j in range(CONV_W):
        u = u + xpad[:, j:j + T] * conv_w[j]
    new_conv = xpad[:, -(CONV_W - 1):]
    uf = u.astype(f32)
    ub = uf.reshape(B, T, LRU_BLOCKS, LRU_BW)
    r = jax.nn.sigmoid(jnp.einsum('btnc,ncd->btnd', ub, wa.astype(f32)).reshape(B, T, LRU_W) + ba.astype(f32))
    i = jax.nn.sigmoid(jnp.einsum('btnc,ncd->btnd', ub, wx.astype(f32)).reshape(B, T, LRU_W) + bx.astype(f32))
    log_a = -LRU_C * r * jax.nn.softplus(-lam.astype(f32))
    a = jnp.exp(log_a)
    b = jnp.sqrt(-jnp.expm1(2.0 * log_a)) * (i * uf)
    b = b.at[:, 0].add(a[:, 0] * h0.astype(f32))

    def combine(left, right):
        a1, b1 = left
        a2, b2 = right
        return a1 * a2, a2 * b1 + b2

    _, h = lax.associative_scan(combine, (a, b), axis=1)
    return h, h[:, -1], new_conv


def hybrid_layer(x, pos, past, conv0, h0, blocked, topk, p):
    B, T = x.shape[0], x.shape[1]
    xn = rmsnorm(x, p['norm_mix'])
    proj = xn @ p['w_in']
    q, k, v, iq, iw, ik, xl, yl, ga, gl = jnp.split(proj, list(IN_SPLITS), axis=-1)
    q = rope_partial(rmsnorm(q.reshape(B, T, N_HEADS, HEAD_DIM), p['norm_q']), pos, ROT_DIM)
    k = rope_partial(rmsnorm(k.reshape(B, T, N_KV_HEADS, HEAD_DIM), p['norm_k']), pos, ROT_DIM)
    v = v.reshape(B, T, N_KV_HEADS, HEAD_DIM)
    iq = rope_partial(iq.reshape(B, T, IDX_HEADS, IDX_DIM), pos, IDX_ROT_DIM)
    ik = rope_partial(rmsnorm(ik, p['norm_idx_k'])[:, :, None, :], pos, IDX_ROT_DIM)[:, :, 0, :]
    iw = iw * ((IDX_HEADS * IDX_DIM) ** -0.5)
    if past is None:
        k_all, v_all, ik_all, k_pos = k, v, ik, pos
    else:
        pk, pv, pik = past
        k_all = jnp.concatenate([pk.astype(k.dtype), k], axis=1)
        v_all = jnp.concatenate([pv.astype(v.dtype), v], axis=1)
        ik_all = jnp.concatenate([pik.astype(ik.dtype), ik], axis=1)
        k_pos = jnp.concatenate([jnp.arange(pk.shape[1], dtype=jnp.int32), pos])
    if blocked:
        nb = T // Q_BLOCK

        def to_blocks(a):
            return a.reshape((B, nb, Q_BLOCK) + a.shape[2:]).swapaxes(0, 1)

        xs = (to_blocks(q), to_blocks(iq), to_blocks(iw), pos.reshape(nb, Q_BLOCK))
        o = lax.map(lambda a: sparse_attend(a[0], a[1], a[2], a[3], k_all, v_all, ik_all, k_pos, topk), xs)
        o_attn = o.swapaxes(0, 1).reshape(B, T, ATTN_W)
    else:
        o_attn = sparse_attend(q, iq, iw, pos, k_all, v_all, ik_all, k_pos, topk)
    h_seq, h_last, conv_new = rg_lru_branch(xl, conv0, h0, p['conv_w'], p['conv_b'], p['lru_wa'],
                                            p['lru_ba'], p['lru_wx'], p['lru_bx'], p['lru_lambda'])
    o_lru = h_seq.astype(x.dtype) * jax.nn.gelu(yl)
    wb = p['w_branch']
    mixed = jax.nn.sigmoid(ga) * (o_attn @ wb[:ATTN_W]) + jax.nn.sigmoid(gl) * (o_lru @ wb[ATTN_W:])
    x = x + mixed @ p['w_out']
    xn2 = rmsnorm(x, p['norm_ffn'])
    x = x + (jax.nn.silu(xn2 @ p['w_gate']) * (xn2 @ p['w_up'])) @ p['w_down']
    return x, (k, v, ik, h_last, conv_new)


def setup_inputs(seed: int = 0) -> dict:
    key = jax.random.key(seed)
    ks = jax.random.split(key, 26)
    f32 = jnp.float32
    L = DEPTH

    def nrm(k, shape, scale):
        return scale * jax.random.normal(k, shape, f32)

    a0 = jax.random.uniform(ks[18], (L, LRU_W), f32, 0.9, 0.999)
    s = a0 ** (1.0 / LRU_C)
    lam = jnp.log(s) - jnp.log1p(-s)
    return {
        'x_prompt': nrm(ks[0], (BATCH, SEQ, D_MODEL), 1.0),
        'x_sample': nrm(ks[1], (DEC_BATCH, DEC_SEQ, D_MODEL), 1.0),
        'cache_k': nrm(ks[2], (L, DEC_BATCH, PAST_LEN, N_KV_HEADS, HEAD_DIM), 1.0),
        'cache_v': nrm(ks[3], (L, DEC_BATCH, PAST_LEN, N_KV_HEADS, HEAD_DIM), 1.0),
        'cache_idx_k': nrm(ks[4], (L, DEC_BATCH, PAST_LEN, IDX_DIM), 1.0),
        'state_lru': nrm(ks[5], (L, DEC_BATCH, LRU_W), 0.5),
        'state_conv': nrm(ks[6], (L, DEC_BATCH, CONV_W - 1, LRU_W), 1.0),
        'norm_mix': 1.0 + nrm(ks[7], (L, D_MODEL), 0.02),
        'w_in': nrm(ks[8], (L, D_MODEL, IN_COLS), D_MODEL ** -0.5),
        'norm_q': 1.0 + nrm(ks[9], (L, HEAD_DIM), 0.02),
        'norm_k': 1.0 + nrm(ks[10], (L, HEAD_DIM), 0.02),
        'norm_idx_k': 1.0 + nrm(ks[11], (L, IDX_DIM), 0.02),
        'conv_w': nrm(ks[12], (L, CONV_W, LRU_W), CONV_W ** -0.5),
        'conv_b': nrm(ks[13], (L, LRU_W), 0.01),
        'lru_wa': nrm(ks[14], (L, LRU_BLOCKS, LRU_BW, LRU_BW), LRU_BW ** -0.5),
        'lru_ba': nrm(ks[15], (L, LRU_W), 0.01),
        'lru_wx': nrm(ks[16], (L, LRU_BLOCKS, LRU_BW, LRU_BW), LRU_BW ** -0.5),
        'lru_bx': nrm(ks[17], (L, LRU_W), 0.01),
        'lru_lambda': lam,
        'w_branch': nrm(ks[19], (L, ATTN_W + LRU_W, D_MODEL), D_MODEL ** -0.5),
        'w_out': nrm(ks[20], (L, D_MODEL, D_MODEL), D_MODEL ** -0.5),
        'norm_ffn': 1.0 + nrm(ks[21], (L, D_MODEL), 0.02),
        'w_gate': nrm(ks[22], (L, D_MODEL, D_FF), D_MODEL ** -0.5),
        'w_up': nrm(ks[23], (L, D_MODEL, D_FF), D_MODEL ** -0.5),
        'w_down': nrm(ks[24], (L, D_FF, D_MODEL), D_FF ** -0.5),
    }


def reference(x_prompt, x_sample, cache_k, cache_v, cache_idx_k, state_lru, state_conv,
              norm_mix, w_in, norm_q, norm_k, norm_idx_k, conv_w, conv_b, lru_wa, lru_ba,
              lru_wx, lru_bx, lru_lambda, w_branch, w_out, norm_ffn, w_gate, w_up, w_down):
    Bp, Tp = x_prompt.shape[0], x_prompt.shape[1]
    Bs, Ts = x_sample.shape[0], x_sample.shape[1]
    past_len = cache_k.shape[2]
    topk_prompt = min(TOPK_MAX, Tp // 4)
    topk_sample = min(TOPK_MAX, (past_len + Ts) // 4)
    pos_p = jnp.arange(Tp, dtype=jnp.int32)
    pos_s = past_len + jnp.arange(Ts, dtype=jnp.int32)
    yp, ys = x_prompt, x_sample
    kp_l, vp_l, ikp_l, hp_l, cp_l = [], [], [], [], []
    ks_l, vs_l, iks_l, hs_l, cs_l = [], [], [], [], []
    for l in range(DEPTH):
        p = {'norm_mix': norm_mix[l], 'w_in': w_in[l], 'norm_q': norm_q[l], 'norm_k': norm_k[l],
             'norm_idx_k': norm_idx_k[l], 'conv_w': conv_w[l], 'conv_b': conv_b[l],
             'lru_wa': lru_wa[l], 'lru_ba': lru_ba[l], 'lru_wx': lru_wx[l], 'lru_bx': lru_bx[l],
             'lru_lambda': lru_lambda[l], 'w_branch': w_branch[l], 'w_out': w_out[l],
             'norm_ffn': norm_ffn[l], 'w_gate': w_gate[l], 'w_up': w_up[l], 'w_down': w_down[l]}
        conv0_p = jnp.zeros((Bp, CONV_W - 1, LRU_W), x_prompt.dtype)
        h0_p = jnp.zeros((Bp, LRU_W), jnp.float32)
        yp, (kp, vp, ikp, hp, cp) = hybrid_layer(yp, pos_p, None, conv0_p, h0_p, True, topk_prompt, p)
        ys, (kss, vss, ikss, hss, css) = hybrid_layer(
            ys, pos_s, (cache_k[l], cache_v[l], cache_idx_k[l]), state_conv[l], state_lru[l],
            False, topk_sample, p)
        kp_l.append(kp); vp_l.append(vp); ikp_l.append(ikp); hp_l.append(hp); cp_l.append(cp)
        ks_l.append(kss); vs_l.append(vss); iks_l.append(ikss); hs_l.append(hss); cs_l.append(css)
    k_prompt = jnp.stack(kp_l)
    v_prompt = jnp.stack(vp_l)
    idx_k_prompt = jnp.stack(ikp_l)
    lru_prompt = jnp.stack(hp_l)
    conv_prompt = jnp.stack(cp_l)
    k_sample = jnp.stack(ks_l)
    v_sample = jnp.stack(vs_l)
    idx_k_sample = jnp.stack(iks_l)
    lru_sample = jnp.stack(hs_l)
    conv_sample = jnp.stack(cs_l)
    return (yp, ys, k_prompt, v_prompt, idx_k_prompt, lru_prompt, conv_prompt,
            k_sample, v_sample, idx_k_sample, lru_sample, conv_sample)
```

```cpp
#include <hip/hip_runtime.h>
#include <cstdio>
#include <cstdint>

#ifndef DBL
#define DBL 0
#endif
#ifndef P9_FP8
#define P9_FP8 1
#endif
#ifndef FP8_MX
#define FP8_MX 2
#endif
#define LAS __attribute__((address_space(3)))
#define GAS __attribute__((address_space(1)))
typedef unsigned short bf16_t;
typedef short bf16x8 __attribute__((ext_vector_type(8)));
typedef float f32x4 __attribute__((ext_vector_type(4)));
typedef float f32x2 __attribute__((ext_vector_type(2)));
typedef float f32x16 __attribute__((ext_vector_type(16)));
typedef unsigned u32x4 __attribute__((ext_vector_type(4)));
typedef unsigned u32x2 __attribute__((ext_vector_type(2)));
typedef int i32x8 __attribute__((ext_vector_type(8)));

constexpr int DM = 4096, SEQ = 4096, NB_P = 2, NTOK_P = NB_P * SEQ, DEC_B = 16, DEC_T = 32, NTOK_S = DEC_B * DEC_T, MTOK = NTOK_P + NTOK_S;
constexpr int PAST = 2048, SKV_S = PAST + DEC_T, SKV_SP = 2112;
constexpr int NH = 32, NKVH = 8, HD = 128, KVW = NKVH * HD, IDXH = 32, IDXD = 128;
constexpr int DFF = 11008, TOPK = 256;
constexpr int N1 = 105 * 256;
constexpr int N1_SRC = 26784;
constexpr float EPS = 1e-6f;
static_assert(MTOK % 256 == 0 && DFF % 128 == 0, "tiling");

constexpr size_t O_YP = 0, O_YS = O_YP + (size_t)NTOK_P * DM, O_KP = O_YS + (size_t)NTOK_S * DM, O_VP = O_KP + (size_t)NTOK_P * KVW, O_IKP = O_VP + (size_t)NTOK_P * KVW,
                 O_LRUP = O_IKP + (size_t)NTOK_P * IDXD, O_CONVP = O_LRUP + (size_t)NB_P * DM, O_KS = O_CONVP + (size_t)NB_P * 3 * DM, O_VS = O_KS + (size_t)NTOK_S * KVW,
                 O_IKS = O_VS + (size_t)NTOK_S * KVW, O_LRUS = O_IKS + (size_t)NTOK_S * IDXD, O_CONVS = O_LRUS + (size_t)DEC_B * DM, O_END = O_CONVS + (size_t)DEC_B * 3 * DM;
static_assert(O_END == 54886400, "output size");

constexpr size_t al256(size_t x) { return (x + 255) & ~(size_t)255; }
constexpr size_t SZ_ACT = (size_t)MTOK * DM * 2;
constexpr size_t WS_CTL = 0, CTL_BYTES = 1u << 20;
constexpr size_t WS_ROPE = WS_CTL + CTL_BYTES;
constexpr size_t WS_WI = WS_ROPE + (size_t)4096 * 16 * 8;
constexpr size_t WS_WI8 = WS_WI + (size_t)41 * 256 * DM * 2;
constexpr size_t WS_XN8 = WS_WI8 + (size_t)64 * 256 * DM;
static_assert(WS_XN8 + (size_t)MTOK * DM <= WS_WI + (size_t)N1 * DM * 2, "WI region");
constexpr size_t WS_WB = WS_WI + (size_t)N1 * DM * 2;
constexpr size_t WS_WO = WS_WB + (size_t)DM * 2 * DM * 2;
constexpr size_t WS_WGU = WS_WO + (size_t)DM * DM * 2;
constexpr size_t WS_WD = WS_WGU + (size_t)2 * DFF * DM * 2;
constexpr size_t WS_WG = WS_WD + (size_t)DM * DFF * 2;
constexpr size_t WS_XN = WS_WG + (size_t)16 * 512 * 256 * 2;
constexpr size_t WS_Q = WS_XN + SZ_ACT;
constexpr size_t WS_IQ = WS_Q + SZ_ACT;
constexpr size_t WS_XL = WS_IQ + SZ_ACT;
constexpr size_t WS_GY = WS_XL + SZ_ACT;
constexpr size_t WS_SGA = WS_GY + SZ_ACT;
constexpr size_t WS_SGL = WS_SGA + SZ_ACT;
constexpr size_t WS_KV = WS_SGL + SZ_ACT;
constexpr size_t WS_IWK = WS_KV + (size_t)MTOK * 2048 * 2;
constexpr size_t WS_IKB = WS_IWK + (size_t)MTOK * 256 * 2;
constexpr size_t WS_IWF = WS_IKB + (size_t)MTOK * 128 * 2;
constexpr size_t WS_KVS = WS_IWF + (size_t)MTOK * 32 * 4;
constexpr size_t WS_IKS = WS_KVS + (size_t)DEC_B * SKV_SP * 2048 * 2;
constexpr size_t WS_SC = WS_IKS + (size_t)DEC_B * SKV_SP * 128 * 2;
constexpr size_t WS_SCS = WS_SC + (size_t)NTOK_P * SEQ * 4;
constexpr size_t WS_BM = WS_SCS + (size_t)NTOK_S * SKV_SP * 4;
constexpr size_t WS_AB = WS_BM + (size_t)MTOK * 512;
constexpr size_t WS_SUM = WS_AB + (size_t)MTOK * DM * 4;
constexpr size_t WS_OAL = WS_SUM + (size_t)128 * DM * 8;
constexpr size_t WS_END = WS_OAL + 2 * SZ_ACT;
constexpr size_t WS_PSSQ = WS_SUM;
constexpr size_t WS_H = WS_Q, WS_U = WS_XN, WS_MIX = WS_XN, WS_X1 = WS_AB, WS_A2 = WS_SC, WS_PART = WS_SC + SZ_ACT;
static_assert(WS_PART + (size_t)256 * 65536 * 4 <= WS_BM, "partial slots");
static_assert((size_t)MTOK * DFF * 2 <= 3 * SZ_ACT, "H overlay");
static_assert(WS_END <= (size_t)4 * 109707264 * 4, "workspace");

constexpr int CW_BAR = 0;
constexpr int CW_QATT = 4096;
constexpr int CW_QIDX = 4096 + 256;
constexpr int CW_SSQ = 8192;
static_assert((CW_SSQ + 2 * MTOK) * 4 <= (int)CTL_BYTES, "ctl");

__device__ __forceinline__ unsigned pk2(float lo, float hi) { unsigned r; asm volatile("v_cvt_pk_bf16_f32 %0, %1, %2" : "=v"(r) : "v"(lo), "v"(hi)); return r; }
__device__ __forceinline__ float bflo(unsigned w) { return __uint_as_float(w << 16); }
__device__ __forceinline__ float bfhi(unsigned w) { return __uint_as_float(w & 0xffff0000u); }
__device__ __forceinline__ float bf1(bf16_t b) { return __uint_as_float((unsigned)b << 16); }
__device__ __forceinline__ void unpack8(u32x4 w, float (&v)[8]) { v[0] = bflo(w.x); v[1] = bfhi(w.x); v[2] = bflo(w.y); v[3] = bfhi(w.y); v[4] = bflo(w.z); v[5] = bfhi(w.z); v[6] = bflo(w.w); v[7] = bfhi(w.w); }
__device__ __forceinline__ u32x4 pack8f(const float (&v)[8]) { u32x4 w; w.x = pk2(v[0], v[1]); w.y = pk2(v[2], v[3]); w.z = pk2(v[4], v[5]); w.w = pk2(v[6], v[7]); return w; }
__device__ __forceinline__ float sigmoidf_(float x) { return __builtin_amdgcn_rcpf(1.0f + __builtin_amdgcn_exp2f(-1.4426950408889634f * x)); }
__device__ __forceinline__ float gelu_tanh_(float x) {
    const float u = x * (1.0f + 0.044715f * x * x); return x * __builtin_amdgcn_rcpf(1.0f + __builtin_amdgcn_exp2f(-2.0f * 0.7978845608028654f * 1.4426950408889634f * u)); }
constexpr float SW8 = 64.f, SA_ATT = 8.f, SA_LRU = 4.f, S_MIX = 8.f, SXN = 4.f;
__device__ __forceinline__ unsigned pk4_fp8(float a, float b, float c, float d) { int w = __builtin_amdgcn_cvt_pk_fp8_f32(a, b, 0, false); w = __builtin_amdgcn_cvt_pk_fp8_f32(c, d, w, true); return (unsigned)w; }
#define LDS_WAIT() asm volatile("s_waitcnt lgkmcnt(0)" ::: "memory")
#define VM_WAIT() asm volatile("s_waitcnt vmcnt(0)" ::: "memory")

__device__ __forceinline__ int tid_of(int wv) { int l; asm volatile("v_mbcnt_lo_u32_b32 %0, -1, 0\n\tv_mbcnt_hi_u32_b32 %0, -1, %0" : "=v"(l)); return (wv << 6) | l; }
namespace pg8 {
typedef int i32x4_ __attribute__((ext_vector_type(4)));
constexpr int BM = 256, BK = 64, HALF = 128, HTB = HALF * BK * 2, STAGE_BYTES = 8 * HTB, NXCD = 8, WGM = 4;
__host__ __device__ __forceinline__ int lds_byte(int r, int c) { const int st = (r >> 4) * 2 + (c >> 5), rr = r & 15, cc = c & 31, ob = rr * 64 + cc * 2; return st * 1024 + (ob ^ (((ob >> 9) & 1) << 5)); }
__host__ __device__ __forceinline__ void stage_rc(int b, int& R, int& C) { const int st = b / 1024, sb = b % 1024, swz = sb ^ (((sb >> 9) & 1) << 5); R = (st >> 1) * 16 + swz / 64; C = (st & 1) * 32 + (swz % 64) / 2; }
__host__ __device__ __forceinline__ int perm32(int rho) { const int n = rho >> 4, i = rho & 15; return 8 * (i >> 2) + 4 * n + (i & 3); }

struct Unit { int pm, pn, acol, bcol, nt, part; };
struct Gemm { unsigned char* ws; size_t a_off, b_off; int lda, ldb, K; };

__device__ __forceinline__ void map_unit(int L, int nM, int nN, int& pm, int& pn) {
    const int nwg = nM * nN; int wgid = L; { const int q = nwg / NXCD, r = nwg % NXCD, xcd = wgid % NXCD, off = wgid / NXCD; wgid = (xcd < r ? xcd * (q + 1) : r * (q + 1) + (xcd - r) * q) + off; }
    const int nig = WGM * nN, gid = wgid / nig, fm = gid * WGM, gsz = (nM - fm) < WGM ? (nM - fm) : WGM;
    pm = fm + ((wgid % nig) % gsz); pn = (wgid % nig) / gsz;
}
struct StaticOrder {
    int nM, nN, nwg, G, c, blockdiag, ntk, tail;
    __device__ void init(int M, int N, int K, int G_, int c_, int bd = 0, int tail_ = 0) { tail = (G_ == 256) ? tail_ : 0; nM = M / BM - (tail == 1 ? 2 : 0); nN = N / BM; nwg = nM * nN; G = G_; c = c_; blockdiag = bd; ntk = K / BK; }
    __device__ bool next(int i, Unit& u) const {
        const long L = (long)i * G + c; const int rfull = nwg / G;
        const bool t2 = (tail == 2 && i >= rfull);
        const bool tl = (L >= nwg) && !t2;
        if (tl && (tail != 1 || i != rfull)) return false;
        if (t2 && (i > rfull || c >= 2 * (nwg - rfull * G))) return false;
        int pm0, pn0; map_unit(t2 ? rfull * G + (c >> 1) : (tl ? 0 : (int)L), nM, nN, pm0, pn0);
        const int tile = c >> 3, sp = c & 7, npair = ntk >> 1, base = npair >> 3, rem = npair & 7, p0 = sp * base + (sp < rem ? sp : rem), np = base + (sp < rem ? 1 : 0);
        const int pm = tl ? nM + (tile >> 4) : pm0, pn = tl ? (tile & 15) : pn0;
        const int koff = tl ? p0 * 2 * BK : (t2 ? (c & 1) * (ntk >> 1) * BK : 0);
        const int ac = koff + ((!tl && blockdiag) ? 256 * (pn0 >> 1) : 0);
        u = Unit{pm, pn, ac, koff, tl ? 2 * np : (t2 ? (ntk >> 1) : ntk), (tl || t2) ? c : -1};
        return true;
    }
};

template <class Epi, class Sched>
__device__ __forceinline__ void gemm_phase(LAS unsigned char* lds, const Gemm g, const Sched& S, const Epi& E, int wv) {
    const int tid = tid_of(wv);
    const int wid = __builtin_amdgcn_readfirstlane(tid >> 6), lane = tid & 63, wr = wid >> 2, wc = wid & 3, fr = lane & 15, fq = lane >> 4;
    unsigned voffA[2], voffB[2];
#pragma unroll
    for (int i = 0; i < 2; ++i) { int R, C; stage_rc(tid * 16 + i * 8192, R, C); const int Rb = Epi::PERM ? ((R & ~31) + perm32(R & 31)) : R;
        voffA[i] = (unsigned)(R * g.lda + C) * 2u; voffB[i] = (unsigned)(Rb * g.ldb + C) * 2u; }
    const size_t kstep = (size_t)(BK * 2);
    const size_t hstepA = (size_t)HALF * g.lda * 2, hstepB = (size_t)HALF * g.ldb * 2;
    const size_t tstepA = 2 * hstepA, tstepB = 2 * hstepB;
    const unsigned ldsw = (unsigned)wid * 1024u;
    constexpr bool FP8 = Epi::FP8;
    const int aoff = lds_byte(wr * 64 + fr, FP8 ? fq * 16 : fq * 8), boff = lds_byte(wc * 32 + fr, FP8 ? fq * 16 : fq * 8);
#define PG8_SA(b, h) (((b) * 2 + (h)) * HTB)
#define PG8_SB(b, h) ((4 + (b) * 2 + (h)) * HTB)
#define PG8_STAGE(bufoff, gbase, voff) do { _Pragma("unroll") for (int _i = 0; _i < 2; ++_i) \
        __builtin_amdgcn_global_load_lds((const unsigned*)((const char*)(gbase) + (voff)[_i]), (LAS unsigned*)(lds + (bufoff) + ldsw + _i * 8192), 16, 0, 0); } while (0)
#define PG8_P64(v, j) ((long)(((unsigned long)(unsigned)(v)[2 * (j) + 1] << 32) | (unsigned long)(unsigned)(v)[2 * (j)]))
#define PG8_LD32(p) __builtin_shufflevector(*(const LAS i32x4_*)(p), *(const LAS i32x4_*)((p) + 16), 0, 1, 2, 3, 4, 5, 6, 7)
#define PG8_LDA(dst, b, h) do { if constexpr (FP8) { _Pragma("unroll") for (int m = 0; m < 4; ++m) dst##8[m] = PG8_LD32(lds + PG8_SA(b, h) + aoff + m * 2048); } \
        else { _Pragma("unroll") for (int m = 0; m < 4; ++m) _Pragma("unroll") for (int k = 0; k < 2; ++k) dst[m][k] = *(const LAS bf16x8*)(lds + PG8_SA(b, h) + aoff + m * 2048 + k * 1024); } } while (0)
#define PG8_LDB(dst, b, h) do { if constexpr (FP8) { _Pragma("unroll") for (int n = 0; n < 2; ++n) dst##8[n] = PG8_LD32(lds + PG8_SB(b, h) + boff + n * 2048); } \
        else { _Pragma("unroll") for (int n = 0; n < 2; ++n) _Pragma("unroll") for (int k = 0; k < 2; ++k) dst[n][k] = *(const LAS bf16x8*)(lds + PG8_SB(b, h) + boff + n * 2048 + k * 1024); } } while (0)
#define PG8_MMA(ai, bj, At, Bt) do { __builtin_amdgcn_s_setprio(1); _Pragma("unroll") for (int m = 0; m < 4; ++m) _Pragma("unroll") for (int n = 0; n < 2; ++n) { \
        if constexpr (FP8 && FP8_MX == 2) asm volatile("v_mfma_f32_16x16x128_f8f6f4 %0, %1, %2, %0" : "+v"(acc[ai][bj][m][n]) : "v"(Bt##8[n]), "v"(At##8[m])); \
        else if constexpr (FP8 && FP8_MX == 1) acc[ai][bj][m][n] = __builtin_amdgcn_mfma_scale_f32_16x16x128_f8f6f4(Bt##8[n], At##8[m], acc[ai][bj][m][n], 0, 0, 0, 0, 0, 0); \
        else if constexpr (FP8) { _Pragma("unroll") for (int j = 0; j < 4; ++j) acc[ai][bj][m][n] = __builtin_amdgcn_mfma_f32_16x16x32_fp8_fp8(PG8_P64(Bt##8[n], j), PG8_P64(At##8[m], j), acc[ai][bj][m][n], 0, 0, 0); } \
        else { _Pragma("unroll") for (int k = 0; k < 2; ++k) acc[ai][bj][m][n] = __builtin_amdgcn_mfma_f32_16x16x32_bf16(Bt[n][k], At[m][k], acc[ai][bj][m][n], 0, 0, 0); } } __builtin_amdgcn_s_setprio(0); } while (0)
#define PG8_WAIT_V(n) asm volatile("s_waitcnt vmcnt(" #n ")" ::: "memory")
#define PG8_WAIT_L(n) asm volatile("s_waitcnt lgkmcnt(" #n ")" ::: "memory")
#define PG8_BAR __builtin_amdgcn_s_barrier()
#define PG8_SCHED __builtin_amdgcn_sched_barrier(0)
    Unit cur, nxt; int ui = 0;
    if (!S.next(0, cur)) return;
    f32x4 acc[2][2][4][2];
#pragma unroll
    for (int a = 0; a < 2; ++a)
#pragma unroll
        for (int b = 0; b < 2; ++b)
#pragma unroll
            for (int m = 0; m < 4; ++m)
#pragma unroll
                for (int n = 0; n < 2; ++n) acc[a][b][m][n] = (f32x4){0.f, 0.f, 0.f, 0.f};
    bf16x8 At[4][2], B0[2][2], B1[2][2]; i32x8 At8[4], B08[2], B18[2];
    const char* cA = (const char*)g.ws + g.a_off + (size_t)cur.pm * tstepA + (size_t)cur.acol * 2; const char* cB = (const char*)g.ws + g.b_off + (size_t)cur.pn * tstepB + (size_t)cur.bcol * 2;
    PG8_STAGE(PG8_SB(0, 0), cB, voffB); PG8_STAGE(PG8_SB(0, 1), cB + hstepB, voffB); PG8_STAGE(PG8_SA(0, 0), cA, voffA); PG8_STAGE(PG8_SA(0, 1), cA + hstepA, voffA);
    if (wr == 1) PG8_BAR;
    PG8_WAIT_V(2); PG8_BAR;
    PG8_STAGE(PG8_SB(1, 0), cB + kstep, voffB); PG8_STAGE(PG8_SA(1, 0), cA + kstep, voffA); PG8_STAGE(PG8_SB(1, 1), cB + hstepB + kstep, voffB);
    PG8_WAIT_V(6); PG8_BAR;
    for (;;) {
        const bool has_next = S.next(ui + 1, nxt);
        const char* nA = has_next ? (const char*)g.ws + g.a_off + (size_t)nxt.pm * tstepA + (size_t)nxt.acol * 2 : cA; const char* nB = has_next ? (const char*)g.ws + g.b_off + (size_t)nxt.pn * tstepB + (size_t)nxt.bcol * 2 : cB;
        const int nt = cur.nt;
        for (int t = 0; t < nt; t += 2) {
            const bool last = (t == nt - 2);
            const char* a1 = cA + (size_t)(t + 1) * kstep;
            const char* a2 = last ? nA : cA + (size_t)(t + 2) * kstep; const char* b2 = last ? nB : cB + (size_t)(t + 2) * kstep;
            const char* a3 = a2 + kstep; const char* b3 = b2 + kstep;
            if constexpr (Epi::MID) { if (cur.part < 0 && t == (nt >> 1)) { if constexpr (FP8 && FP8_MX == 2) asm volatile("s_nop 15\n\ts_nop 15" ::: "memory"); E.mid(acc, cur, wr, wc, fr, fq); } }
            PG8_LDB(B0, 0, 0); PG8_LDB(B1, 0, 1); PG8_SCHED; PG8_LDA(At, 0, 0); PG8_STAGE(PG8_SA(1, 1), a1 + hstepA, voffA);
            PG8_WAIT_V(8); PG8_WAIT_L(0); PG8_BAR; PG8_MMA(0, 0, At, B0); PG8_MMA(0, 1, At, B1); PG8_BAR; PG8_SCHED;
            PG8_LDA(At, 0, 1); PG8_STAGE(PG8_SB(0, 0), b2, voffB); PG8_STAGE(PG8_SB(0, 1), b2 + hstepB, voffB); PG8_STAGE(PG8_SA(0, 0), a2, voffA);
            PG8_WAIT_V(8); PG8_WAIT_L(0); PG8_BAR; PG8_MMA(1, 0, At, B0); PG8_MMA(1, 1, At, B1); PG8_BAR; PG8_SCHED;
            PG8_LDB(B0, 1, 0); PG8_LDB(B1, 1, 1); PG8_SCHED; PG8_LDA(At, 1, 0); PG8_STAGE(PG8_SA(0, 1), a2 + hstepA, voffA);
            PG8_WAIT_V(8); PG8_WAIT_L(0); PG8_BAR; PG8_MMA(0, 0, At, B0); PG8_MMA(0, 1, At, B1); PG8_BAR; PG8_SCHED;
            PG8_LDA(At, 1, 1); PG8_STAGE(PG8_SB(1, 0), b3, voffB); PG8_STAGE(PG8_SB(1, 1), b3 + hstepB, voffB); PG8_STAGE(PG8_SA(1, 0), a3, voffA);
            PG8_WAIT_V(8); PG8_WAIT_L(0); PG8_BAR; PG8_MMA(1, 0, At, B0); PG8_MMA(1, 1, At, B1); PG8_BAR; PG8_SCHED;
        }
        if (wr == 0) PG8_BAR;
        if constexpr (FP8 && FP8_MX == 2) asm volatile("s_nop 15\n\ts_nop 15" ::: "memory");
        int fr_ = fr, fq_ = fq; asm volatile("" : "+v"(fr_), "+v"(fq_));
        if (cur.part < 0) E(acc, cur, wr, wc, fr_, fq_);
        else {
            float* P = (float*)(g.ws + WS_PART) + (size_t)cur.part * (BM * BM) + (size_t)(wr * 64 + fr_) * BM + wc * 32 + (Epi::PERM ? 8 * fq_ : 4 * fq_);
#pragma unroll
            for (int ai = 0; ai < 2; ++ai)
#pragma unroll
                for (int m = 0; m < 4; ++m)
#pragma unroll
                    for (int bj = 0; bj < 2; ++bj)
#pragma unroll
                        for (int n = 0; n < 2; ++n) *(f32x4*)(P + (size_t)(ai * HALF + m * 16) * BM + bj * HALF + (Epi::PERM ? 4 * n : 16 * n)) = acc[ai][bj][m][n]; }
        if (!has_next) break;
#pragma unroll
        for (int a = 0; a < 2; ++a)
#pragma unroll
            for (int b = 0; b < 2; ++b)
#pragma unroll
                for (int m = 0; m < 4; ++m)
#pragma unroll
                    for (int n = 0; n < 2; ++n) acc[a][b][m][n] = (f32x4){0.f, 0.f, 0.f, 0.f};
        cur = nxt; cA = nA; cB = nB; ++ui;
        if (wr == 1) PG8_BAR;
    }
    PG8_WAIT_V(0);
    PG8_BAR;
#undef PG8_SA
#undef PG8_SB
#undef PG8_STAGE
#undef PG8_LDA
#undef PG8_LDB
#undef PG8_MMA
#undef PG8_LD32
#undef PG8_P64
#undef PG8_WAIT_V
#undef PG8_WAIT_L
#undef PG8_BAR
#undef PG8_SCHED
}
}

#define XB_TMO      128
#define XB_XCNT(j)  (256  + 64 * (j))
#define XB_XSUB(j)  (1280 + 64 * (j))
#define XB_XGEN(j)  (2304 + 64 * (j))
#define XB_TOP      3328
#define XB_TOPGEN   3392
#define XCD_BAR_WORDS 3456
#define XB_SPIN_CAP (1u << 18)
__device__ __forceinline__ unsigned xb_ld(unsigned* p)              { return __hip_atomic_load(p, __ATOMIC_RELAXED, __HIP_MEMORY_SCOPE_AGENT); }
__device__ __forceinline__ unsigned xb_add(unsigned* p, unsigned v) { return __hip_atomic_fetch_add(p, v, __ATOMIC_RELAXED, __HIP_MEMORY_SCOPE_AGENT); }
__device__ __forceinline__ unsigned xb_xcc_id() { return (unsigned)__builtin_amdgcn_s_getreg((3 << 11) | 20) & 0xFu; }
#define XB_SPIN(cond, bar) do { unsigned _sp = 0; while (cond) { __builtin_amdgcn_s_sleep(1); \
    if ((++_sp & 255u) == 0u) { if (xb_ld(&(bar)[XB_TMO])) break; if (_sp > XB_SPIN_CAP) { atomicAdd(&(bar)[XB_TMO], 1u); break; } } } } while (0)
struct XcdBarrier { unsigned* bar; unsigned x; volatile LAS unsigned* st; int wv; };
__device__ __forceinline__ bool xb_leader(int wv) { return wv == 0 && __builtin_amdgcn_mbcnt_hi(~0u, __builtin_amdgcn_mbcnt_lo(~0u, 0u)) == 0u; }
__device__ __forceinline__ XcdBarrier xcd_barrier_post(unsigned* bar, volatile LAS unsigned* st, int wv) {
    XcdBarrier b; b.bar = bar; b.x = xb_xcc_id(); b.st = st; b.wv = wv;
    if (xb_leader(wv)) (void)xb_add(&bar[XB_XCNT(b.x)], 1u);
    return b;
}
__device__ __forceinline__ void xcd_barrier_complete(unsigned* bar, unsigned x, unsigned& nloc, unsigned& nx) {
    const unsigned G = gridDim.x * gridDim.y * gridDim.z;
    unsigned sum, cnt, mine, sp = 0u;
    for (;;) {
        sum = 0u; cnt = 0u; mine = 0u;
#pragma unroll
        for (unsigned j = 0; j < 16; ++j) { const unsigned c = xb_ld(&bar[XB_XCNT(j)]); sum += c; cnt += (c > 0u) ? 1u : 0u; mine = (j == x) ? c : mine; }
        if (sum == G) break;
        __builtin_amdgcn_s_sleep(1);
        if ((++sp & 255u) == 0u) { if (xb_ld(&bar[XB_TMO])) break; if (sp > XB_SPIN_CAP) { atomicAdd(&bar[XB_TMO], 1u); break; } }
    }
    nloc = mine > 0u ? mine : 1u; nx = cnt > 0u ? cnt : 1u;
}
__device__ __forceinline__ void xcd_barrier(const XcdBarrier& b) {
    asm volatile("s_waitcnt vmcnt(0)" ::: "memory");
    __syncthreads();
    if (xb_leader(b.wv)) {
        unsigned* bar = b.bar;
        __builtin_amdgcn_s_waitcnt(0);
        unsigned nloc = b.st[0], nx = b.st[1];
        if (nloc == 0u) { xcd_barrier_complete(bar, b.x, nloc, nx); b.st[0] = nloc; b.st[1] = nx; }
        const unsigned old = xb_add(&bar[XB_XSUB(b.x)], 1u);
        const unsigned gen = old / nloc;
        if (old + 1u == (gen + 1u) * nloc) {
            __builtin_amdgcn_fence(__ATOMIC_RELEASE, "agent");
            asm volatile("s_waitcnt vmcnt(0)" ::: "memory");
            const unsigned og = xb_add(&bar[XB_TOP], 1u);
            const unsigned tg = og / nx;
            if (og + 1u == (tg + 1u) * nx) xb_add(&bar[XB_TOPGEN], 1u);
            else XB_SPIN(xb_ld(&bar[XB_TOPGEN]) == tg, bar);
            __builtin_amdgcn_fence(__ATOMIC_ACQUIRE, "agent");
            xb_add(&bar[XB_XGEN(b.x)], 1u);
            asm volatile("s_waitcnt vmcnt(0)" ::: "memory");
        } else {
            XB_SPIN(xb_ld(&bar[XB_XGEN(b.x)]) == gen, bar);
            __builtin_amdgcn_fence(__ATOMIC_ACQUIRE, "agent");
            asm volatile("s_waitcnt vmcnt(0)" ::: "memory");
        }
    }
    __syncthreads();
}

constexpr int NWAVES = 8, NTHR = 512;
constexpr int RING_OFF = 0, RING_BYTES = 131072;
constexpr int LDSCTL_OFF = RING_BYTES, MISC_OFF = LDSCTL_OFF + 320;
constexpr int LDS_BYTES = 147456;
struct Args { const float* in[25]; float* out; unsigned char* ws; };
constexpr int PTR_OFF = MISC_OFF + 128;
static_assert(PTR_OFF + 28 * 8 <= LDS_BYTES, "LDS map");
struct Frame {
    LAS unsigned char* lds; volatile LAS unsigned* MISC;
    int tid, lane, wave, vcu, G, gw, NGW;
};
__device__ __forceinline__ Frame make_frame(LAS unsigned char* lds, int wv) {
    Frame F; F.lds = lds; F.MISC = (volatile LAS unsigned*)(lds + MISC_OFF);
    const int t = tid_of(wv);
    F.tid = t; F.lane = t & 63; F.wave = wv;
    F.G = gridDim.x; { const int bx = blockIdx.x; F.vcu = (F.G % 8 == 0) ? (bx % 8) * (F.G / 8) + bx / 8 : bx; }
    F.gw = F.vcu * NWAVES + F.wave; F.NGW = F.G * NWAVES; return F;
}
__device__ __forceinline__ unsigned long long ldsb_u64(LAS unsigned char* lds, int i) {
    volatile LAS unsigned* p = (volatile LAS unsigned*)(lds + PTR_OFF) + 2 * i;
    const unsigned lo = __builtin_amdgcn_readfirstlane(p[0]), hi = __builtin_amdgcn_readfirstlane(p[1]);
    return ((unsigned long long)hi << 32) | lo;
}
__device__ __forceinline__ const float* e_in(LAS unsigned char* lds, int i) { return (const float*)(const GAS float*)ldsb_u64(lds, i); }
__device__ __forceinline__ float* e_out(LAS unsigned char* lds) { return (float*)(GAS float*)ldsb_u64(lds, 25); }
__device__ __forceinline__ unsigned char* e_ws(LAS unsigned char* lds) { return (unsigned char*)(GAS unsigned char*)ldsb_u64(lds, 26); }
__device__ __forceinline__ unsigned long long lds_u64(const Frame& F, int i) {
    volatile LAS unsigned* p = (volatile LAS unsigned*)(F.lds + PTR_OFF) + 2 * i;
    const unsigned lo = __builtin_amdgcn_readfirstlane(p[0]), hi = __builtin_amdgcn_readfirstlane(p[1]);
    return ((unsigned long long)hi << 32) | lo;
}
__device__ __forceinline__ const float* in_ptr(const Frame& F, int i) { return (const float*)(const GAS float*)lds_u64(F, i); }
__device__ __forceinline__ float* out_ptr(const Frame& F) { return (float*)(GAS float*)lds_u64(F, 25); }
__device__ __forceinline__ unsigned char* ws_ptr(const Frame& F) { return (unsigned char*)(GAS unsigned char*)lds_u64(F, 26); }
__device__ __forceinline__ unsigned* ctl_ptr(const Frame& F) { return (unsigned*)(ws_ptr(F) + WS_CTL); }

__device__ __forceinline__ void tr_item(const float* src, size_t spitch, int k0, int c0, bf16_t* dst, size_t dpitch, int r0, LAS unsigned* scr, int lane) {
    const int ln = lane & 7, g = lane >> 3;
    if (src == nullptr) {
#pragma unroll
        for (int j = 0; j < 8; ++j) { const int n = 4 * j + (lane >> 4), c = lane & 15; *(u32x4*)(dst + (size_t)(r0 + n) * dpitch + k0 + 8 * c) = (u32x4){0u, 0u, 0u, 0u}; }
        return;
    }
    f32x4 v[16];
#pragma unroll
    for (int i = 0; i < 16; ++i) { const int k = k0 + 16 * (i >> 1) + 2 * g + (i & 1); v[i] = __builtin_nontemporal_load((const f32x4*)(src + (size_t)k * spitch + c0 + 4 * ln)); }
#pragma unroll
    for (int ip = 0; ip < 8; ++ip)
#pragma unroll
        for (int c = 0; c < 4; ++c) scr[(4 * ln + c) * 65 + 8 * ip + g] = pk2(v[2 * ip][c], v[2 * ip + 1][c]);
    LDS_WAIT();
#pragma unroll
    for (int j = 0; j < 8; ++j) { const int n = 4 * j + (lane >> 4), c = lane & 15; const LAS unsigned* s = scr + n * 65 + 4 * c;
        u32x4 o; o.x = s[0]; o.y = s[1]; o.z = s[2]; o.w = s[3];
        *(u32x4*)(dst + (size_t)(r0 + n) * dpitch + k0 + 8 * c) = o; }
    LDS_WAIT();
}
__device__ __forceinline__ void tr_item8(const float* src, size_t spitch, int k0, int c0, unsigned char* dst, size_t dpitch, int r0, float scale, LAS unsigned* scr, int lane) {
    const int ln = lane & 7, g = lane >> 3;
    f32x4 v[16];
#pragma unroll
    for (int i = 0; i < 16; ++i) { const int k = k0 + 32 * (i >> 2) + 4 * g + (i & 3); v[i] = __builtin_nontemporal_load((const f32x4*)(src + (size_t)k * spitch + c0 + 4 * ln)); }
#pragma unroll
    for (int ib = 0; ib < 4; ++ib)
#pragma unroll
        for (int c = 0; c < 4; ++c) scr[(4 * ln + c) * 33 + 8 * ib + g] = pk4_fp8(v[4 * ib][c] * scale, v[4 * ib + 1][c] * scale, v[4 * ib + 2][c] * scale, v[4 * ib + 3][c] * scale);
    LDS_WAIT();
#pragma unroll
    for (int j = 0; j < 4; ++j) { const int n = 8 * j + (lane >> 3), c8 = lane & 7; const LAS unsigned* p = scr + n * 33 + 4 * c8;
        u32x4 o; o.x = p[0]; o.y = p[1]; o.z = p[2]; o.w = p[3];
        *(u32x4*)(dst + (size_t)(r0 + n) * dpitch + k0 + 16 * c8) = o; }
    LDS_WAIT();
}
__device__ __forceinline__ float wave_sum(float v) {
#pragma unroll
    for (int o = 1; o < 64; o <<= 1) v += __shfl_xor(v, o);
    return v;
}
struct TrDesc { const float* src; unsigned char* dst; int spitch, dpitch  ; int k0, c0, r0, f8; };
struct TrPtrs { const float *w_in, *w_branch, *w_out, *w_gate, *w_up, *w_down, *wa, *wx; unsigned char* ws; };
__device__ __forceinline__ TrDesc tr_decode(const TrPtrs& P, int it) {
    constexpr int I0 = 32 * 840, I1 = 64 * 128, I2 = 32 * 128, I3 = 32 * 688, I4 = 86 * 128;
    TrDesc d; int r = it;
    if (r < I0) { const int kb = r / 840, gidx = r % 840, pn = gidx >> 3, gi = gidx & 7; int c0; const float* src = P.w_in;
        if (gidx < 320) c0 = 32 * gidx; else if (gidx < 324) c0 = 10272 + 32 * (gidx - 320); else if (gidx == 324) c0 = 10240; else if (gidx < 328) { c0 = 0; src = nullptr; } else c0 = 32 * gidx - 96;
        const bool f8 = pn < 16 || pn >= 57; const int lt = pn < 16 ? pn : (pn < 24 ? pn - 16 : (pn < 40 ? pn - 16 : (pn < 41 ? 24 : (pn < 57 ? pn - 16 : pn - 41))));
        d = TrDesc{src, P.ws + (f8 ? WS_WI8 : WS_WI), N1_SRC, f8 ? DM : 2 * DM, 128 * kb, c0, 256 * lt + 32 * gi, f8 ? 1 : 0}; return d; } r -= I0;
    if (r < I1) { const int kb = r / 128, gidx = r % 128; d = TrDesc{P.w_branch, P.ws + WS_WB, DM, 2 * DM, 128 * kb, 32 * gidx, 32 * gidx, 1}; return d; } r -= I1;
    if (r < I2) { const int kb = r / 128, gidx = r % 128; d = TrDesc{P.w_out, P.ws + WS_WO, DM, P9_FP8 ? DM : 2 * DM, 128 * kb, 32 * gidx, 32 * gidx, P9_FP8 ? 1 : 0}; return d; } r -= I2;
    if (r < I3) { const int kb = r / 688, gidx = r % 688, pn = gidx >> 3, gi = gidx & 7; d = TrDesc{(gi < 4) ? P.w_gate : P.w_up, P.ws + WS_WGU, DFF, 2 * DM, 128 * kb, 128 * pn + 32 * (gi & 3), 32 * gidx, 0}; return d; } r -= I3;
    if (r < I4) { const int kb = r / 128, gidx = r % 128; d = TrDesc{P.w_down, P.ws + WS_WD, DM, 2 * DFF, 128 * kb, 32 * gidx, 32 * gidx, 0}; return d; } r -= I4;
    { const int kb = r / 256, gidx = r % 256, tn = gidx >> 3, gi = gidx & 7, blk = tn >> 1, hh = tn & 1;
      d = TrDesc{((gi < 4) ? P.wa : P.wx) + (size_t)blk * 65536, P.ws + WS_WG, 256, 512, 128 * kb, 128 * hh + 32 * (gi & 3), 32 * gidx, 0}; return d; }
}
__device__ __forceinline__ void tr_load(const TrDesc& d, f32x4 (&v)[16], int lane) {
    if (d.src == nullptr) return;
    const int ln = lane & 7, g = lane >> 3; const float* p = d.src + d.c0 + 4 * ln;
    if (d.f8) {
#pragma unroll
        for (int i = 0; i < 16; ++i) v[i] = __builtin_nontemporal_load((const f32x4*)(p + (size_t)(d.k0 + 32 * (i >> 2) + 4 * g + (i & 3)) * d.spitch)); }
    else {
#pragma unroll
        for (int i = 0; i < 16; ++i) v[i] = __builtin_nontemporal_load((const f32x4*)(p + (size_t)(d.k0 + 16 * (i >> 1) + 2 * g + (i & 1)) * d.spitch)); }
}
__device__ __forceinline__ void tr_store(const TrDesc& d, const f32x4 (&v)[16], LAS unsigned* scr, int lane) {
    const int ln = lane & 7, g = lane >> 3;
    if (d.f8) {
#pragma unroll
        for (int ib = 0; ib < 4; ++ib)
#pragma unroll
            for (int c = 0; c < 4; ++c) scr[(4 * ln + c) * 33 + 8 * ib + g] = pk4_fp8(v[4 * ib][c] * SW8, v[4 * ib + 1][c] * SW8, v[4 * ib + 2][c] * SW8, v[4 * ib + 3][c] * SW8);
        LDS_WAIT();
#pragma unroll
        for (int j = 0; j < 4; ++j) { const int n = 8 * j + (lane >> 3), c8 = lane & 7; const LAS unsigned* p = scr + n * 33 + 4 * c8;
            *(u32x4*)(d.dst + (size_t)(d.r0 + n) * d.dpitch + d.k0 + 16 * c8) = (u32x4){p[0], p[1], p[2], p[3]}; }
        LDS_WAIT();
    } else if (d.src == nullptr) {
#pragma unroll
        for (int j = 0; j < 8; ++j) { const int n = 4 * j + (lane >> 4), c = lane & 15; *(u32x4*)(d.dst + (size_t)(d.r0 + n) * d.dpitch + 2 * d.k0 + 16 * c) = (u32x4){0u, 0u, 0u, 0u}; }
    } else {
#pragma unroll
        for (int ip = 0; ip < 8; ++ip)
#pragma unroll
            for (int c = 0; c < 4; ++c) scr[(4 * ln + c) * 65 + 8 * ip + g] = pk2(v[2 * ip][c], v[2 * ip + 1][c]);
        LDS_WAIT();
#pragma unroll
        for (int j = 0; j < 8; ++j) { const int n = 4 * j + (lane >> 4), c = lane & 15; const LAS unsigned* p = scr + n * 65 + 4 * c;
            *(u32x4*)(d.dst + (size_t)(d.r0 + n) * d.dpitch + 2 * d.k0 + 16 * c) = (u32x4){p[0], p[1], p[2], p[3]}; }
        LDS_WAIT();
    }
}
constexpr int CONV_BASE = 32 * 840, CONV_N = 64 * 128 + 32 * 128 + 32 * 688 + 86 * 128;
constexpr int CW_QCONV = 4096 + 512;
__device__ __forceinline__ void conv_drain(Frame& F) {
    unsigned char* const ws = ws_ptr(F); unsigned* head = ctl_ptr(F) + CW_QCONV;
    LAS unsigned* scr = (LAS unsigned*)(F.lds + RING_OFF + F.wave * 16384);
    TrPtrs P{in_ptr(F, 8), in_ptr(F, 19), in_ptr(F, 20), in_ptr(F, 22), in_ptr(F, 23), in_ptr(F, 24), in_ptr(F, 14), in_ptr(F, 16), ws};
    constexpr int NQ8 = (CONV_N * 7 / 8) / 8, REST0 = NQ8 * 8, NQ = NQ8 + (CONV_N - REST0) / 2;
    static_assert((CONV_N - REST0) % 2 == 0, "pairs");
    int q = 0; if (F.lane == 0) q = (int)__hip_atomic_fetch_add(head, 1u, __ATOMIC_RELAXED, __HIP_MEMORY_SCOPE_AGENT);
    q = __builtin_amdgcn_readfirstlane(q);
    while (q < NQ) {
        int qn = 0; if (F.lane == 0) qn = (int)__hip_atomic_fetch_add(head, 1u, __ATOMIC_RELAXED, __HIP_MEMORY_SCOPE_AGENT);
        const int i0 = CONV_BASE + (q < NQ8 ? 8 * q : REST0 + 2 * (q - NQ8)), n = q < NQ8 ? 8 : 2;
#pragma unroll 1
        for (int j = 0; j < n; j += 2) {
            const TrDesc da = tr_decode(P, i0 + j), db = tr_decode(P, i0 + j + 1);
            f32x4 va[16], vb[16]; tr_load(da, va, F.lane); tr_load(db, vb, F.lane);
            tr_store(da, va, scr, F.lane); tr_store(db, vb, scr, F.lane);
        }
        q = __builtin_amdgcn_readfirstlane(qn);
    }
}
__device__ __forceinline__ void p0_prologue(Frame& F) {
    unsigned char* const ws = ws_ptr(F); const float* const in0 = in_ptr(F, 0); const float* const in1 = in_ptr(F, 1); const float* const in2 = in_ptr(F, 2); const float* const in3 = in_ptr(F, 3); const float* const in4 = in_ptr(F, 4); const float* const in7 = in_ptr(F, 7); const float* const in8 = in_ptr(F, 8); const float* const in14 = in_ptr(F, 14); const float* const in16 = in_ptr(F, 16); const float* const in19 = in_ptr(F, 19); const float* const in20 = in_ptr(F, 20); const float* const in22 = in_ptr(F, 22); const float* const in23 = in_ptr(F, 23); const float* const in24 = in_ptr(F, 24);
    LAS unsigned* scr = (LAS unsigned*)(F.lds + RING_OFF + F.wave * 16384);
    const int lane = F.lane;
    constexpr int I0 = 32 * 840, I1 = 64 * 128, I2 = 32 * 128, I3 = 32 * 688, I4 = 86 * 128, I5 = 2 * 256;
    constexpr int NITEMS = I0 + I1 + I2 + I3 + I4 + I5;
    bf16_t* WI = (bf16_t*)(ws + WS_WI); bf16_t* WB = (bf16_t*)(ws + WS_WB); bf16_t* WO = (bf16_t*)(ws + WS_WO); bf16_t* WGU = (bf16_t*)(ws + WS_WGU); bf16_t* WD = (bf16_t*)(ws + WS_WD); bf16_t* WG = (bf16_t*)(ws + WS_WG);
    for (int jt = F.gw; jt < NITEMS - CONV_N; jt += F.NGW) { const int it = jt < I0 ? jt : jt + CONV_N;
        int r = it;
        if (r < I0) { const int kb = r / 840, gidx = r % 840, pn = gidx >> 3, gi = gidx & 7; int c0; const float* src = in8;
            if (gidx < 320) c0 = 32 * gidx; else if (gidx < 324) c0 = 10272 + 32 * (gidx - 320); else if (gidx == 324) c0 = 10240; else if (gidx < 328) { c0 = 0; src = nullptr; } else c0 = 32 * gidx - 96;
            const bool f8 = pn < 16 || pn >= 57; const int lt = pn < 16 ? pn : (pn < 24 ? pn - 16 : (pn < 40 ? pn - 16 : (pn < 41 ? 24 : (pn < 57 ? pn - 16 : pn - 41))));
            if (f8) tr_item8(src, N1_SRC, 128 * kb, c0, ws + WS_WI8, DM, 256 * lt + 32 * gi, SW8, scr, lane);
            else tr_item(src, N1_SRC, 128 * kb, c0, WI, DM, 256 * lt + 32 * gi, scr, lane);
            continue; } r -= I0;
        if (r < I1) { const int kb = r / 128, gidx = r % 128; tr_item8(in19, DM, 128 * kb, 32 * gidx, (unsigned char*)WB, 2 * DM, 32 * gidx, SW8, scr, lane); continue; } r -= I1;
        if (r < I2) { const int kb = r / 128, gidx = r % 128;
            if (P9_FP8) tr_item8(in20, DM, 128 * kb, 32 * gidx, (unsigned char*)WO, DM, 32 * gidx, SW8, scr, lane); else tr_item(in20, DM, 128 * kb, 32 * gidx, WO, DM, 32 * gidx, scr, lane);
            continue; } r -= I2;
        if (r < I3) { const int kb = r / 688, gidx = r % 688, pn = gidx >> 3, gi = gidx & 7; const float* src = (gi < 4) ? in22 : in23;
            tr_item(src, DFF, 128 * kb, 128 * pn + 32 * (gi & 3), WGU, DM, 32 * gidx, scr, lane); continue; } r -= I3;
        if (r < I4) { const int kb = r / 128, gidx = r % 128; tr_item(in24, DM, 128 * kb, 32 * gidx, WD, DFF, 32 * gidx, scr, lane); continue; } r -= I4;
        { const int kb = r / 256, gidx = r % 256, tn = gidx >> 3, gi = gidx & 7, blk = tn >> 1, hh = tn & 1; const float* src = ((gi < 4) ? in14 : in16) + (size_t)blk * 65536;
            tr_item(src, 256, 128 * kb, 128 * hh + 32 * (gi & 3), WG, 256, 32 * gidx, scr, lane); }
    }
    {
        bf16_t* XN = (bf16_t*)(ws + WS_XN); const float* gm = in7;
        f32x4 ggv[16];
#pragma unroll
        for (int j = 0; j < 16; ++j) ggv[j] = *(const f32x4*)(gm + 4 * lane + 256 * j);
        for (int m = F.gw; m < MTOK; m += F.NGW) {
            const float* xr = (m < NTOK_P) ? in0 + (size_t)m * DM : in1 + (size_t)(m - NTOK_P) * DM;
            f32x4 v[16]; float s = 0.f;
#pragma unroll
            for (int j = 0; j < 16; ++j) { v[j] = __builtin_nontemporal_load((const f32x4*)(xr + 4 * lane + 256 * j)); s += (v[j].x * v[j].x + v[j].y * v[j].y) + (v[j].z * v[j].z + v[j].w * v[j].w); }
            const float rstd = 1.0f / sqrtf(wave_sum(s) * (1.0f / DM) + EPS);
#pragma unroll
            for (int j = 0; j < 16; ++j) { const f32x4 gg = ggv[j];
                u32x2 o; o.x = pk2(v[j].x * rstd * gg.x, v[j].y * rstd * gg.y); o.y = pk2(v[j].z * rstd * gg.z, v[j].w * rstd * gg.w);
                *(u32x2*)(XN + (size_t)m * DM + 4 * lane + 256 * j) = o;
                *(unsigned*)(ws + WS_XN8 + (size_t)m * DM + 4 * lane + 256 * j) = pk4_fp8(v[j].x * rstd * gg.x * SXN, v[j].y * rstd * gg.y * SXN, v[j].z * rstd * gg.z * SXN, v[j].w * rstd * gg.w * SXN); }
        }
    }
    {
        f32x2* RT = (f32x2*)(ws + WS_ROPE);
        for (int i = F.gw * 64 + lane; i < 4096 * 16; i += F.NGW * 64) { const int pos = i >> 4, j = i & 15;
            const double inv = pow(500000.0, -(double)j / 16.0); const double ang = (double)pos * inv; RT[i] = (f32x2){(float)cos(ang), (float)sin(ang)}; }
    }
    {
        bf16_t* KVS = (bf16_t*)(ws + WS_KVS); bf16_t* IKS = (bf16_t*)(ws + WS_IKS);
        const size_t gt = (size_t)F.gw * 64 + lane, GT = (size_t)F.NGW * 64;
        for (size_t i = gt; i < (size_t)DEC_B * PAST * 128; i += GT) {
            const size_t row = i >> 7; const int ch = (int)(i & 127); const size_t b = row >> 11, s = row & 2047;
            const f32x4 k0 = __builtin_nontemporal_load((const f32x4*)(in2 + row * 1024 + 8 * ch)), k1 = __builtin_nontemporal_load((const f32x4*)(in2 + row * 1024 + 8 * ch + 4));
            const f32x4 v0 = __builtin_nontemporal_load((const f32x4*)(in3 + row * 1024 + 8 * ch)), v1 = __builtin_nontemporal_load((const f32x4*)(in3 + row * 1024 + 8 * ch + 4));
            bf16_t* d = KVS + (b * SKV_SP + s) * 2048 + 8 * ch;
            *(u32x4*)d = (u32x4){pk2(k0.x, k0.y), pk2(k0.z, k0.w), pk2(k1.x, k1.y), pk2(k1.z, k1.w)};
            *(u32x4*)(d + 1024) = (u32x4){pk2(v0.x, v0.y), pk2(v0.z, v0.w), pk2(v1.x, v1.y), pk2(v1.z, v1.w)};
        }
        for (size_t i = gt; i < (size_t)DEC_B * PAST * 16; i += GT) {
            const size_t row = i >> 4; const int ch = (int)(i & 15); const size_t b = row >> 11, s = row & 2047;
            const f32x4 k0 = *(const f32x4*)(in4 + row * 128 + 8 * ch), k1 = *(const f32x4*)(in4 + row * 128 + 8 * ch + 4);
            *(u32x4*)(IKS + (b * SKV_SP + s) * 128 + 8 * ch) = (u32x4){pk2(k0.x, k0.y), pk2(k0.z, k0.w), pk2(k1.x, k1.y), pk2(k1.z, k1.w)};
        }
        for (size_t i = gt; i < (size_t)DEC_B * 32 * 256; i += GT) {
            const size_t r = i >> 8; const int ch = (int)(i & 255); const size_t b = r >> 5, s = SKV_S + (r & 31);
            *(u32x4*)(KVS + (b * SKV_SP + s) * 2048 + 8 * ch) = (u32x4){0u, 0u, 0u, 0u};
        }
        for (size_t i = gt; i < (size_t)DEC_B * 32 * 16; i += GT) {
            const size_t r = i >> 4; const int ch = (int)(i & 15); const size_t b = r >> 5, s = SKV_S + (r & 31);
            *(u32x4*)(IKS + (b * SKV_SP + s) * 128 + 8 * ch) = (u32x4){0u, 0u, 0u, 0u};
        }
    }
}

constexpr int XCH_OFF = LDSCTL_OFF + 1024;
static_assert(XCH_OFF + 8192 <= LDS_BYTES, "LDS map");
__device__ __forceinline__ void head_sumsq_exchange(const f32x4 (&acc)[2][2][4][2], float ds2, LAS unsigned char* lds, int wr, int wc, int fr, int fq) {
    LAS float* X = (LAS float*)(lds + XCH_OFF);
#pragma unroll
    for (int ai = 0; ai < 2; ++ai)
#pragma unroll
        for (int m = 0; m < 4; ++m)
#pragma unroll
            for (int bj = 0; bj < 2; ++bj) { const f32x4 a = acc[ai][bj][m][0], b = acc[ai][bj][m][1];
                float s = ((a[0] * a[0] + a[1] * a[1]) + (a[2] * a[2] + a[3] * a[3])) + ((b[0] * b[0] + b[1] * b[1]) + (b[2] * b[2] + b[3] * b[3]));
                s += __shfl_xor(s, 16); s += __shfl_xor(s, 32);
                if (fq == 0) X[((ai * 128 + wr * 64 + m * 16 + fr) * 2 + bj) * 4 + wc] = s * ds2; }
    asm volatile("s_waitcnt lgkmcnt(0)" ::: "memory"); __builtin_amdgcn_s_barrier(); asm volatile("" ::: "memory");
}
__device__ __forceinline__ float head_rstd(LAS unsigned char* lds, int rl, int bj) {
    const f32x4 p = *(const LAS f32x4*)(lds + XCH_OFF + ((rl * 2 + bj) * 4) * 4); return 1.0f / sqrtf(((p[0] + p[1]) + (p[2] + p[3])) * (1.0f / 128.0f) + EPS); }
__device__ __forceinline__ void rope_epi(float (&y)[8], const f32x2* RT, int pos, int fq) {
    const f32x4* cp = (const f32x4*)(RT + (size_t)pos * 16 + 8 * (fq & 1)); const f32x4 c0 = cp[0], c1 = cp[1], c2 = cp[2], c3 = cp[3];
    const float cs[8] = {c0[0], c0[2], c1[0], c1[2], c2[0], c2[2], c3[0], c3[2]}, sn[8] = {c0[1], c0[3], c1[1], c1[3], c2[1], c2[3], c3[1], c3[3]};
#pragma unroll
    for (int e = 0; e < 8; ++e) { const float p = __shfl_xor(y[e], 32); y[e] = (fq < 2) ? (y[e] * cs[e] - p * sn[e]) : (y[e] * cs[e] + p * sn[e]); }
}
struct RopeCS { f32x4 c0, c1, c2, c3; };
__device__ __forceinline__ RopeCS rope_load(const f32x2* RT, int pos, int fq) { const f32x4* cp = (const f32x4*)(RT + (size_t)pos * 16 + 8 * (fq & 1)); RopeCS r; r.c0 = cp[0]; r.c1 = cp[1]; r.c2 = cp[2]; r.c3 = cp[3]; return r; }
__device__ __forceinline__ void rope_apply(float (&y)[8], const RopeCS& r, int fq) {
    const float cs[8] = {r.c0[0], r.c0[2], r.c1[0], r.c1[2], r.c2[0], r.c2[2], r.c3[0], r.c3[2]}, sn[8] = {r.c0[1], r.c0[3], r.c1[1], r.c1[3], r.c2[1], r.c2[3], r.c3[1], r.c3[3]};
#pragma unroll
    for (int e = 0; e < 8; ++e) { const float p = __shfl_xor(y[e], 32); y[e] = (fq < 2) ? (y[e] * cs[e] - p * sn[e]) : (y[e] * cs[e] + p * sn[e]); }
}
__device__ __forceinline__ int row_pos(int row) { return row < NTOK_P ? (row & (SEQ - 1)) : PAST + ((row - NTOK_P) & (DEC_T - 1)); }
constexpr int RB = 4;
struct EpiProjA {
    static constexpr bool PERM = true, MID = false, FP8 = false;
    LAS unsigned char* lds;
    __device__ __forceinline__ void operator()(const f32x4 (&acc)[2][2][4][2], const pg8::Unit& u, int wr, int wc, int fr, int fq) const {
        unsigned char* const ws = e_ws(lds); const int pn = u.pn; const bool samp = u.pm >= NTOK_P / 256;
        const int rowl0 = wr * 64 + fr, row0 = u.pm * 256 + rowl0, cw = wc * 32 + 8 * fq;
        const f32x2* RT = (const f32x2*)(ws + WS_ROPE);
        if (pn >= 25) {
            bf16_t* O = (bf16_t*)(ws + WS_XL) + (pn - 25) * 256 + cw;
#pragma unroll
            for (int ai = 0; ai < 2; ++ai)
#pragma unroll
                for (int m = 0; m < 4; ++m)
#pragma unroll
                    for (int bj = 0; bj < 2; ++bj) { const f32x4 v0 = acc[ai][bj][m][0], v1 = acc[ai][bj][m][1];
                        *(u32x4*)(O + (size_t)(row0 + ai * 128 + m * 16) * DM + bj * 128) = (u32x4){pk2(v0[0], v0[1]), pk2(v0[2], v0[3]), pk2(v1[0], v1[1]), pk2(v1[2], v1[3])}; }
        } else if (pn >= 8 && pn < 24) {
            bf16_t* O = (bf16_t*)(ws + WS_IQ) + (pn - 8) * 256 + cw;
#pragma unroll
            for (int ai = 0; ai < 2; ++ai) {
                RopeCS rc[RB];
#pragma unroll
                for (int mb = 0; mb < 4; mb += RB) {
                    if (wc == 0) {
#pragma unroll
                        for (int m = 0; m < RB; ++m) rc[m] = rope_load(RT, row_pos(row0 + ai * 128 + (mb + m) * 16), fq); }
                    asm volatile("" ::: "memory");
#pragma unroll
                    for (int m = mb; m < mb + RB; ++m) { const int row = row0 + ai * 128 + m * 16;
#pragma unroll
                        for (int bj = 0; bj < 2; ++bj) { const f32x4 v0 = acc[ai][bj][m][0], v1 = acc[ai][bj][m][1]; float y[8] = {v0[0], v0[1], v0[2], v0[3], v1[0], v1[1], v1[2], v1[3]};
                            if (wc == 0) rope_apply(y, rc[m - mb], fq);
                            *(u32x4*)(O + (size_t)row * DM + bj * 128) = pack8f(y); } } } }
        } else if (pn >= 4 && pn < 8) {
            float* outv = e_out(lds) + (samp ? O_VS - (size_t)NTOK_P * KVW : O_VP) + (pn - 4) * 256 + cw;
#pragma unroll
            for (int ai = 0; ai < 2; ++ai)
#pragma unroll
                for (int m = 0; m < 4; ++m) { const int row = row0 + ai * 128 + m * 16;
                    bf16_t* d = samp ? (bf16_t*)(ws + WS_KVS) + ((size_t)((row - NTOK_P) >> 5) * SKV_SP + PAST + ((row - NTOK_P) & 31)) * 2048 : (bf16_t*)(ws + WS_KV) + (size_t)row * 2048;
#pragma unroll
                    for (int bj = 0; bj < 2; ++bj) { const f32x4 v0 = acc[ai][bj][m][0], v1 = acc[ai][bj][m][1]; const int col = (pn - 4) * 256 + bj * 128 + cw;
                        *(f32x4*)(outv + (size_t)row * KVW + bj * 128) = v0; *(f32x4*)(outv + (size_t)row * KVW + bj * 128 + 4) = v1;
                        *(u32x4*)(d + 1024 + col) = (u32x4){pk2(v0[0], v0[1]), pk2(v0[2], v0[3]), pk2(v1[0], v1[1]), pk2(v1[2], v1[3])}; } }
        } else {
            const bool isk = pn < 4;
            head_sumsq_exchange(acc, 1.0f, lds, wr, wc, fr, fq);
            const float* gp = e_in(lds, isk ? 10 : 11) + cw; const f32x4 g0 = *(const f32x4*)gp, g1 = *(const f32x4*)(gp + 4); const float g[8] = {g0[0], g0[1], g0[2], g0[3], g1[0], g1[1], g1[2], g1[3]};
            float* outp = e_out(lds);
#pragma unroll
            for (int am = 0; am < 4; ++am) { const int ai = am >> 1;
                RopeCS rc[2];
                if (wc == 0) {
#pragma unroll
                    for (int m = 0; m < 2; ++m) rc[m] = rope_load(RT, row_pos(u.pm * 256 + rowl0 + ai * 128 + (2 * (am & 1) + m) * 16), fq); }
                asm volatile("" ::: "memory");
#pragma unroll
                for (int m = 2 * (am & 1); m < 2 * (am & 1) + 2; ++m) { const int rl = rowl0 + ai * 128 + m * 16, row = u.pm * 256 + rl, rs = row - NTOK_P;
#pragma unroll
                    for (int bj = 0; bj < 2; ++bj) { const f32x4 v0 = acc[ai][bj][m][0], v1 = acc[ai][bj][m][1];
                        if (isk || bj == 0) { const float rstd = head_rstd(lds, rl, bj); float y[8];
#pragma unroll
                            for (int e = 0; e < 4; ++e) { y[e] = v0[e] * rstd * g[e]; y[4 + e] = v1[e] * rstd * g[4 + e]; }
                            if (wc == 0) rope_apply(y, rc[m & 1], fq);
                            if (isk) { const int col = pn * 256 + bj * 128 + cw; float* o = outp + (samp ? O_KS + (size_t)rs * KVW : O_KP + (size_t)row * KVW) + col;
                                *(f32x4*)o = (f32x4){y[0], y[1], y[2], y[3]}; *(f32x4*)(o + 4) = (f32x4){y[4], y[5], y[6], y[7]};
                                bf16_t* d = samp ? (bf16_t*)(ws + WS_KVS) + ((size_t)(rs >> 5) * SKV_SP + PAST + (rs & 31)) * 2048 : (bf16_t*)(ws + WS_KV) + (size_t)row * 2048;
                                *(u32x4*)(d + col) = pack8f(y); }
                            else { float* o = outp + (samp ? O_IKS + (size_t)rs * IDXD : O_IKP + (size_t)row * IDXD) + cw;
                                *(f32x4*)o = (f32x4){y[0], y[1], y[2], y[3]}; *(f32x4*)(o + 4) = (f32x4){y[4], y[5], y[6], y[7]};
                                bf16_t* d = samp ? (bf16_t*)(ws + WS_IKS) + ((size_t)(rs >> 5) * SKV_SP + PAST + (rs & 31)) * IDXD : (bf16_t*)(ws + WS_IKB) + (size_t)row * IDXD;
                                *(u32x4*)(d + cw) = pack8f(y); } }
                        else if (wc == 0) { float* o = (float*)(ws + WS_IWF) + (size_t)row * 32 + 8 * fq;
                            *(f32x4*)o = v0 * 0.015625f; *(f32x4*)(o + 4) = v1 * 0.015625f; } } } }
        }
    }
};
struct EpiProjB {
    static constexpr bool PERM = true, MID = false, FP8 = true;
    LAS unsigned char* lds;
    __device__ __forceinline__ void operator()(const f32x4 (&acc)[2][2][4][2], const pg8::Unit& u, int wr, int wc, int fr, int fq) const {
        unsigned char* const ws = e_ws(lds);
        const int seg = u.pn >> 4, pn = u.pn & 15; constexpr float DS = 1.0f / (SXN * SW8);
        const int rowl0 = wr * 64 + fr, row0 = u.pm * 256 + rowl0, cw = wc * 32 + 8 * fq, col0 = pn * 256 + cw;
        if (seg == 0) {
            head_sumsq_exchange(acc, DS * DS, lds, wr, wc, fr, fq);
            const float* gp = e_in(lds, 9) + cw; const f32x4 g0 = *(const f32x4*)gp, g1 = *(const f32x4*)(gp + 4); const float g[8] = {g0[0], g0[1], g0[2], g0[3], g1[0], g1[1], g1[2], g1[3]};
            const f32x2* RT = (const f32x2*)(ws + WS_ROPE); bf16_t* O = (bf16_t*)(ws + WS_Q) + col0;
#pragma unroll
            for (int ai = 0; ai < 2; ++ai) {
                RopeCS rc[4];
                if (wc == 0) {
#pragma unroll
                    for (int m = 0; m < 4; ++m) rc[m] = rope_load(RT, row_pos(u.pm * 256 + rowl0 + ai * 128 + m * 16), fq); }
                asm volatile("" ::: "memory");
#pragma unroll
                for (int m = 0; m < 4; ++m) { const int rl = rowl0 + ai * 128 + m * 16, row = u.pm * 256 + rl;
#pragma unroll
                    for (int bj = 0; bj < 2; ++bj) { const f32x4 v0 = acc[ai][bj][m][0], v1 = acc[ai][bj][m][1]; const float rstd = head_rstd(lds, rl, bj) * DS; float y[8];
#pragma unroll
                        for (int e = 0; e < 4; ++e) { y[e] = v0[e] * rstd * g[e]; y[4 + e] = v1[e] * rstd * g[4 + e]; }
                        if (wc == 0) rope_apply(y, rc[m], fq);
                        *(u32x4*)(O + (size_t)row * DM + bj * 128) = pack8f(y); } } }
        } else {
            bf16_t* O = (bf16_t*)(ws + (seg == 1 ? WS_GY : (seg == 2 ? WS_SGA : WS_SGL))) + col0;
#pragma unroll
            for (int ai = 0; ai < 2; ++ai)
#pragma unroll
                for (int m = 0; m < 4; ++m) { bf16_t* rowp = O + (size_t)(row0 + ai * 128 + m * 16) * DM;
#pragma unroll
                    for (int bj = 0; bj < 2; ++bj) { f32x4 v0 = acc[ai][bj][m][0] * DS, v1 = acc[ai][bj][m][1] * DS;
                        if (seg == 1) {
#pragma unroll
                            for (int e = 0; e < 4; ++e) { v0[e] = gelu_tanh_(v0[e]); v1[e] = gelu_tanh_(v1[e]); } }
                        else {
#pragma unroll
                            for (int e = 0; e < 4; ++e) { v0[e] = sigmoidf_(v0[e]); v1[e] = sigmoidf_(v1[e]); } }
                        *(u32x4*)(rowp + bj * 128) = (u32x4){pk2(v0[0], v0[1]), pk2(v0[2], v0[3]), pk2(v1[0], v1[1]), pk2(v1[2], v1[3])}; } }
        }
    }
};

__device__ __forceinline__ void rope8(float (&y)[8], const f32x2 (&cs)[8], int hl) {
    float p[8];
#pragma unroll
    for (int e = 0; e < 8; ++e) p[e] = __shfl_xor(y[e], 2);
    if (hl < 4) {
#pragma unroll
        for (int e = 0; e < 8; ++e) y[e] = (hl < 2) ? (y[e] * cs[e].x - p[e] * cs[e].y) : (y[e] * cs[e].x + p[e] * cs[e].y);
    }
}
__device__ __forceinline__ float sum16(float s) { s += __shfl_xor(s, 1); s += __shfl_xor(s, 2); s += __shfl_xor(s, 4); s += __shfl_xor(s, 8); return s; }
struct P2Ptrs { unsigned char* ws; float* out; const float* sconv; const float* gq; const float* gk; const float* gi; const float* cw; const float* cb; };
__device__ __forceinline__ void p2_rowinfo(int m, bool& samp, int& ml, int& b, int& t, int& pos) { samp = m >= NTOK_P; ml = samp ? m - NTOK_P : m; b = samp ? (ml >> 5) : (ml >> 12); t = samp ? (ml & 31) : (ml & 4095); pos = samp ? PAST + t : t; }
__device__ __forceinline__ void p2_taskC(const P2Ptrs& P, int item, int lane) {
    const int strip = item >> 3, col = 512 * (item & 7) + 8 * lane, m0 = 16 * strip; bool samp; int ml, b, t0, pos; p2_rowinfo(m0, samp, ml, b, t0, pos);
    const bf16_t* XLb = (const bf16_t*)(P.ws + WS_XL); bf16_t* Ub = (bf16_t*)(P.ws + WS_U);
    float x[19][8];
#pragma unroll
    for (int i = 0; i < 19; ++i) { const int tt = t0 + i - 3;
        if (tt >= 0) unpack8(*(const u32x4*)(XLb + (size_t)(m0 + i - 3) * DM + col), x[i]);
        else if (samp) { const float* sp = P.sconv + ((size_t)b * 3 + i) * DM + col; const f32x4 s0 = *(const f32x4*)sp, s1 = *(const f32x4*)(sp + 4); x[i][0] = s0.x; x[i][1] = s0.y; x[i][2] = s0.z; x[i][3] = s0.w; x[i][4] = s1.x; x[i][5] = s1.y; x[i][6] = s1.z; x[i][7] = s1.w; }
        else {
#pragma unroll
            for (int e = 0; e < 8; ++e) x[i][e] = 0.f; } }
    float w[4][8], cb[8];
#pragma unroll
    for (int e = 0; e < 8; ++e) { cb[e] = P.cb[col + e];
#pragma unroll
        for (int j = 0; j < 4; ++j) w[j][e] = P.cw[(size_t)j * DM + col + e]; }
    const int T = samp ? DEC_T : SEQ;
#pragma unroll
    for (int r = 0; r < 16; ++r) { float u[8];
#pragma unroll
        for (int e = 0; e < 8; ++e) u[e] = cb[e] + x[r][e] * w[0][e] + x[r + 1][e] * w[1][e] + x[r + 2][e] * w[2][e] + x[r + 3][e] * w[3][e];
        *(u32x4*)(Ub + (size_t)(m0 + r) * DM + col) = pack8f(u);
        const int t = t0 + r;
        if (t >= T - 3) { float* oc = P.out + (samp ? O_CONVS : O_CONVP) + ((size_t)b * 3 + (t - (T - 3))) * DM + col;
            *(f32x4*)oc = (f32x4){x[r + 3][0], x[r + 3][1], x[r + 3][2], x[r + 3][3]}; *(f32x4*)(oc + 4) = (f32x4){x[r + 3][4], x[r + 3][5], x[r + 3][6], x[r + 3][7]}; } }
}
__device__ __forceinline__ void p2_phase(Frame& F) {
    P2Ptrs P{ws_ptr(F), out_ptr(F), in_ptr(F, 6), in_ptr(F, 9), in_ptr(F, 10), in_ptr(F, 11), in_ptr(F, 12), in_ptr(F, 13)};
    for (int it = F.gw; it < (MTOK / 16) * 8; it += F.NGW) p2_taskC(P, it, F.lane);
}

__device__ __forceinline__ float expf_(float x) { return __builtin_amdgcn_exp2f(1.4426950408889634f * x); }
__device__ __forceinline__ float softplusf_(float x) { return fmaxf(x, 0.f) + log1pf(expf(-fabsf(x))); }
struct EpiGates {
    static constexpr bool PERM = false, MID = false, FP8 = false;
    LAS unsigned char* lds;
    __device__ __forceinline__ void operator()(const f32x4 (&acc)[2][2][4][2], const pg8::Unit& u, int wr, int wc, int fr, int fq) const {
        unsigned char* const ws = e_ws(lds); const bf16_t* U = (const bf16_t*)(ws + WS_U); const float* ba = e_in(lds, 15); const float* bx = e_in(lds, 17); const float* lam = e_in(lds, 18); unsigned* AB = (unsigned*)(ws + WS_AB);
        const int row0 = u.pm * 256 + wr * 64 + fr, chb = 256 * (u.pn >> 1) + 128 * (u.pn & 1) + 32 * wc + 4 * fq;
        u32x2 uw[2][2][4];
#pragma unroll
        for (int n = 0; n < 2; ++n)
#pragma unroll
            for (int ai = 0; ai < 2; ++ai)
#pragma unroll
                for (int m = 0; m < 4; ++m) uw[n][ai][m] = *(const u32x2*)(U + (size_t)(row0 + ai * 128 + m * 16) * DM + chb + 16 * n);
        asm volatile("" ::: "memory");
#pragma unroll
        for (int n = 0; n < 2; ++n) { const int ch0 = chb + 16 * n;
            const f32x4 ba4 = *(const f32x4*)(ba + ch0), bx4 = *(const f32x4*)(bx + ch0), lm4 = *(const f32x4*)(lam + ch0); float sp[4];
#pragma unroll
            for (int e = 0; e < 4; ++e) sp[e] = 8.0f * softplusf_(-lm4[e]);
#pragma unroll
            for (int ai = 0; ai < 2; ++ai)
#pragma unroll
                for (int m = 0; m < 4; ++m) { const size_t row = (size_t)(row0 + ai * 128 + m * 16); const u32x2 w2 = uw[n][ai][m];
                    const float uu[4] = {bflo(w2.x), bfhi(w2.x), bflo(w2.y), bfhi(w2.y)}; u32x4 o;
#pragma unroll
                    for (int e = 0; e < 4; ++e) { const float r = sigmoidf_(acc[ai][0][m][n][e] + ba4[e]), ig = sigmoidf_(acc[ai][1][m][n][e] + bx4[e]);
                        const float la = -sp[e] * r, em = 1.0f - expf_(2.0f * la);
                        const float bb = __builtin_amdgcn_sqrtf(fmaxf(em, 0.f)) * (ig * uu[e]);
                        const _Float16 hl_ = (_Float16)la, hb_ = (_Float16)bb;
                        o[e] = (unsigned)__builtin_bit_cast(unsigned short, hl_) | ((unsigned)__builtin_bit_cast(unsigned short, hb_) << 16); }
                    *(u32x4*)(AB + row * DM + ch0) = o; } }
    }
};
__device__ __forceinline__ float h_lo(unsigned w) { return (float)__builtin_bit_cast(_Float16, (unsigned short)(w & 0xffffu)); }
__device__ __forceinline__ float h_hi(unsigned w) { return (float)__builtin_bit_cast(_Float16, (unsigned short)(w >> 16)); }
__device__ __forceinline__ void scan_summaries(Frame& F) {
    unsigned char* const ws = ws_ptr(F);
    const unsigned* AB = (const unsigned*)(ws + WS_AB); f32x4* SUM = (f32x4*)(ws + WS_SUM);
    for (int it = F.gw * 64 + F.lane; it < 128 * 2048; it += F.NGW * 64) { const int q = it >> 11, cp = it & 2047;
        const size_t m0 = (size_t)(q >> 6) * SEQ + (size_t)(q & 63) * 64; const unsigned* p = AB + m0 * DM + 2 * cp;
        float al0 = 0.f, al1 = 0.f, h0 = 0.f, h1 = 0.f;
        for (int r0 = 0; r0 < 64; r0 += 16) { u32x2 w[16];
#pragma unroll
            for (int r = 0; r < 16; ++r) w[r] = *(const u32x2*)(p + (size_t)(r0 + r) * DM);
#pragma unroll
            for (int r = 0; r < 16; ++r) { const float la0 = h_lo(w[r].x), la1 = h_lo(w[r].y); al0 += la0; al1 += la1; h0 = expf_(la0) * h0 + h_hi(w[r].x); h1 = expf_(la1) * h1 + h_hi(w[r].y); } }
        SUM[(size_t)q * 2048 + cp] = (f32x4){al0, h0, al1, h1}; }
}
__device__ __forceinline__ void scan_apply(Frame& F) {
    unsigned char* const ws = ws_ptr(F); float* const out = out_ptr(F); const float* const in5 = in_ptr(F, 5);
    const unsigned* AB = (const unsigned*)(ws + WS_AB); const f32x4* SUM = (const f32x4*)(ws + WS_SUM); const bf16_t* GY = (const bf16_t*)(ws + WS_GY); bf16_t* OAL = (bf16_t*)(ws + WS_OAL);
    for (int it = F.gw * 64 + F.lane; it < 144 * 2048; it += F.NGW * 64) { const int q = it >> 11, cp = it & 2047;
        float h0, h1; size_t m0; int nr; float* lout = nullptr;
        if (q < 128) { const int ch = q & 63; m0 = (size_t)(q >> 6) * SEQ + (size_t)ch * 64; nr = 64; h0 = 0.f; h1 = 0.f;
            for (int j = 0; j < ch; ++j) { const f32x4 s = SUM[(size_t)((q & ~63) + j) * 2048 + cp]; h0 = expf_(s.x) * h0 + s.y; h1 = expf_(s.z) * h1 + s.w; }
            if (ch == 63) lout = out + O_LRUP + (size_t)(q >> 6) * DM + 2 * cp; }
        else { const int bs = q - 128; m0 = (size_t)NTOK_P + (size_t)bs * DEC_T; nr = DEC_T; const f32x2 s = *(const f32x2*)(in5 + (size_t)bs * DM + 2 * cp); h0 = s.x; h1 = s.y;
            lout = out + O_LRUS + (size_t)bs * DM + 2 * cp; }
        const unsigned* p = AB + m0 * DM + 2 * cp; const bf16_t* g = GY + m0 * DM + 2 * cp; unsigned char* o = (unsigned char*)OAL + m0 * (2 * DM) + DM + 2 * cp;
        for (int r0 = 0; r0 < nr; r0 += 16) { u32x2 w[16]; unsigned gw_[16];
#pragma unroll
            for (int r = 0; r < 16; ++r) { w[r] = *(const u32x2*)(p + (size_t)(r0 + r) * DM); gw_[r] = *(const unsigned*)(g + (size_t)(r0 + r) * DM); }
            asm volatile("" ::: "memory");
#pragma unroll
            for (int r = 0; r < 16; ++r) { h0 = expf_(h_lo(w[r].x)) * h0 + h_hi(w[r].x); h1 = expf_(h_lo(w[r].y)) * h1 + h_hi(w[r].y);
                *(unsigned short*)(o + (size_t)(r0 + r) * (2 * DM)) = (unsigned short)__builtin_amdgcn_cvt_pk_fp8_f32(h0 * bflo(gw_[r]) * SA_LRU, h1 * bfhi(gw_[r]) * SA_LRU, 0, false); }
            asm volatile("" ::: "memory"); }
        if (lout) *(f32x2*)lout = (f32x2){h0, h1}; }
}


__device__ __forceinline__ int crow_(int r, int hi) { return (r & 3) + 8 * (r >> 2) + 4 * hi; }
struct IdxItem { int m0, qw, nvalid, samp; const bf16_t* kp; float* sp; int sld; };
__device__ __forceinline__ IdxItem idx_decode(int it, unsigned char* ws) {
    IdxItem r; constexpr int NPI = 4 * 16 * 17;
    if (it < NPI) { int g = 15; int rr = it; while (rr >= 8 * (g + 1)) { rr -= 8 * (g + 1); --g; }
        const int seg = rr % (g + 1); rr /= (g + 1); const int cl = rr & 3, b = rr >> 2, chunk = 4 * g + cl;
        r.m0 = b * SEQ + 64 * chunk; r.qw = 8; r.samp = 0; const int nk = (chunk + 1) * 64 - 256 * seg; r.nvalid = nk < 256 ? nk : 256;
        r.kp = (const bf16_t*)(ws + WS_IKB) + ((size_t)b * SEQ + 256 * seg) * IDXD; r.sp = (float*)(ws + WS_SC) + (size_t)r.m0 * SEQ + 256 * seg; r.sld = SEQ; }
    else { const int rr = it - NPI, bs = rr / 9, seg = rr % 9;
        r.m0 = NTOK_P + 32 * bs; r.qw = 4; r.samp = 1; const int nk = SKV_SP - 256 * seg; r.nvalid = nk < 256 ? nk : 256;
        r.kp = (const bf16_t*)(ws + WS_IKS) + ((size_t)bs * SKV_SP + 256 * seg) * IDXD; r.sp = (float*)(ws + WS_SCS) + (size_t)(32 * bs) * SKV_SP + 256 * seg; r.sld = SKV_SP; }
    return r;
}
__device__ __forceinline__ void idx_phase(Frame& F) {
    unsigned char* const ws = ws_ptr(F); unsigned* const ctl = ctl_ptr(F);
    __syncthreads(); const unsigned qsel = F.MISC[16]; __syncthreads(); if (F.tid == 0) F.MISC[16] = qsel + 1u;
    unsigned* qhead = ctl + CW_QIDX + 64 * qsel;
    const bf16_t* IQ = (const bf16_t*)(ws + WS_IQ); const float* IWF = (const float*)(ws + WS_IWF);
    const int tid = F.tid, lane = F.lane, wave = F.wave, c = lane & 31, hi = lane >> 5;
    constexpr int TOTAL = 4 * 16 * 17 + 16 * 9;
    if (tid == 0) { F.MISC[20] = __hip_atomic_fetch_add(qhead, 1u, __ATOMIC_RELAXED, __HIP_MEMORY_SCOPE_AGENT); F.MISC[21] = __hip_atomic_fetch_add(qhead, 1u, __ATOMIC_RELAXED, __HIP_MEMORY_SCOPE_AGENT); }
    __syncthreads();
    int icur = (int)F.MISC[20], inxt = (int)F.MISC[21];
    __syncthreads();
    if (icur >= TOTAL) return;
#define IDX_STAGE(IT, BUF) do { _Pragma("unroll") for (int j = 0; j < 8; ++j) { const int r0 = 32 * j + 4 * wave; if (r0 < (IT).nvalid) { const int key = r0 + (lane >> 4), chunk = (lane & 15) ^ (key & 15); \
        __builtin_amdgcn_global_load_lds((const unsigned*)((IT).kp + (size_t)key * IDXD + 8 * chunk), (LAS unsigned*)(F.lds + RING_OFF + (BUF) * 65536 + r0 * 256), 16, 0, 0); } } } while (0)
    IdxItem cur = idx_decode(icur, ws);
    IDX_STAGE(cur, 0);
    asm volatile("s_waitcnt vmcnt(0)" ::: "memory");
    __syncthreads();
    int p = 0;
    for (;;) {
        const bool has = inxt < TOTAL;
        unsigned inn = 0u;
        if (tid == 0 && has) inn = __hip_atomic_fetch_add(qhead, 1u, __ATOMIC_RELAXED, __HIP_MEMORY_SCOPE_AGENT);
        IdxItem nxt = cur;
        if (has) { nxt = idx_decode(inxt, ws); IDX_STAGE(nxt, p ^ 1); }
        const LAS unsigned char* kb = F.lds + RING_OFF + p * 65536;
        const int nblk = cur.nvalid >> 5, npair = cur.qw >> 1;
#define IDX_LDK(BK, BLK) do { const int key_ = 32 * (BLK) + c; const LAS unsigned char* rowp_ = kb + key_ * 256; const int sw_ = key_ & 15; \
            _Pragma("unroll") for (int d0 = 0; d0 < 8; ++d0) BK[d0] = *(const LAS bf16x8*)(rowp_ + (((2 * d0 + hi) ^ sw_) << 4)); } while (0)
#define IDX_RELU(x) __builtin_amdgcn_fmed3f((x), 0.f, __builtin_inff())
#define IDX_BLOCK(BK, BLK) do { f32x16 a0 = {}, a1 = {}; \
            _Pragma("unroll") for (int d0 = 0; d0 < 8; ++d0) { a0 = __builtin_amdgcn_mfma_f32_32x32x16_bf16(aq[0][d0], BK[d0], a0, 0, 0, 0); a1 = __builtin_amdgcn_mfma_f32_32x32x16_bf16(aq[1][d0], BK[d0], a1, 0, 0, 0); } \
            f32x2 t0v = {0.f, 0.f}, t1v = {0.f, 0.f}; \
            _Pragma("unroll") for (int r = 0; r < 16; r += 2) { \
                const f32x2 w0 = {w[0][r >> 2][r & 3], w[0][r >> 2][(r & 3) + 1]}, w1 = {w[1][r >> 2][r & 3], w[1][r >> 2][(r & 3) + 1]}; \
                t0v = (f32x2){IDX_RELU(a0[r]), IDX_RELU(a0[r + 1])} * w0 + t0v; t1v = (f32x2){IDX_RELU(a1[r]), IDX_RELU(a1[r + 1])} * w1 + t1v; } \
            const float t0 = t0v.x + t0v.y, t1 = t1v.x + t1v.y; \
            auto rr_ = __builtin_amdgcn_permlane32_swap(__float_as_uint(t0), __float_as_uint(t1), false, false);     \
            s0[loff + 32 * (BLK)] = __uint_as_float(rr_[0]) + __uint_as_float(rr_[1]); } while (0)
        for (int pr = 0; pr < npair; ++pr) {
            const int m = cur.m0 + wave * cur.qw + 2 * pr;
            bf16x8 aq[2][8]; f32x4 w[2][4];
#pragma unroll
            for (int q = 0; q < 2; ++q) {
#pragma unroll
                for (int d0 = 0; d0 < 8; ++d0) aq[q][d0] = *(const bf16x8*)(IQ + (size_t)(m + q) * DM + c * IDXD + d0 * 16 + hi * 8);
#pragma unroll
                for (int g = 0; g < 4; ++g) w[q][g] = *(const f32x4*)(IWF + (size_t)(m + q) * 32 + 8 * g + 4 * hi); }
            float* s0 = cur.sp + (size_t)(m - cur.m0) * cur.sld; const int loff = c + (hi ? cur.sld : 0);
            bf16x8 bka[8], bkb[8];
            IDX_LDK(bka, 0);
            for (int blk = 0; blk < nblk; blk += 2) {
                IDX_LDK(bkb, blk + 1);
                IDX_BLOCK(bka, blk);
                if (blk + 2 < nblk) IDX_LDK(bka, blk + 2);
                IDX_BLOCK(bkb, blk + 1); }
        }
#undef IDX_LDK
#undef IDX_BLOCK
#undef IDX_RELU
        if (tid == 0) F.MISC[20 + p] = inn;
        asm volatile("s_waitcnt vmcnt(0)" ::: "memory");
        __syncthreads();
        if (!has) break;
        cur = nxt; inxt = (int)F.MISC[20 + p]; p ^= 1;
    }
#undef IDX_STAGE
}
__device__ __forceinline__ void select_row(Frame& F, int m) {
    unsigned char* const ws = ws_ptr(F);
    const int lane = F.lane;
    const float* sp; int n;
    if (m < NTOK_P) { n = (((m & (SEQ - 1)) >> 6) + 1) * 64; sp = (const float*)(ws + WS_SC) + (size_t)m * SEQ; }
    else { n = SKV_S; sp = (const float*)(ws + WS_SCS) + (size_t)(m - NTOK_P) * SKV_SP; }
    unsigned key[64];
#pragma unroll
    for (int j = 0; j < 64; ++j) { const int idx = 64 * j + lane; key[j] = __float_as_uint(sp[idx < n ? idx : n - 1]); }
    asm volatile("" ::: "memory");
#pragma unroll
    for (int j = 0; j < 64; ++j) { const int idx = 64 * j + lane; const unsigned u = key[j]; const unsigned k = (u & 0x80000000u) ? ~u : (u | 0x80000000u); key[j] = idx < n ? k : 0u; }
    unsigned thr = 1u;
    if (n > TOPK) { unsigned prefix = 0u;
        const int ngrp = (n + 511) >> 9;
        for (int bit = 31; bit >= 0; --bit) { const unsigned cand = prefix | (1u << bit); int c0 = 0, c1 = 0, c2 = 0, c3 = 0;
#pragma unroll
            for (int g = 0; g < 8; ++g) if (g < ngrp) {
#pragma unroll
                for (int j = 8 * g; j < 8 * g + 8; j += 4) { c0 += (key[j] >= cand) ? 1 : 0; c1 += (key[j + 1] >= cand) ? 1 : 0; c2 += (key[j + 2] >= cand) ? 1 : 0; c3 += (key[j + 3] >= cand) ? 1 : 0; } }
            const int cl = (c0 + c1) + (c2 + c3); int cnt = 0;
#pragma unroll
            for (int b = 0; b < 7; ++b) cnt += __builtin_popcountll(__ballot((cl >> b) & 1)) << b;
            if (cnt >= TOPK) prefix = cand;
            if (cnt == TOPK) break; }
        thr = prefix; }
    unsigned long long mine = 0ull;
#pragma unroll
    for (int j = 0; j < 64; ++j) { const unsigned long long bal = __ballot(key[j] >= thr); mine = (lane == j) ? bal : mine; }
    ((unsigned long long*)(ws + WS_BM))[(size_t)m * 64 + lane] = mine;
}
__device__ __forceinline__ void select_phase(Frame& F) {
    volatile LAS unsigned* cnt = F.MISC + 24;
    __syncthreads(); if (F.tid == 0) *cnt = 0u; __syncthreads();
    const int G = F.G, b = (int)blockIdx.x;
    for (;;) {
        unsigned i = 0u; if (F.lane == 0) i = __hip_atomic_fetch_add((LAS unsigned*)cnt, 1u, __ATOMIC_RELAXED, __HIP_MEMORY_SCOPE_WORKGROUP);
        const int q = (int)__builtin_amdgcn_readfirstlane(i) * G + b;
        if (q >= MTOK) break;
        int m;
        if (q < MTOK - NTOK_P) m = NTOK_P + q;
        else { const int t = q - (MTOK - NTOK_P); m = (t & 1) * SEQ + (SEQ - 1 - (t >> 1)); }
        select_row(F, m);
    }
}

namespace att {
constexpr int NW = 8, QBLK = 32, KVBLK = 64, D = 128, KVLD = 2048, QLD = 4096, OLD = 8192;
constexpr float SCALE = 0.08838834764831845f, THR = 8.f;
constexpr int SHM_V = KVBLK * D * 2, SHM_K = KVBLK * D * 2;
constexpr int ATT_LDS = 2 * SHM_V + 2 * SHM_K + NW * 64 * 4 + 64;
typedef short s16x4 __attribute__((ext_vector_type(4)));
#define KSWZ(row, colB) ((row) * 256 + ((colB) ^ (((row) & 7) << 4)))
#define SBAR() __builtin_amdgcn_sched_barrier(0)
__device__ __forceinline__ int v_st(int k, int c) { const int kk = (k & ~0xC) | ((k & 4) << 1) | ((k & 8) >> 1); return ((kk >> 3) * 4 + (c >> 5)) * 512 + ((kk & 7) * 32 + (c & 31)) * 2; }
__device__ __forceinline__ int v_rd_base(int lane) { return ((lane & 3) << 3) | (((lane >> 2) & 3) << 6) | (((lane >> 4) & 1) << 5) | (((lane >> 5) & 1) << 8); }
constexpr int v_rd_off(int d0, int ks, int half) { return d0 * 512 + ks * 4096 + half * 2048; }
__device__ __forceinline__ int crow(int r, int hi) { return (r & 3) + 8 * (r >> 2) + 4 * hi; }
__device__ __forceinline__ bf16x8 load8(const bf16_t* p) { return *reinterpret_cast<const bf16x8*>(p); }
__device__ __forceinline__ void mask_bits(f32x16& p0, f32x16& p1, unsigned long long mw, int hi) {
    const float NEG = -__builtin_inff(); const unsigned lo = (unsigned)mw >> (4 * hi), hw = (unsigned)(mw >> 32) >> (4 * hi);
#pragma unroll
    for (int r = 0; r < 16; ++r) { const int c = (r & 3) + 8 * (r >> 2);
        if (!((lo >> c) & 1u)) p0[r] = NEG;
        if (!((hw >> c) & 1u)) p1[r] = NEG; }
}
__device__ __forceinline__ void partialSM(f32x16& p0, f32x16& p1, float& m_reg, float& mn, float& alpha) {
    float pmax = p0[0]; for (int r = 1; r < 16; ++r) pmax = fmaxf(pmax, p0[r]); for (int r = 0; r < 16; ++r) pmax = fmaxf(pmax, p1[r]);
    { auto rr = __builtin_amdgcn_permlane32_swap(__float_as_uint(pmax), __float_as_uint(pmax), false, false);
      pmax = fmaxf(__uint_as_float(rr[0]), __uint_as_float(rr[1])); }
    constexpr float C2 = 1.4426950408889634f * SCALE;
    if (__builtin_expect(__all((pmax - m_reg) * SCALE <= THR), 1)) { mn = m_reg; alpha = 1.f; }
    else { mn = fmaxf(m_reg, pmax); alpha = __builtin_amdgcn_exp2f((m_reg - mn) * C2); m_reg = mn; }
    const float mnL = -mn * C2;
    for (int r = 0; r < 16; ++r) p0[r] = fmaf(p0[r], C2, mnL); for (int r = 0; r < 16; ++r) p1[r] = fmaf(p1[r], C2, mnL);
    for (int r = 0; r < 16; ++r) p0[r] = __builtin_amdgcn_exp2f(p0[r]);
}
__device__ __forceinline__ void finishSM(f32x16& p0, f32x16& p1, float alpha, float& l_reg, bf16x8& pa0, bf16x8& pa1, bf16x8& pa2, bf16x8& pa3) {
    for (int r = 0; r < 16; ++r) p1[r] = __builtin_amdgcn_exp2f(p1[r]);
    float ps = 0; for (int r = 0; r < 16; ++r) ps += p0[r]; for (int r = 0; r < 16; ++r) ps += p1[r];
    { auto rr = __builtin_amdgcn_permlane32_swap(__float_as_uint(ps), __float_as_uint(ps), false, false);
      ps = __uint_as_float(rr[0]) + __uint_as_float(rr[1]); }
    l_reg = l_reg * alpha + ps;
#define PK4(P, B_, OUT) do { unsigned a0 = pk2(P[B_+0], P[B_+1]), a1 = pk2(P[B_+2], P[B_+3]);                          \
        unsigned b0 = pk2(P[B_+4], P[B_+5]), b1 = pk2(P[B_+6], P[B_+7]);                                             \
        auto r0 = __builtin_amdgcn_permlane32_swap(a0, b0, false, false); auto r1 = __builtin_amdgcn_permlane32_swap(a1, b1, false, false); \
        u32x4 w = {r0[0], r1[0], r0[1], r1[1]}; OUT = *reinterpret_cast<bf16x8*>(&w); } while (0)
    PK4(p0, 0, pa0); PK4(p0, 8, pa1); PK4(p1, 0, pa2); PK4(p1, 8, pa3);
#undef PK4
}
template <int KB>
__device__ __forceinline__ void qkt(f32x16& p0, f32x16& p1, const char* K_lds, int r32, int hi, const bf16x8* qr) {
    p0 = f32x16{}; p1 = f32x16{};
    const char* kb[4];
#pragma unroll
    for (int dd = 0; dd < 4; ++dd) kb[dd] = K_lds + KB * SHM_K + KSWZ(r32, (dd * 16 + hi * 8) * 2);
#pragma unroll
    for (int d0 = 0; d0 < 8; ++d0) { const char* a = kb[d0 & 3] + (d0 >> 2) * 128;
        bf16x8 b0 = *reinterpret_cast<const bf16x8*>(a);
        bf16x8 b1 = *reinterpret_cast<const bf16x8*>(a + 32 * 256);
        p0 = __builtin_amdgcn_mfma_f32_32x32x16_bf16(b0, qr[d0], p0, 0, 0, 0);
        p1 = __builtin_amdgcn_mfma_f32_32x32x16_bf16(b1, qr[d0], p1, 0, 0, 0); }
}
template <int VB>
__device__ __forceinline__ void pv_tile(f32x16* o, int vb0, bf16x8 pa0, bf16x8 pa1, bf16x8 pa2, bf16x8 pa3) {
#define TRRD(dst, off) asm volatile("ds_read_b64_tr_b16 %0, %1 offset:%2" : "=&v"(dst) : "v"(vb0), "i"(off) : "memory")
#define PV_D0(d0) do { s16x4 l0, l1, l2, l3, h0, h1, h2, h3; constexpr int b_ = VB * SHM_V + v_rd_off(d0, 0, 0); \
        TRRD(l0, b_); TRRD(h0, b_ + 2048); TRRD(l1, b_ + 4096); TRRD(h1, b_ + 6144); TRRD(l2, b_ + 8192); TRRD(h2, b_ + 10240); TRRD(l3, b_ + 12288); TRRD(h3, b_ + 14336); \
        asm volatile("s_waitcnt lgkmcnt(0)" ::: "memory"); SBAR();   \
        o[d0] = __builtin_amdgcn_mfma_f32_32x32x16_bf16(pa0, (bf16x8){l0[0], l0[1], l0[2], l0[3], h0[0], h0[1], h0[2], h0[3]}, o[d0], 0, 0, 0);   \
        o[d0] = __builtin_amdgcn_mfma_f32_32x32x16_bf16(pa1, (bf16x8){l1[0], l1[1], l1[2], l1[3], h1[0], h1[1], h1[2], h1[3]}, o[d0], 0, 0, 0);   \
        o[d0] = __builtin_amdgcn_mfma_f32_32x32x16_bf16(pa2, (bf16x8){l2[0], l2[1], l2[2], l2[3], h2[0], h2[1], h2[2], h2[3]}, o[d0], 0, 0, 0);   \
        o[d0] = __builtin_amdgcn_mfma_f32_32x32x16_bf16(pa3, (bf16x8){l3[0], l3[1], l3[2], l3[3], h3[0], h3[1], h3[2], h3[3]}, o[d0], 0, 0, 0); } while (0)
    PV_D0(0); PV_D0(1); PV_D0(2); PV_D0(3);
#undef PV_D0
#undef TRRD
}
struct BlockRef { const bf16_t* K; int m0, g, NT, samp; };
__device__ __forceinline__ const bf16_t* ref_q(const BlockRef& r, const unsigned char* ws) { return (const bf16_t*)(ws + WS_Q) + (size_t)r.m0 * QLD + 4 * r.g * D; }
__device__ __forceinline__ unsigned char* ref_o(const BlockRef& r, unsigned char* ws) { return ws + WS_OAL + (size_t)r.m0 * OLD + 4 * r.g * D; }
__device__ __forceinline__ const char* ref_bm(const BlockRef& r, const unsigned char* ws) { return (const char*)(ws + WS_BM) + (size_t)r.m0 * 512; }
struct Seam { bf16x8 qr[8]; bf16x8 st_v0, st_v1, st_k0, st_k1; };
#define ROW(p, k0, rr) ((p) + (size_t)((k0) + (rr)) * KVLD + sc)
#define VMW() asm volatile("s_waitcnt vmcnt(0)" ::: "memory")
#define VMWN(n) asm volatile("s_waitcnt vmcnt(%0)" :: "i"(n) : "memory")
#define SLOAD_H(Kp, Vp, k0) do { S.st_v0 = load8(ROW(Vp, k0, sr)); S.st_v1 = load8(ROW(Vp, k0, 32 + sr));              \
                         S.st_k0 = load8(ROW(Kp, k0, sr)); S.st_k1 = load8(ROW(Kp, k0, 32 + sr)); } while (0)
#define SWRITE_HK(bf) do { *(bf16x8*)(K_lds + (bf) * SHM_K + kws) = S.st_k0; *(bf16x8*)(K_lds + (bf) * SHM_K + kws + 32 * 256) = S.st_k1; } while (0)
#define SWRITE_HV(bf) do { *(bf16x8*)(V_lds + (bf) * SHM_V + vst0) = S.st_v0; *(bf16x8*)(V_lds + (bf) * SHM_V + vst1) = S.st_v1; } while (0)
#define SWRITE_H(bf) do { SWRITE_HV(bf); SWRITE_HK(bf); } while (0)
__device__ __forceinline__ int q_rowoff(int samp, int wid) { return samp ? 0 : 32 * (wid & 1); }
__device__ __forceinline__ int q_headoff(int samp, int wid) { return samp ? (wid & 3) : (wid >> 1); }
__device__ __forceinline__ void attn_prime(const BlockRef& cur, unsigned char* wsb, char* lds, Seam& S, int wv) {
    const int tid = tid_of(wv);
    const int wid = __builtin_amdgcn_readfirstlane(tid >> 6), lane = tid & 63, r32 = lane & 31, hi = lane >> 5;
    const int sr = tid >> 4, sc = (tid & 15) * 8, kws = KSWZ(sr, sc * 2); char* K_lds = lds + 2 * SHM_V;
    const bf16_t* qp = ref_q(cur, wsb) + (size_t)(q_rowoff(cur.samp, wid) + r32) * QLD + q_headoff(cur.samp, wid) * D + hi * 8;
    for (int d0 = 0; d0 < 8; ++d0) S.qr[d0] = load8(qp + d0 * 16);
    SLOAD_H(cur.K, cur.K + 1024, 0); VMW(); SWRITE_HK(0);
    __syncthreads();
}
__device__ __forceinline__ void attn_block(const BlockRef& cur, const BlockRef& nxt, unsigned char* wsb, char* lds, Seam& S, int wv) {
    const int tid = tid_of(wv);
    const int wid = __builtin_amdgcn_readfirstlane(tid >> 6), lane = tid & 63, r32 = lane & 31, hi = lane >> 5;
    const int NT = cur.NT;
    char* V_lds = lds; char* K_lds = lds + 2 * SHM_V;
    float* ws = (float*)(lds + 2 * SHM_V + 2 * SHM_K) + wid * 64; float* li_l = ws, * al_l = ws + 32;
    float m_reg = -1e30f, l_reg = 0; f32x16 o[4] = {};
    const int sr = tid >> 4, sc = (tid & 15) * 8, vst0 = v_st(sr, sc), vst1 = v_st(32 + sr, sc), kws = KSWZ(sr, sc * 2);
    const int vb0 = (int)(uintptr_t)V_lds + v_rd_base(lane);
    const bf16_t* Kh = cur.K; const bf16_t* Vh = cur.K + 1024;
    const int qro = q_rowoff(cur.samp, wid), qho = q_headoff(cur.samp, wid);
    const char* bmb = ref_bm(cur, wsb); const unsigned bmo = (unsigned)(qro + r32) * 512u;
#define BMW(t) (*(const unsigned long long*)(bmb + bmo + (unsigned)(t) * 8u))
#define RESC(a) do { if (__any((a) < 1.f)) { if (hi == 0) al_l[r32] = (a); asm volatile("s_waitcnt lgkmcnt(0)" ::: "memory");              \
                     for (int d_ = 0; d_ < 4; ++d_) for (int r = 0; r < 16; ++r) o[d_][r] *= al_l[crow(r, hi)]; } } while (0)
#define KBASE(t) ((t) * KVBLK)
    f32x16 pA0, pA1, pB0, pB1; float mnA, mnB, alA, alB; bf16x8 pa0, pa1, pa2, pa3;
    SWRITE_HV(0); SBAR();
    if (NT > 1) SLOAD_H(Kh, Vh, KBASE(1));
    const unsigned long long mw0 = BMW(0);
    SBAR(); qkt<0>(pA0, pA1, K_lds, r32, hi, S.qr);
    mask_bits(pA0, pA1, mw0, hi); partialSM(pA0, pA1, m_reg, mnA, alA);
    if (NT > 1) { VMW(); SWRITE_H(1); }
    __syncthreads();
#define HALF_STEP(PX0, PX1, mnX, alX, PY0, PY1, alY, t, KB, VB, SB) do {                                                      \
        SBAR(); qkt<KB>(PX0, PX1, K_lds, r32, hi, S.qr);                                                                      \
        finishSM(PY0, PY1, alY, l_reg, pa0, pa1, pa2, pa3); SBAR();                                                           \
        const unsigned long long mw_ = BMW(t);                                                                               \
        if ((t) + 1 < NT) { SLOAD_H(Kh, Vh, KBASE((t) + 1)); SBAR(); }                                                        \
        pv_tile<VB>(o, vb0, pa0, pa1, pa2, pa3); mask_bits(PX0, PX1, mw_, hi); partialSM(PX0, PX1, m_reg, mnX, alX);         \
        __syncthreads();                                                                                                      \
        if ((t) + 1 < NT) { VMW(); SWRITE_H(SB); }                                                                            \
        RESC(alX); __syncthreads(); } while (0)
    for (int t = 1; t + 1 < NT; t += 2) {
        HALF_STEP(pB0, pB1, mnB, alB, pA0, pA1, alA, t, 1, 0, 0);
        HALF_STEP(pA0, pA1, mnA, alA, pB0, pB1, alB, t + 1, 0, 1, 1);
    }
    const bool even = (NT & 1) == 0;
    unsigned long long mwT = 0ull;
    if (even) { mwT = BMW(NT - 1); SBAR(); qkt<1>(pB0, pB1, K_lds, r32, hi, S.qr); SBAR(); }
    SLOAD_H(nxt.K, nxt.K + 1024, 0); SBAR();
    { const bf16_t* qp = ref_q(nxt, wsb) + (size_t)(q_rowoff(nxt.samp, wid) + r32) * QLD + q_headoff(nxt.samp, wid) * D + hi * 8;
#pragma unroll
      for (int d0 = 0; d0 < 8; ++d0) S.qr[d0] = load8(qp + d0 * 16); }
    SBAR();
    finishSM(pA0, pA1, alA, l_reg, pa0, pa1, pa2, pa3); SBAR();
    pv_tile<0>(o, vb0, pa0, pa1, pa2, pa3);
    if (even) { mask_bits(pB0, pB1, mwT, hi); partialSM(pB0, pB1, m_reg, mnB, alB); __syncthreads(); RESC(alB);
        finishSM(pB0, pB1, alB, l_reg, pa0, pa1, pa2, pa3); SBAR(); pv_tile<1>(o, vb0, pa0, pa1, pa2, pa3); }
    SBAR(); VMWN(8); SWRITE_HK(0); SBAR();
    if (hi == 0) li_l[r32] = l_reg; asm volatile("s_waitcnt lgkmcnt(0)" ::: "memory");
    float rli[16];
#pragma unroll
    for (int r = 0; r < 16; ++r) rli[r] = __builtin_amdgcn_rcpf(li_l[crow(r, hi)]);
    unsigned char* Ow = ref_o(cur, wsb) + (size_t)qro * OLD + qho * D;
    const bool st_ok = !cur.samp || wid < 4;
#pragma unroll
    for (int r = 0; r < 16; ++r) { const int orow = crow(r, hi);
#pragma unroll
        for (int d0 = 0; d0 < 4; ++d0) { const float v = o[d0][r] * (rli[r] * SA_ATT);
            const float vn = __shfl_xor(v, 1);
            const int h2 = __builtin_amdgcn_cvt_pk_fp8_f32(v, vn, 0, false), h4 = __shfl_xor(h2, 2);
            if (st_ok && (r32 & 3) == 0) *(unsigned*)(Ow + (size_t)orow * OLD + d0 * 32 + r32) = ((unsigned)h2 & 0xffffu) | ((unsigned)h4 << 16); } }
    __syncthreads();
#undef RESC
#undef KBASE
#undef HALF_STEP
#undef BMW
}
#undef ROW
#undef VMW
#undef VMWN
#undef SLOAD_H
#undef SWRITE_HK
#undef SWRITE_HV
#undef SWRITE_H
}
__device__ __forceinline__ att::BlockRef attn_item(unsigned char* ws, int i) {
    att::BlockRef r;
    if (i < 128) { const int bs = i >> 3, g = i & 7; r.m0 = NTOK_P + bs * DEC_T; r.g = g; r.K = (const bf16_t*)(ws + WS_KVS) + (size_t)bs * SKV_SP * 2048 + g * HD; r.NT = SKV_SP / 64; r.samp = 1; }
    else { const int j = i - 128, c = 63 - (j >> 4), b = (j >> 3) & 1, g = j & 7; r.m0 = b * SEQ + c * 64; r.g = g; r.K = (const bf16_t*)(ws + WS_KV) + (size_t)b * SEQ * 2048 + g * HD; r.NT = c + 1; r.samp = 0; }
    return r;
}
__device__ __forceinline__ void attn_phase(Frame& F, char* lds) {
    unsigned char* const ws = ws_ptr(F); unsigned* const ctl = (unsigned*)(ws + WS_CTL);
    constexpr int TOTAL = 128 + 1024;
    volatile LAS unsigned* qw = (volatile LAS unsigned*)(F.lds + RING_OFF + att::ATT_LDS - 64);
    __syncthreads(); const unsigned qsel = F.MISC[17]; __syncthreads(); if (F.tid == 0) F.MISC[17] = qsel + 1u;
    unsigned* qhead = ctl + CW_QATT + 64 * qsel;
    if (F.tid == 0) { qw[0] = __hip_atomic_fetch_add(qhead, 1u, __ATOMIC_RELAXED, __HIP_MEMORY_SCOPE_AGENT); qw[1] = __hip_atomic_fetch_add(qhead, 1u, __ATOMIC_RELAXED, __HIP_MEMORY_SCOPE_AGENT); }
    __syncthreads();
    int i0 = (int)qw[0], i1 = (int)qw[1];
    __syncthreads();
    if (i0 < TOTAL) {
        att::BlockRef cur = attn_item(ws, i0);
        att::Seam S;
        att::attn_prime(cur, ws, lds, S, F.wave);
        for (;;) {
            const bool has = i1 < TOTAL;
            const att::BlockRef nxt = has ? attn_item(ws, i1) : cur;
            if (F.tid == 0 && has) qw[0] = __hip_atomic_fetch_add(qhead, 1u, __ATOMIC_RELAXED, __HIP_MEMORY_SCOPE_AGENT);
            att::attn_block(cur, nxt, ws, lds, S, F.wave);
            if (!has) break;
            __syncthreads();
            i1 = (int)qw[0];
            __syncthreads();
            cur = nxt;
        }
    }
    __syncthreads(); conv_drain(F);
}

struct EpiMix {
    static constexpr bool PERM = true, MID = true, FP8 = true;
    LAS unsigned char* lds;
    __device__ __forceinline__ void mid(f32x4 (&acc)[2][2][4][2], const pg8::Unit& u, int wr, int wc, int fr, int fq) const {
        int row0 = u.pm * 256 + wr * 64 + fr, col0 = u.pn * 256 + wc * 32 + 8 * fq;
        asm volatile("" : "+v"(row0), "+v"(col0));
        unsigned char* const ws = e_ws(lds); const bf16_t* SGA = (const bf16_t*)(ws + WS_SGA); const bf16_t* SGL = (const bf16_t*)(ws + WS_SGL);
#pragma unroll
        for (int ai = 0; ai < 2; ++ai) { u32x4 ga[4][2], gl[4][2];
#pragma unroll
            for (int m = 0; m < 4; ++m)
#pragma unroll
                for (int bj = 0; bj < 2; ++bj) { const size_t off = (size_t)(row0 + ai * 128 + m * 16) * DM + col0 + bj * 128; ga[m][bj] = *(const u32x4*)(SGA + off); gl[m][bj] = *(const u32x4*)(SGL + off); }
            asm volatile("" ::: "memory");
#pragma unroll
            for (int m = 0; m < 4; ++m)
#pragma unroll
                for (int bj = 0; bj < 2; ++bj) { float a[8], l[8]; unpack8(ga[m][bj], a); unpack8(gl[m][bj], l);
#pragma unroll
                    for (int e = 0; e < 4; ++e) { acc[ai][bj][m][0][e] *= a[e] * (SA_LRU / SA_ATT) * __builtin_amdgcn_rcpf(l[e]); acc[ai][bj][m][1][e] *= a[4 + e] * (SA_LRU / SA_ATT) * __builtin_amdgcn_rcpf(l[4 + e]); }
                    asm volatile("" : "+v"(acc[ai][bj][m][0]), "+v"(acc[ai][bj][m][1])); }
            asm volatile("" ::: "memory"); }
    }
    __device__ __forceinline__ void operator()(const f32x4 (&acc)[2][2][4][2], const pg8::Unit& u, int wr, int wc, int fr, int fq) const {
        const int row0 = u.pm * 256 + wr * 64 + fr, col0 = u.pn * 256 + wc * 32 + 8 * fq; constexpr float SC = S_MIX / (SA_LRU * SW8);
        unsigned char* const ws = e_ws(lds); const bf16_t* SGL = (const bf16_t*)(ws + WS_SGL); unsigned char* MIX = ws + WS_MIX;
        u32x4 glr[2][4][2];
#pragma unroll
        for (int ai = 0; ai < 2; ++ai)
#pragma unroll
            for (int m = 0; m < 4; ++m)
#pragma unroll
                for (int bj = 0; bj < 2; ++bj) glr[ai][m][bj] = *(const u32x4*)(SGL + (size_t)(row0 + ai * 128 + m * 16) * DM + col0 + bj * 128);
        asm volatile("" ::: "memory");
#pragma unroll
        for (int ai = 0; ai < 2; ++ai)
#pragma unroll
            for (int m = 0; m < 4; ++m)
#pragma unroll
                for (int bj = 0; bj < 2; ++bj) { const size_t off = (size_t)(row0 + ai * 128 + m * 16) * DM + col0 + bj * 128; float gl[8]; unpack8(glr[ai][m][bj], gl);
                    const f32x4 v0 = acc[ai][bj][m][0], v1 = acc[ai][bj][m][1];
                    if (P9_FP8) { u32x2 w; w.x = pk4_fp8(v0[0] * gl[0] * SC, v0[1] * gl[1] * SC, v0[2] * gl[2] * SC, v0[3] * gl[3] * SC); w.y = pk4_fp8(v1[0] * gl[4] * SC, v1[1] * gl[5] * SC, v1[2] * gl[6] * SC, v1[3] * gl[7] * SC);
                        *(u32x2*)(MIX + off) = w; }
                    else { constexpr float S1 = 1.0f / (SA_LRU * SW8); u32x4 w; w.x = pk2(v0[0] * gl[0] * S1, v0[1] * gl[1] * S1); w.y = pk2(v0[2] * gl[2] * S1, v0[3] * gl[3] * S1); w.z = pk2(v1[0] * gl[4] * S1, v1[1] * gl[5] * S1); w.w = pk2(v1[2] * gl[6] * S1, v1[3] * gl[7] * S1);
                        *(u32x4*)((bf16_t*)MIX + off) = w; } }
    }
};
struct EpiOut {
    static constexpr bool PERM = false, MID = false, FP8 = (P9_FP8 != 0);
    LAS unsigned char* lds;
    __device__ __forceinline__ void operator()(const f32x4 (&acc)[2][2][4][2], const pg8::Unit& u, int wr, int wc, int fr, int fq) const {
        unsigned char* const ws = e_ws(lds); const float* xp = e_in(lds, 0); const float* xs = e_in(lds, 1); const float* gf = e_in(lds, 21);
        float* X1 = (float*)(ws + WS_X1); bf16_t* A2 = (bf16_t*)(ws + WS_A2); LAS float* X = (LAS float*)(lds + XCH_OFF);
        const int row0 = u.pm * 256 + wr * 64 + fr, col0 = u.pn * 256 + wc * 32 + 4 * fq;
        const float* xb = (u.pm < NTOK_P / 256) ? xp : xs - (size_t)NTOK_P * DM;
        f32x4 gv[2][2];
#pragma unroll
        for (int bj = 0; bj < 2; ++bj)
#pragma unroll
            for (int n = 0; n < 2; ++n) gv[bj][n] = *(const f32x4*)(gf + col0 + bj * 128 + n * 16);
#pragma unroll
        for (int ai = 0; ai < 2; ++ai) { f32x4 xv[4][2][2];
#pragma unroll
            for (int m = 0; m < 4; ++m)
#pragma unroll
                for (int bj = 0; bj < 2; ++bj)
#pragma unroll
                    for (int n = 0; n < 2; ++n) xv[m][bj][n] = *(const f32x4*)(xb + (size_t)(row0 + ai * 128 + m * 16) * DM + col0 + bj * 128 + n * 16);
            asm volatile("" ::: "memory");
#pragma unroll
            for (int m = 0; m < 4; ++m) { const size_t row = (size_t)(row0 + ai * 128 + m * 16); const size_t off = row * DM + col0; float s = 0.f;
#pragma unroll
                for (int bj = 0; bj < 2; ++bj)
#pragma unroll
                    for (int n = 0; n < 2; ++n) { const f32x4 x1 = xv[m][bj][n] + acc[ai][bj][m][n] * (P9_FP8 ? 1.0f / (S_MIX * SW8) : 1.0f);
                        *(f32x4*)(X1 + off + bj * 128 + n * 16) = x1; s += (x1[0] * x1[0] + x1[1] * x1[1]) + (x1[2] * x1[2] + x1[3] * x1[3]);
                        const f32x4 y = x1 * gv[bj][n]; u32x2 w; w.x = pk2(y[0], y[1]); w.y = pk2(y[2], y[3]); *(u32x2*)(A2 + off + bj * 128 + n * 16) = w; }
                s += __shfl_xor(s, 16); s += __shfl_xor(s, 32);
                if (fq == 0) X[(ai * 128 + wr * 64 + m * 16 + fr) * 4 + wc] = s; }
            asm volatile("" ::: "memory"); }
        asm volatile("s_waitcnt lgkmcnt(0)" ::: "memory"); __builtin_amdgcn_s_barrier(); asm volatile("" ::: "memory");
        { const int t = (wr * 4 + wc) * 64 + (fq * 16 + fr);
          if (t < 256) { const f32x4 p = *(const LAS f32x4*)(X + t * 4); ((float*)(ws + WS_PSSQ))[(size_t)u.pn * MTOK + u.pm * 256 + t] = (p[0] + p[1]) + (p[2] + p[3]); } }
    }
};
struct EpiGU {
    static constexpr bool PERM = true, MID = false, FP8 = false;
    LAS unsigned char* lds;
    __device__ __forceinline__ void operator()(const f32x4 (&acc)[2][2][4][2], const pg8::Unit& u, int wr, int wc, int fr, int fq) const {
        unsigned char* const ws = e_ws(lds); const float* RSTD = (const float*)(ws + WS_CTL) + CW_SSQ; bf16_t* H = (bf16_t*)(ws + WS_H);
        const int row0 = u.pm * 256 + wr * 64 + fr, col0 = u.pn * 128 + wc * 32 + 8 * fq;
#pragma unroll
        for (int ai = 0; ai < 2; ++ai)
#pragma unroll
            for (int m = 0; m < 4; ++m) { const size_t row = (size_t)(row0 + ai * 128 + m * 16);
                const float rstd = RSTD[row]; float hv[8];
#pragma unroll
                for (int n = 0; n < 2; ++n)
#pragma unroll
                    for (int e = 0; e < 4; ++e) { const float g = acc[ai][0][m][n][e] * rstd, up = acc[ai][1][m][n][e] * rstd; hv[4 * n + e] = g * sigmoidf_(g) * up; }
                *(u32x4*)(H + row * DFF + col0) = pack8f(hv); }
    }
};
struct EpiDown {
    static constexpr bool PERM = false, MID = false, FP8 = false;
    LAS unsigned char* lds;
    __device__ __forceinline__ void operator()(const f32x4 (&acc)[2][2][4][2], const pg8::Unit& u, int wr, int wc, int fr, int fq) const {
        const float* X1 = (const float*)(e_ws(lds) + WS_X1); float* Y = e_out(lds);
        const int row0 = u.pm * 256 + wr * 64 + fr, col0 = u.pn * 256 + wc * 32 + 4 * fq;
#pragma unroll
        for (int ai = 0; ai < 2; ++ai) { f32x4 xv[4][2][2];
#pragma unroll
            for (int m = 0; m < 4; ++m)
#pragma unroll
                for (int bj = 0; bj < 2; ++bj)
#pragma unroll
                    for (int n = 0; n < 2; ++n) xv[m][bj][n] = *(const f32x4*)(X1 + (size_t)(row0 + ai * 128 + m * 16) * DM + col0 + bj * 128 + n * 16);
            asm volatile("" ::: "memory");
#pragma unroll
            for (int m = 0; m < 4; ++m)
#pragma unroll
                for (int bj = 0; bj < 2; ++bj)
#pragma unroll
                    for (int n = 0; n < 2; ++n) *(f32x4*)(Y + (size_t)(row0 + ai * 128 + m * 16) * DM + col0 + bj * 128 + n * 16) = xv[m][bj][n] + acc[ai][bj][m][n];
            asm volatile("" ::: "memory"); }
    }
};

__device__ __forceinline__ f32x4 part_sum(const float* PART, int tile, int s0, int s1, int rr, int cc) {
    f32x4 a = {0.f, 0.f, 0.f, 0.f};
#pragma unroll
    for (int s = 0; s < 8; ++s) if (s >= s0 && s < s1) a += *(const f32x4*)(PART + ((size_t)(tile * 8 + s) * 65536 + (size_t)rr * 256 + cc));
    return a;
}
__device__ __forceinline__ void reduce_mix(Frame& F) {
    unsigned char* const ws = ws_ptr(F); const float* PART = (const float*)(ws + WS_PART);
    const bf16_t* SGA = (const bf16_t*)(ws + WS_SGA); const bf16_t* SGL = (const bf16_t*)(ws + WS_SGL); unsigned char* MIX = ws + WS_MIX;
    for (int it = F.gw * 64 + F.lane; it < NTOK_S * 1024; it += F.NGW * 64) { const int r = it >> 10, col = 4 * (it & 1023), tile = (r >> 8) * 16 + (col >> 8), rr = r & 255, cc = col & 255;
        const f32x4 sA = part_sum(PART, tile, 0, 4, rr, cc), sL = part_sum(PART, tile, 4, 8, rr, cc);
        const size_t off = (size_t)(NTOK_P + r) * DM + col; const u32x2 ga = *(const u32x2*)(SGA + off), gl = *(const u32x2*)(SGL + off);
        constexpr float CA = (P9_FP8 ? S_MIX : 1.0f) / (SA_ATT * SW8), CL = (P9_FP8 ? S_MIX : 1.0f) / (SA_LRU * SW8);
        const float m0 = bflo(ga.x) * sA[0] * CA + bflo(gl.x) * sL[0] * CL, m1 = bfhi(ga.x) * sA[1] * CA + bfhi(gl.x) * sL[1] * CL, m2 = bflo(ga.y) * sA[2] * CA + bflo(gl.y) * sL[2] * CL, m3 = bfhi(ga.y) * sA[3] * CA + bfhi(gl.y) * sL[3] * CL;
        if (P9_FP8) *(unsigned*)(MIX + off) = pk4_fp8(m0, m1, m2, m3); else *(u32x2*)((bf16_t*)MIX + off) = (u32x2){pk2(m0, m1), pk2(m2, m3)}; }
}
__device__ __forceinline__ void reduce_out(Frame& F, bool tail) {
    unsigned char* const ws = ws_ptr(F); const float* PART = (const float*)(ws + WS_PART); const float* xs = in_ptr(F, 1); const float* gf = in_ptr(F, 21);
    float* X1 = (float*)(ws + WS_X1); bf16_t* A2 = (bf16_t*)(ws + WS_A2); float* RSTD = (float*)(ctl_ptr(F) + CW_SSQ); const float* PSSQ = (const float*)(ws + WS_PSSQ);
    for (int r = F.gw * 64 + F.lane; r < (tail ? NTOK_P : MTOK); r += F.NGW * 64) { float ss = 0.f;
#pragma unroll
        for (int j = 0; j < 16; ++j) ss += PSSQ[(size_t)j * MTOK + r];
        RSTD[r] = 1.0f / sqrtf(ss * (1.0f / DM) + EPS); }
    if (tail) for (int r = F.gw; r < NTOK_S; r += F.NGW) { float ss = 0.f;
#pragma unroll 4
        for (int j = 0; j < 16; ++j) { const int col = 4 * F.lane + 256 * j, tile = (r >> 8) * 16 + j, rr = r & 255, cc = 4 * F.lane;
            const f32x4 x1 = *(const f32x4*)(xs + (size_t)r * DM + col) + part_sum(PART, tile, 0, 8, rr, cc) * (P9_FP8 ? 1.0f / (S_MIX * SW8) : 1.0f); const f32x4 gg = *(const f32x4*)(gf + col);
            const size_t off = (size_t)(NTOK_P + r) * DM + col; *(f32x4*)(X1 + off) = x1; ss += (x1[0] * x1[0] + x1[1] * x1[1]) + (x1[2] * x1[2] + x1[3] * x1[3]);
            u32x2 o; o.x = pk2(x1[0] * gg[0], x1[1] * gg[1]); o.y = pk2(x1[2] * gg[2], x1[3] * gg[3]); *(u32x2*)(A2 + off) = o; }
        ss = wave_sum(ss);
        if (F.lane == 0) RSTD[NTOK_P + r] = 1.0f / sqrtf(ss * (1.0f / DM) + EPS); }
}
__device__ __forceinline__ void reduce_down(Frame& F) {
    unsigned char* const ws = ws_ptr(F); const float* PART = (const float*)(ws + WS_PART); const float* X1 = (const float*)(ws + WS_X1); float* Y = out_ptr(F);
    for (int it = F.gw * 64 + F.lane; it < NTOK_S * 1024; it += F.NGW * 64) { const int r = it >> 10, col = 4 * (it & 1023), tile = (r >> 8) * 16 + (col >> 8), rr = r & 255, cc = col & 255;
        const size_t off = (size_t)(NTOK_P + r) * DM + col;
        *(f32x4*)(Y + off) = *(const f32x4*)(X1 + off) + part_sum(PART, tile, 0, 8, rr, cc); }
}

__device__ __forceinline__ void reduce_gu(Frame& F) {
    unsigned char* const ws = ws_ptr(F); const float* PART = (const float*)(ws + WS_PART); const float* RSTD = (const float*)(ws + WS_CTL) + CW_SSQ; bf16_t* H = (bf16_t*)(ws + WS_H);
    constexpr int nM = MTOK / 256, nN = 2 * DFF / 256, NW = nM * nN, RF = NW / 256, REM = NW - RF * 256;
    for (int it = F.gw * 64 + F.lane; it < REM * 256 * 32; it += F.NGW * 64) { const int t = it >> 13, rr = (it >> 5) & 255, cc = 4 * (it & 31);
        int pm, pn; pg8::map_unit(RF * 256 + t, nM, nN, pm, pn);
        const float* p0 = PART + (size_t)(2 * t) * 65536 + (size_t)rr * 256 + cc; const float* p1 = p0 + 65536;
        const f32x4 g = *(const f32x4*)p0 + *(const f32x4*)p1, u = *(const f32x4*)(p0 + 128) + *(const f32x4*)(p1 + 128);
        const size_t row = (size_t)pm * 256 + rr; const float rstd = RSTD[row];
        float h[4];
#pragma unroll
        for (int e = 0; e < 4; ++e) { const float gg = g[e] * rstd; h[e] = gg * sigmoidf_(gg) * (u[e] * rstd); }
        *(u32x2*)(H + row * DFF + pn * 128 + cc) = (u32x2){pk2(h[0], h[1]), pk2(h[2], h[3])}; }
}

__global__ void __launch_bounds__(NTHR, 2) fwd_kernel(Args args) {
    extern __shared__ __attribute__((aligned(16))) unsigned char lds_raw[];
    LAS unsigned char* const ldsb = (LAS unsigned char*)lds_raw;
    int wv0 = __builtin_amdgcn_readfirstlane((int)(threadIdx.x >> 6)); asm volatile("" : "+s"(wv0));
    Frame F = make_frame(ldsb, wv0);
    for (int u = F.tid; u < (LDS_BYTES - LDSCTL_OFF) / 4; u += NTHR) ((LAS unsigned*)(F.lds + LDSCTL_OFF))[u] = 0u;
    __syncthreads();
    if (F.tid == 0) { volatile LAS unsigned* p = (volatile LAS unsigned*)(F.lds + PTR_OFF);
#pragma unroll
        for (int i = 0; i < 25; ++i) { const unsigned long long v = (unsigned long long)args.in[i]; p[2 * i] = (unsigned)v; p[2 * i + 1] = (unsigned)(v >> 32); }
        { const unsigned long long v = (unsigned long long)args.out; p[50] = (unsigned)v; p[51] = (unsigned)(v >> 32); }
        { const unsigned long long v = (unsigned long long)args.ws; p[52] = (unsigned)v; p[53] = (unsigned)(v >> 32); } }
    __syncthreads();
    XcdBarrier bar = xcd_barrier_post(ctl_ptr(F) + CW_BAR, F.MISC + 8, wv0);

#define REP(n, ...) do { __VA_ARGS__; if constexpr ((DBL >> (n)) & 1) { xcd_barrier(bar); __VA_ARGS__; } } while (0)
#define GEMM_PHASE_C(EPI, AOFF, BOFF, LDA, LDB, KK, NN, BD, TAIL, CIDX) do { F = make_frame(ldsb, wv0); unsigned char* const ws = ws_ptr(F); \
        pg8::Gemm g{ws, (AOFF), (BOFF), (LDA), (LDB), (KK)}; pg8::StaticOrder S; S.init(MTOK, (NN), (KK), F.G, (CIDX), (BD), (TAIL)); \
        EPI E{F.lds}; pg8::gemm_phase<EPI, pg8::StaticOrder>(F.lds + RING_OFF, g, S, E, F.wave); } while (0)
#define GEMM_PHASE(EPI, AOFF, BOFF, LDA, LDB, KK, NN, BD, TAIL) GEMM_PHASE_C(EPI, AOFF, BOFF, LDA, LDB, KK, NN, BD, TAIL, (int)blockIdx.x)
    REP(0, F = make_frame(ldsb, wv0); p0_prologue(F));
    xcd_barrier(bar);
    REP(1, GEMM_PHASE(EpiProjA, WS_XN, WS_WI, DM, DM, DM, 41 * 256, 0, 0));
    REP(13, GEMM_PHASE_C(EpiProjB, WS_XN8, WS_WI8, DM / 2, DM / 2, DM / 2, 64 * 256, 0, 0, (int)(gridDim.x - 1 - blockIdx.x)));
    xcd_barrier(bar);
    REP(2, F = make_frame(ldsb, wv0); p2_phase(F));
    xcd_barrier(bar);
    REP(3, GEMM_PHASE(EpiGates, WS_U, WS_WG, DM, 256, 256, 32 * 256, 1, 0));
    REP(10, F = make_frame(ldsb, wv0); idx_phase(F));
    xcd_barrier(bar);
    REP(4, F = make_frame(ldsb, wv0); scan_summaries(F));
    REP(11, F = make_frame(ldsb, wv0); select_phase(F));
    xcd_barrier(bar);
    REP(5, F = make_frame(ldsb, wv0); scan_apply(F));
    REP(12, F = make_frame(ldsb, wv0); attn_phase(F, (char*)lds_raw + RING_OFF));
    xcd_barrier(bar);
    REP(6, GEMM_PHASE(EpiMix, WS_OAL, WS_WB, DM, DM, DM, DM, 0, 1));
    xcd_barrier(bar);
    if (gridDim.x == 256) { F = make_frame(ldsb, wv0); reduce_mix(F); xcd_barrier(bar); }
    GEMM_PHASE(EpiOut, WS_MIX, WS_WO, (P9_FP8 ? DM / 2 : DM), (P9_FP8 ? DM / 2 : DM), (P9_FP8 ? DM / 2 : DM), DM, 0, 1);
    xcd_barrier(bar);
    F = make_frame(ldsb, wv0); reduce_out(F, gridDim.x == 256); xcd_barrier(bar);
    REP(8, GEMM_PHASE(EpiGU, WS_A2, WS_WGU, DM, DM, DM, 2 * DFF, 0, 2));
    xcd_barrier(bar);
    if (gridDim.x == 256) { F = make_frame(ldsb, wv0); reduce_gu(F); xcd_barrier(bar); }
    REP(9, GEMM_PHASE(EpiDown, WS_H, WS_WD, DFF, DFF, DFF, DM, 0, 1));
    if (gridDim.x == 256) { xcd_barrier(bar); F = make_frame(ldsb, wv0); reduce_down(F); }
#undef REP
#undef GEMM_PHASE
#undef GEMM_PHASE_C
}

extern "C" void kernel_launch(void* const* d_in, const int* in_sizes, int n_in, void* d_out, int out_size, void* d_ws, size_t ws_size, hipStream_t stream) {
    static int grid = 0;
    if (grid == 0) {
        if (n_in != 25 || out_size != (int)O_END || ws_size < WS_END) { fprintf(stderr, "kernel_launch: unexpected shapes (n_in %d, out %d, ws %zu; need ws >= %zu); nothing launched\n", n_in, out_size, ws_size, (size_t)WS_END); grid = -1; return; }
        int dev = 0, cus = 0, per_cu = 0;
        if (hipGetDevice(&dev) != hipSuccess || hipDeviceGetAttribute(&cus, hipDeviceAttributeMultiprocessorCount, dev) != hipSuccess) { fprintf(stderr, "kernel_launch: device query failed\n"); grid = -1; return; }
        if (hipFuncSetAttribute((const void*)fwd_kernel, hipFuncAttributeMaxDynamicSharedMemorySize, LDS_BYTES) != hipSuccess) { fprintf(stderr, "kernel_launch: hipFuncSetAttribute failed\n"); grid = -1; return; }
        if (hipOccupancyMaxActiveBlocksPerMultiprocessor(&per_cu, (const void*)fwd_kernel, NTHR, LDS_BYTES) != hipSuccess || per_cu < 1) { fprintf(stderr, "kernel_launch: occupancy query reports %d blocks per CU\n", per_cu); }
        (void)hipGetLastError();
        grid = cus;
    }
    if (grid < 0) return;
    if (hipMemsetAsync((char*)d_ws + WS_CTL, 0, CTL_BYTES, stream) != hipSuccess) { fprintf(stderr, "kernel_launch: memset failed\n"); return; }
    Args a{};
    for (int i = 0; i < 25; ++i) a.in[i] = (const float*)d_in[i];
    a.out = (float*)d_out; a.ws = (unsigned char*)d_ws;
    hipLaunchKernelGGL(fwd_kernel, dim3(grid), dim3(NTHR), LDS_BYTES, stream, a);
    const hipError_t le = hipPeekAtLastError();
    if (le != hipSuccess) fprintf(stderr, "kernel_launch: launch failed: %s\n", hipGetErrorName(le));
}
```

```cpp
#include <hip/hip_runtime.h>
#include <cstdio>
#include <cstdint>

#ifndef DBL
#define DBL 0
#endif
#ifndef P9_FP8
#define P9_FP8 1
#endif
#ifndef FP8_MX
#define FP8_MX 2
#endif
#define LAS __attribute__((address_space(3)))
#define GAS __attribute__((address_space(1)))
typedef unsigned short bf16_t;
typedef short bf16x8 __attribute__((ext_vector_type(8)));
typedef float f32x4 __attribute__((ext_vector_type(4)));
typedef float f32x2 __attribute__((ext_vector_type(2)));
typedef float f32x16 __attribute__((ext_vector_type(16)));
typedef unsigned u32x4 __attribute__((ext_vector_type(4)));
typedef unsigned u32x2 __attribute__((ext_vector_type(2)));
typedef int i32x8 __attribute__((ext_vector_type(8)));

constexpr int DM = 4096, SEQ = 4096, NB_P = 2, NTOK_P = NB_P * SEQ, DEC_B = 16, DEC_T = 32, NTOK_S = DEC_B * DEC_T, MTOK = NTOK_P + NTOK_S;
constexpr int PAST = 2048, SKV_S = PAST + DEC_T, SKV_SP = 2112;
constexpr int NH = 32, NKVH = 8, HD = 128, KVW = NKVH * HD, IDXH = 32, IDXD = 128;
constexpr int DFF = 11008, TOPK = 256;
constexpr int N1 = 105 * 256;
constexpr int N1_SRC = 26784;
constexpr float EPS = 1e-6f;
static_assert(MTOK % 256 == 0 && DFF % 128 == 0, "tiling");

constexpr size_t O_YP = 0, O_YS = O_YP + (size_t)NTOK_P * DM, O_KP = O_YS + (size_t)NTOK_S * DM, O_VP = O_KP + (size_t)NTOK_P * KVW, O_IKP = O_VP + (size_t)NTOK_P * KVW,
                 O_LRUP = O_IKP + (size_t)NTOK_P * IDXD, O_CONVP = O_LRUP + (size_t)NB_P * DM, O_KS = O_CONVP + (size_t)NB_P * 3 * DM, O_VS = O_KS + (size_t)NTOK_S * KVW,
                 O_IKS = O_VS + (size_t)NTOK_S * KVW, O_LRUS = O_IKS + (size_t)NTOK_S * IDXD, O_CONVS = O_LRUS + (size_t)DEC_B * DM, O_END = O_CONVS + (size_t)DEC_B * 3 * DM;
static_assert(O_END == 54886400, "output size");

constexpr size_t al256(size_t x) { return (x + 255) & ~(size_t)255; }
constexpr size_t SZ_ACT = (size_t)MTOK * DM * 2;
constexpr size_t WS_CTL = 0, CTL_BYTES = 1u << 20;
constexpr size_t WS_ROPE = WS_CTL + CTL_BYTES;
constexpr size_t WS_WI = WS_ROPE + (size_t)4096 * 16 * 8;
constexpr size_t WS_WI8 = WS_WI + (size_t)41 * 256 * DM * 2;
constexpr size_t WS_XN8 = WS_WI8 + (size_t)64 * 256 * DM;
static_assert(WS_XN8 + (size_t)MTOK * DM <= WS_WI + (size_t)N1 * DM * 2, "WI region");
constexpr size_t WS_WB = WS_WI + (size_t)N1 * DM * 2;
constexpr size_t WS_WO = WS_WB + (size_t)DM * 2 * DM * 2;
constexpr size_t WS_WGU = WS_WO + (size_t)DM * DM * 2;
constexpr size_t WS_WD = WS_WGU + (size_t)2 * DFF * DM * 2;
constexpr size_t WS_WG = WS_WD + (size_t)DM * DFF * 2;
constexpr size_t WS_XN = WS_WG + (size_t)16 * 512 * 256 * 2;
constexpr size_t WS_Q = WS_XN + SZ_ACT;
constexpr size_t WS_IQ = WS_Q + SZ_ACT;
constexpr size_t WS_XL = WS_IQ + SZ_ACT;
constexpr size_t WS_GY = WS_XL + SZ_ACT;
constexpr size_t WS_SGA = WS_GY + SZ_ACT;
constexpr size_t WS_SGL = WS_SGA + SZ_ACT;
constexpr size_t WS_KV = WS_SGL + SZ_ACT;
constexpr size_t WS_IWK = WS_KV + (size_t)MTOK * 2048 * 2;
constexpr size_t WS_IKB = WS_IWK + (size_t)MTOK * 256 * 2;
constexpr size_t WS_IWF = WS_IKB + (size_t)MTOK * 128 * 2;
constexpr size_t WS_KVS = WS_IWF + (size_t)MTOK * 32 * 4;
constexpr size_t WS_IKS = WS_KVS + (size_t)DEC_B * SKV_SP * 2048 * 2;
constexpr size_t WS_SC = WS_IKS + (size_t)DEC_B * SKV_SP * 128 * 2;
constexpr size_t WS_SCS = WS_SC + (size_t)NTOK_P * SEQ * 4;
constexpr size_t WS_BM = WS_SCS + (size_t)NTOK_S * SKV_SP * 4;
constexpr size_t WS_AB = WS_BM + (size_t)MTOK * 512;
constexpr size_t WS_SUM = WS_AB + (size_t)MTOK * DM * 4;
constexpr size_t WS_OAL = WS_SUM + (size_t)128 * DM * 8;
constexpr size_t WS_END = WS_OAL + 2 * SZ_ACT;
constexpr size_t WS_PSSQ = WS_SUM;
constexpr size_t WS_H = WS_Q, WS_U = WS_XN, WS_MIX = WS_XN, WS_X1 = WS_AB, WS_A2 = WS_SC, WS_PART = WS_SC + SZ_ACT;
static_assert(WS_PART + (size_t)256 * 65536 * 4 <= WS_BM, "partial slots");
static_assert((size_t)MTOK * DFF * 2 <= 3 * SZ_ACT, "H overlay");
static_assert(WS_END <= (size_t)4 * 109707264 * 4, "workspace");

constexpr int CW_BAR = 0;
constexpr int CW_QATT = 4096;
constexpr int CW_QIDX = 4096 + 256;
constexpr int CW_SSQ = 8192;
static_assert((CW_SSQ + 2 * MTOK) * 4 <= (int)CTL_BYTES, "ctl");

__device__ __forceinline__ unsigned pk2(float lo, float hi) { unsigned r; asm volatile("v_cvt_pk_bf16_f32 %0, %1, %2" : "=v"(r) : "v"(lo), "v"(hi)); return r; }
__device__ __forceinline__ float bflo(unsigned w) { return __uint_as_float(w << 16); }
__device__ __forceinline__ float bfhi(unsigned w) { return __uint_as_float(w & 0xffff0000u); }
__device__ __forceinline__ float bf1(bf16_t b) { return __uint_as_float((unsigned)b << 16); }
__device__ __forceinline__ void unpack8(u32x4 w, float (&v)[8]) { v[0] = bflo(w.x); v[1] = bfhi(w.x); v[2] = bflo(w.y); v[3] = bfhi(w.y); v[4] = bflo(w.z); v[5] = bfhi(w.z); v[6] = bflo(w.w); v[7] = bfhi(w.w); }
__device__ __forceinline__ u32x4 pack8f(const float (&v)[8]) { u32x4 w; w.x = pk2(v[0], v[1]); w.y = pk2(v[2], v[3]); w.z = pk2(v[4], v[5]); w.w = pk2(v[6], v[7]); return w; }
__device__ __forceinline__ float sigmoidf_(float x) { return __builtin_amdgcn_rcpf(1.0f + __builtin_amdgcn_exp2f(-1.4426950408889634f * x)); }
__device__ __forceinline__ float gelu_tanh_(float x) {
    const float u = x * (1.0f + 0.044715f * x * x); return x * __builtin_amdgcn_rcpf(1.0f + __builtin_amdgcn_exp2f(-2.0f * 0.7978845608028654f * 1.4426950408889634f * u)); }
constexpr float SW8 = 64.f, SA_ATT = 8.f, SA_LRU = 4.f, S_MIX = 8.f, SXN = 4.f;
__device__ __forceinline__ unsigned pk4_fp8(float a, float b, float c, float d) { int w = __builtin_amdgcn_cvt_pk_fp8_f32(a, b, 0, false); w = __builtin_amdgcn_cvt_pk_fp8_f32(c, d, w, true); return (unsigned)w; }
#define LDS_WAIT() asm volatile("s_waitcnt lgkmcnt(0)" ::: "memory")
#define VM_WAIT() asm volatile("s_waitcnt vmcnt(0)" ::: "memory")

__device__ __forceinline__ int tid_of(int wv) { int l; asm volatile("v_mbcnt_lo_u32_b32 %0, -1, 0\n\tv_mbcnt_hi_u32_b32 %0, -1, %0" : "=v"(l)); return (wv << 6) | l; }
namespace pg8 {
typedef int i32x4_ __attribute__((ext_vector_type(4)));
constexpr int BM = 256, BK = 64, HALF = 128, HTB = HALF * BK * 2, STAGE_BYTES = 8 * HTB, NXCD = 8, WGM = 4;
__host__ __device__ __forceinline__ int lds_byte(int r, int c) { const int st = (r >> 4) * 2 + (c >> 5), rr = r & 15, cc = c & 31, ob = rr * 64 + cc * 2; return st * 1024 + (ob ^ (((ob >> 9) & 1) << 5)); }
__host__ __device__ __forceinline__ void stage_rc(int b, int& R, int& C) { const int st = b / 1024, sb = b % 1024, swz = sb ^ (((sb >> 9) & 1) << 5); R = (st >> 1) * 16 + swz / 64; C = (st & 1) * 32 + (swz % 64) / 2; }
__host__ __device__ __forceinline__ int perm32(int rho) { const int n = rho >> 4, i = rho & 15; return 8 * (i >> 2) + 4 * n + (i & 3); }

struct Unit { int pm, pn, acol, bcol, nt, part; };
struct Gemm { unsigned char* ws; size_t a_off, b_off; int lda, ldb, K; };

__device__ __forceinline__ void map_unit(int L, int nM, int nN, int& pm, int& pn) {
    const int nwg = nM * nN; int wgid = L; { const int q = nwg / NXCD, r = nwg % NXCD, xcd = wgid % NXCD, off = wgid / NXCD; wgid = (xcd < r ? xcd * (q + 1) : r * (q + 1) + (xcd - r) * q) + off; }
    const int nig = WGM * nN, gid = wgid / nig, fm = gid * WGM, gsz = (nM - fm) < WGM ? (nM - fm) : WGM;
    pm = fm + ((wgid % nig) % gsz); pn = (wgid % nig) / gsz;
}
struct StaticOrder {
    int nM, nN, nwg, G, c, blockdiag, ntk, tail;
    __device__ void init(int M, int N, int K, int G_, int c_, int bd = 0, int tail_ = 0) { tail = (G_ == 256) ? tail_ : 0; nM = M / BM - (tail == 1 ? 2 : 0); nN = N / BM; nwg = nM * nN; G = G_; c = c_; blockdiag = bd; ntk = K / BK; }
    __device__ bool next(int i, Unit& u) const {
        const long L = (long)i * G + c; const int rfull = nwg / G;
        const bool t2 = (tail == 2 && i >= rfull);
        const bool tl = (L >= nwg) && !t2;
        if (tl && (tail != 1 || i != rfull)) return false;
        if (t2 && (i > rfull || c >= 2 * (nwg - rfull * G))) return false;
        int pm0, pn0; map_unit(t2 ? rfull * G + (c >> 1) : (tl ? 0 : (int)L), nM, nN, pm0, pn0);
        const int tile = c >> 3, sp = c & 7, npair = ntk >> 1, base = npair >> 3, rem = npair & 7, p0 = sp * base + (sp < rem ? sp : rem), np = base + (sp < rem ? 1 : 0);
        const int pm = tl ? nM + (tile >> 4) : pm0, pn = tl ? (tile & 15) : pn0;
        const int koff = tl ? p0 * 2 * BK : (t2 ? (c & 1) * (ntk >> 1) * BK : 0);
        const int ac = koff + ((!tl && blockdiag) ? 256 * (pn0 >> 1) : 0);
        u = Unit{pm, pn, ac, koff, tl ? 2 * np : (t2 ? (ntk >> 1) : ntk), (tl || t2) ? c : -1};
        return true;
    }
};

template <class Epi, class Sched>
__device__ __forceinline__ void gemm_phase(LAS unsigned char* lds, const Gemm g, const Sched& S, const Epi& E, int wv) {
    const int tid = tid_of(wv);
    const int wid = __builtin_amdgcn_readfirstlane(tid >> 6), lane = tid & 63, wr = wid >> 2, wc = wid & 3, fr = lane & 15, fq = lane >> 4;
    unsigned voffA[2], voffB[2];
#pragma unroll
    for (int i = 0; i < 2; ++i) { int R, C; stage_rc(tid * 16 + i * 8192, R, C); const int Rb = Epi::PERM ? ((R & ~31) + perm32(R & 31)) : R;
        voffA[i] = (unsigned)(R * g.lda + C) * 2u; voffB[i] = (unsigned)(Rb * g.ldb + C) * 2u; }
    const size_t kstep = (size_t)(BK * 2);
    const size_t hstepA = (size_t)HALF * g.lda * 2, hstepB = (size_t)HALF * g.ldb * 2;
    const size_t tstepA = 2 * hstepA, tstepB = 2 * hstepB;
    const unsigned ldsw = (unsigned)wid * 1024u;
    constexpr bool FP8 = Epi::FP8;
    const int aoff = lds_byte(wr * 64 + fr, FP8 ? fq * 16 : fq * 8), boff = lds_byte(wc * 32 + fr, FP8 ? fq * 16 : fq * 8);
#define PG8_SA(b, h) (((b) * 2 + (h)) * HTB)
#define PG8_SB(b, h) ((4 + (b) * 2 + (h)) * HTB)
#define PG8_STAGE(bufoff, gbase, voff) do { _Pragma("unroll") for (int _i = 0; _i < 2; ++_i) \
        __builtin_amdgcn_global_load_lds((const unsigned*)((const char*)(gbase) + (voff)[_i]), (LAS unsigned*)(lds + (bufoff) + ldsw + _i * 8192), 16, 0, 0); } while (0)
#define PG8_P64(v, j) ((long)(((unsigned long)(unsigned)(v)[2 * (j) + 1] << 32) | (unsigned long)(unsigned)(v)[2 * (j)]))
#define PG8_LD32(p) __builtin_shufflevector(*(const LAS i32x4_*)(p), *(const LAS i32x4_*)((p) + 16), 0, 1, 2, 3, 4, 5, 6, 7)
#define PG8_LDA(dst, b, h) do { if constexpr (FP8) { _Pragma("unroll") for (int m = 0; m < 4; ++m) dst##8[m] = PG8_LD32(lds + PG8_SA(b, h) + aoff + m * 2048); } \
        else { _Pragma("unroll") for (int m = 0; m < 4; ++m) _Pragma("unroll") for (int k = 0; k < 2; ++k) dst[m][k] = *(const LAS bf16x8*)(lds + PG8_SA(b, h) + aoff + m * 2048 + k * 1024); } } while (0)
#define PG8_LDB(dst, b, h) do { if constexpr (FP8) { _Pragma("unroll") for (int n = 0; n < 2; ++n) dst##8[n] = PG8_LD32(lds + PG8_SB(b, h) + boff + n * 2048); } \
        else { _Pragma("unroll") for (int n = 0; n < 2; ++n) _Pragma("unroll") for (int k = 0; k < 2; ++k) dst[n][k] = *(const LAS bf16x8*)(lds + PG8_SB(b, h) + boff + n * 2048 + k * 1024); } } while (0)
#define PG8_MMA(ai, bj, At, Bt) do { __builtin_amdgcn_s_setprio(1); _Pragma("unroll") for (int m = 0; m < 4; ++m) _Pragma("unroll") for (int n = 0; n < 2; ++n) { \
        if constexpr (FP8 && FP8_MX == 2) asm volatile("v_mfma_f32_16x16x128_f8f6f4 %0, %1, %2, %0" : "+v"(acc[ai][bj][m][n]) : "v"(Bt##8[n]), "v"(At##8[m])); \
        else if constexpr (FP8 && FP8_MX == 1) acc[ai][bj][m][n] = __builtin_amdgcn_mfma_scale_f32_16x16x128_f8f6f4(Bt##8[n], At##8[m], acc[ai][bj][m][n], 0, 0, 0, 0, 0, 0); \
        else if constexpr (FP8) { _Pragma("unroll") for (int j = 0; j < 4; ++j) acc[ai][bj][m][n] = __builtin_amdgcn_mfma_f32_16x16x32_fp8_fp8(PG8_P64(Bt##8[n], j), PG8_P64(At##8[m], j), acc[ai][bj][m][n], 0, 0, 0); } \
        else { _Pragma("unroll") for (int k = 0; k < 2; ++k) acc[ai][bj][m][n] = __builtin_amdgcn_mfma_f32_16x16x32_bf16(Bt[n][k], At[m][k], acc[ai][bj][m][n], 0, 0, 0); } } __builtin_amdgcn_s_setprio(0); } while (0)
#define PG8_WAIT_V(n) asm volatile("s_waitcnt vmcnt(" #n ")" ::: "memory")
#define PG8_WAIT_L(n) asm volatile("s_waitcnt lgkmcnt(" #n ")" ::: "memory")
#define PG8_BAR __builtin_amdgcn_s_barrier()
#define PG8_SCHED __builtin_amdgcn_sched_barrier(0)
    Unit cur, nxt; int ui = 0;
    if (!S.next(0, cur)) return;
    f32x4 acc[2][2][4][2];
#pragma unroll
    for (int a = 0; a < 2; ++a)
#pragma unroll
        for (int b = 0; b < 2; ++b)
#pragma unroll
            for (int m = 0; m < 4; ++m)
#pragma unroll
                for (int n = 0; n < 2; ++n) acc[a][b][m][n] = (f32x4){0.f, 0.f, 0.f, 0.f};
    bf16x8 At[4][2], B0[2][2], B1[2][2]; i32x8 At8[4], B08[2], B18[2];
    const char* cA = (const char*)g.ws + g.a_off + (size_t)cur.pm * tstepA + (size_t)cur.acol * 2; const char* cB = (const char*)g.ws + g.b_off + (size_t)cur.pn * tstepB + (size_t)cur.bcol * 2;
    PG8_STAGE(PG8_SB(0, 0), cB, voffB); PG8_STAGE(PG8_SB(0, 1), cB + hstepB, voffB); PG8_STAGE(PG8_SA(0, 0), cA, voffA); PG8_STAGE(PG8_SA(0, 1), cA + hstepA, voffA);
    if (wr == 1) PG8_BAR;
    PG8_WAIT_V(2); PG8_BAR;
    PG8_STAGE(PG8_SB(1, 0), cB + kstep, voffB); PG8_STAGE(PG8_SA(1, 0), cA + kstep, voffA); PG8_STAGE(PG8_SB(1, 1), cB + hstepB + kstep, voffB);
    PG8_WAIT_V(6); PG8_BAR;
    for (;;) {
        const bool has_next = S.next(ui + 1, nxt);
        const char* nA = has_next ? (const char*)g.ws + g.a_off + (size_t)nxt.pm * tstepA + (size_t)nxt.acol * 2 : cA; const char* nB = has_next ? (const char*)g.ws + g.b_off + (size_t)nxt.pn * tstepB + (size_t)nxt.bcol * 2 : cB;
        const int nt = cur.nt;
        for (int t = 0; t < nt; t += 2) {
            const bool last = (t == nt - 2);
            const char* a1 = cA + (size_t)(t + 1) * kstep;
            const char* a2 = last ? nA : cA + (size_t)(t + 2) * kstep; const char* b2 = last ? nB : cB + (size_t)(t + 2) * kstep;
            const char* a3 = a2 + kstep; const char* b3 = b2 + kstep;
            if constexpr (Epi::MID) { if (cur.part < 0 && t == (nt >> 1)) { if constexpr (FP8 && FP8_MX == 2) asm volatile("s_nop 15\n\ts_nop 15" ::: "memory"); E.mid(acc, cur, wr, wc, fr, fq); } }
            PG8_LDB(B0, 0, 0); PG8_LDB(B1, 0, 1); PG8_SCHED; PG8_LDA(At, 0, 0); PG8_STAGE(PG8_SA(1, 1), a1 + hstepA, voffA);
            PG8_WAIT_V(8); PG8_WAIT_L(0); PG8_BAR; PG8_MMA(0, 0, At, B0); PG8_MMA(0, 1, At, B1); PG8_BAR; PG8_SCHED;
            PG8_LDA(At, 0, 1); PG8_STAGE(PG8_SB(0, 0), b2, voffB); PG8_STAGE(PG8_SB(0, 1), b2 + hstepB, voffB); PG8_STAGE(PG8_SA(0, 0), a2, voffA);
            PG8_WAIT_V(8); PG8_WAIT_L(0); PG8_BAR; PG8_MMA(1, 0, At, B0); PG8_MMA(1, 1, At, B1); PG8_BAR; PG8_SCHED;
            PG8_LDB(B0, 1, 0); PG8_LDB(B1, 1, 1); PG8_SCHED; PG8_LDA(At, 1, 0); PG8_STAGE(PG8_SA(0, 1), a2 + hstepA, voffA);
            PG8_WAIT_V(8); PG8_WAIT_L(0); PG8_BAR; PG8_MMA(0, 0, At, B0); PG8_MMA(0, 1, At, B1); PG8_BAR; PG8_SCHED;
            PG8_LDA(At, 1, 1); PG8_STAGE(PG8_SB(1, 0), b3, voffB); PG8_STAGE(PG8_SB(1, 1), b3 + hstepB, voffB); PG8_STAGE(PG8_SA(1, 0), a3, voffA);
            PG8_WAIT_V(8); PG8_WAIT_L(0); PG8_BAR; PG8_MMA(1, 0, At, B0); PG8_MMA(1, 1, At, B1); PG8_BAR; PG8_SCHED;
        }
        if (wr == 0) PG8_BAR;
        if constexpr (FP8 && FP8_MX == 2) asm volatile("s_nop 15\n\ts_nop 15" ::: "memory");
        int fr_ = fr, fq_ = fq; asm volatile("" : "+v"(fr_), "+v"(fq_));
        if (cur.part < 0) E(acc, cur, wr, wc, fr_, fq_);
        else {
            float* P = (float*)(g.ws + WS_PART) + (size_t)cur.part * (BM * BM) + (size_t)(wr * 64 + fr_) * BM + wc * 32 + (Epi::PERM ? 8 * fq_ : 4 * fq_);
#pragma unroll
            for (int ai = 0; ai < 2; ++ai)
#pragma unroll
                for (int m = 0; m < 4; ++m)
#pragma unroll
                    for (int bj = 0; bj < 2; ++bj)
#pragma unroll
                        for (int n = 0; n < 2; ++n) *(f32x4*)(P + (size_t)(ai * HALF + m * 16) * BM + bj * HALF + (Epi::PERM ? 4 * n : 16 * n)) = acc[ai][bj][m][n]; }
        if (!has_next) break;
#pragma unroll
        for (int a = 0; a < 2; ++a)
#pragma unroll
            for (int b = 0; b < 2; ++b)
#pragma unroll
                for (int m = 0; m < 4; ++m)
#pragma unroll
                    for (int n = 0; n < 2; ++n) acc[a][b][m][n] = (f32x4){0.f, 0.f, 0.f, 0.f};
        cur = nxt; cA = nA; cB = nB; ++ui;
        if (wr == 1) PG8_BAR;
    }
    PG8_WAIT_V(0);
    PG8_BAR;
#undef PG8_SA
#undef PG8_SB
#undef PG8_STAGE
#undef PG8_LDA
#undef PG8_LDB
#undef PG8_MMA
#undef PG8_LD32
#undef PG8_P64
#undef PG8_WAIT_V
#undef PG8_WAIT_L
#undef PG8_BAR
#undef PG8_SCHED
}
}

#define XB_TMO      128
#define XB_XCNT(j)  (256  + 64 * (j))
#define XB_XSUB(j)  (1280 + 64 * (j))
#define XB_XGEN(j)  (2304 + 64 * (j))
#define XB_TOP      3328
#define XB_TOPGEN   3392
#define XCD_BAR_WORDS 3456
#define XB_SPIN_CAP (1u << 18)
__device__ __forceinline__ unsigned xb_ld(unsigned* p)              { return __hip_atomic_load(p, __ATOMIC_RELAXED, __HIP_MEMORY_SCOPE_AGENT); }
__device__ __forceinline__ unsigned xb_add(unsigned* p, unsigned v) { return __hip_atomic_fetch_add(p, v, __ATOMIC_RELAXED, __HIP_MEMORY_SCOPE_AGENT); }
__device__ __forceinline__ unsigned xb_xcc_id() { return (unsigned)__builtin_amdgcn_s_getreg((3 << 11) | 20) & 0xFu; }
#define XB_SPIN(cond, bar) do { unsigned _sp = 0; while (cond) { __builtin_amdgcn_s_sleep(1); \
    if ((++_sp & 255u) == 0u) { if (xb_ld(&(bar)[XB_TMO])) break; if (_sp > XB_SPIN_CAP) { atomicAdd(&(bar)[XB_TMO], 1u); break; } } } } while (0)
struct XcdBarrier { unsigned* bar; unsigned x; volatile LAS unsigned* st; int wv; };
__device__ __forceinline__ bool xb_leader(int wv) { return wv == 0 && __builtin_amdgcn_mbcnt_hi(~0u, __builtin_amdgcn_mbcnt_lo(~0u, 0u)) == 0u; }
__device__ __forceinline__ XcdBarrier xcd_barrier_post(unsigned* bar, volatile LAS unsigned* st, int wv) {
    XcdBarrier b; b.bar = bar; b.x = xb_xcc_id(); b.st = st; b.wv = wv;
    if (xb_leader(wv)) (void)xb_add(&bar[XB_XCNT(b.x)], 1u);
    return b;
}
__device__ __forceinline__ void xcd_barrier_complete(unsigned* bar, unsigned x, unsigned& nloc, unsigned& nx) {
    const unsigned G = gridDim.x * gridDim.y * gridDim.z;
    unsigned sum, cnt, mine, sp = 0u;
    for (;;) {
        sum = 0u; cnt = 0u; mine = 0u;
#pragma unroll
        for (unsigned j = 0; j < 16; ++j) { const unsigned c = xb_ld(&bar[XB_XCNT(j)]); sum += c; cnt += (c > 0u) ? 1u : 0u; mine = (j == x) ? c : mine; }
        if (sum == G) break;
        __builtin_amdgcn_s_sleep(1);
        if ((++sp & 255u) == 0u) { if (xb_ld(&bar[XB_TMO])) break; if (sp > XB_SPIN_CAP) { atomicAdd(&bar[XB_TMO], 1u); break; } }
    }
    nloc = mine > 0u ? mine : 1u; nx = cnt > 0u ? cnt : 1u;
}
__device__ __forceinline__ void xcd_barrier(const XcdBarrier& b) {
    asm volatile("s_waitcnt vmcnt(0)" ::: "memory");
    __syncthreads();
    if (xb_leader(b.wv)) {
        unsigned* bar = b.bar;
        __builtin_amdgcn_s_waitcnt(0);
        unsigned nloc = b.st[0], nx = b.st[1];
        if (nloc == 0u) { xcd_barrier_complete(bar, b.x, nloc, nx); b.st[0] = nloc; b.st[1] = nx; }
        const unsigned old = xb_add(&bar[XB_XSUB(b.x)], 1u);
        const unsigned gen = old / nloc;
        if (old + 1u == (gen + 1u) * nloc) {
            __builtin_amdgcn_fence(__ATOMIC_RELEASE, "agent");
            asm volatile("s_waitcnt vmcnt(0)" ::: "memory");
            const unsigned og = xb_add(&bar[XB_TOP], 1u);
            const unsigned tg = og / nx;
            if (og + 1u == (tg + 1u) * nx) xb_add(&bar[XB_TOPGEN], 1u);
            else XB_SPIN(xb_ld(&bar[XB_TOPGEN]) == tg, bar);
            __builtin_amdgcn_fence(__ATOMIC_ACQUIRE, "agent");
            xb_add(&bar[XB_XGEN(b.x)], 1u);
            asm volatile("s_waitcnt vmcnt(0)" ::: "memory");
        } else {
            XB_SPIN(xb_ld(&bar[XB_XGEN(b.x)]) == gen, bar);
            __builtin_amdgcn_fence(__ATOMIC_ACQUIRE, "agent");
            asm volatile("s_waitcnt vmcnt(0)" ::: "memory");
        }
    }
    __syncthreads();
}

constexpr int NWAVES = 8, NTHR = 512;
constexpr int RING_OFF = 0, RING_BYTES = 131072;
constexpr int LDSCTL_OFF = RING_BYTES, MISC_OFF = LDSCTL_OFF + 320;
constexpr int LDS_BYTES = 147456;
struct Args { const float* in[25]; float* out; unsigned char* ws; };
constexpr int PTR_OFF = MISC_OFF + 128;
static_assert(PTR_OFF + 28 * 8 <= LDS_BYTES, "LDS map");
struct Frame {
    LAS unsigned char* lds; volatile LAS unsigned* MISC;
    int tid, lane, wave, vcu, G, gw, NGW;
};
__device__ __forceinline__ Frame make_frame(LAS unsigned char* lds, int wv) {
    Frame F; F.lds = lds; F.MISC = (volatile LAS unsigned*)(lds + MISC_OFF);
    const int t = tid_of(wv);
    F.tid = t; F.lane = t & 63; F.wave = wv;
    F.G = gridDim.x; { const int bx = blockIdx.x; F.vcu = (F.G % 8 == 0) ? (bx % 8) * (F.G / 8) + bx / 8 : bx; }
    F.gw = F.vcu * NWAVES + F.wave; F.NGW = F.G * NWAVES; return F;
}
__device__ __forceinline__ unsigned long long ldsb_u64(LAS unsigned char* lds, int i) {
    volatile LAS unsigned* p = (volatile LAS unsigned*)(lds + PTR_OFF) + 2 * i;
    const unsigned lo = __builtin_amdgcn_readfirstlane(p[0]), hi = __builtin_amdgcn_readfirstlane(p[1]);
    return ((unsigned long long)hi << 32) | lo;
}
__device__ __forceinline__ const float* e_in(LAS unsigned char* lds, int i) { return (const float*)(const GAS float*)ldsb_u64(lds, i); }
__device__ __forceinline__ float* e_out(LAS unsigned char* lds) { return (float*)(GAS float*)ldsb_u64(lds, 25); }
__device__ __forceinline__ unsigned char* e_ws(LAS unsigned char* lds) { return (unsigned char*)(GAS unsigned char*)ldsb_u64(lds, 26); }
__device__ __forceinline__ unsigned long long lds_u64(const Frame& F, int i) {
    volatile LAS unsigned* p = (volatile LAS unsigned*)(F.lds + PTR_OFF) + 2 * i;
    const unsigned lo = __builtin_amdgcn_readfirstlane(p[0]), hi = __builtin_amdgcn_readfirstlane(p[1]);
    return ((unsigned long long)hi << 32) | lo;
}
__device__ __forceinline__ const float* in_ptr(const Frame& F, int i) { return (const float*)(const GAS float*)lds_u64(F, i); }
__device__ __forceinline__ float* out_ptr(const Frame& F) { return (float*)(GAS float*)lds_u64(F, 25); }
__device__ __forceinline__ unsigned char* ws_ptr(const Frame& F) { return (unsigned char*)(GAS unsigned char*)lds_u64(F, 26); }
__device__ __forceinline__ unsigned* ctl_ptr(const Frame& F) { return (unsigned*)(ws_ptr(F) + WS_CTL); }

__device__ __forceinline__ void tr_item(const float* src, size_t spitch, int k0, int c0, bf16_t* dst, size_t dpitch, int r0, LAS unsigned* scr, int lane) {
    const int ln = lane & 7, g = lane >> 3;
    if (src == nullptr) {
#pragma unroll
        for (int j = 0; j < 8; ++j) { const int n = 4 * j + (lane >> 4), c = lane & 15; *(u32x4*)(dst + (size_t)(r0 + n) * dpitch + k0 + 8 * c) = (u32x4){0u, 0u, 0u, 0u}; }
        return;
    }
    f32x4 v[16];
#pragma unroll
    for (int i = 0; i < 16; ++i) { const int k = k0 + 16 * (i >> 1) + 2 * g + (i & 1); v[i] = __builtin_nontemporal_load((const f32x4*)(src + (size_t)k * spitch + c0 + 4 * ln)); }
#pragma unroll
    for (int ip = 0; ip < 8; ++ip)
#pragma unroll
        for (int c = 0; c < 4; ++c) scr[(4 * ln + c) * 65 + 8 * ip + g] = pk2(v[2 * ip][c], v[2 * ip + 1][c]);
    LDS_WAIT();
#pragma unroll
    for (int j = 0; j < 8; ++j) { const int n = 4 * j + (lane >> 4), c = lane & 15; const LAS unsigned* s = scr + n * 65 + 4 * c;
        u32x4 o; o.x = s[0]; o.y = s[1]; o.z = s[2]; o.w = s[3];
        *(u32x4*)(dst + (size_t)(r0 + n) * dpitch + k0 + 8 * c) = o; }
    LDS_WAIT();
}
__device__ __forceinline__ void tr_item8(const float* src, size_t spitch, int k0, int c0, unsigned char* dst, size_t dpitch, int r0, float scale, LAS unsigned* scr, int lane) {
    const int ln = lane & 7, g = lane >> 3;
    f32x4 v[16];
#pragma unroll
    for (int i = 0; i < 16; ++i) { const int k = k0 + 32 * (i >> 2) + 4 * g + (i & 3); v[i] = __builtin_nontemporal_load((const f32x4*)(src + (size_t)k * spitch + c0 + 4 * ln)); }
#pragma unroll
    for (int ib = 0; ib < 4; ++ib)
#pragma unroll
        for (int c = 0; c < 4; ++c) scr[(4 * ln + c) * 33 + 8 * ib + g] = pk4_fp8(v[4 * ib][c] * scale, v[4 * ib + 1][c] * scale, v[4 * ib + 2][c] * scale, v[4 * ib + 3][c] * scale);
    LDS_WAIT();
#pragma unroll
    for (int j = 0; j < 4; ++j) { const int n = 8 * j + (lane >> 3), c8 = lane & 7; const LAS unsigned* p = scr + n * 33 + 4 * c8;
        u32x4 o; o.x = p[0]; o.y = p[1]; o.z = p[2]; o.w = p[3];
        *(u32x4*)(dst + (size_t)(r0 + n) * dpitch + k0 + 16 * c8) = o; }
    LDS_WAIT();
}
__device__ __forceinline__ float wave_sum(float v) {
#pragma unroll
    for (int o = 1; o < 64; o <<= 1) v += __shfl_xor(v, o);
    return v;
}
struct TrDesc { const float* src; unsigned char* dst; int spitch, dpitch  ; int k0, c0, r0, f8; };
struct TrPtrs { const float *w_in, *w_branch, *w_out, *w_gate, *w_up, *w_down, *wa, *wx; unsigned char* ws; };
__device__ __forceinline__ TrDesc tr_decode(const TrPtrs& P, int it) {
    constexpr int I0 = 32 * 840, I1 = 64 * 128, I2 = 32 * 128, I3 = 32 * 688, I4 = 86 * 128;
    TrDesc d; int r = it;
    if (r < I0) { const int kb = r / 840, gidx = r % 840, pn = gidx >> 3, gi = gidx & 7; int c0; const float* src = P.w_in;
        if (gidx < 320) c0 = 32 * gidx; else if (gidx < 324) c0 = 10272 + 32 * (gidx - 320); else if (gidx == 324) c0 = 10240; else if (gidx < 328) { c0 = 0; src = nullptr; } else c0 = 32 * gidx - 96;
        const bool f8 = pn < 16 || pn >= 57; const int lt = pn < 16 ? pn : (pn < 24 ? pn - 16 : (pn < 40 ? pn - 16 : (pn < 41 ? 24 : (pn < 57 ? pn - 16 : pn - 41))));
        d = TrDesc{src, P.ws + (f8 ? WS_WI8 : WS_WI), N1_SRC, f8 ? DM : 2 * DM, 128 * kb, c0, 256 * lt + 32 * gi, f8 ? 1 : 0}; return d; } r -= I0;
    if (r < I1) { const int kb = r / 128, gidx = r % 128; d = TrDesc{P.w_branch, P.ws + WS_WB, DM, 2 * DM, 128 * kb, 32 * gidx, 32 * gidx, 1}; return d; } r -= I1;
    if (r < I2) { const int kb = r / 128, gidx = r % 128; d = TrDesc{P.w_out, P.ws + WS_WO, DM, P9_FP8 ? DM : 2 * DM, 128 * kb, 32 * gidx, 32 * gidx, P9_FP8 ? 1 : 0}; return d; } r -= I2;
    if (r < I3) { const int kb = r / 688, gidx = r % 688, pn = gidx >> 3, gi = gidx & 7; d = TrDesc{(gi < 4) ? P.w_gate : P.w_up, P.ws + WS_WGU, DFF, 2 * DM, 128 * kb, 128 * pn + 32 * (gi & 3), 32 * gidx, 0}; return d; } r -= I3;
    if (r < I4) { const int kb = r / 128, gidx = r % 128; d = TrDesc{P.w_down, P.ws + WS_WD, DM, 2 * DFF, 128 * kb, 32 * gidx, 32 * gidx, 0}; return d; } r -= I4;
    { const int kb = r / 256, gidx = r % 256, tn = gidx >> 3, gi = gidx & 7, blk = tn >> 1, hh = tn & 1;
      d = TrDesc{((gi < 4) ? P.wa : P.wx) + (size_t)blk * 65536, P.ws + WS_WG, 256, 512, 128 * kb, 128 * hh + 32 * (gi & 3), 32 * gidx, 0}; return d; }
}
__device__ __forceinline__ void tr_load(const TrDesc& d, f32x4 (&v)[16], int lane) {
    if (d.src == nullptr) return;
    const int ln = lane & 7, g = lane >> 3; const float* p = d.src + d.c0 + 4 * ln;
    if (d.f8) {
#pragma unroll
        for (int i = 0; i < 16; ++i) v[i] = __builtin_nontemporal_load((const f32x4*)(p + (size_t)(d.k0 + 32 * (i >> 2) + 4 * g + (i & 3)) * d.spitch)); }
    else {
#pragma unroll
        for (int i = 0; i < 16; ++i) v[i] = __builtin_nontemporal_load((const f32x4*)(p + (size_t)(d.k0 + 16 * (i >> 1) + 2 * g + (i & 1)) * d.spitch)); }
}
__device__ __forceinline__ void tr_store(const TrDesc& d, const f32x4 (&v)[16], LAS unsigned* scr, int lane) {
    const int ln = lane & 7, g = lane >> 3;
    if (d.f8) {
#pragma unroll
        for (int ib = 0; ib < 4; ++ib)
#pragma unroll
            for (int c = 0; c < 4; ++c) scr[(4 * ln + c) * 33 + 8 * ib + g] = pk4_fp8(v[4 * ib][c] * SW8, v[4 * ib + 1][c] * SW8, v[4 * ib + 2][c] * SW8, v[4 * ib + 3][c] * SW8);
        LDS_WAIT();
#pragma unroll
        for (int j = 0; j < 4; ++j) { const int n = 8 * j + (lane >> 3), c8 = lane & 7; const LAS unsigned* p = scr + n * 33 + 4 * c8;
            *(u32x4*)(d.dst + (size_t)(d.r0 + n) * d.dpitch + d.k0 + 16 * c8) = (u32x4){p[0], p[1], p[2], p[3]}; }
        LDS_WAIT();
    } else if (d.src == nullptr) {
#pragma unroll
        for (int j = 0; j < 8; ++j) { const int n = 4 * j + (lane >> 4), c = lane & 15; *(u32x4*)(d.dst + (size_t)(d.r0 + n) * d.dpitch + 2 * d.k0 + 16 * c) = (u32x4){0u, 0u, 0u, 0u}; }
    } else {
#pragma unroll
        for (int ip = 0; ip < 8; ++ip)
#pragma unroll
            for (int c = 0; c < 4; ++c) scr[(4 * ln + c) * 65 + 8 * ip + g] = pk2(v[2 * ip][c], v[2 * ip + 1][c]);
        LDS_WAIT();
#pragma unroll
        for (int j = 0; j < 8; ++j) { const int n = 4 * j + (lane >> 4), c = lane & 15; const LAS unsigned* p = scr + n * 65 + 4 * c;
            *(u32x4*)(d.dst + (size_t)(d.r0 + n) * d.dpitch + 2 * d.k0 + 16 * c) = (u32x4){p[0], p[1], p[2], p[3]}; }
        LDS_WAIT();
    }
}
constexpr int CONV_BASE = 32 * 840, CONV_N = 64 * 128 + 32 * 128 + 32 * 688 + 86 * 128;
constexpr int CW_QCONV = 4096 + 512;
__device__ __forceinline__ void conv_drain(Frame& F) {
    unsigned char* const ws = ws_ptr(F); unsigned* head = ctl_ptr(F) + CW_QCONV;
    LAS unsigned* scr = (LAS unsigned*)(F.lds + RING_OFF + F.wave * 16384);
    TrPtrs P{in_ptr(F, 8), in_ptr(F, 19), in_ptr(F, 20), in_ptr(F, 22), in_ptr(F, 23), in_ptr(F, 24), in_ptr(F, 14), in_ptr(F, 16), ws};
    constexpr int NQ8 = (CONV_N * 7 / 8) / 8, REST0 = NQ8 * 8, NQ = NQ8 + (CONV_N - REST0) / 2;
    static_assert((CONV_N - REST0) % 2 == 0, "pairs");
    int q = 0; if (F.lane == 0) q = (int)__hip_atomic_fetch_add(head, 1u, __ATOMIC_RELAXED, __HIP_MEMORY_SCOPE_AGENT);
    q = __builtin_amdgcn_readfirstlane(q);
    while (q < NQ) {
        int qn = 0; if (F.lane == 0) qn = (int)__hip_atomic_fetch_add(head, 1u, __ATOMIC_RELAXED, __HIP_MEMORY_SCOPE_AGENT);
        const int i0 = CONV_BASE + (q < NQ8 ? 8 * q : REST0 + 2 * (q - NQ8)), n = q < NQ8 ? 8 : 2;
#pragma unroll 1
        for (int j = 0; j < n; j += 2) {
            const TrDesc da = tr_decode(P, i0 + j), db = tr_decode(P, i0 + j + 1);
            f32x4 va[16], vb[16]; tr_load(da, va, F.lane); tr_load(db, vb, F.lane);
            tr_store(da, va, scr, F.lane); tr_store(db, vb, scr, F.lane);
        }
        q = __builtin_amdgcn_readfirstlane(qn);
    }
}
__device__ __forceinline__ void p0_prologue(Frame& F) {
    unsigned char* const ws = ws_ptr(F); const float* const in0 = in_ptr(F, 0); const float* const in1 = in_ptr(F, 1); const float* const in2 = in_ptr(F, 2); const float* const in3 = in_ptr(F, 3); const float* const in4 = in_ptr(F, 4); const float* const in7 = in_ptr(F, 7); const float* const in8 = in_ptr(F, 8); const float* const in14 = in_ptr(F, 14); const float* const in16 = in_ptr(F, 16); const float* const in19 = in_ptr(F, 19); const float* const in20 = in_ptr(F, 20); const float* const in22 = in_ptr(F, 22); const float* const in23 = in_ptr(F, 23); const float* const in24 = in_ptr(F, 24);
    LAS unsigned* scr = (LAS unsigned*)(F.lds + RING_OFF + F.wave * 16384);
    const int lane = F.lane;
    constexpr int I0 = 32 * 840, I1 = 64 * 128, I2 = 32 * 128, I3 = 32 * 688, I4 = 86 * 128, I5 = 2 * 256;
    constexpr int NITEMS = I0 + I1 + I2 + I3 + I4 + I5;
    bf16_t* WI = (bf16_t*)(ws + WS_WI); bf16_t* WB = (bf16_t*)(ws + WS_WB); bf16_t* WO = (bf16_t*)(ws + WS_WO); bf16_t* WGU = (bf16_t*)(ws + WS_WGU); bf16_t* WD = (bf16_t*)(ws + WS_WD); bf16_t* WG = (bf16_t*)(ws + WS_WG);
    for (int jt = F.gw; jt < NITEMS - CONV_N; jt += F.NGW) { const int it = jt < I0 ? jt : jt + CONV_N;
        int r = it;
        if (r < I0) { const int kb = r / 840, gidx = r % 840, pn = gidx >> 3, gi = gidx & 7; int c0; const float* src = in8;
            if (gidx < 320) c0 = 32 * gidx; else if (gidx < 324) c0 = 10272 + 32 * (gidx - 320); else if (gidx == 324) c0 = 10240; else if (gidx < 328) { c0 = 0; src = nullptr; } else c0 = 32 * gidx - 96;
            const bool f8 = pn < 16 || pn >= 57; const int lt = pn < 16 ? pn : (pn < 24 ? pn - 16 : (pn < 40 ? pn - 16 : (pn < 41 ? 24 : (pn < 57 ? pn - 16 : pn - 41))));
            if (f8) tr_item8(src, N1_SRC, 128 * kb, c0, ws + WS_WI8, DM, 256 * lt + 32 * gi, SW8, scr, lane);
            else tr_item(src, N1_SRC, 128 * kb, c0, WI, DM, 256 * lt + 32 * gi, scr, lane);
            continue; } r -= I0;
        if (r < I1) { const int kb = r / 128, gidx = r % 128; tr_item8(in19, DM, 128 * kb, 32 * gidx, (unsigned char*)WB, 2 * DM, 32 * gidx, SW8, scr, lane); continue; } r -= I1;
        if (r < I2) { const int kb = r / 128, gidx = r % 128;
            if (P9_FP8) tr_item8(in20, DM, 128 * kb, 32 * gidx, (unsigned char*)WO, DM, 32 * gidx, SW8, scr, lane); else tr_item(in20, DM, 128 * kb, 32 * gidx, WO, DM, 32 * gidx, scr, lane);
            continue; } r -= I2;
        if (r < I3) { const int kb = r / 688, gidx = r % 688, pn = gidx >> 3, gi = gidx & 7; const float* src = (gi < 4) ? in22 : in23;
            tr_item(src, DFF, 128 * kb, 128 * pn + 32 * (gi & 3), WGU, DM, 32 * gidx, scr, lane); continue; } r -= I3;
        if (r < I4) { const int kb = r / 128, gidx = r % 128; tr_item(in24, DM, 128 * kb, 32 * gidx, WD, DFF, 32 * gidx, scr, lane); continue; } r -= I4;
        { const int kb = r / 256, gidx = r % 256, tn = gidx >> 3, gi = gidx & 7, blk = tn >> 1, hh = tn & 1; const float* src = ((gi < 4) ? in14 : in16) + (size_t)blk * 65536;
            tr_item(src, 256, 128 * kb, 128 * hh + 32 * (gi & 3), WG, 256, 32 * gidx, scr, lane); }
    }
    {
        bf16_t* XN = (bf16_t*)(ws + WS_XN); const float* gm = in7;
        f32x4 ggv[16];
#pragma unroll
        for (int j = 0; j < 16; ++j) ggv[j] = *(const f32x4*)(gm + 4 * lane + 256 * j);
        for (int m = F.gw; m < MTOK; m += F.NGW) {
            const float* xr = (m < NTOK_P) ? in0 + (size_t)m * DM : in1 + (size_t)(m - NTOK_P) * DM;
            f32x4 v[16]; float s = 0.f;
#pragma unroll
            for (int j = 0; j < 16; ++j) { v[j] = __builtin_nontemporal_load((const f32x4*)(xr + 4 * lane + 256 * j)); s += (v[j].x * v[j].x + v[j].y * v[j].y) + (v[j].z * v[j].z + v[j].w * v[j].w); }
            const float rstd = 1.0f / sqrtf(wave_sum(s) * (1.0f / DM) + EPS);
#pragma unroll
            for (int j = 0; j < 16; ++j) { const f32x4 gg = ggv[j];
                u32x2 o; o.x = pk2(v[j].x * rstd * gg.x, v[j].y * rstd * gg.y); o.y = pk2(v[j].z * rstd * gg.z, v[j].w * rstd * gg.w);
                *(u32x2*)(XN + (size_t)m * DM + 4 * lane + 256 * j) = o;
                *(unsigned*)(ws + WS_XN8 + (size_t)m * DM + 4 * lane + 256 * j) = pk4_fp8(v[j].x * rstd * gg.x * SXN, v[j].y * rstd * gg.y * SXN, v[j].z * rstd * gg.z * SXN, v[j].w * rstd * gg.w * SXN); }
        }
    }
    {
        f32x2* RT = (f32x2*)(ws + WS_ROPE);
        for (int i = F.gw * 64 + lane; i < 4096 * 16; i += F.NGW * 64) { const int pos = i >> 4, j = i & 15;
            const double inv = pow(500000.0, -(double)j / 16.0); const double ang = (double)pos * inv; RT[i] = (f32x2){(float)cos(ang), (float)sin(ang)}; }
    }
    {
        bf16_t* KVS = (bf16_t*)(ws + WS_KVS); bf16_t* IKS = (bf16_t*)(ws + WS_IKS);
        const size_t gt = (size_t)F.gw * 64 + lane, GT = (size_t)F.NGW * 64;
        for (size_t i = gt; i < (size_t)DEC_B * PAST * 128; i += GT) {
            const size_t row = i >> 7; const int ch = (int)(i & 127); const size_t b = row >> 11, s = row & 2047;
            const f32x4 k0 = __builtin_nontemporal_load((const f32x4*)(in2 + row * 1024 + 8 * ch)), k1 = __builtin_nontemporal_load((const f32x4*)(in2 + row * 1024 + 8 * ch + 4));
            const f32x4 v0 = __builtin_nontemporal_load((const f32x4*)(in3 + row * 1024 + 8 * ch)), v1 = __builtin_nontemporal_load((const f32x4*)(in3 + row * 1024 + 8 * ch + 4));
            bf16_t* d = KVS + (b * SKV_SP + s) * 2048 + 8 * ch;
            *(u32x4*)d = (u32x4){pk2(k0.x, k0.y), pk2(k0.z, k0.w), pk2(k1.x, k1.y), pk2(k1.z, k1.w)};
            *(u32x4*)(d + 1024) = (u32x4){pk2(v0.x, v0.y), pk2(v0.z, v0.w), pk2(v1.x, v1.y), pk2(v1.z, v1.w)};
        }
        for (size_t i = gt; i < (size_t)DEC_B * PAST * 16; i += GT) {
            const size_t row = i >> 4; const int ch = (int)(i & 15); const size_t b = row >> 11, s = row & 2047;
            const f32x4 k0 = *(const f32x4*)(in4 + row * 128 + 8 * ch), k1 = *(const f32x4*)(in4 + row * 128 + 8 * ch + 4);
            *(u32x4*)(IKS + (b * SKV_SP + s) * 128 + 8 * ch) = (u32x4){pk2(k0.x, k0.y), pk2(k0.z, k0.w), pk2(k1.x, k1.y), pk2(k1.z, k1.w)};
        }
        for (size_t i = gt; i < (size_t)DEC_B * 32 * 256; i += GT) {
            const size_t r = i >> 8; const int ch = (int)(i & 255); const size_t b = r >> 5, s = SKV_S + (r & 31);
            *(u32x4*)(KVS + (b * SKV_SP + s) * 2048 + 8 * ch) = (u32x4){0u, 0u, 0u, 0u};
        }
        for (size_t i = gt; i < (size_t)DEC_B * 32 * 16; i += GT) {
            const size_t r = i >> 4; const int ch = (int)(i & 15); const size_t b = r >> 5, s = SKV_S + (r & 31);
            *(u32x4*)(IKS + (b * SKV_SP + s) * 128 + 8 * ch) = (u32x4){0u, 0u, 0u, 0u};
        }
    }
}

constexpr int XCH_OFF = LDSCTL_OFF + 1024;
static_assert(XCH_OFF + 8192 <= LDS_BYTES, "LDS map");
__device__ __forceinline__ void head_sumsq_exchange(const f32x4 (&acc)[2][2][4][2], float ds2, LAS unsigned char* lds, int wr, int wc, int fr, int fq) {
    LAS float* X = (LAS float*)(lds + XCH_OFF);
#pragma unroll
    for (int ai = 0; ai < 2; ++ai)
#pragma unroll
        for (int m = 0; m < 4; ++m)
#pragma unroll
            for (int bj = 0; bj < 2; ++bj) { const f32x4 a = acc[ai][bj][m][0], b = acc[ai][bj][m][1];
                float s = ((a[0] * a[0] + a[1] * a[1]) + (a[2] * a[2] + a[3] * a[3])) + ((b[0] * b[0] + b[1] * b[1]) + (b[2] * b[2] + b[3] * b[3]));
                s += __shfl_xor(s, 16); s += __shfl_xor(s, 32);
                if (fq == 0) X[((ai * 128 + wr * 64 + m * 16 + fr) * 2 + bj) * 4 + wc] = s * ds2; }
    asm volatile("s_waitcnt lgkmcnt(0)" ::: "memory"); __builtin_amdgcn_s_barrier(); asm volatile("" ::: "memory");
}
__device__ __forceinline__ float head_rstd(LAS unsigned char* lds, int rl, int bj) {
    const f32x4 p = *(const LAS f32x4*)(lds + XCH_OFF + ((rl * 2 + bj) * 4) * 4); return 1.0f / sqrtf(((p[0] + p[1]) + (p[2] + p[3])) * (1.0f / 128.0f) + EPS); }
__device__ __forceinline__ void rope_epi(float (&y)[8], const f32x2* RT, int pos, int fq) {
    const f32x4* cp = (const f32x4*)(RT + (size_t)pos * 16 + 8 * (fq & 1)); const f32x4 c0 = cp[0], c1 = cp[1], c2 = cp[2], c3 = cp[3];
    const float cs[8] = {c0[0], c0[2], c1[0], c1[2], c2[0], c2[2], c3[0], c3[2]}, sn[8] = {c0[1], c0[3], c1[1], c1[3], c2[1], c2[3], c3[1], c3[3]};
#pragma unroll
    for (int e = 0; e < 8; ++e) { const float p = __shfl_xor(y[e], 32); y[e] = (fq < 2) ? (y[e] * cs[e] - p * sn[e]) : (y[e] * cs[e] + p * sn[e]); }
}
struct RopeCS { f32x4 c0, c1, c2, c3; };
__device__ __forceinline__ RopeCS rope_load(const f32x2* RT, int pos, int fq) { const f32x4* cp = (const f32x4*)(RT + (size_t)pos * 16 + 8 * (fq & 1)); RopeCS r; r.c0 = cp[0]; r.c1 = cp[1]; r.c2 = cp[2]; r.c3 = cp[3]; return r; }
__device__ __forceinline__ void rope_apply(float (&y)[8], const RopeCS& r, int fq) {
    const float cs[8] = {r.c0[0], r.c0[2], r.c1[0], r.c1[2], r.c2[0], r.c2[2], r.c3[0], r.c3[2]}, sn[8] = {r.c0[1], r.c0[3], r.c1[1], r.c1[3], r.c2[1], r.c2[3], r.c3[1], r.c3[3]};
#pragma unroll
    for (int e = 0; e < 8; ++e) { const float p = __shfl_xor(y[e], 32); y[e] = (fq < 2) ? (y[e] * cs[e] - p * sn[e]) : (y[e] * cs[e] + p * sn[e]); }
}
__device__ __forceinline__ int row_pos(int row) { return row < NTOK_P ? (row & (SEQ - 1)) : PAST + ((row - NTOK_P) & (DEC_T - 1)); }
constexpr int RB = 4;
struct EpiProjA {
    static constexpr bool PERM = true, MID = false, FP8 = false;
    LAS unsigned char* lds;
    __device__ __forceinline__ void operator()(const f32x4 (&acc)[2][2][4][2], const pg8::Unit& u, int wr, int wc, int fr, int fq) const {
        unsigned char* const ws = e_ws(lds); const int pn = u.pn; const bool samp = u.pm >= NTOK_P / 256;
        const int rowl0 = wr * 64 + fr, row0 = u.pm * 256 + rowl0, cw = wc * 32 + 8 * fq;
        const f32x2* RT = (const f32x2*)(ws + WS_ROPE);
        if (pn >= 25) {
            bf16_t* O = (bf16_t*)(ws + WS_XL) + (pn - 25) * 256 + cw;
#pragma unroll
            for (int ai = 0; ai < 2; ++ai)
#pragma unroll
                for (int m = 0; m < 4; ++m)
#pragma unroll
                    for (int bj = 0; bj < 2; ++bj) { const f32x4 v0 = acc[ai][bj][m][0], v1 = acc[ai][bj][m][1];
                        *(u32x4*)(O + (size_t)(row0 + ai * 128 + m * 16) * DM + bj * 128) = (u32x4){pk2(v0[0], v0[1]), pk2(v0[2], v0[3]), pk2(v1[0], v1[1]), pk2(v1[2], v1[3])}; }
        } else if (pn >= 8 && pn < 24) {
            bf16_t* O = (bf16_t*)(ws + WS_IQ) + (pn - 8) * 256 + cw;
#pragma unroll
            for (int ai = 0; ai < 2; ++ai) {
                RopeCS rc[RB];
#pragma unroll
                for (int mb = 0; mb < 4; mb += RB) {
                    if (wc == 0) {
#pragma unroll
                        for (int m = 0; m < RB; ++m) rc[m] = rope_load(RT, row_pos(row0 + ai * 128 + (mb + m) * 16), fq); }
                    asm volatile("" ::: "memory");
#pragma unroll
                    for (int m = mb; m < mb + RB; ++m) { const int row = row0 + ai * 128 + m * 16;
#pragma unroll
                        for (int bj = 0; bj < 2; ++bj) { const f32x4 v0 = acc[ai][bj][m][0], v1 = acc[ai][bj][m][1]; float y[8] = {v0[0], v0[1], v0[2], v0[3], v1[0], v1[1], v1[2], v1[3]};
                            if (wc == 0) rope_apply(y, rc[m - mb], fq);
                            *(u32x4*)(O + (size_t)row * DM + bj * 128) = pack8f(y); } } } }
        } else if (pn >= 4 && pn < 8) {
            float* outv = e_out(lds) + (samp ? O_VS - (size_t)NTOK_P * KVW : O_VP) + (pn - 4) * 256 + cw;
#pragma unroll
            for (int ai = 0; ai < 2; ++ai)
#pragma unroll
                for (int m = 0; m < 4; ++m) { const int row = row0 + ai * 128 + m * 16;
                    bf16_t* d = samp ? (bf16_t*)(ws + WS_KVS) + ((size_t)((row - NTOK_P) >> 5) * SKV_SP + PAST + ((row - NTOK_P) & 31)) * 2048 : (bf16_t*)(ws + WS_KV) + (size_t)row * 2048;
#pragma unroll
                    for (int bj = 0; bj < 2; ++bj) { const f32x4 v0 = acc[ai][bj][m][0], v1 = acc[ai][bj][m][1]; const int col = (pn - 4) * 256 + bj * 128 + cw;
                        *(f32x4*)(outv + (size_t)row * KVW + bj * 128) = v0; *(f32x4*)(outv + (size_t)row * KVW + bj * 128 + 4) = v1;
                        *(u32x4*)(d + 1024 + col) = (u32x4){pk2(v0[0], v0[1]), pk2(v0[2], v0[3]), pk2(v1[0], v1[1]), pk2(v1[2], v1[3])}; } }
        } else {
            const bool isk = pn < 4;
            head_sumsq_exchange(acc, 1.0f, lds, wr, wc, fr, fq);
            const float* gp = e_in(lds, isk ? 10 : 11) + cw; const f32x4 g0 = *(const f32x4*)gp, g1 = *(const f32x4*)(gp + 4); const float g[8] = {g0[0], g0[1], g0[2], g0[3], g1[0], g1[1], g1[2], g1[3]};
            float* outp = e_out(lds);
#pragma unroll
            for (int am = 0; am < 4; ++am) { const int ai = am >> 1;
                RopeCS rc[2];
                if (wc == 0) {
#pragma unroll
                    for (int m = 0; m < 2; ++m) rc[m] = rope_load(RT, row_pos(u.pm * 256 + rowl0 + ai * 128 + (2 * (am & 1) + m) * 16), fq); }
                asm volatile("" ::: "memory");
#pragma unroll
                for (int m = 2 * (am & 1); m < 2 * (am & 1) + 2; ++m) { const int rl = rowl0 + ai * 128 + m * 16, row = u.pm * 256 + rl, rs = row - NTOK_P;
#pragma unroll
                    for (int bj = 0; bj < 2; ++bj) { const f32x4 v0 = acc[ai][bj][m][0], v1 = acc[ai][bj][m][1];
                        if (isk || bj == 0) { const float rstd = head_rstd(lds, rl, bj); float y[8];
#pragma unroll
                            for (int e = 0; e < 4; ++e) { y[e] = v0[e] * rstd * g[e]; y[4 + e] = v1[e] * rstd * g[4 + e]; }
                            if (wc == 0) rope_apply(y, rc[m & 1], fq);
                            if (isk) { const int col = pn * 256 + bj * 128 + cw; float* o = outp + (samp ? O_KS + (size_t)rs * KVW : O_KP + (size_t)row * KVW) + col;
                                *(f32x4*)o = (f32x4){y[0], y[1], y[2], y[3]}; *(f32x4*)(o + 4) = (f32x4){y[4], y[5], y[6], y[7]};
                                bf16_t* d = samp ? (bf16_t*)(ws + WS_KVS) + ((size_t)(rs >> 5) * SKV_SP + PAST + (rs & 31)) * 2048 : (bf16_t*)(ws + WS_KV) + (size_t)row * 2048;
                                *(u32x4*)(d + col) = pack8f(y); }
                            else { float* o = outp + (samp ? O_IKS + (size_t)rs * IDXD : O_IKP + (size_t)row * IDXD) + cw;
                                *(f32x4*)o = (f32x4){y[0], y[1], y[2], y[3]}; *(f32x4*)(o + 4) = (f32x4){y[4], y[5], y[6], y[7]};
                                bf16_t* d = samp ? (bf16_t*)(ws + WS_IKS) + ((size_t)(rs >> 5) * SKV_SP + PAST + (rs & 31)) * IDXD : (bf16_t*)(ws + WS_IKB) + (size_t)row * IDXD;
                                *(u32x4*)(d + cw) = pack8f(y); } }
                        else if (wc == 0) { float* o = (float*)(ws + WS_IWF) + (size_t)row * 32 + 8 * fq;
                            *(f32x4*)o = v0 * 0.015625f; *(f32x4*)(o + 4) = v1 * 0.015625f; } } } }
        }
    }
};
struct EpiProjB {
    static constexpr bool PERM = true, MID = false, FP8 = true;
    LAS unsigned char* lds;
    __device__ __forceinline__ void operator()(const f32x4 (&acc)[2][2][4][2], const pg8::Unit& u, int wr, int wc, int fr, int fq) const {
        unsigned char* const ws = e_ws(lds);
        const int seg = u.pn >> 4, pn = u.pn & 15; constexpr float DS = 1.0f / (SXN * SW8);
        const int rowl0 = wr * 64 + fr, row0 = u.pm * 256 + rowl0, cw = wc * 32 + 8 * fq, col0 = pn * 256 + cw;
        if (seg == 0) {
            head_sumsq_exchange(acc, DS * DS, lds, wr, wc, fr, fq);
            const float* gp = e_in(lds, 9) + cw; const f32x4 g0 = *(const f32x4*)gp, g1 = *(const f32x4*)(gp + 4); const float g[8] = {g0[0], g0[1], g0[2], g0[3], g1[0], g1[1], g1[2], g1[3]};
            const f32x2* RT = (const f32x2*)(ws + WS_ROPE); bf16_t* O = (bf16_t*)(ws + WS_Q) + col0;
#pragma unroll
            for (int ai = 0; ai < 2; ++ai) {
                RopeCS rc[4];
                if (wc == 0) {
#pragma unroll
                    for (int m = 0; m < 4; ++m) rc[m] = rope_load(RT, row_pos(u.pm * 256 + rowl0 + ai * 128 + m * 16), fq); }
                asm volatile("" ::: "memory");
#pragma unroll
                for (int m = 0; m < 4; ++m) { const int rl = rowl0 + ai * 128 + m * 16, row = u.pm * 256 + rl;
#pragma unroll
                    for (int bj = 0; bj < 2; ++bj) { const f32x4 v0 = acc[ai][bj][m][0], v1 = acc[ai][bj][m][1]; const float rstd = head_rstd(lds, rl, bj) * DS; float y[8];
#pragma unroll
                        for (int e = 0; e < 4; ++e) { y[e] = v0[e] * rstd * g[e]; y[4 + e] = v1[e] * rstd * g[4 + e]; }
                        if (wc == 0) rope_apply(y, rc[m], fq);
                        *(u32x4*)(O + (size_t)row * DM + bj * 128) = pack8f(y); } } }
        } else {
            bf16_t* O = (bf16_t*)(ws + (seg == 1 ? WS_GY : (seg == 2 ? WS_SGA : WS_SGL))) + col0;
#pragma unroll
            for (int ai = 0; ai < 2; ++ai)
#pragma unroll
                for (int m = 0; m < 4; ++m) { bf16_t* rowp = O + (size_t)(row0 + ai * 128 + m * 16) * DM;
#pragma unroll
                    for (int bj = 0; bj < 2; ++bj) { f32x4 v0 = acc[ai][bj][m][0] * DS, v1 = acc[ai][bj][m][1] * DS;
                        if (seg == 1) {
#pragma unroll
                            for (int e = 0; e < 4; ++e) { v0[e] = gelu_tanh_(v0[e]); v1[e] = gelu_tanh_(v1[e]); } }
                        else {
#pragma unroll
                            for (int e = 0; e < 4; ++e) { v0[e] = sigmoidf_(v0[e]); v1[e] = sigmoidf_(v1[e]); } }
                        *(u32x4*)(rowp + bj * 128) = (u32x4){pk2(v0[0], v0[1]), pk2(v0[2], v0[3]), pk2(v1[0], v1[1]), pk2(v1[2], v1[3])}; } }
        }
    }
};

__device__ __forceinline__ void rope8(float (&y)[8], const f32x2 (&cs)[8], int hl) {
    float p[8];
#pragma unroll
    for (int e = 0; e < 8; ++e) p[e] = __shfl_xor(y[e], 2);
    if (hl < 4) {
#pragma unroll
        for (int e = 0; e < 8; ++e) y[e] = (hl < 2) ? (y[e] * cs[e].x - p[e] * cs[e].y) : (y[e] * cs[e].x + p[e] * cs[e].y);
    }
}
__device__ __forceinline__ float sum16(float s) { s += __shfl_xor(s, 1); s += __shfl_xor(s, 2); s += __shfl_xor(s, 4); s += __shfl_xor(s, 8); return s; }
struct P2Ptrs { unsigned char* ws; float* out; const float* sconv; const float* gq; const float* gk; const float* gi; const float* cw; const float* cb; };
__device__ __forceinline__ void p2_rowinfo(int m, bool& samp, int& ml, int& b, int& t, int& pos) { samp = m >= NTOK_P; ml = samp ? m - NTOK_P : m; b = samp ? (ml >> 5) : (ml >> 12); t = samp ? (ml & 31) : (ml & 4095); pos = samp ? PAST + t : t; }
__device__ __forceinline__ void p2_taskC(const P2Ptrs& P, int item, int lane) {
    const int strip = item >> 3, col = 512 * (item & 7) + 8 * lane, m0 = 16 * strip; bool samp; int ml, b, t0, pos; p2_rowinfo(m0, samp, ml, b, t0, pos);
    const bf16_t* XLb = (const bf16_t*)(P.ws + WS_XL); bf16_t* Ub = (bf16_t*)(P.ws + WS_U);
    float x[19][8];
#pragma unroll
    for (int i = 0; i < 19; ++i) { const int tt = t0 + i - 3;
        if (tt >= 0) unpack8(*(const u32x4*)(XLb + (size_t)(m0 + i - 3) * DM + col), x[i]);
        else if (samp) { const float* sp = P.sconv + ((size_t)b * 3 + i) * DM + col; const f32x4 s0 = *(const f32x4*)sp, s1 = *(const f32x4*)(sp + 4); x[i][0] = s0.x; x[i][1] = s0.y; x[i][2] = s0.z; x[i][3] = s0.w; x[i][4] = s1.x; x[i][5] = s1.y; x[i][6] = s1.z; x[i][7] = s1.w; }
        else {
#pragma unroll
            for (int e = 0; e < 8; ++e) x[i][e] = 0.f; } }
    float w[4][8], cb[8];
#pragma unroll
    for (int e = 0; e < 8; ++e) { cb[e] = P.cb[col + e];
#pragma unroll
        for (int j = 0; j < 4; ++j) w[j][e] = P.cw[(size_t)j * DM + col + e]; }
    const int T = samp ? DEC_T : SEQ;
#pragma unroll
    for (int r = 0; r < 16; ++r) { float u[8];
#pragma unroll
        for (int e = 0; e < 8; ++e) u[e] = cb[e] + x[r][e] * w[0][e] + x[r + 1][e] * w[1][e] + x[r + 2][e] * w[2][e] + x[r + 3][e] * w[3][e];
        *(u32x4*)(Ub + (size_t)(m0 + r) * DM + col) = pack8f(u);
        const int t = t0 + r;
        if (t >= T - 3) { float* oc = P.out + (samp ? O_CONVS : O_CONVP) + ((size_t)b * 3 + (t - (T - 3))) * DM + col;
            *(f32x4*)oc = (f32x4){x[r + 3][0], x[r + 3][1], x[r + 3][2], x[r + 3][3]}; *(f32x4*)(oc + 4) = (f32x4){x[r + 3][4], x[r + 3][5], x[r + 3][6], x[r + 3][7]}; } }
}
__device__ __forceinline__ void p2_phase(Frame& F) {
    P2Ptrs P{ws_ptr(F), out_ptr(F), in_ptr(F, 6), in_ptr(F, 9), in_ptr(F, 10), in_ptr(F, 11), in_ptr(F, 12), in_ptr(F, 13)};
    for (int it = F.gw; it < (MTOK / 16) * 8; it += F.NGW) p2_taskC(P, it, F.lane);
}

__device__ __forceinline__ float expf_(float x) { return __builtin_amdgcn_exp2f(1.4426950408889634f * x); }
__device__ __forceinline__ float softplusf_(float x) { return fmaxf(x, 0.f) + log1pf(expf(-fabsf(x))); }
struct EpiGates {
    static constexpr bool PERM = false, MID = false, FP8 = false;
    LAS unsigned char* lds;
    __device__ __forceinline__ void operator()(const f32x4 (&acc)[2][2][4][2], const pg8::Unit& u, int wr, int wc, int fr, int fq) const {
        unsigned char* const ws = e_ws(lds); const bf16_t* U = (const bf16_t*)(ws + WS_U); const float* ba = e_in(lds, 15); const float* bx = e_in(lds, 17); const float* lam = e_in(lds, 18); unsigned* AB = (unsigned*)(ws + WS_AB);
        const int row0 = u.pm * 256 + wr * 64 + fr, chb = 256 * (u.pn >> 1) + 128 * (u.pn & 1) + 32 * wc + 4 * fq;
        u32x2 uw[2][2][4];
#pragma unroll
        for (int n = 0; n < 2; ++n)
#pragma unroll
            for (int ai = 0; ai < 2; ++ai)
#pragma unroll
                for (int m = 0; m < 4; ++m) uw[n][ai][m] = *(const u32x2*)(U + (size_t)(row0 + ai * 128 + m * 16) * DM + chb + 16 * n);
        asm volatile("" ::: "memory");
#pragma unroll
        for (int n = 0; n < 2; ++n) { const int ch0 = chb + 16 * n;
            const f32x4 ba4 = *(const f32x4*)(ba + ch0), bx4 = *(const f32x4*)(bx + ch0), lm4 = *(const f32x4*)(lam + ch0); float sp[4];
#pragma unroll
            for (int e = 0; e < 4; ++e) sp[e] = 8.0f * softplusf_(-lm4[e]);
#pragma unroll
            for (int ai = 0; ai < 2; ++ai)
#pragma unroll
                for (int m = 0; m < 4; ++m) { const size_t row = (size_t)(row0 + ai * 128 + m * 16); const u32x2 w2 = uw[n][ai][m];
                    const float uu[4] = {bflo(w2.x), bfhi(w2.x), bflo(w2.y), bfhi(w2.y)}; u32x4 o;
#pragma unroll
                    for (int e = 0; e < 4; ++e) { const float r = sigmoidf_(acc[ai][0][m][n][e] + ba4[e]), ig = sigmoidf_(acc[ai][1][m][n][e] + bx4[e]);
                        const float la = -sp[e] * r, em = 1.0f - expf_(2.0f * la);
                        const float bb = __builtin_amdgcn_sqrtf(fmaxf(em, 0.f)) * (ig * uu[e]);
                        const _Float16 hl_ = (_Float16)la, hb_ = (_Float16)bb;
                        o[e] = (unsigned)__builtin_bit_cast(unsigned short, hl_) | ((unsigned)__builtin_bit_cast(unsigned short, hb_) << 16); }
                    *(u32x4*)(AB + row * DM + ch0) = o; } }
    }
};
__device__ __forceinline__ float h_lo(unsigned w) { return (float)__builtin_bit_cast(_Float16, (unsigned short)(w & 0xffffu)); }
__device__ __forceinline__ float h_hi(unsigned w) { return (float)__builtin_bit_cast(_Float16, (unsigned short)(w >> 16)); }
__device__ __forceinline__ void scan_summaries(Frame& F) {
    unsigned char* const ws = ws_ptr(F);
    const unsigned* AB = (const unsigned*)(ws + WS_AB); f32x4* SUM = (f32x4*)(ws + WS_SUM);
    for (int it = F.gw * 64 + F.lane; it < 128 * 2048; it += F.NGW * 64) { const int q = it >> 11, cp = it & 2047;
        const size_t m0 = (size_t)(q >> 6) * SEQ + (size_t)(q & 63) * 64; const unsigned* p = AB + m0 * DM + 2 * cp;
        float al0 = 0.f, al1 = 0.f, h0 = 0.f, h1 = 0.f;
        for (int r0 = 0; r0 < 64; r0 += 16) { u32x2 w[16];
#pragma unroll
            for (int r = 0; r < 16; ++r) w[r] = *(const u32x2*)(p + (size_t)(r0 + r) * DM);
#pragma unroll
            for (int r = 0; r < 16; ++r) { const float la0 = h_lo(w[r].x), la1 = h_lo(w[r].y); al0 += la0; al1 += la1; h0 = expf_(la0) * h0 + h_hi(w[r].x); h1 = expf_(la1) * h1 + h_hi(w[r].y); } }
        SUM[(size_t)q * 2048 + cp] = (f32x4){al0, h0, al1, h1}; }
}
__device__ __forceinline__ void scan_apply(Frame& F) {
    unsigned char* const ws = ws_ptr(F); float* const out = out_ptr(F); const float* const in5 = in_ptr(F, 5);
    const unsigned* AB = (const unsigned*)(ws + WS_AB); const f32x4* SUM = (const f32x4*)(ws + WS_SUM); const bf16_t* GY = (const bf16_t*)(ws + WS_GY); bf16_t* OAL = (bf16_t*)(ws + WS_OAL);
    for (int it = F.gw * 64 + F.lane; it < 144 * 2048; it += F.NGW * 64) { const int q = it >> 11, cp = it & 2047;
        float h0, h1; size_t m0; int nr; float* lout = nullptr;
        if (q < 128) { const int ch = q & 63; m0 = (size_t)(q >> 6) * SEQ + (size_t)ch * 64; nr = 64; h0 = 0.f; h1 = 0.f;
            for (int j = 0; j < ch; ++j) { const f32x4 s = SUM[(size_t)((q & ~63) + j) * 2048 + cp]; h0 = expf_(s.x) * h0 + s.y; h1 = expf_(s.z) * h1 + s.w; }
            if (ch == 63) lout = out + O_LRUP + (size_t)(q >> 6) * DM + 2 * cp; }
        else { const int bs = q - 128; m0 = (size_t)NTOK_P + (size_t)bs * DEC_T; nr = DEC_T; const f32x2 s = *(const f32x2*)(in5 + (size_t)bs * DM + 2 * cp); h0 = s.x; h1 = s.y;
            lout = out + O_LRUS + (size_t)bs * DM + 2 * cp; }
        const unsigned* p = AB + m0 * DM + 2 * cp; const bf16_t* g = GY + m0 * DM + 2 * cp; unsigned char* o = (unsigned char*)OAL + m0 * (2 * DM) + DM + 2 * cp;
        for (int r0 = 0; r0 < nr; r0 += 16) { u32x2 w[16]; unsigned gw_[16];
#pragma unroll
            for (int r = 0; r < 16; ++r) { w[r] = *(const u32x2*)(p + (size_t)(r0 + r) * DM); gw_[r] = *(const unsigned*)(g + (size_t)(r0 + r) * DM); }
            asm volatile("" ::: "memory");
#pragma unroll
            for (int r = 0; r < 16; ++r) { h0 = expf_(h_lo(w[r].x)) * h0 + h_hi(w[r].x); h1 = expf_(h_lo(w[r].y)) * h1 + h_hi(w[r].y);
                *(unsigned short*)(o + (size_t)(r0 + r) * (2 * DM)) = (unsigned short)__builtin_amdgcn_cvt_pk_fp8_f32(h0 * bflo(gw_[r]) * SA_LRU, h1 * bfhi(gw_[r]) * SA_LRU, 0, false); }
            asm volatile("" ::: "memory"); }
        if (lout) *(f32x2*)lout = (f32x2){h0, h1}; }
}


__device__ __forceinline__ int crow_(int r, int hi) { return (r & 3) + 8 * (r >> 2) + 4 * hi; }
struct IdxItem { int m0, qw, nvalid, samp; const bf16_t* kp; float* sp; int sld; };
__device__ __forceinline__ IdxItem idx_decode(int it, unsigned char* ws) {
    IdxItem r; constexpr int NPI = 4 * 16 * 17;
    if (it < NPI) { int g = 15; int rr = it; while (rr >= 8 * (g + 1)) { rr -= 8 * (g + 1); --g; }
        const int seg = rr % (g + 1); rr /= (g + 1); const int cl = rr & 3, b = rr >> 2, chunk = 4 * g + cl;
        r.m0 = b * SEQ + 64 * chunk; r.qw = 8; r.samp = 0; const int nk = (chunk + 1) * 64 - 256 * seg; r.nvalid = nk < 256 ? nk : 256;
        r.kp = (const bf16_t*)(ws + WS_IKB) + ((size_t)b * SEQ + 256 * seg) * IDXD; r.sp = (float*)(ws + WS_SC) + (size_t)r.m0 * SEQ + 256 * seg; r.sld = SEQ; }
    else { const int rr = it - NPI, bs = rr / 9, seg = rr % 9;
        r.m0 = NTOK_P + 32 * bs; r.qw = 4; r.samp = 1; const int nk = SKV_SP - 256 * seg; r.nvalid = nk < 256 ? nk : 256;
        r.kp = (const bf16_t*)(ws + WS_IKS) + ((size_t)bs * SKV_SP + 256 * seg) * IDXD; r.sp = (float*)(ws + WS_SCS) + (size_t)(32 * bs) * SKV_SP + 256 * seg; r.sld = SKV_SP; }
    return r;
}
__device__ __forceinline__ void idx_phase(Frame& F) {
    unsigned char* const ws = ws_ptr(F); unsigned* const ctl = ctl_ptr(F);
    __syncthreads(); const unsigned qsel = F.MISC[16]; __syncthreads(); if (F.tid == 0) F.MISC[16] = qsel + 1u;
    unsigned* qhead = ctl + CW_QIDX + 64 * qsel;
    const bf16_t* IQ = (const bf16_t*)(ws + WS_IQ); const float* IWF = (const float*)(ws + WS_IWF);
    const int tid = F.tid, lane = F.lane, wave = F.wave, c = lane & 31, hi = lane >> 5;
    constexpr int TOTAL = 4 * 16 * 17 + 16 * 9;
    if (tid == 0) { F.MISC[20] = __hip_atomic_fetch_add(qhead, 1u, __ATOMIC_RELAXED, __HIP_MEMORY_SCOPE_AGENT); F.MISC[21] = __hip_atomic_fetch_add(qhead, 1u, __ATOMIC_RELAXED, __HIP_MEMORY_SCOPE_AGENT); }
    __syncthreads();
    int icur = (int)F.MISC[20], inxt = (int)F.MISC[21];
    __syncthreads();
    if (icur >= TOTAL) return;
#define IDX_STAGE(IT, BUF) do { _Pragma("unroll") for (int j = 0; j < 8; ++j) { const int r0 = 32 * j + 4 * wave; if (r0 < (IT).nvalid) { const int key = r0 + (lane >> 4), chunk = (lane & 15) ^ (key & 15); \
        __builtin_amdgcn_global_load_lds((const unsigned*)((IT).kp + (size_t)key * IDXD + 8 * chunk), (LAS unsigned*)(F.lds + RING_OFF + (BUF) * 65536 + r0 * 256), 16, 0, 0); } } } while (0)
    IdxItem cur = idx_decode(icur, ws);
    IDX_STAGE(cur, 0);
    asm volatile("s_waitcnt vmcnt(0)" ::: "memory");
    __syncthreads();
    int p = 0;
    for (;;) {
        const bool has = inxt < TOTAL;
        unsigned inn = 0u;
        if (tid == 0 && has) inn = __hip_atomic_fetch_add(qhead, 1u, __ATOMIC_RELAXED, __HIP_MEMORY_SCOPE_AGENT);
        IdxItem nxt = cur;
        if (has) { nxt = idx_decode(inxt, ws); IDX_STAGE(nxt, p ^ 1); }
        const LAS unsigned char* kb = F.lds + RING_OFF + p * 65536;
        const int nblk = cur.nvalid >> 5, npair = cur.qw >> 1;
#define IDX_LDK(BK, BLK) do { const int key_ = 32 * (BLK) + c; const LAS unsigned char* rowp_ = kb + key_ * 256; const int sw_ = key_ & 15; \
            _Pragma("unroll") for (int d0 = 0; d0 < 8; ++d0) BK[d0] = *(const LAS bf16x8*)(rowp_ + (((2 * d0 + hi) ^ sw_) << 4)); } while (0)
#define IDX_RELU(x) __builtin_amdgcn_fmed3f((x), 0.f, __builtin_inff())
#define IDX_BLOCK(BK, BLK) do { f32x16 a0 = {}, a1 = {}; \
            _Pragma("unroll") for (int d0 = 0; d0 < 8; ++d0) { a0 = __builtin_amdgcn_mfma_f32_32x32x16_bf16(aq[0][d0], BK[d0], a0, 0, 0, 0); a1 = __builtin_amdgcn_mfma_f32_32x32x16_bf16(aq[1][d0], BK[d0], a1, 0, 0, 0); } \
            f32x2 t0v = {0.f, 0.f}, t1v = {0.f, 0.f}; \
            _Pragma("unroll") for (int r = 0; r < 16; r += 2) { \
                const f32x2 w0 = {w[0][r >> 2][r & 3], w[0][r >> 2][(r & 3) + 1]}, w1 = {w[1][r >> 2][r & 3], w[1][r >> 2][(r & 3) + 1]}; \
                t0v = (f32x2){IDX_RELU(a0[r]), IDX_RELU(a0[r + 1])} * w0 + t0v; t1v = (f32x2){IDX_RELU(a1[r]), IDX_RELU(a1[r + 1])} * w1 + t1v; } \
            const float t0 = t0v.x + t0v.y, t1 = t1v.x + t1v.y; \
            auto rr_ = __builtin_amdgcn_permlane32_swap(__float_as_uint(t0), __float_as_uint(t1), false, false);     \
            s0[loff + 32 * (BLK)] = __uint_as_float(rr_[0]) + __uint_as_float(rr_[1]); } while (0)
        for (int pr = 0; pr < npair; ++pr) {
            const int m = cur.m0 + wave * cur.qw + 2 * pr;
            bf16x8 aq[2][8]; f32x4 w[2][4];
#pragma unroll
            for (int q = 0; q < 2; ++q) {
#pragma unroll
                for (int d0 = 0; d0 < 8; ++d0) aq[q][d0] = *(const bf16x8*)(IQ + (size_t)(m + q) * DM + c * IDXD + d0 * 16 + hi * 8);
#pragma unroll
                for (int g = 0; g < 4; ++g) w[q][g] = *(const f32x4*)(IWF + (size_t)(m + q) * 32 + 8 * g + 4 * hi); }
            float* s0 = cur.sp + (size_t)(m - cur.m0) * cur.sld; const int loff = c + (hi ? cur.sld : 0);
            bf16x8 bka[8], bkb[8];
            IDX_LDK(bka, 0);
            for (int blk = 0; blk < nblk; blk += 2) {
                IDX_LDK(bkb, blk + 1);
                IDX_BLOCK(bka, blk);
                if (blk + 2 < nblk) IDX_LDK(bka, blk + 2);
                IDX_BLOCK(bkb, blk + 1); }
        }
#undef IDX_LDK
#undef IDX_BLOCK
#undef IDX_RELU
        if (tid == 0) F.MISC[20 + p] = inn;
        asm volatile("s_waitcnt vmcnt(0)" ::: "memory");
        __syncthreads();
        if (!has) break;
        cur = nxt; inxt = (int)F.MISC[20 + p]; p ^= 1;
    }
#undef IDX_STAGE
}
__device__ __forceinline__ void select_row(Frame& F, int m) {
    unsigned char* const ws = ws_ptr(F);
    const int lane = F.lane;
    const float* sp; int n;
    if (m < NTOK_P) { n = (((m & (SEQ - 1)) >> 6) + 1) * 64; sp = (const float*)(ws + WS_SC) + (size_t)m * SEQ; }
    else { n = SKV_S; sp = (const float*)(ws + WS_SCS) + (size_t)(m - NTOK_P) * SKV_SP; }
    unsigned key[64];
#pragma unroll
    for (int j = 0; j < 64; ++j) { const int idx = 64 * j + lane; key[j] = __float_as_uint(sp[idx < n ? idx : n - 1]); }
    asm volatile("" ::: "memory");
#pragma unroll
    for (int j = 0; j < 64; ++j) { const int idx = 64 * j + lane; const unsigned u = key[j]; const unsigned k = (u & 0x80000000u) ? ~u : (u | 0x80000000u); key[j] = idx < n ? k : 0u; }
    unsigned thr = 1u;
    if (n > TOPK) { unsigned prefix = 0u;
        const int ngrp = (n + 511) >> 9;
        for (int bit = 31; bit >= 0; --bit) { const unsigned cand = prefix | (1u << bit); int c0 = 0, c1 = 0, c2 = 0, c3 = 0;
#pragma unroll
            for (int g = 0; g < 8; ++g) if (g < ngrp) {
#pragma unroll
                for (int j = 8 * g; j < 8 * g + 8; j += 4) { c0 += (key[j] >= cand) ? 1 : 0; c1 += (key[j + 1] >= cand) ? 1 : 0; c2 += (key[j + 2] >= cand) ? 1 : 0; c3 += (key[j + 3] >= cand) ? 1 : 0; } }
            const int cl = (c0 + c1) + (c2 + c3); int cnt = 0;
#pragma unroll
            for (int b = 0; b < 7; ++b) cnt += __builtin_popcountll(__ballot((cl >> b) & 1)) << b;
            if (cnt >= TOPK) prefix = cand;
            if (cnt == TOPK) break; }
        thr = prefix; }
    unsigned long long mine = 0ull;
#pragma unroll
    for (int j = 0; j < 64; ++j) { const unsigned long long bal = __ballot(key[j] >= thr); mine = (lane == j) ? bal : mine; }
    ((unsigned long long*)(ws + WS_BM))[(size_t)m * 64 + lane] = mine;
}
__device__ __forceinline__ void select_phase(Frame& F) {
    volatile LAS unsigned* cnt = F.MISC + 24;
    __syncthreads(); if (F.tid == 0) *cnt = 0u; __syncthreads();
    const int G = F.G, b = (int)blockIdx.x;
    for (;;) {
        unsigned i = 0u; if (F.lane == 0) i = __hip_atomic_fetch_add((LAS unsigned*)cnt, 1u, __ATOMIC_RELAXED, __HIP_MEMORY_SCOPE_WORKGROUP);
        const int q = (int)__builtin_amdgcn_readfirstlane(i) * G + b;
        if (q >= MTOK) break;
        int m;
        if (q < MTOK - NTOK_P) m = NTOK_P + q;
        else { const int t = q - (MTOK - NTOK_P); m = (t & 1) * SEQ + (SEQ - 1 - (t >> 1)); }
        select_row(F, m);
    }
}

namespace att {
constexpr int NW = 8, QBLK = 32, KVBLK = 64, D = 128, KVLD = 2048, QLD = 4096, OLD = 8192;
constexpr float SCALE = 0.08838834764831845f, THR = 8.f;
constexpr int SHM_V = KVBLK * D * 2, SHM_K = KVBLK * D * 2;
constexpr int ATT_LDS = 2 * SHM_V + 2 * SHM_K + NW * 64 * 4 + 64;
typedef short s16x4 __attribute__((ext_vector_type(4)));
#define KSWZ(row, colB) ((row) * 256 + ((colB) ^ (((row) & 7) << 4)))
#define SBAR() __builtin_amdgcn_sched_barrier(0)
__device__ __forceinline__ int v_st(int k, int c) { const int kk = (k & ~0xC) | ((k & 4) << 1) | ((k & 8) >> 1); return ((kk >> 3) * 4 + (c >> 5)) * 512 + ((kk & 7) * 32 + (c & 31)) * 2; }
__device__ __forceinline__ int v_rd_base(int lane) { return ((lane & 3) << 3) | (((lane >> 2) & 3) << 6) | (((lane >> 4) & 1) << 5) | (((lane >> 5) & 1) << 8); }
constexpr int v_rd_off(int d0, int ks, int half) { return d0 * 512 + ks * 4096 + half * 2048; }
__device__ __forceinline__ int crow(int r, int hi) { return (r & 3) + 8 * (r >> 2) + 4 * hi; }
__device__ __forceinline__ bf16x8 load8(const bf16_t* p) { return *reinterpret_cast<const bf16x8*>(p); }
__device__ __forceinline__ void mask_bits(f32x16& p0, f32x16& p1, unsigned long long mw, int hi) {
    const float NEG = -__builtin_inff(); const unsigned lo = (unsigned)mw >> (4 * hi), hw = (unsigned)(mw >> 32) >> (4 * hi);
#pragma unroll
    for (int r = 0; r < 16; ++r) { const int c = (r & 3) + 8 * (r >> 2);
        if (!((lo >> c) & 1u)) p0[r] = NEG;
        if (!((hw >> c) & 1u)) p1[r] = NEG; }
}
__device__ __forceinline__ void partialSM(f32x16& p0, f32x16& p1, float& m_reg, float& mn, float& alpha) {
    float pmax = p0[0]; for (int r = 1; r < 16; ++r) pmax = fmaxf(pmax, p0[r]); for (int r = 0; r < 16; ++r) pmax = fmaxf(pmax, p1[r]);
    { auto rr = __builtin_amdgcn_permlane32_swap(__float_as_uint(pmax), __float_as_uint(pmax), false, false);
      pmax = fmaxf(__uint_as_float(rr[0]), __uint_as_float(rr[1])); }
    constexpr float C2 = 1.4426950408889634f * SCALE;
    if (__builtin_expect(__all((pmax - m_reg) * SCALE <= THR), 1)) { mn = m_reg; alpha = 1.f; }
    else { mn = fmaxf(m_reg, pmax); alpha = __builtin_amdgcn_exp2f((m_reg - mn) * C2); m_reg = mn; }
    const float mnL = -mn * C2;
    for (int r = 0; r < 16; ++r) p0[r] = fmaf(p0[r], C2, mnL); for (int r = 0; r < 16; ++r) p1[r] = fmaf(p1[r], C2, mnL);
    for (int r = 0; r < 16; ++r) p0[r] = __builtin_amdgcn_exp2f(p0[r]);
}
__device__ __forceinline__ void finishSM(f32x16& p0, f32x16& p1, float alpha, float& l_reg, bf16x8& pa0, bf16x8& pa1, bf16x8& pa2, bf16x8& pa3) {
    for (int r = 0; r < 16; ++r) p1[r] = __builtin_amdgcn_exp2f(p1[r]);
    float ps = 0; for (int r = 0; r < 16; ++r) ps += p0[r]; for (int r = 0; r < 16; ++r) ps += p1[r];
    { auto rr = __builtin_amdgcn_permlane32_swap(__float_as_uint(ps), __float_as_uint(ps), false, false);
      ps = __uint_as_float(rr[0]) + __uint_as_float(rr[1]); }
    l_reg = l_reg * alpha + ps;
#define PK4(P, B_, OUT) do { unsigned a0 = pk2(P[B_+0], P[B_+1]), a1 = pk2(P[B_+2], P[B_+3]);                          \
        unsigned b0 = pk2(P[B_+4], P[B_+5]), b1 = pk2(P[B_+6], P[B_+7]);                                             \
        auto r0 = __builtin_amdgcn_permlane32_swap(a0, b0, false, false); auto r1 = __builtin_amdgcn_permlane32_swap(a1, b1, false, false); \
        u32x4 w = {r0[0], r1[0], r0[1], r1[1]}; OUT = *reinterpret_cast<bf16x8*>(&w); } while (0)
    PK4(p0, 0, pa0); PK4(p0, 8, pa1); PK4(p1, 0, pa2); PK4(p1, 8, pa3);
#undef PK4
}
template <int KB>
__device__ __forceinline__ void qkt(f32x16& p0, f32x16& p1, const char* K_lds, int r32, int hi, const bf16x8* qr) {
    p0 = f32x16{}; p1 = f32x16{};
    const char* kb[4];
#pragma unroll
    for (int dd = 0; dd < 4; ++dd) kb[dd] = K_lds + KB * SHM_K + KSWZ(r32, (dd * 16 + hi * 8) * 2);
#pragma unroll
    for (int d0 = 0; d0 < 8; ++d0) { const char* a = kb[d0 & 3] + (d0 >> 2) * 128;
        bf16x8 b0 = *reinterpret_cast<const bf16x8*>(a);
        bf16x8 b1 = *reinterpret_cast<const bf16x8*>(a + 32 * 256);
        p0 = __builtin_amdgcn_mfma_f32_32x32x16_bf16(b0, qr[d0], p0, 0, 0, 0);
        p1 = __builtin_amdgcn_mfma_f32_32x32x16_bf16(b1, qr[d0], p1, 0, 0, 0); }
}
template <int VB>
__device__ __forceinline__ void pv_tile(f32x16* o, int vb0, bf16x8 pa0, bf16x8 pa1, bf16x8 pa2, bf16x8 pa3) {
#define TRRD(dst, off) asm volatile("ds_read_b64_tr_b16 %0, %1 offset:%2" : "=&v"(dst) : "v"(vb0), "i"(off) : "memory")
#define PV_D0(d0) do { s16x4 l0, l1, l2, l3, h0, h1, h2, h3; constexpr int b_ = VB * SHM_V + v_rd_off(d0, 0, 0); \
        TRRD(l0, b_); TRRD(h0, b_ + 2048); TRRD(l1, b_ + 4096); TRRD(h1, b_ + 6144); TRRD(l2, b_ + 8192); TRRD(h2, b_ + 10240); TRRD(l3, b_ + 12288); TRRD(h3, b_ + 14336); \
        asm volatile("s_waitcnt lgkmcnt(0)" ::: "memory"); SBAR();   \
        o[d0] = __builtin_amdgcn_mfma_f32_32x32x16_bf16(pa0, (bf16x8){l0[0], l0[1], l0[2], l0[3], h0[0], h0[1], h0[2], h0[3]}, o[d0], 0, 0, 0);   \
        o[d0] = __builtin_amdgcn_mfma_f32_32x32x16_bf16(pa1, (bf16x8){l1[0], l1[1], l1[2], l1[3], h1[0], h1[1], h1[2], h1[3]}, o[d0], 0, 0, 0);   \
        o[d0] = __builtin_amdgcn_mfma_f32_32x32x16_bf16(pa2, (bf16x8){l2[0], l2[1], l2[2], l2[3], h2[0], h2[1], h2[2], h2[3]}, o[d0], 0, 0, 0);   \
        o[d0] = __builtin_amdgcn_mfma_f32_32x32x16_bf16(pa3, (bf16x8){l3[0], l3[1], l3[2], l3[3], h3[0], h3[1], h3[2], h3[3]}, o[d0], 0, 0, 0); } while (0)
    PV_D0(0); PV_D0(1); PV_D0(2); PV_D0(3);
#undef PV_D0
#undef TRRD
}
struct BlockRef { const bf16_t* K; int m0, g, NT, samp; };
__device__ __forceinline__ const bf16_t* ref_q(const BlockRef& r, const unsigned char* ws) { return (const bf16_t*)(ws + WS_Q) + (size_t)r.m0 * QLD + 4 * r.g * D; }
__device__ __forceinline__ unsigned char* ref_o(const BlockRef& r, unsigned char* ws) { return ws + WS_OAL + (size_t)r.m0 * OLD + 4 * r.g * D; }
__device__ __forceinline__ const char* ref_bm(const BlockRef& r, const unsigned char* ws) { return (const char*)(ws + WS_BM) + (size_t)r.m0 * 512; }
struct Seam { bf16x8 qr[8]; bf16x8 st_v0, st_v1, st_k0, st_k1; };
#define ROW(p, k0, rr) ((p) + (size_t)((k0) + (rr)) * KVLD + sc)
#define VMW() asm volatile("s_waitcnt vmcnt(0)" ::: "memory")
#define VMWN(n) asm volatile("s_waitcnt vmcnt(%0)" :: "i"(n) : "memory")
#define SLOAD_H(Kp, Vp, k0) do { S.st_v0 = load8(ROW(Vp, k0, sr)); S.st_v1 = load8(ROW(Vp, k0, 32 + sr));              \
                         S.st_k0 = load8(ROW(Kp, k0, sr)); S.st_k1 = load8(ROW(Kp, k0, 32 + sr)); } while (0)
#define SWRITE_HK(bf) do { *(bf16x8*)(K_lds + (bf) * SHM_K + kws) = S.st_k0; *(bf16x8*)(K_lds + (bf) * SHM_K + kws + 32 * 256) = S.st_k1; } while (0)
#define SWRITE_HV(bf) do { *(bf16x8*)(V_lds + (bf) * SHM_V + vst0) = S.st_v0; *(bf16x8*)(V_lds + (bf) * SHM_V + vst1) = S.st_v1; } while (0)
#define SWRITE_H(bf) do { SWRITE_HV(bf); SWRITE_HK(bf); } while (0)
__device__ __forceinline__ int q_rowoff(int samp, int wid) { return samp ? 0 : 32 * (wid & 1); }
__device__ __forceinline__ int q_headoff(int samp, int wid) { return samp ? (wid & 3) : (wid >> 1); }
__device__ __forceinline__ void attn_prime(const BlockRef& cur, unsigned char* wsb, char* lds, Seam& S, int wv) {
    const int tid = tid_of(wv);
    const int wid = __builtin_amdgcn_readfirstlane(tid >> 6), lane = tid & 63, r32 = lane & 31, hi = lane >> 5;
    const int sr = tid >> 4, sc = (tid & 15) * 8, kws = KSWZ(sr, sc * 2); char* K_lds = lds + 2 * SHM_V;
    const bf16_t* qp = ref_q(cur, wsb) + (size_t)(q_rowoff(cur.samp, wid) + r32) * QLD + q_headoff(cur.samp, wid) * D + hi * 8;
    for (int d0 = 0; d0 < 8; ++d0) S.qr[d0] = load8(qp + d0 * 16);
    SLOAD_H(cur.K, cur.K + 1024, 0); VMW(); SWRITE_HK(0);
    __syncthreads();
}
__device__ __forceinline__ void attn_block(const BlockRef& cur, const BlockRef& nxt, unsigned char* wsb, char* lds, Seam& S, int wv) {
    const int tid = tid_of(wv);
    const int wid = __builtin_amdgcn_readfirstlane(tid >> 6), lane = tid & 63, r32 = lane & 31, hi = lane >> 5;
    const int NT = cur.NT;
    char* V_lds = lds; char* K_lds = lds + 2 * SHM_V;
    float* ws = (float*)(lds + 2 * SHM_V + 2 * SHM_K) + wid * 64; float* li_l = ws, * al_l = ws + 32;
    float m_reg = -1e30f, l_reg = 0; f32x16 o[4] = {};
    const int sr = tid >> 4, sc = (tid & 15) * 8, vst0 = v_st(sr, sc), vst1 = v_st(32 + sr, sc), kws = KSWZ(sr, sc * 2);
    const int vb0 = (int)(uintptr_t)V_lds + v_rd_base(lane);
    const bf16_t* Kh = cur.K; const bf16_t* Vh = cur.K + 1024;
    const int qro = q_rowoff(cur.samp, wid), qho = q_headoff(cur.samp, wid);
    const char* bmb = ref_bm(cur, wsb); const unsigned bmo = (unsigned)(qro + r32) * 512u;
#define BMW(t) (*(const unsigned long long*)(bmb + bmo + (unsigned)(t) * 8u))
#define RESC(a) do { if (__any((a) < 1.f)) { if (hi == 0) al_l[r32] = (a); asm volatile("s_waitcnt lgkmcnt(0)" ::: "memory");              \
                     for (int d_ = 0; d_ < 4; ++d_) for (int r = 0; r < 16; ++r) o[d_][r] *= al_l[crow(r, hi)]; } } while (0)
#define KBASE(t) ((t) * KVBLK)
    f32x16 pA0, pA1, pB0, pB1; float mnA, mnB, alA, alB; bf16x8 pa0, pa1, pa2, pa3;
    SWRITE_HV(0); SBAR();
    if (NT > 1) SLOAD_H(Kh, Vh, KBASE(1));
    const unsigned long long mw0 = BMW(0);
    SBAR(); qkt<0>(pA0, pA1, K_lds, r32, hi, S.qr);
    mask_bits(pA0, pA1, mw0, hi); partialSM(pA0, pA1, m_reg, mnA, alA);
    if (NT > 1) { VMW(); SWRITE_H(1); }
    __syncthreads();
#define HALF_STEP(PX0, PX1, mnX, alX, PY0, PY1, alY, t, KB, VB, SB) do {                                                      \
        SBAR(); qkt<KB>(PX0, PX1, K_lds, r32, hi, S.qr);                                                                      \
        finishSM(PY0, PY1, alY, l_reg, pa0, pa1, pa2, pa3); SBAR();                                                           \
        const unsigned long long mw_ = BMW(t);                                                                               \
        if ((t) + 1 < NT) { SLOAD_H(Kh, Vh, KBASE((t) + 1)); SBAR(); }                                                        \
        pv_tile<VB>(o, vb0, pa0, pa1, pa2, pa3); mask_bits(PX0, PX1, mw_, hi); partialSM(PX0, PX1, m_reg, mnX, alX);         \
        __syncthreads();                                                                                                      \
        if ((t) + 1 < NT) { VMW(); SWRITE_H(SB); }                                                                            \
        RESC(alX); __syncthreads(); } while (0)
    for (int t = 1; t + 1 < NT; t += 2) {
        HALF_STEP(pB0, pB1, mnB, alB, pA0, pA1, alA, t, 1, 0, 0);
        HALF_STEP(pA0, pA1, mnA, alA, pB0, pB1, alB, t + 1, 0, 1, 1);
    }
    const bool even = (NT & 1) == 0;
    unsigned long long mwT = 0ull;
    if (even) { mwT = BMW(NT - 1); SBAR(); qkt<1>(pB0, pB1, K_lds, r32, hi, S.qr); SBAR(); }
    SLOAD_H(nxt.K, nxt.K + 1024, 0); SBAR();
    { const bf16_t* qp = ref_q(nxt, wsb) + (size_t)(q_rowoff(nxt.samp, wid) + r32) * QLD + q_headoff(nxt.samp, wid) * D + hi * 8;
#pragma unroll
      for (int d0 = 0; d0 < 8; ++d0) S.qr[d0] = load8(qp + d0 * 16); }
    SBAR();
    finishSM(pA0, pA1, alA, l_reg, pa0, pa1, pa2, pa3); SBAR();
    pv_tile<0>(o, vb0, pa0, pa1, pa2, pa3);
    if (even) { mask_bits(pB0, pB1, mwT, hi); partialSM(pB0, pB1, m_reg, mnB, alB); __syncthreads(); RESC(alB);
        finishSM(pB0, pB1, alB, l_reg, pa0, pa1, pa2, pa3); SBAR(); pv_tile<1>(o, vb0, pa0, pa1, pa2, pa3); }
    SBAR(); VMWN(8); SWRITE_HK(0); SBAR();
    if (hi == 0) li_l[r32] = l_reg; asm volatile("s_waitcnt lgkmcnt(0)" ::: "memory");
    float rli[16];
#pragma unroll
    for (int r = 0; r < 16; ++r) rli[r] = __builtin_amdgcn_rcpf(li_l[crow(r, hi)]);
    unsigned char* Ow = ref_o(cur, wsb) + (size_t)qro * OLD + qho * D;
    const bool st_ok = !cur.samp || wid < 4;
#pragma unroll
    for (int r = 0; r < 16; ++r) { const int orow = crow(r, hi);
#pragma unroll
        for (int d0 = 0; d0 < 4; ++d0) { const float v = o[d0][r] * (rli[r] * SA_ATT);
            const float vn = __shfl_xor(v, 1);
            const int h2 = __builtin_amdgcn_cvt_pk_fp8_f32(v, vn, 0, false), h4 = __shfl_xor(h2, 2);
            if (st_ok && (r32 & 3) == 0) *(unsigned*)(Ow + (size_t)orow * OLD + d0 * 32 + r32) = ((unsigned)h2 & 0xffffu) | ((unsigned)h4 << 16); } }
    __syncthreads();
#undef RESC
#undef KBASE
#undef HALF_STEP
#undef BMW
}
#undef ROW
#undef VMW
#undef VMWN
#undef SLOAD_H
#undef SWRITE_HK
#undef SWRITE_HV
#undef SWRITE_H
}
__device__ __forceinline__ att::BlockRef attn_item(unsigned char* ws, int i) {
    att::BlockRef r;
    if (i < 128) { const int bs = i >> 3, g = i & 7; r.m0 = NTOK_P + bs * DEC_T; r.g = g; r.K = (const bf16_t*)(ws + WS_KVS) + (size_t)bs * SKV_SP * 2048 + g * HD; r.NT = SKV_SP / 64; r.samp = 1; }
    else { const int j = i - 128, c = 63 - (j >> 4), b = (j >> 3) & 1, g = j & 7; r.m0 = b * SEQ + c * 64; r.g = g; r.K = (const bf16_t*)(ws + WS_KV) + (size_t)b * SEQ * 2048 + g * HD; r.NT = c + 1; r.samp = 0; }
    return r;
}
__device__ __forceinline__ void attn_phase(Frame& F, char* lds) {
    unsigned char* const ws = ws_ptr(F); unsigned* const ctl = (unsigned*)(ws + WS_CTL);
    constexpr int TOTAL = 128 + 1024;
    volatile LAS unsigned* qw = (volatile LAS unsigned*)(F.lds + RING_OFF + att::ATT_LDS - 64);
    __syncthreads(); const unsigned qsel = F.MISC[17]; __syncthreads(); if (F.tid == 0) F.MISC[17] = qsel + 1u;
    unsigned* qhead = ctl + CW_QATT + 64 * qsel;
    if (F.tid == 0) { qw[0] = __hip_atomic_fetch_add(qhead, 1u, __ATOMIC_RELAXED, __HIP_MEMORY_SCOPE_AGENT); qw[1] = __hip_atomic_fetch_add(qhead, 1u, __ATOMIC_RELAXED, __HIP_MEMORY_SCOPE_AGENT); }
    __syncthreads();
    int i0 = (int)qw[0], i1 = (int)qw[1];
    __syncthreads();
    if (i0 < TOTAL) {
        att::BlockRef cur = attn_item(ws, i0);
        att::Seam S;
        att::attn_prime(cur, ws, lds, S, F.wave);
        for (;;) {
            const bool has = i1 < TOTAL;
            const att::BlockRef nxt = has ? attn_item(ws, i1) : cur;
            if (F.tid == 0 && has) qw[0] = __hip_atomic_fetch_add(qhead, 1u, __ATOMIC_RELAXED, __HIP_MEMORY_SCOPE_AGENT);
            att::attn_block(cur, nxt, ws, lds, S, F.wave);
            if (!has) break;
            __syncthreads();
            i1 = (int)qw[0];
            __syncthreads();
            cur = nxt;
        }
    }
    __syncthreads(); conv_drain(F);
}

struct EpiMix {
    static constexpr bool PERM = true, MID = true, FP8 = true;
    LAS unsigned char* lds;
    __device__ __forceinline__ void mid(f32x4 (&acc)[2][2][4][2], const pg8::Unit& u, int wr, int wc, int fr, int fq) const {
        int row0 = u.pm * 256 + wr * 64 + fr, col0 = u.pn * 256 + wc * 32 + 8 * fq;
        asm volatile("" : "+v"(row0), "+v"(col0));
        unsigned char* const ws = e_ws(lds); const bf16_t* SGA = (const bf16_t*)(ws + WS_SGA); const bf16_t* SGL = (const bf16_t*)(ws + WS_SGL);
#pragma unroll
        for (int ai = 0; ai < 2; ++ai) { u32x4 ga[4][2], gl[4][2];
#pragma unroll
            for (int m = 0; m < 4; ++m)
#pragma unroll
                for (int bj = 0; bj < 2; ++bj) { const size_t off = (size_t)(row0 + ai * 128 + m * 16) * DM + col0 + bj * 128; ga[m][bj] = *(const u32x4*)(SGA + off); gl[m][bj] = *(const u32x4*)(SGL + off); }
            asm volatile("" ::: "memory");
#pragma unroll
            for (int m = 0; m < 4; ++m)
#pragma unroll
                for (int bj = 0; bj < 2; ++bj) { float a[8], l[8]; unpack8(ga[m][bj], a); unpack8(gl[m][bj], l);
#pragma unroll
                    for (int e = 0; e < 4; ++e) { acc[ai][bj][m][0][e] *= a[e] * (SA_LRU / SA_ATT) * __builtin_amdgcn_rcpf(l[e]); acc[ai][bj][m][1][e] *= a[4 + e] * (SA_LRU / SA_ATT) * __builtin_amdgcn_rcpf(l[4 + e]); }
                    asm volatile("" : "+v"(acc[ai][bj][m][0]), "+v"(acc[ai][bj][m][1])); }
            asm volatile("" ::: "memory"); }
    }
    __device__ __forceinline__ void operator()(const f32x4 (&acc)[2][2][4][2], const pg8::Unit& u, int wr, int wc, int fr, int fq) const {
        const int row0 = u.pm * 256 + wr * 64 + fr, col0 = u.pn * 256 + wc * 32 + 8 * fq; constexpr float SC = S_MIX / (SA_LRU * SW8);
        unsigned char* const ws = e_ws(lds); const bf16_t* SGL = (const bf16_t*)(ws + WS_SGL); unsigned char* MIX = ws + WS_MIX;
        u32x4 glr[2][4][2];
#pragma unroll
        for (int ai = 0; ai < 2; ++ai)
#pragma unroll
            for (int m = 0; m < 4; ++m)
#pragma unroll
                for (int bj = 0; bj < 2; ++bj) glr[ai][m][bj] = *(const u32x4*)(SGL + (size_t)(row0 + ai * 128 + m * 16) * DM + col0 + bj * 128);
        asm volatile("" ::: "memory");
#pragma unroll
        for (int ai = 0; ai < 2; ++ai)
#pragma unroll
            for (int m = 0; m < 4; ++m)
#pragma unroll
                for (int bj = 0; bj < 2; ++bj) { const size_t off = (size_t)(row0 + ai * 128 + m * 16) * DM + col0 + bj * 128; float gl[8]; unpack8(glr[ai][m][bj], gl);
                    const f32x4 v0 = acc[ai][bj][m][0], v1 = acc[ai][bj][m][1];
                    if (P9_FP8) { u32x2 w; w.x = pk4_fp8(v0[0] * gl[0] * SC, v0[1] * gl[1] * SC, v0[2] * gl[2] * SC, v0[3] * gl[3] * SC); w.y = pk4_fp8(v1[0] * gl[4] * SC, v1[1] * gl[5] * SC, v1[2] * gl[6] * SC, v1[3] * gl[7] * SC);
                        *(u32x2*)(MIX + off) = w; }
                    else { constexpr float S1 = 1.0f / (SA_LRU * SW8); u32x4 w; w.x = pk2(v0[0] * gl[0] * S1, v0[1] * gl[1] * S1); w.y = pk2(v0[2] * gl[2] * S1, v0[3] * gl[3] * S1); w.z = pk2(v1[0] * gl[4] * S1, v1[1] * gl[5] * S1); w.w = pk2(v1[2] * gl[6] * S1, v1[3] * gl[7] * S1);
                        *(u32x4*)((bf16_t*)MIX + off) = w; } }
    }
};
struct EpiOut {
    static constexpr bool PERM = false, MID = false, FP8 = (P9_FP8 != 0);
    LAS unsigned char* lds;
    __device__ __forceinline__ void operator()(const f32x4 (&acc)[2][2][4][2], const pg8::Unit& u, int wr, int wc, int fr, int fq) const {
        unsigned char* const ws = e_ws(lds); const float* xp = e_in(lds, 0); const float* xs = e_in(lds, 1); const float* gf = e_in(lds, 21);
        float* X1 = (float*)(ws + WS_X1); bf16_t* A2 = (bf16_t*)(ws + WS_A2); LAS float* X = (LAS float*)(lds + XCH_OFF);
        const int row0 = u.pm * 256 + wr * 64 + fr, col0 = u.pn * 256 + wc * 32 + 4 * fq;
        const float* xb = (u.pm < NTOK_P / 256) ? xp : xs - (size_t)NTOK_P * DM;
        f32x4 gv[2][2];
#pragma unroll
        for (int bj = 0; bj < 2; ++bj)
#pragma unroll
            for (int n = 0; n < 2; ++n) gv[bj][n] = *(const f32x4*)(gf + col0 + bj * 128 + n * 16);
#pragma unroll
        for (int ai = 0; ai < 2; ++ai) { f32x4 xv[4][2][2];
#pragma unroll
            for (int m = 0; m < 4; ++m)
#pragma unroll
                for (int bj = 0; bj < 2; ++bj)
#pragma unroll
                    for (int n = 0; n < 2; ++n) xv[m][bj][n] = *(const f32x4*)(xb + (size_t)(row0 + ai * 128 + m * 16) * DM + col0 + bj * 128 + n * 16);
            asm volatile("" ::: "memory");
#pragma unroll
            for (int m = 0; m < 4; ++m) { const size_t row = (size_t)(row0 + ai * 128 + m * 16); const size_t off = row * DM + col0; float s = 0.f;
#pragma unroll
                for (int bj = 0; bj < 2; ++bj)
#pragma unroll
                    for (int n = 0; n < 2; ++n) { const f32x4 x1 = xv[m][bj][n] + acc[ai][bj][m][n] * (P9_FP8 ? 1.0f / (S_MIX * SW8) : 1.0f);
                        *(f32x4*)(X1 + off + bj * 128 + n * 16) = x1; s += (x1[0] * x1[0] + x1[1] * x1[1]) + (x1[2] * x1[2] + x1[3] * x1[3]);
                        const f32x4 y = x1 * gv[bj][n]; u32x2 w; w.x = pk2(y[0], y[1]); w.y = pk2(y[2], y[3]); *(u32x2*)(A2 + off + bj * 128 + n * 16) = w; }
                s += __shfl_xor(s, 16); s += __shfl_xor(s, 32);
                if (fq == 0) X[(ai * 128 + wr * 64 + m * 16 + fr) * 4 + wc] = s; }
            asm volatile("" ::: "memory"); }
        asm volatile("s_waitcnt lgkmcnt(0)" ::: "memory"); __builtin_amdgcn_s_barrier(); asm volatile("" ::: "memory");
        { const int t = (wr * 4 + wc) * 64 + (fq * 16 + fr);
          if (t < 256) { const f32x4 p = *(const LAS f32x4*)(X + t * 4); ((float*)(ws + WS_PSSQ))[(size_t)u.pn * MTOK + u.pm * 256 + t] = (p[0] + p[1]) + (p[2] + p[3]); } }
    }
};
struct EpiGU {
    static constexpr bool PERM = true, MID = false, FP8 = false;
    LAS unsigned char* lds;
    __device__ __forceinline__ void operator()(const f32x4 (&acc)[2][2][4][2], const pg8::Unit& u, int wr, int wc, int fr, int fq) const {
        unsigned char* const ws = e_ws(lds); const float* RSTD = (const float*)(ws + WS_CTL) + CW_SSQ; bf16_t* H = (bf16_t*)(ws + WS_H);
        const int row0 = u.pm * 256 + wr * 64 + fr, col0 = u.pn * 128 + wc * 32 + 8 * fq;
        float rs[2][4];
#pragma unroll
        for (int ai = 0; ai < 2; ++ai)
#pragma unroll
            for (int m = 0; m < 4; ++m) rs[ai][m] = RSTD[row0 + ai * 128 + m * 16];
        asm volatile("" ::: "memory");
#pragma unroll
        for (int ai = 0; ai < 2; ++ai)
#pragma unroll
            for (int m = 0; m < 4; ++m) { const size_t row = (size_t)(row0 + ai * 128 + m * 16);
                const float rstd = rs[ai][m]; float hv[8];
#pragma unroll
                for (int n = 0; n < 2; ++n)
#pragma unroll
                    for (int e = 0; e < 4; ++e) { const float g = acc[ai][0][m][n][e] * rstd, up = acc[ai][1][m][n][e] * rstd; hv[4 * n + e] = g * sigmoidf_(g) * up; }
                *(u32x4*)(H + row * DFF + col0) = pack8f(hv); }
    }
};
struct EpiDown {
    static constexpr bool PERM = false, MID = false, FP8 = false;
    LAS unsigned char* lds;
    __device__ __forceinline__ void operator()(const f32x4 (&acc)[2][2][4][2], const pg8::Unit& u, int wr, int wc, int fr, int fq) const {
        const float* X1 = (const float*)(e_ws(lds) + WS_X1); float* Y = e_out(lds);
        const int row0 = u.pm * 256 + wr * 64 + fr, col0 = u.pn * 256 + wc * 32 + 4 * fq;
#pragma unroll
        for (int ai = 0; ai < 2; ++ai) { f32x4 xv[4][2][2];
#pragma unroll
            for (int m = 0; m < 4; ++m)
#pragma unroll
                for (int bj = 0; bj < 2; ++bj)
#pragma unroll
                    for (int n = 0; n < 2; ++n) xv[m][bj][n] = *(const f32x4*)(X1 + (size_t)(row0 + ai * 128 + m * 16) * DM + col0 + bj * 128 + n * 16);
            asm volatile("" ::: "memory");
#pragma unroll
            for (int m = 0; m < 4; ++m)
#pragma unroll
                for (int bj = 0; bj < 2; ++bj)
#pragma unroll
                    for (int n = 0; n < 2; ++n) *(f32x4*)(Y + (size_t)(row0 + ai * 128 + m * 16) * DM + col0 + bj * 128 + n * 16) = xv[m][bj][n] + acc[ai][bj][m][n];
            asm volatile("" ::: "memory"); }
    }
};

__device__ __forceinline__ f32x4 part_sum(const float* PART, int tile, int s0, int s1, int rr, int cc) {
    f32x4 a = {0.f, 0.f, 0.f, 0.f};
#pragma unroll
    for (int s = 0; s < 8; ++s) if (s >= s0 && s < s1) a += *(const f32x4*)(PART + ((size_t)(tile * 8 + s) * 65536 + (size_t)rr * 256 + cc));
    return a;
}
__device__ __forceinline__ void reduce_mix(Frame& F) {
    unsigned char* const ws = ws_ptr(F); const float* PART = (const float*)(ws + WS_PART);
    const bf16_t* SGA = (const bf16_t*)(ws + WS_SGA); const bf16_t* SGL = (const bf16_t*)(ws + WS_SGL); unsigned char* MIX = ws + WS_MIX;
    for (int it = F.gw * 64 + F.lane; it < NTOK_S * 1024; it += F.NGW * 64) { const int r = it >> 10, col = 4 * (it & 1023), tile = (r >> 8) * 16 + (col >> 8), rr = r & 255, cc = col & 255;
        const f32x4 sA = part_sum(PART, tile, 0, 4, rr, cc), sL = part_sum(PART, tile, 4, 8, rr, cc);
        const size_t off = (size_t)(NTOK_P + r) * DM + col; const u32x2 ga = *(const u32x2*)(SGA + off), gl = *(const u32x2*)(SGL + off);
        constexpr float CA = (P9_FP8 ? S_MIX : 1.0f) / (SA_ATT * SW8), CL = (P9_FP8 ? S_MIX : 1.0f) / (SA_LRU * SW8);
        const float m0 = bflo(ga.x) * sA[0] * CA + bflo(gl.x) * sL[0] * CL, m1 = bfhi(ga.x) * sA[1] * CA + bfhi(gl.x) * sL[1] * CL, m2 = bflo(ga.y) * sA[2] * CA + bflo(gl.y) * sL[2] * CL, m3 = bfhi(ga.y) * sA[3] * CA + bfhi(gl.y) * sL[3] * CL;
        if (P9_FP8) *(unsigned*)(MIX + off) = pk4_fp8(m0, m1, m2, m3); else *(u32x2*)((bf16_t*)MIX + off) = (u32x2){pk2(m0, m1), pk2(m2, m3)}; }
}
__device__ __forceinline__ void reduce_out(Frame& F, bool tail) {
    unsigned char* const ws = ws_ptr(F); const float* PART = (const float*)(ws + WS_PART); const float* xs = in_ptr(F, 1); const float* gf = in_ptr(F, 21);
    float* X1 = (float*)(ws + WS_X1); bf16_t* A2 = (bf16_t*)(ws + WS_A2); float* RSTD = (float*)(ctl_ptr(F) + CW_SSQ); const float* PSSQ = (const float*)(ws + WS_PSSQ);
    for (int r = F.gw * 64 + F.lane; r < (tail ? NTOK_P : MTOK); r += F.NGW * 64) { float ss = 0.f;
#pragma unroll
        for (int j = 0; j < 16; ++j) ss += PSSQ[(size_t)j * MTOK + r];
        RSTD[r] = 1.0f / sqrtf(ss * (1.0f / DM) + EPS); }
    if (tail) for (int r = F.gw; r < NTOK_S; r += F.NGW) { float ss = 0.f;
#pragma unroll 4
        for (int j = 0; j < 16; ++j) { const int col = 4 * F.lane + 256 * j, tile = (r >> 8) * 16 + j, rr = r & 255, cc = 4 * F.lane;
            const f32x4 x1 = *(const f32x4*)(xs + (size_t)r * DM + col) + part_sum(PART, tile, 0, 8, rr, cc) * (P9_FP8 ? 1.0f / (S_MIX * SW8) : 1.0f); const f32x4 gg = *(const f32x4*)(gf + col);
            const size_t off = (size_t)(NTOK_P + r) * DM + col; *(f32x4*)(X1 + off) = x1; ss += (x1[0] * x1[0] + x1[1] * x1[1]) + (x1[2] * x1[2] + x1[3] * x1[3]);
            u32x2 o; o.x = pk2(x1[0] * gg[0], x1[1] * gg[1]); o.y = pk2(x1[2] * gg[2], x1[3] * gg[3]); *(u32x2*)(A2 + off) = o; }
        ss = wave_sum(ss);
        if (F.lane == 0) RSTD[NTOK_P + r] = 1.0f / sqrtf(ss * (1.0f / DM) + EPS); }
}
__device__ __forceinline__ void reduce_down(Frame& F) {
    unsigned char* const ws = ws_ptr(F); const float* PART = (const float*)(ws + WS_PART); const float* X1 = (const float*)(ws + WS_X1); float* Y = out_ptr(F);
    for (int it = F.gw * 64 + F.lane; it < NTOK_S * 1024; it += F.NGW * 64) { const int r = it >> 10, col = 4 * (it & 1023), tile = (r >> 8) * 16 + (col >> 8), rr = r & 255, cc = col & 255;
        const size_t off = (size_t)(NTOK_P + r) * DM + col;
        *(f32x4*)(Y + off) = *(const f32x4*)(X1 + off) + part_sum(PART, tile, 0, 8, rr, cc); }
}

__device__ __forceinline__ void reduce_gu(Frame& F) {
    unsigned char* const ws = ws_ptr(F); const float* PART = (const float*)(ws + WS_PART); const float* RSTD = (const float*)(ws + WS_CTL) + CW_SSQ; bf16_t* H = (bf16_t*)(ws + WS_H);
    constexpr int nM = MTOK / 256, nN = 2 * DFF / 256, NW = nM * nN, RF = NW / 256, REM = NW - RF * 256;
    for (int it = F.gw * 64 + F.lane; it < REM * 256 * 32; it += F.NGW * 64) { const int t = it >> 13, rr = (it >> 5) & 255, cc = 4 * (it & 31);
        int pm, pn; pg8::map_unit(RF * 256 + t, nM, nN, pm, pn);
        const float* p0 = PART + (size_t)(2 * t) * 65536 + (size_t)rr * 256 + cc; const float* p1 = p0 + 65536;
        const f32x4 g = *(const f32x4*)p0 + *(const f32x4*)p1, u = *(const f32x4*)(p0 + 128) + *(const f32x4*)(p1 + 128);
        const size_t row = (size_t)pm * 256 + rr; const float rstd = RSTD[row];
        float h[4];
#pragma unroll
        for (int e = 0; e < 4; ++e) { const float gg = g[e] * rstd; h[e] = gg * sigmoidf_(gg) * (u[e] * rstd); }
        *(u32x2*)(H + row * DFF + pn * 128 + cc) = (u32x2){pk2(h[0], h[1]), pk2(h[2], h[3])}; }
}

__global__ void __launch_bounds__(NTHR, 2) fwd_kernel(Args args) {
    extern __shared__ __attribute__((aligned(16))) unsigned char lds_raw[];
    LAS unsigned char* const ldsb = (LAS unsigned char*)lds_raw;
    int wv0 = __builtin_amdgcn_readfirstlane((int)(threadIdx.x >> 6)); asm volatile("" : "+s"(wv0));
    Frame F = make_frame(ldsb, wv0);
    for (int u = F.tid; u < (LDS_BYTES - LDSCTL_OFF) / 4; u += NTHR) ((LAS unsigned*)(F.lds + LDSCTL_OFF))[u] = 0u;
    __syncthreads();
    if (F.tid == 0) { volatile LAS unsigned* p = (volatile LAS unsigned*)(F.lds + PTR_OFF);
#pragma unroll
        for (int i = 0; i < 25; ++i) { const unsigned long long v = (unsigned long long)args.in[i]; p[2 * i] = (unsigned)v; p[2 * i + 1] = (unsigned)(v >> 32); }
        { const unsigned long long v = (unsigned long long)args.out; p[50] = (unsigned)v; p[51] = (unsigned)(v >> 32); }
        { const unsigned long long v = (unsigned long long)args.ws; p[52] = (unsigned)v; p[53] = (unsigned)(v >> 32); } }
    __syncthreads();
    XcdBarrier bar = xcd_barrier_post(ctl_ptr(F) + CW_BAR, F.MISC + 8, wv0);

#define REP(n, ...) do { __VA_ARGS__; if constexpr ((DBL >> (n)) & 1) { xcd_barrier(bar); __VA_ARGS__; } } while (0)
#define GEMM_PHASE_C(EPI, AOFF, BOFF, LDA, LDB, KK, NN, BD, TAIL, CIDX) do { F = make_frame(ldsb, wv0); unsigned char* const ws = ws_ptr(F); \
        pg8::Gemm g{ws, (AOFF), (BOFF), (LDA), (LDB), (KK)}; pg8::StaticOrder S; S.init(MTOK, (NN), (KK), F.G, (CIDX), (BD), (TAIL)); \
        EPI E{F.lds}; pg8::gemm_phase<EPI, pg8::StaticOrder>(F.lds + RING_OFF, g, S, E, F.wave); } while (0)
#define GEMM_PHASE(EPI, AOFF, BOFF, LDA, LDB, KK, NN, BD, TAIL) GEMM_PHASE_C(EPI, AOFF, BOFF, LDA, LDB, KK, NN, BD, TAIL, (int)blockIdx.x)
    REP(0, F = make_frame(ldsb, wv0); p0_prologue(F));
    xcd_barrier(bar);
    REP(1, GEMM_PHASE(EpiProjA, WS_XN, WS_WI, DM, DM, DM, 41 * 256, 0, 0));
    REP(13, GEMM_PHASE_C(EpiProjB, WS_XN8, WS_WI8, DM / 2, DM / 2, DM / 2, 64 * 256, 0, 0, (int)(gridDim.x - 1 - blockIdx.x)));
    xcd_barrier(bar);
    REP(2, F = make_frame(ldsb, wv0); p2_phase(F));
    xcd_barrier(bar);
    REP(3, GEMM_PHASE(EpiGates, WS_U, WS_WG, DM, 256, 256, 32 * 256, 1, 0));
    REP(10, F = make_frame(ldsb, wv0); idx_phase(F));
    xcd_barrier(bar);
    REP(4, F = make_frame(ldsb, wv0); scan_summaries(F));
    REP(11, F = make_frame(ldsb, wv0); select_phase(F));
    xcd_barrier(bar);
    REP(5, F = make_frame(ldsb, wv0); scan_apply(F));
    REP(12, F = make_frame(ldsb, wv0); attn_phase(F, (char*)lds_raw + RING_OFF));
    xcd_barrier(bar);
    REP(6, GEMM_PHASE(EpiMix, WS_OAL, WS_WB, DM, DM, DM, DM, 0, 1));
    xcd_barrier(bar);
    if (gridDim.x == 256) { F = make_frame(ldsb, wv0); reduce_mix(F); xcd_barrier(bar); }
    GEMM_PHASE(EpiOut, WS_MIX, WS_WO, (P9_FP8 ? DM / 2 : DM), (P9_FP8 ? DM / 2 : DM), (P9_FP8 ? DM / 2 : DM), DM, 0, 1);
    xcd_barrier(bar);
    F = make_frame(ldsb, wv0); reduce_out(F, gridDim.x == 256); xcd_barrier(bar);
    REP(8, GEMM_PHASE(EpiGU, WS_A2, WS_WGU, DM, DM, DM, 2 * DFF, 0, 2));
    xcd_barrier(bar);
    if (gridDim.x == 256) { F = make_frame(ldsb, wv0); reduce_gu(F); xcd_barrier(bar); }
    REP(9, GEMM_PHASE(EpiDown, WS_H, WS_WD, DFF, DFF, DFF, DM, 0, 1));
    if (gridDim.x == 256) { xcd_barrier(bar); F = make_frame(ldsb, wv0); reduce_down(F); }
#undef REP
#undef GEMM_PHASE
#undef GEMM_PHASE_C
}

extern "C" void kernel_launch(void* const* d_in, const int* in_sizes, int n_in, void* d_out, int out_size, void* d_ws, size_t ws_size, hipStream_t stream) {
    static int grid = 0;
    if (grid == 0) {
        if (n_in != 25 || out_size != (int)O_END || ws_size < WS_END) { fprintf(stderr, "kernel_launch: unexpected shapes (n_in %d, out %d, ws %zu; need ws >= %zu); nothing launched\n", n_in, out_size, ws_size, (size_t)WS_END); grid = -1; return; }
        int dev = 0, cus = 0, per_cu = 0;
        if (hipGetDevice(&dev) != hipSuccess || hipDeviceGetAttribute(&cus, hipDeviceAttributeMultiprocessorCount, dev) != hipSuccess) { fprintf(stderr, "kernel_launch: device query failed\n"); grid = -1; return; }
        if (hipFuncSetAttribute((const void*)fwd_kernel, hipFuncAttributeMaxDynamicSharedMemorySize, LDS_BYTES) != hipSuccess) { fprintf(stderr, "kernel_launch: hipFuncSetAttribute failed\n"); grid = -1; return; }
        if (hipOccupancyMaxActiveBlocksPerMultiprocessor(&per_cu, (const void*)fwd_kernel, NTHR, LDS_BYTES) != hipSuccess || per_cu < 1) { fprintf(stderr, "kernel_launch: occupancy query reports %d blocks per CU\n", per_cu); }
        (void)hipGetLastError();
        grid = cus;
    }
    if (grid < 0) return;
    if (hipMemsetAsync((char*)d_ws + WS_CTL, 0, CTL_BYTES, stream) != hipSuccess) { fprintf(stderr, "kernel_launch: memset failed\n"); return; }
    Args a{};
    for (int i = 0; i < 25; ++i) a.in[i] = (const float*)d_in[i];
    a.out = (float*)d_out; a.ws = (unsigned char*)d_ws;
    hipLaunchKernelGGL(fwd_kernel, dim3(grid), dim3(NTHR), LDS_BYTES, stream, a);
    const hipError_t le = hipPeekAtLastError();
    if (le != hipSuccess) fprintf(stderr, "kernel_launch: launch failed: %s\n", hipGetErrorName(le));
}
```

```cpp
#include <hip/hip_runtime.h>
#include <cstdio>
#include <cstdint>

#ifndef DBL
#define DBL 0
#endif
#ifndef P9_FP8
#define P9_FP8 1
#endif
#ifndef FP8_MX
#define FP8_MX 2
#endif
#define LAS __attribute__((address_space(3)))
#define GAS __attribute__((address_space(1)))
typedef unsigned short bf16_t;
typedef short bf16x8 __attribute__((ext_vector_type(8)));
typedef float f32x4 __attribute__((ext_vector_type(4)));
typedef float f32x2 __attribute__((ext_vector_type(2)));
typedef float f32x16 __attribute__((ext_vector_type(16)));
typedef unsigned u32x4 __attribute__((ext_vector_type(4)));
typedef unsigned u32x2 __attribute__((ext_vector_type(2)));
typedef int i32x8 __attribute__((ext_vector_type(8)));

constexpr int DM = 4096, SEQ = 4096, NB_P = 2, NTOK_P = NB_P * SEQ, DEC_B = 16, DEC_T = 32, NTOK_S = DEC_B * DEC_T, MTOK = NTOK_P + NTOK_S;
constexpr int PAST = 2048, SKV_S = PAST + DEC_T, SKV_SP = 2112;
constexpr int NH = 32, NKVH = 8, HD = 128, KVW = NKVH * HD, IDXH = 32, IDXD = 128;
constexpr int DFF = 11008, TOPK = 256;
constexpr int N1 = 105 * 256;
constexpr int N1_SRC = 26784;
constexpr float EPS = 1e-6f;
static_assert(MTOK % 256 == 0 && DFF % 128 == 0, "tiling");

constexpr size_t O_YP = 0, O_YS = O_YP + (size_t)NTOK_P * DM, O_KP = O_YS + (size_t)NTOK_S * DM, O_VP = O_KP + (size_t)NTOK_P * KVW, O_IKP = O_VP + (size_t)NTOK_P * KVW,
                 O_LRUP = O_IKP + (size_t)NTOK_P * IDXD, O_CONVP = O_LRUP + (size_t)NB_P * DM, O_KS = O_CONVP + (size_t)NB_P * 3 * DM, O_VS = O_KS + (size_t)NTOK_S * KVW,
                 O_IKS = O_VS + (size_t)NTOK_S * KVW, O_LRUS = O_IKS + (size_t)NTOK_S * IDXD, O_CONVS = O_LRUS + (size_t)DEC_B * DM, O_END = O_CONVS + (size_t)DEC_B * 3 * DM;
static_assert(O_END == 54886400, "output size");

constexpr size_t al256(size_t x) { return (x + 255) & ~(size_t)255; }
constexpr size_t SZ_ACT = (size_t)MTOK * DM * 2;
constexpr size_t WS_CTL = 0, CTL_BYTES = 1u << 20;
constexpr size_t WS_ROPE = WS_CTL + CTL_BYTES;
constexpr size_t WS_WI = WS_ROPE + (size_t)4096 * 16 * 8;
constexpr size_t WS_WI8 = WS_WI + (size_t)41 * 256 * DM * 2;
constexpr size_t WS_XN8 = WS_WI8 + (size_t)64 * 256 * DM;
static_assert(WS_XN8 + (size_t)MTOK * DM <= WS_WI + (size_t)N1 * DM * 2, "WI region");
constexpr size_t WS_WB = WS_WI + (size_t)N1 * DM * 2;
constexpr size_t WS_WO = WS_WB + (size_t)DM * 2 * DM * 2;
constexpr size_t WS_WGU = WS_WO + (size_t)DM * DM * 2;
constexpr size_t WS_WD = WS_WGU + (size_t)2 * DFF * DM * 2;
constexpr size_t WS_WG = WS_WD + (size_t)DM * DFF * 2;
constexpr size_t WS_XN = WS_WG + (size_t)16 * 512 * 256 * 2;
constexpr size_t WS_Q = WS_XN + SZ_ACT;
constexpr size_t WS_IQ = WS_Q + SZ_ACT;
constexpr size_t WS_XL = WS_IQ + SZ_ACT;
constexpr size_t WS_GY = WS_XL + SZ_ACT;
constexpr size_t WS_SGA = WS_GY + SZ_ACT;
constexpr size_t WS_SGL = WS_SGA + SZ_ACT;
constexpr size_t WS_KV = WS_SGL + SZ_ACT;
constexpr size_t WS_IWK = WS_KV + (size_t)MTOK * 2048 * 2;
constexpr size_t WS_IKB = WS_IWK + (size_t)MTOK * 256 * 2;
constexpr size_t WS_IWF = WS_IKB + (size_t)MTOK * 128 * 2;
constexpr size_t WS_KVS = WS_IWF + (size_t)MTOK * 32 * 4;
constexpr size_t WS_IKS = WS_KVS + (size_t)DEC_B * SKV_SP * 2048 * 2;
constexpr size_t WS_SC = WS_IKS + (size_t)DEC_B * SKV_SP * 128 * 2;
constexpr size_t WS_SCS = WS_SC + (size_t)NTOK_P * SEQ * 4;
constexpr size_t WS_BM = WS_SCS + (size_t)NTOK_S * SKV_SP * 4;
constexpr size_t WS_AB = WS_BM + (size_t)MTOK * 512;
constexpr size_t WS_SUM = WS_AB + (size_t)MTOK * DM * 4;
constexpr size_t WS_OAL = WS_SUM + (size_t)128 * DM * 8;
constexpr size_t WS_END = WS_OAL + 2 * SZ_ACT;
constexpr size_t WS_PSSQ = WS_SUM;
constexpr size_t WS_H = WS_Q, WS_U = WS_XN, WS_MIX = WS_XN, WS_X1 = WS_AB, WS_A2 = WS_SC, WS_PART = WS_SC + SZ_ACT;
static_assert(WS_PART + (size_t)256 * 65536 * 4 <= WS_BM, "partial slots");
static_assert((size_t)MTOK * DFF * 2 <= 3 * SZ_ACT, "H overlay");
static_assert(WS_END <= (size_t)4 * 109707264 * 4, "workspace");

constexpr int CW_BAR = 0;
constexpr int CW_QATT = 4096;
constexpr int CW_QIDX = 4096 + 256;
constexpr int CW_SSQ = 8192;
static_assert((CW_SSQ + 2 * MTOK) * 4 <= (int)CTL_BYTES, "ctl");

__device__ __forceinline__ unsigned pk2(float lo, float hi) { unsigned r; asm volatile("v_cvt_pk_bf16_f32 %0, %1, %2" : "=v"(r) : "v"(lo), "v"(hi)); return r; }
__device__ __forceinline__ float bflo(unsigned w) { return __uint_as_float(w << 16); }
__device__ __forceinline__ float bfhi(unsigned w) { return __uint_as_float(w & 0xffff0000u); }
__device__ __forceinline__ float bf1(bf16_t b) { return __uint_as_float((unsigned)b << 16); }
__device__ __forceinline__ void unpack8(u32x4 w, float (&v)[8]) { v[0] = bflo(w.x); v[1] = bfhi(w.x); v[2] = bflo(w.y); v[3] = bfhi(w.y); v[4] = bflo(w.z); v[5] = bfhi(w.z); v[6] = bflo(w.w); v[7] = bfhi(w.w); }
__device__ __forceinline__ u32x4 pack8f(const float (&v)[8]) { u32x4 w; w.x = pk2(v[0], v[1]); w.y = pk2(v[2], v[3]); w.z = pk2(v[4], v[5]); w.w = pk2(v[6], v[7]); return w; }
__device__ __forceinline__ float sigmoidf_(float x) { return __builtin_amdgcn_rcpf(1.0f + __builtin_amdgcn_exp2f(-1.4426950408889634f * x)); }
__device__ __forceinline__ float gelu_tanh_(float x) {
    const float u = x * (1.0f + 0.044715f * x * x); return x * __builtin_amdgcn_rcpf(1.0f + __builtin_amdgcn_exp2f(-2.0f * 0.7978845608028654f * 1.4426950408889634f * u)); }
constexpr float SW8 = 64.f, SA_ATT = 8.f, SA_LRU = 4.f, S_MIX = 8.f, SXN = 4.f;
__device__ __forceinline__ unsigned pk4_fp8(float a, float b, float c, float d) { int w = __builtin_amdgcn_cvt_pk_fp8_f32(a, b, 0, false); w = __builtin_amdgcn_cvt_pk_fp8_f32(c, d, w, true); return (unsigned)w; }
#define LDS_WAIT() asm volatile("s_waitcnt lgkmcnt(0)" ::: "memory")
#define VM_WAIT() asm volatile("s_waitcnt vmcnt(0)" ::: "memory")

__device__ __forceinline__ int tid_of(int wv) { int l; asm volatile("v_mbcnt_lo_u32_b32 %0, -1, 0\n\tv_mbcnt_hi_u32_b32 %0, -1, %0" : "=v"(l)); return (wv << 6) | l; }
namespace pg8 {
typedef int i32x4_ __attribute__((ext_vector_type(4)));
constexpr int BM = 256, BK = 64, HALF = 128, HTB = HALF * BK * 2, STAGE_BYTES = 8 * HTB, NXCD = 8, WGM = 4;
__host__ __device__ __forceinline__ int lds_byte(int r, int c) { const int st = (r >> 4) * 2 + (c >> 5), rr = r & 15, cc = c & 31, ob = rr * 64 + cc * 2; return st * 1024 + (ob ^ (((ob >> 9) & 1) << 5)); }
__host__ __device__ __forceinline__ void stage_rc(int b, int& R, int& C) { const int st = b / 1024, sb = b % 1024, swz = sb ^ (((sb >> 9) & 1) << 5); R = (st >> 1) * 16 + swz / 64; C = (st & 1) * 32 + (swz % 64) / 2; }
__host__ __device__ __forceinline__ int perm32(int rho) { const int n = rho >> 4, i = rho & 15; return 8 * (i >> 2) + 4 * n + (i & 3); }

struct Unit { int pm, pn, acol, bcol, nt, part; };
struct Gemm { unsigned char* ws; size_t a_off, b_off; int lda, ldb, K; };

__device__ __forceinline__ void map_unit(int L, int nM, int nN, int& pm, int& pn) {
    const int nwg = nM * nN; int wgid = L; { const int q = nwg / NXCD, r = nwg % NXCD, xcd = wgid % NXCD, off = wgid / NXCD; wgid = (xcd < r ? xcd * (q + 1) : r * (q + 1) + (xcd - r) * q) + off; }
    const int nig = WGM * nN, gid = wgid / nig, fm = gid * WGM, gsz = (nM - fm) < WGM ? (nM - fm) : WGM;
    pm = fm + ((wgid % nig) % gsz); pn = (wgid % nig) / gsz;
}
struct StaticOrder {
    int nM, nN, nwg, G, c, blockdiag, ntk, tail;
    __device__ void init(int M, int N, int K, int G_, int c_, int bd = 0, int tail_ = 0) { tail = (G_ == 256) ? tail_ : 0; nM = M / BM - (tail == 1 ? 2 : 0); nN = N / BM; nwg = nM * nN; G = G_; c = c_; blockdiag = bd; ntk = K / BK; }
    __device__ bool next(int i, Unit& u) const {
        const long L = (long)i * G + c; const int rfull = nwg / G;
        const bool t2 = (tail == 2 && i >= rfull);
        const bool tl = (L >= nwg) && !t2;
        if (tl && (tail != 1 || i != rfull)) return false;
        if (t2 && (i > rfull || c >= 2 * (nwg - rfull * G))) return false;
        int pm0, pn0; map_unit(t2 ? rfull * G + (c >> 1) : (tl ? 0 : (int)L), nM, nN, pm0, pn0);
        const int tile = c >> 3, sp = c & 7, npair = ntk >> 1, base = npair >> 3, rem = npair & 7, p0 = sp * base + (sp < rem ? sp : rem), np = base + (sp < rem ? 1 : 0);
        const int pm = tl ? nM + (tile >> 4) : pm0, pn = tl ? (tile & 15) : pn0;
        const int koff = tl ? p0 * 2 * BK : (t2 ? (c & 1) * (ntk >> 1) * BK : 0);
        const int ac = koff + ((!tl && blockdiag) ? 256 * (pn0 >> 1) : 0);
        u = Unit{pm, pn, ac, koff, tl ? 2 * np : (t2 ? (ntk >> 1) : ntk), (tl || t2) ? c : -1};
        return true;
    }
};

template <class Epi, class Sched>
__device__ __forceinline__ void gemm_phase(LAS unsigned char* lds, const Gemm g, const Sched& S, const Epi& E, int wv) {
    const int tid = tid_of(wv);
    const int wid = __builtin_amdgcn_readfirstlane(tid >> 6), lane = tid & 63, wr = wid >> 2, wc = wid & 3, fr = lane & 15, fq = lane >> 4;
    unsigned voffA[2], voffB[2];
#pragma unroll
    for (int i = 0; i < 2; ++i) { int R, C; stage_rc(tid * 16 + i * 8192, R, C); const int Rb = Epi::PERM ? ((R & ~31) + perm32(R & 31)) : R;
        voffA[i] = (unsigned)(R * g.lda + C) * 2u; voffB[i] = (unsigned)(Rb * g.ldb + C) * 2u; }
    const size_t kstep = (size_t)(BK * 2);
    const size_t hstepA = (size_t)HALF * g.lda * 2, hstepB = (size_t)HALF * g.ldb * 2;
    const size_t tstepA = 2 * hstepA, tstepB = 2 * hstepB;
    const unsigned ldsw = (unsigned)wid * 1024u;
    constexpr bool FP8 = Epi::FP8;
    const int aoff = lds_byte(wr * 64 + fr, FP8 ? fq * 16 : fq * 8), boff = lds_byte(wc * 32 + fr, FP8 ? fq * 16 : fq * 8);
#define PG8_SA(b, h) (((b) * 2 + (h)) * HTB)
#define PG8_SB(b, h) ((4 + (b) * 2 + (h)) * HTB)
#define PG8_STAGE(bufoff, gbase, voff) do { _Pragma("unroll") for (int _i = 0; _i < 2; ++_i) \
        __builtin_amdgcn_global_load_lds((const unsigned*)((const char*)(gbase) + (voff)[_i]), (LAS unsigned*)(lds + (bufoff) + ldsw + _i * 8192), 16, 0, 0); } while (0)
#define PG8_P64(v, j) ((long)(((unsigned long)(unsigned)(v)[2 * (j) + 1] << 32) | (unsigned long)(unsigned)(v)[2 * (j)]))
#define PG8_LD32(p) __builtin_shufflevector(*(const LAS i32x4_*)(p), *(const LAS i32x4_*)((p) + 16), 0, 1, 2, 3, 4, 5, 6, 7)
#define PG8_LDA(dst, b, h) do { if constexpr (FP8) { _Pragma("unroll") for (int m = 0; m < 4; ++m) dst##8[m] = PG8_LD32(lds + PG8_SA(b, h) + aoff + m * 2048); } \
        else { _Pragma("unroll") for (int m = 0; m < 4; ++m) _Pragma("unroll") for (int k = 0; k < 2; ++k) dst[m][k] = *(const LAS bf16x8*)(lds + PG8_SA(b, h) + aoff + m * 2048 + k * 1024); } } while (0)
#define PG8_LDB(dst, b, h) do { if constexpr (FP8) { _Pragma("unroll") for (int n = 0; n < 2; ++n) dst##8[n] = PG8_LD32(lds + PG8_SB(b, h) + boff + n * 2048); } \
        else { _Pragma("unroll") for (int n = 0; n < 2; ++n) _Pragma("unroll") for (int k = 0; k < 2; ++k) dst[n][k] = *(const LAS bf16x8*)(lds + PG8_SB(b, h) + boff + n * 2048 + k * 1024); } } while (0)
#define PG8_MMA(ai, bj, At, Bt) do { __builtin_amdgcn_s_setprio(1); _Pragma("unroll") for (int m = 0; m < 4; ++m) _Pragma("unroll") for (int n = 0; n < 2; ++n) { \
        if constexpr (FP8 && FP8_MX == 2) asm volatile("v_mfma_f32_16x16x128_f8f6f4 %0, %1, %2, %0" : "+v"(acc[ai][bj][m][n]) : "v"(Bt##8[n]), "v"(At##8[m])); \
        else if constexpr (FP8 && FP8_MX == 1) acc[ai][bj][m][n] = __builtin_amdgcn_mfma_scale_f32_16x16x128_f8f6f4(Bt##8[n], At##8[m], acc[ai][bj][m][n], 0, 0, 0, 0, 0, 0); \
        else if constexpr (FP8) { _Pragma("unroll") for (int j = 0; j < 4; ++j) acc[ai][bj][m][n] = __builtin_amdgcn_mfma_f32_16x16x32_fp8_fp8(PG8_P64(Bt##8[n], j), PG8_P64(At##8[m], j), acc[ai][bj][m][n], 0, 0, 0); } \
        else { _Pragma("unroll") for (int k = 0; k < 2; ++k) acc[ai][bj][m][n] = __builtin_amdgcn_mfma_f32_16x16x32_bf16(Bt[n][k], At[m][k], acc[ai][bj][m][n], 0, 0, 0); } } __builtin_amdgcn_s_setprio(0); } while (0)
#define PG8_WAIT_V(n) asm volatile("s_waitcnt vmcnt(" #n ")" ::: "memory")
#define PG8_WAIT_L(n) asm volatile("s_waitcnt lgkmcnt(" #n ")" ::: "memory")
#define PG8_BAR __builtin_amdgcn_s_barrier()
#define PG8_SCHED __builtin_amdgcn_sched_barrier(0)
    Unit cur, nxt; int ui = 0;
    if (!S.next(0, cur)) return;
    f32x4 acc[2][2][4][2];
#pragma unroll
    for (int a = 0; a < 2; ++a)
#pragma unroll
        for (int b = 0; b < 2; ++b)
#pragma unroll
            for (int m = 0; m < 4; ++m)
#pragma unroll
                for (int n = 0; n < 2; ++n) acc[a][b][m][n] = (f32x4){0.f, 0.f, 0.f, 0.f};
    bf16x8 At[4][2], B0[2][2], B1[2][2]; i32x8 At8[4], B08[2], B18[2];
    const char* cA = (const char*)g.ws + g.a_off + (size_t)cur.pm * tstepA + (size_t)cur.acol * 2; const char* cB = (const char*)g.ws + g.b_off + (size_t)cur.pn * tstepB + (size_t)cur.bcol * 2;
    PG8_STAGE(PG8_SB(0, 0), cB, voffB); PG8_STAGE(PG8_SB(0, 1), cB + hstepB, voffB); PG8_STAGE(PG8_SA(0, 0), cA, voffA); PG8_STAGE(PG8_SA(0, 1), cA + hstepA, voffA);
    if (wr == 1) PG8_BAR;
    PG8_WAIT_V(2); PG8_BAR;
    PG8_STAGE(PG8_SB(1, 0), cB + kstep, voffB); PG8_STAGE(PG8_SA(1, 0), cA + kstep, voffA); PG8_STAGE(PG8_SB(1, 1), cB + hstepB + kstep, voffB);
    PG8_WAIT_V(6); PG8_BAR;
    for (;;) {
        const bool has_next = S.next(ui + 1, nxt);
        const char* nA = has_next ? (const char*)g.ws + g.a_off + (size_t)nxt.pm * tstepA + (size_t)nxt.acol * 2 : cA; const char* nB = has_next ? (const char*)g.ws + g.b_off + (size_t)nxt.pn * tstepB + (size_t)nxt.bcol * 2 : cB;
        const int nt = cur.nt;
        for (int t = 0; t < nt; t += 2) {
            const bool last = (t == nt - 2);
            const char* a1 = cA + (size_t)(t + 1) * kstep;
            const char* a2 = last ? nA : cA + (size_t)(t + 2) * kstep; const char* b2 = last ? nB : cB + (size_t)(t + 2) * kstep;
            const char* a3 = a2 + kstep; const char* b3 = b2 + kstep;
            if constexpr (Epi::MID) { if (cur.part < 0 && t == (nt >> 1)) { if constexpr (FP8 && FP8_MX == 2) asm volatile("s_nop 15\n\ts_nop 15" ::: "memory"); E.mid(acc, cur, wr, wc, fr, fq); } }
            PG8_LDB(B0, 0, 0); PG8_LDB(B1, 0, 1); PG8_SCHED; PG8_LDA(At, 0, 0); PG8_STAGE(PG8_SA(1, 1), a1 + hstepA, voffA);
            PG8_WAIT_V(8); PG8_WAIT_L(0); PG8_BAR; PG8_MMA(0, 0, At, B0); PG8_MMA(0, 1, At, B1); PG8_BAR; PG8_SCHED;
            PG8_LDA(At, 0, 1); PG8_STAGE(PG8_SB(0, 0), b2, voffB); PG8_STAGE(PG8_SB(0, 1), b2 + hstepB, voffB); PG8_STAGE(PG8_SA(0, 0), a2, voffA);
            PG8_WAIT_V(8); PG8_WAIT_L(0); PG8_BAR; PG8_MMA(1, 0, At, B0); PG8_MMA(1, 1, At, B1); PG8_BAR; PG8_SCHED;
            PG8_LDB(B0, 1, 0); PG8_LDB(B1, 1, 1); PG8_SCHED; PG8_LDA(At, 1, 0); PG8_STAGE(PG8_SA(0, 1), a2 + hstepA, voffA);
            PG8_WAIT_V(8); PG8_WAIT_L(0); PG8_BAR; PG8_MMA(0, 0, At, B0); PG8_MMA(0, 1, At, B1); PG8_BAR; PG8_SCHED;
            PG8_LDA(At, 1, 1); PG8_STAGE(PG8_SB(1, 0), b3, voffB); PG8_STAGE(PG8_SB(1, 1), b3 + hstepB, voffB); PG8_STAGE(PG8_SA(1, 0), a3, voffA);
            PG8_WAIT_V(8); PG8_WAIT_L(0); PG8_BAR; PG8_MMA(1, 0, At, B0); PG8_MMA(1, 1, At, B1); PG8_BAR; PG8_SCHED;
        }
        if (wr == 0) PG8_BAR;
        if constexpr (FP8 && FP8_MX == 2) asm volatile("s_nop 15\n\ts_nop 15" ::: "memory");
        int fr_ = fr, fq_ = fq; asm volatile("" : "+v"(fr_), "+v"(fq_));
        if (cur.part < 0) E(acc, cur, wr, wc, fr_, fq_);
        else {
            float* P = (float*)(g.ws + WS_PART) + (size_t)cur.part * (BM * BM) + (size_t)(wr * 64 + fr_) * BM + wc * 32 + (Epi::PERM ? 8 * fq_ : 4 * fq_);
#pragma unroll
            for (int ai = 0; ai < 2; ++ai)
#pragma unroll
                for (int m = 0; m < 4; ++m)
#pragma unroll
                    for (int bj = 0; bj < 2; ++bj)
#pragma unroll
                        for (int n = 0; n < 2; ++n) *(f32x4*)(P + (size_t)(ai * HALF + m * 16) * BM + bj * HALF + (Epi::PERM ? 4 * n : 16 * n)) = acc[ai][bj][m][n]; }
        if (!has_next) break;
#pragma unroll
        for (int a = 0; a < 2; ++a)
#pragma unroll
            for (int b = 0; b < 2; ++b)
#pragma unroll
                for (int m = 0; m < 4; ++m)
#pragma unroll
                    for (int n = 0; n < 2; ++n) acc[a][b][m][n] = (f32x4){0.f, 0.f, 0.f, 0.f};
        cur = nxt; cA = nA; cB = nB; ++ui;
        if (wr == 1) PG8_BAR;
    }
    PG8_WAIT_V(0);
    PG8_BAR;
#undef PG8_SA
#undef PG8_SB
#undef PG8_STAGE
#undef PG8_LDA
#undef PG8_LDB
#undef PG8_MMA
#undef PG8_LD32
#undef PG8_P64
#undef PG8_WAIT_V
#undef PG8_WAIT_L
#undef PG8_BAR
#undef PG8_SCHED
}
}

#define XB_TMO      128
#define XB_XCNT(j)  (256  + 64 * (j))
#define XB_XSUB(j)  (1280 + 64 * (j))
#define XB_XGEN(j)  (2304 + 64 * (j))
#define XB_TOP      3328
#define XB_TOPGEN   3392
#define XCD_BAR_WORDS 3456
#define XB_SPIN_CAP (1u << 18)
__device__ __forceinline__ unsigned xb_ld(unsigned* p)              { return __hip_atomic_load(p, __ATOMIC_RELAXED, __HIP_MEMORY_SCOPE_AGENT); }
__device__ __forceinline__ unsigned xb_add(unsigned* p, unsigned v) { return __hip_atomic_fetch_add(p, v, __ATOMIC_RELAXED, __HIP_MEMORY_SCOPE_AGENT); }
__device__ __forceinline__ unsigned xb_xcc_id() { return (unsigned)__builtin_amdgcn_s_getreg((3 << 11) | 20) & 0xFu; }
#define XB_SPIN(cond, bar) do { unsigned _sp = 0; while (cond) { __builtin_amdgcn_s_sleep(1); \
    if ((++_sp & 255u) == 0u) { if (xb_ld(&(bar)[XB_TMO])) break; if (_sp > XB_SPIN_CAP) { atomicAdd(&(bar)[XB_TMO], 1u); break; } } } } while (0)
struct XcdBarrier { unsigned* bar; unsigned x; volatile LAS unsigned* st; int wv; };
__device__ __forceinline__ bool xb_leader(int wv) { return wv == 0 && __builtin_amdgcn_mbcnt_hi(~0u, __builtin_amdgcn_mbcnt_lo(~0u, 0u)) == 0u; }
__device__ __forceinline__ XcdBarrier xcd_barrier_post(unsigned* bar, volatile LAS unsigned* st, int wv) {
    XcdBarrier b; b.bar = bar; b.x = xb_xcc_id(); b.st = st; b.wv = wv;
    if (xb_leader(wv)) (void)xb_add(&bar[XB_XCNT(b.x)], 1u);
    return b;
}
__device__ __forceinline__ void xcd_barrier_complete(unsigned* bar, unsigned x, unsigned& nloc, unsigned& nx) {
    const unsigned G = gridDim.x * gridDim.y * gridDim.z;
    unsigned sum, cnt, mine, sp = 0u;
    for (;;) {
        sum = 0u; cnt = 0u; mine = 0u;
#pragma unroll
        for (unsigned j = 0; j < 16; ++j) { const unsigned c = xb_ld(&bar[XB_XCNT(j)]); sum += c; cnt += (c > 0u) ? 1u : 0u; mine = (j == x) ? c : mine; }
        if (sum == G) break;
        __builtin_amdgcn_s_sleep(1);
        if ((++sp & 255u) == 0u) { if (xb_ld(&bar[XB_TMO])) break; if (sp > XB_SPIN_CAP) { atomicAdd(&bar[XB_TMO], 1u); break; } }
    }
    nloc = mine > 0u ? mine : 1u; nx = cnt > 0u ? cnt : 1u;
}
__device__ __forceinline__ void xcd_barrier(const XcdBarrier& b) {
    asm volatile("s_waitcnt vmcnt(0)" ::: "memory");
    __syncthreads();
    if (xb_leader(b.wv)) {
        unsigned* bar = b.bar;
        __builtin_amdgcn_s_waitcnt(0);
        unsigned nloc = b.st[0], nx = b.st[1];
        if (nloc == 0u) { xcd_barrier_complete(bar, b.x, nloc, nx); b.st[0] = nloc; b.st[1] = nx; }
        const unsigned old = xb_add(&bar[XB_XSUB(b.x)], 1u);
        const unsigned gen = old / nloc;
        if (old + 1u == (gen + 1u) * nloc) {
            __builtin_amdgcn_fence(__ATOMIC_RELEASE, "agent");
            asm volatile("s_waitcnt vmcnt(0)" ::: "memory");
            const unsigned og = xb_add(&bar[XB_TOP], 1u);
            const unsigned tg = og / nx;
            if (og + 1u == (tg + 1u) * nx) xb_add(&bar[XB_TOPGEN], 1u);
            else XB_SPIN(xb_ld(&bar[XB_TOPGEN]) == tg, bar);
            __builtin_amdgcn_fence(__ATOMIC_ACQUIRE, "agent");
            xb_add(&bar[XB_XGEN(b.x)], 1u);
            asm volatile("s_waitcnt vmcnt(0)" ::: "memory");
        } else {
            XB_SPIN(xb_ld(&bar[XB_XGEN(b.x)]) == gen, bar);
            __builtin_amdgcn_fence(__ATOMIC_ACQUIRE, "agent");
            asm volatile("s_waitcnt vmcnt(0)" ::: "memory");
        }
    }
    __syncthreads();
}

constexpr int NWAVES = 8, NTHR = 512;
constexpr int RING_OFF = 0, RING_BYTES = 131072;
constexpr int LDSCTL_OFF = RING_BYTES, MISC_OFF = LDSCTL_OFF + 320;
constexpr int LDS_BYTES = 147456;
struct Args { const float* in[25]; float* out; unsigned char* ws; };
constexpr int PTR_OFF = MISC_OFF + 128;
static_assert(PTR_OFF + 28 * 8 <= LDS_BYTES, "LDS map");
struct Frame {
    LAS unsigned char* lds; volatile LAS unsigned* MISC;
    int tid, lane, wave, vcu, G, gw, NGW;
};
__device__ __forceinline__ Frame make_frame(LAS unsigned char* lds, int wv) {
    Frame F; F.lds = lds; F.MISC = (volatile LAS unsigned*)(lds + MISC_OFF);
    const int t = tid_of(wv);
    F.tid = t; F.lane = t & 63; F.wave = wv;
    F.G = gridDim.x; { const int bx = blockIdx.x; F.vcu = (F.G % 8 == 0) ? (bx % 8) * (F.G / 8) + bx / 8 : bx; }
    F.gw = F.vcu * NWAVES + F.wave; F.NGW = F.G * NWAVES; return F;
}
__device__ __forceinline__ unsigned long long ldsb_u64(LAS unsigned char* lds, int i) {
    volatile LAS unsigned* p = (volatile LAS unsigned*)(lds + PTR_OFF) + 2 * i;
    const unsigned lo = __builtin_amdgcn_readfirstlane(p[0]), hi = __builtin_amdgcn_readfirstlane(p[1]);
    return ((unsigned long long)hi << 32) | lo;
}
__device__ __forceinline__ const float* e_in(LAS unsigned char* lds, int i) { return (const float*)(const GAS float*)ldsb_u64(lds, i); }
__device__ __forceinline__ float* e_out(LAS unsigned char* lds) { return (float*)(GAS float*)ldsb_u64(lds, 25); }
__device__ __forceinline__ unsigned char* e_ws(LAS unsigned char* lds) { return (unsigned char*)(GAS unsigned char*)ldsb_u64(lds, 26); }
__device__ __forceinline__ unsigned long long lds_u64(const Frame& F, int i) {
    volatile LAS unsigned* p = (volatile LAS unsigned*)(F.lds + PTR_OFF) + 2 * i;
    const unsigned lo = __builtin_amdgcn_readfirstlane(p[0]), hi = __builtin_amdgcn_readfirstlane(p[1]);
    return ((unsigned long long)hi << 32) | lo;
}
__device__ __forceinline__ const float* in_ptr(const Frame& F, int i) { return (const float*)(const GAS float*)lds_u64(F, i); }
__device__ __forceinline__ float* out_ptr(const Frame& F) { return (float*)(GAS float*)lds_u64(F, 25); }
__device__ __forceinline__ unsigned char* ws_ptr(const Frame& F) { return (unsigned char*)(GAS unsigned char*)lds_u64(F, 26); }
__device__ __forceinline__ unsigned* ctl_ptr(const Frame& F) { return (unsigned*)(ws_ptr(F) + WS_CTL); }

__device__ __forceinline__ void tr_item(const float* src, size_t spitch, int k0, int c0, bf16_t* dst, size_t dpitch, int r0, LAS unsigned* scr, int lane) {
    const int ln = lane & 7, g = lane >> 3;
    if (src == nullptr) {
#pragma unroll
        for (int j = 0; j < 8; ++j) { const int n = 4 * j + (lane >> 4), c = lane & 15; *(u32x4*)(dst + (size_t)(r0 + n) * dpitch + k0 + 8 * c) = (u32x4){0u, 0u, 0u, 0u}; }
        return;
    }
    f32x4 v[16];
#pragma unroll
    for (int i = 0; i < 16; ++i) { const int k = k0 + 16 * (i >> 1) + 2 * g + (i & 1); v[i] = __builtin_nontemporal_load((const f32x4*)(src + (size_t)k * spitch + c0 + 4 * ln)); }
#pragma unroll
    for (int ip = 0; ip < 8; ++ip)
#pragma unroll
        for (int c = 0; c < 4; ++c) scr[(4 * ln + c) * 65 + 8 * ip + g] = pk2(v[2 * ip][c], v[2 * ip + 1][c]);
    LDS_WAIT();
#pragma unroll
    for (int j = 0; j < 8; ++j) { const int n = 4 * j + (lane >> 4), c = lane & 15; const LAS unsigned* s = scr + n * 65 + 4 * c;
        u32x4 o; o.x = s[0]; o.y = s[1]; o.z = s[2]; o.w = s[3];
        *(u32x4*)(dst + (size_t)(r0 + n) * dpitch + k0 + 8 * c) = o; }
    LDS_WAIT();
}
__device__ __forceinline__ void tr_item8(const float* src, size_t spitch, int k0, int c0, unsigned char* dst, size_t dpitch, int r0, float scale, LAS unsigned* scr, int lane) {
    const int ln = lane & 7, g = lane >> 3;
    f32x4 v[16];
#pragma unroll
    for (int i = 0; i < 16; ++i) { const int k = k0 + 32 * (i >> 2) + 4 * g + (i & 3); v[i] = __builtin_nontemporal_load((const f32x4*)(src + (size_t)k * spitch + c0 + 4 * ln)); }
#pragma unroll
    for (int ib = 0; ib < 4; ++ib)
#pragma unroll
        for (int c = 0; c < 4; ++c) scr[(4 * ln + c) * 33 + 8 * ib + g] = pk4_fp8(v[4 * ib][c] * scale, v[4 * ib + 1][c] * scale, v[4 * ib + 2][c] * scale, v[4 * ib + 3][c] * scale);
    LDS_WAIT();
#pragma unroll
    for (int j = 0; j < 4; ++j) { const int n = 8 * j + (lane >> 3), c8 = lane & 7; const LAS unsigned* p = scr + n * 33 + 4 * c8;
        u32x4 o; o.x = p[0]; o.y = p[1]; o.z = p[2]; o.w = p[3];
        *(u32x4*)(dst + (size_t)(r0 + n) * dpitch + k0 + 16 * c8) = o; }
    LDS_WAIT();
}
__device__ __forceinline__ float wave_sum(float v) {
#pragma unroll
    for (int o = 1; o < 64; o <<= 1) v += __shfl_xor(v, o);
    return v;
}
struct TrDesc { const float* src; unsigned char* dst; int spitch, dpitch  ; int k0, c0, r0, f8; };
struct TrPtrs { const float *w_in, *w_branch, *w_out, *w_gate, *w_up, *w_down, *wa, *wx; unsigned char* ws; };
__device__ __forceinline__ TrDesc tr_decode(const TrPtrs& P, int it) {
    constexpr int I0 = 32 * 840, I1 = 64 * 128, I2 = 32 * 128, I3 = 32 * 688, I4 = 86 * 128;
    TrDesc d; int r = it;
    if (r < I0) { const int kb = r / 840, gidx = r % 840, pn = gidx >> 3, gi = gidx & 7; int c0; const float* src = P.w_in;
        if (gidx < 320) c0 = 32 * gidx; else if (gidx < 324) c0 = 10272 + 32 * (gidx - 320); else if (gidx == 324) c0 = 10240; else if (gidx < 328) { c0 = 0; src = nullptr; } else c0 = 32 * gidx - 96;
        const bool f8 = pn < 16 || pn >= 57; const int lt = pn < 16 ? pn : (pn < 24 ? pn - 16 : (pn < 40 ? pn - 16 : (pn < 41 ? 24 : (pn < 57 ? pn - 16 : pn - 41))));
        d = TrDesc{src, P.ws + (f8 ? WS_WI8 : WS_WI), N1_SRC, f8 ? DM : 2 * DM, 128 * kb, c0, 256 * lt + 32 * gi, f8 ? 1 : 0}; return d; } r -= I0;
    if (r < I1) { const int kb = r / 128, gidx = r % 128; d = TrDesc{P.w_branch, P.ws + WS_WB, DM, 2 * DM, 128 * kb, 32 * gidx, 32 * gidx, 1}; return d; } r -= I1;
    if (r < I2) { const int kb = r / 128, gidx = r % 128; d = TrDesc{P.w_out, P.ws + WS_WO, DM, P9_FP8 ? DM : 2 * DM, 128 * kb, 32 * gidx, 32 * gidx, P9_FP8 ? 1 : 0}; return d; } r -= I2;
    if (r < I3) { const int kb = r / 688, gidx = r % 688, pn = gidx >> 3, gi = gidx & 7; d = TrDesc{(gi < 4) ? P.w_gate : P.w_up, P.ws + WS_WGU, DFF, 2 * DM, 128 * kb, 128 * pn + 32 * (gi & 3), 32 * gidx, 0}; return d; } r -= I3;
    if (r < I4) { const int kb = r / 128, gidx = r % 128; d = TrDesc{P.w_down, P.ws + WS_WD, DM, 2 * DFF, 128 * kb, 32 * gidx, 32 * gidx, 0}; return d; } r -= I4;
    { const int kb = r / 256, gidx = r % 256, tn = gidx >> 3, gi = gidx & 7, blk = tn >> 1, hh = tn & 1;
      d = TrDesc{((gi < 4) ? P.wa : P.wx) + (size_t)blk * 65536, P.ws + WS_WG, 256, 512, 128 * kb, 128 * hh + 32 * (gi & 3), 32 * gidx, 0}; return d; }
}
__device__ __forceinline__ void tr_load(const TrDesc& d, f32x4 (&v)[16], int lane) {
    if (d.src == nullptr) return;
    const int ln = lane & 7, g = lane >> 3; const float* p = d.src + d.c0 + 4 * ln;
    if (d.f8) {
#pragma unroll
        for (int i = 0; i < 16; ++i) v[i] = __builtin_nontemporal_load((const f32x4*)(p + (size_t)(d.k0 + 32 * (i >> 2) + 4 * g + (i & 3)) * d.spitch)); }
    else {
#pragma unroll
        for (int i = 0; i < 16; ++i) v[i] = __builtin_nontemporal_load((const f32x4*)(p + (size_t)(d.k0 + 16 * (i >> 1) + 2 * g + (i & 1)) * d.spitch)); }
}
__device__ __forceinline__ void tr_store(const TrDesc& d, const f32x4 (&v)[16], LAS unsigned* scr, int lane) {
    const int ln = lane & 7, g = lane >> 3;
    if (d.f8) {
#pragma unroll
        for (int ib = 0; ib < 4; ++ib)
#pragma unroll
            for (int c = 0; c < 4; ++c) scr[(4 * ln + c) * 33 + 8 * ib + g] = pk4_fp8(v[4 * ib][c] * SW8, v[4 * ib + 1][c] * SW8, v[4 * ib + 2][c] * SW8, v[4 * ib + 3][c] * SW8);
        LDS_WAIT();
#pragma unroll
        for (int j = 0; j < 4; ++j) { const int n = 8 * j + (lane >> 3), c8 = lane & 7; const LAS unsigned* p = scr + n * 33 + 4 * c8;
            *(u32x4*)(d.dst + (size_t)(d.r0 + n) * d.dpitch + d.k0 + 16 * c8) = (u32x4){p[0], p[1], p[2], p[3]}; }
        LDS_WAIT();
    } else if (d.src == nullptr) {
#pragma unroll
        for (int j = 0; j < 8; ++j) { const int n = 4 * j + (lane >> 4), c = lane & 15; *(u32x4*)(d.dst + (size_t)(d.r0 + n) * d.dpitch + 2 * d.k0 + 16 * c) = (u32x4){0u, 0u, 0u, 0u}; }
    } else {
#pragma unroll
        for (int ip = 0; ip < 8; ++ip)
#pragma unroll
            for (int c = 0; c < 4; ++c) scr[(4 * ln + c) * 65 + 8 * ip + g] = pk2(v[2 * ip][c], v[2 * ip + 1][c]);
        LDS_WAIT();
#pragma unroll
        for (int j = 0; j < 8; ++j) { const int n = 4 * j + (lane >> 4), c = lane & 15; const LAS unsigned* p = scr + n * 65 + 4 * c;
            *(u32x4*)(d.dst + (size_t)(d.r0 + n) * d.dpitch + 2 * d.k0 + 16 * c) = (u32x4){p[0], p[1], p[2], p[3]}; }
        LDS_WAIT();
    }
}
constexpr int CONV_BASE = 32 * 840, CONV_N = 64 * 128 + 32 * 128 + 32 * 688 + 86 * 128;
constexpr int CW_QCONV = 4096 + 512;
__device__ __forceinline__ void conv_drain(Frame& F) {
    unsigned char* const ws = ws_ptr(F); unsigned* head = ctl_ptr(F) + CW_QCONV;
    LAS unsigned* scr = (LAS unsigned*)(F.lds + RING_OFF + F.wave * 16384);
    TrPtrs P{in_ptr(F, 8), in_ptr(F, 19), in_ptr(F, 20), in_ptr(F, 22), in_ptr(F, 23), in_ptr(F, 24), in_ptr(F, 14), in_ptr(F, 16), ws};
    constexpr int NQ8 = (CONV_N * 7 / 8) / 8, REST0 = NQ8 * 8, NQ = NQ8 + (CONV_N - REST0) / 2;
    static_assert((CONV_N - REST0) % 2 == 0, "pairs");
    int q = 0; if (F.lane == 0) q = (int)__hip_atomic_fetch_add(head, 1u, __ATOMIC_RELAXED, __HIP_MEMORY_SCOPE_AGENT);
    q = __builtin_amdgcn_readfirstlane(q);
    while (q < NQ) {
        int qn = 0; if (F.lane == 0) qn = (int)__hip_atomic_fetch_add(head, 1u, __ATOMIC_RELAXED, __HIP_MEMORY_SCOPE_AGENT);
        const int i0 = CONV_BASE + (q < NQ8 ? 8 * q : REST0 + 2 * (q - NQ8)), n = q < NQ8 ? 8 : 2;
#pragma unroll 1
        for (int j = 0; j < n; j += 2) {
            const TrDesc da = tr_decode(P, i0 + j), db = tr_decode(P, i0 + j + 1);
            f32x4 va[16], vb[16]; tr_load(da, va, F.lane); tr_load(db, vb, F.lane);
            tr_store(da, va, scr, F.lane); tr_store(db, vb, scr, F.lane);
        }
        q = __builtin_amdgcn_readfirstlane(qn);
    }
}
__device__ __forceinline__ void p0_prologue(Frame& F) {
    unsigned char* const ws = ws_ptr(F); const float* const in0 = in_ptr(F, 0); const float* const in1 = in_ptr(F, 1); const float* const in2 = in_ptr(F, 2); const float* const in3 = in_ptr(F, 3); const float* const in4 = in_ptr(F, 4); const float* const in7 = in_ptr(F, 7); const float* const in8 = in_ptr(F, 8); const float* const in14 = in_ptr(F, 14); const float* const in16 = in_ptr(F, 16); const float* const in19 = in_ptr(F, 19); const float* const in20 = in_ptr(F, 20); const float* const in22 = in_ptr(F, 22); const float* const in23 = in_ptr(F, 23); const float* const in24 = in_ptr(F, 24);
    LAS unsigned* scr = (LAS unsigned*)(F.lds + RING_OFF + F.wave * 16384);
    const int lane = F.lane;
    constexpr int I0 = 32 * 840, I1 = 64 * 128, I2 = 32 * 128, I3 = 32 * 688, I4 = 86 * 128, I5 = 2 * 256;
    constexpr int NITEMS = I0 + I1 + I2 + I3 + I4 + I5;
    bf16_t* WI = (bf16_t*)(ws + WS_WI); bf16_t* WB = (bf16_t*)(ws + WS_WB); bf16_t* WO = (bf16_t*)(ws + WS_WO); bf16_t* WGU = (bf16_t*)(ws + WS_WGU); bf16_t* WD = (bf16_t*)(ws + WS_WD); bf16_t* WG = (bf16_t*)(ws + WS_WG);
    for (int jt = F.gw; jt < NITEMS - CONV_N; jt += F.NGW) { const int it = jt < I0 ? jt : jt + CONV_N;
        int r = it;
        if (r < I0) { const int kb = r / 840, gidx = r % 840, pn = gidx >> 3, gi = gidx & 7; int c0; const float* src = in8;
            if (gidx < 320) c0 = 32 * gidx; else if (gidx < 324) c0 = 10272 + 32 * (gidx - 320); else if (gidx == 324) c0 = 10240; else if (gidx < 328) { c0 = 0; src = nullptr; } else c0 = 32 * gidx - 96;
            const bool f8 = pn < 16 || pn >= 57; const int lt = pn < 16 ? pn : (pn < 24 ? pn - 16 : (pn < 40 ? pn - 16 : (pn < 41 ? 24 : (pn < 57 ? pn - 16 : pn - 41))));
            if (f8) tr_item8(src, N1_SRC, 128 * kb, c0, ws + WS_WI8, DM, 256 * lt + 32 * gi, SW8, scr, lane);
            else tr_item(src, N1_SRC, 128 * kb, c0, WI, DM, 256 * lt + 32 * gi, scr, lane);
            continue; } r -= I0;
        if (r < I1) { const int kb = r / 128, gidx = r % 128; tr_item8(in19, DM, 128 * kb, 32 * gidx, (unsigned char*)WB, 2 * DM, 32 * gidx, SW8, scr, lane); continue; } r -= I1;
        if (r < I2) { const int kb = r / 128, gidx = r % 128;
            if (P9_FP8) tr_item8(in20, DM, 128 * kb, 32 * gidx, (unsigned char*)WO, DM, 32 * gidx, SW8, scr, lane); else tr_item(in20, DM, 128 * kb, 32 * gidx, WO, DM, 32 * gidx, scr, lane);
            continue; } r -= I2;
        if (r < I3) { const int kb = r / 688, gidx = r % 688, pn = gidx >> 3, gi = gidx & 7; const float* src = (gi < 4) ? in22 : in23;
            tr_item(src, DFF, 128 * kb, 128 * pn + 32 * (gi & 3), WGU, DM, 32 * gidx, scr, lane); continue; } r -= I3;
        if (r < I4) { const int kb = r / 128, gidx = r % 128; tr_item(in24, DM, 128 * kb, 32 * gidx, WD, DFF, 32 * gidx, scr, lane); continue; } r -= I4;
        { const int kb = r / 256, gidx = r % 256, tn = gidx >> 3, gi = gidx & 7, blk = tn >> 1, hh = tn & 1; const float* src = ((gi < 4) ? in14 : in16) + (size_t)blk * 65536;
            tr_item(src, 256, 128 * kb, 128 * hh + 32 * (gi & 3), WG, 256, 32 * gidx, scr, lane); }
    }
    {
        bf16_t* XN = (bf16_t*)(ws + WS_XN); const float* gm = in7;
        f32x4 ggv[16];
#pragma unroll
        for (int j = 0; j < 16; ++j) ggv[j] = *(const f32x4*)(gm + 4 * lane + 256 * j);
        for (int m = F.gw; m < MTOK; m += F.NGW) {
            const float* xr = (m < NTOK_P) ? in0 + (size_t)m * DM : in1 + (size_t)(m - NTOK_P) * DM;
            f32x4 v[16]; float s = 0.f;
#pragma unroll
            for (int j = 0; j < 16; ++j) { v[j] = __builtin_nontemporal_load((const f32x4*)(xr + 4 * lane + 256 * j)); s += (v[j].x * v[j].x + v[j].y * v[j].y) + (v[j].z * v[j].z + v[j].w * v[j].w); }
            const float rstd = 1.0f / sqrtf(wave_sum(s) * (1.0f / DM) + EPS);
#pragma unroll
            for (int j = 0; j < 16; ++j) { const f32x4 gg = ggv[j];
                u32x2 o; o.x = pk2(v[j].x * rstd * gg.x, v[j].y * rstd * gg.y); o.y = pk2(v[j].z * rstd * gg.z, v[j].w * rstd * gg.w);
                *(u32x2*)(XN + (size_t)m * DM + 4 * lane + 256 * j) = o;
                *(unsigned*)(ws + WS_XN8 + (size_t)m * DM + 4 * lane + 256 * j) = pk4_fp8(v[j].x * rstd * gg.x * SXN, v[j].y * rstd * gg.y * SXN, v[j].z * rstd * gg.z * SXN, v[j].w * rstd * gg.w * SXN); }
        }
    }
    {
        f32x2* RT = (f32x2*)(ws + WS_ROPE);
        for (int i = F.gw * 64 + lane; i < 4096 * 16; i += F.NGW * 64) { const int pos = i >> 4, j = i & 15;
            const double inv = pow(500000.0, -(double)j / 16.0); const double ang = (double)pos * inv; RT[i] = (f32x2){(float)cos(ang), (float)sin(ang)}; }
    }
    {
        bf16_t* KVS = (bf16_t*)(ws + WS_KVS); bf16_t* IKS = (bf16_t*)(ws + WS_IKS);
        const size_t gt = (size_t)F.gw * 64 + lane, GT = (size_t)F.NGW * 64;
        for (size_t i = gt; i < (size_t)DEC_B * PAST * 128; i += 2 * GT) {
            size_t ia[2]; ia[0] = i; ia[1] = (i + GT < (size_t)DEC_B * PAST * 128) ? i + GT : i;
            f32x4 kk[2][2], vv[2][2];
#pragma unroll
            for (int h = 0; h < 2; ++h) { const size_t row = ia[h] >> 7; const int ch = (int)(ia[h] & 127);
                kk[h][0] = __builtin_nontemporal_load((const f32x4*)(in2 + row * 1024 + 8 * ch)); kk[h][1] = __builtin_nontemporal_load((const f32x4*)(in2 + row * 1024 + 8 * ch + 4));
                vv[h][0] = __builtin_nontemporal_load((const f32x4*)(in3 + row * 1024 + 8 * ch)); vv[h][1] = __builtin_nontemporal_load((const f32x4*)(in3 + row * 1024 + 8 * ch + 4)); }
            asm volatile("" ::: "memory");
#pragma unroll
            for (int h = 0; h < 2; ++h) { const size_t row = ia[h] >> 7; const int ch = (int)(ia[h] & 127); const size_t b = row >> 11, sidx = row & 2047;
                bf16_t* d = KVS + (b * SKV_SP + sidx) * 2048 + 8 * ch;
                *(u32x4*)d = (u32x4){pk2(kk[h][0].x, kk[h][0].y), pk2(kk[h][0].z, kk[h][0].w), pk2(kk[h][1].x, kk[h][1].y), pk2(kk[h][1].z, kk[h][1].w)};
                *(u32x4*)(d + 1024) = (u32x4){pk2(vv[h][0].x, vv[h][0].y), pk2(vv[h][0].z, vv[h][0].w), pk2(vv[h][1].x, vv[h][1].y), pk2(vv[h][1].z, vv[h][1].w)}; }
        }
        for (size_t i = gt; i < (size_t)DEC_B * PAST * 16; i += GT) {
            const size_t row = i >> 4; const int ch = (int)(i & 15); const size_t b = row >> 11, s = row & 2047;
            const f32x4 k0 = *(const f32x4*)(in4 + row * 128 + 8 * ch), k1 = *(const f32x4*)(in4 + row * 128 + 8 * ch + 4);
            *(u32x4*)(IKS + (b * SKV_SP + s) * 128 + 8 * ch) = (u32x4){pk2(k0.x, k0.y), pk2(k0.z, k0.w), pk2(k1.x, k1.y), pk2(k1.z, k1.w)};
        }
        for (size_t i = gt; i < (size_t)DEC_B * 32 * 256; i += GT) {
            const size_t r = i >> 8; const int ch = (int)(i & 255); const size_t b = r >> 5, s = SKV_S + (r & 31);
            *(u32x4*)(KVS + (b * SKV_SP + s) * 2048 + 8 * ch) = (u32x4){0u, 0u, 0u, 0u};
        }
        for (size_t i = gt; i < (size_t)DEC_B * 32 * 16; i += GT) {
            const size_t r = i >> 4; const int ch = (int)(i & 15); const size_t b = r >> 5, s = SKV_S + (r & 31);
            *(u32x4*)(IKS + (b * SKV_SP + s) * 128 + 8 * ch) = (u32x4){0u, 0u, 0u, 0u};
        }
    }
}

constexpr int XCH_OFF = LDSCTL_OFF + 1024;
static_assert(XCH_OFF + 8192 <= LDS_BYTES, "LDS map");
__device__ __forceinline__ void head_sumsq_exchange(const f32x4 (&acc)[2][2][4][2], float ds2, LAS unsigned char* lds, int wr, int wc, int fr, int fq) {
    LAS float* X = (LAS float*)(lds + XCH_OFF);
#pragma unroll
    for (int ai = 0; ai < 2; ++ai)
#pragma unroll
        for (int m = 0; m < 4; ++m)
#pragma unroll
            for (int bj = 0; bj < 2; ++bj) { const f32x4 a = acc[ai][bj][m][0], b = acc[ai][bj][m][1];
                float s = ((a[0] * a[0] + a[1] * a[1]) + (a[2] * a[2] + a[3] * a[3])) + ((b[0] * b[0] + b[1] * b[1]) + (b[2] * b[2] + b[3] * b[3]));
                s += __shfl_xor(s, 16); s += __shfl_xor(s, 32);
                if (fq == 0) X[((ai * 128 + wr * 64 + m * 16 + fr) * 2 + bj) * 4 + wc] = s * ds2; }
    asm volatile("s_waitcnt lgkmcnt(0)" ::: "memory"); __builtin_amdgcn_s_barrier(); asm volatile("" ::: "memory");
}
__device__ __forceinline__ float head_rstd(LAS unsigned char* lds, int rl, int bj) {
    const f32x4 p = *(const LAS f32x4*)(lds + XCH_OFF + ((rl * 2 + bj) * 4) * 4); return 1.0f / sqrtf(((p[0] + p[1]) + (p[2] + p[3])) * (1.0f / 128.0f) + EPS); }
__device__ __forceinline__ void rope_epi(float (&y)[8], const f32x2* RT, int pos, int fq) {
    const f32x4* cp = (const f32x4*)(RT + (size_t)pos * 16 + 8 * (fq & 1)); const f32x4 c0 = cp[0], c1 = cp[1], c2 = cp[2], c3 = cp[3];
    const float cs[8] = {c0[0], c0[2], c1[0], c1[2], c2[0], c2[2], c3[0], c3[2]}, sn[8] = {c0[1], c0[3], c1[1], c1[3], c2[1], c2[3], c3[1], c3[3]};
#pragma unroll
    for (int e = 0; e < 8; ++e) { const float p = __shfl_xor(y[e], 32); y[e] = (fq < 2) ? (y[e] * cs[e] - p * sn[e]) : (y[e] * cs[e] + p * sn[e]); }
}
struct RopeCS { f32x4 c0, c1, c2, c3; };
__device__ __forceinline__ RopeCS rope_load(const f32x2* RT, int pos, int fq) { const f32x4* cp = (const f32x4*)(RT + (size_t)pos * 16 + 8 * (fq & 1)); RopeCS r; r.c0 = cp[0]; r.c1 = cp[1]; r.c2 = cp[2]; r.c3 = cp[3]; return r; }
__device__ __forceinline__ void rope_apply(float (&y)[8], const RopeCS& r, int fq) {
    const float cs[8] = {r.c0[0], r.c0[2], r.c1[0], r.c1[2], r.c2[0], r.c2[2], r.c3[0], r.c3[2]}, sn[8] = {r.c0[1], r.c0[3], r.c1[1], r.c1[3], r.c2[1], r.c2[3], r.c3[1], r.c3[3]};
#pragma unroll
    for (int e = 0; e < 8; ++e) { const float p = __shfl_xor(y[e], 32); y[e] = (fq < 2) ? (y[e] * cs[e] - p * sn[e]) : (y[e] * cs[e] + p * sn[e]); }
}
__device__ __forceinline__ int row_pos(int row) { return row < NTOK_P ? (row & (SEQ - 1)) : PAST + ((row - NTOK_P) & (DEC_T - 1)); }
constexpr int RB = 4;
struct EpiProjA {
    static constexpr bool PERM = true, MID = false, FP8 = false;
    LAS unsigned char* lds;
    __device__ __forceinline__ void operator()(const f32x4 (&acc)[2][2][4][2], const pg8::Unit& u, int wr, int wc, int fr, int fq) const {
        unsigned char* const ws = e_ws(lds); const int pn = u.pn; const bool samp = u.pm >= NTOK_P / 256;
        const int rowl0 = wr * 64 + fr, row0 = u.pm * 256 + rowl0, cw = wc * 32 + 8 * fq;
        const f32x2* RT = (const f32x2*)(ws + WS_ROPE);
        if (pn >= 25) {
            bf16_t* O = (bf16_t*)(ws + WS_XL) + (pn - 25) * 256 + cw;
#pragma unroll
            for (int ai = 0; ai < 2; ++ai)
#pragma unroll
                for (int m = 0; m < 4; ++m)
#pragma unroll
                    for (int bj = 0; bj < 2; ++bj) { const f32x4 v0 = acc[ai][bj][m][0], v1 = acc[ai][bj][m][1];
                        *(u32x4*)(O + (size_t)(row0 + ai * 128 + m * 16) * DM + bj * 128) = (u32x4){pk2(v0[0], v0[1]), pk2(v0[2], v0[3]), pk2(v1[0], v1[1]), pk2(v1[2], v1[3])}; }
        } else if (pn >= 8 && pn < 24) {
            bf16_t* O = (bf16_t*)(ws + WS_IQ) + (pn - 8) * 256 + cw;
#pragma unroll
            for (int ai = 0; ai < 2; ++ai) {
                RopeCS rc[RB];
#pragma unroll
                for (int mb = 0; mb < 4; mb += RB) {
                    if (wc == 0) {
#pragma unroll
                        for (int m = 0; m < RB; ++m) rc[m] = rope_load(RT, row_pos(row0 + ai * 128 + (mb + m) * 16), fq); }
                    asm volatile("" ::: "memory");
#pragma unroll
                    for (int m = mb; m < mb + RB; ++m) { const int row = row0 + ai * 128 + m * 16;
#pragma unroll
                        for (int bj = 0; bj < 2; ++bj) { const f32x4 v0 = acc[ai][bj][m][0], v1 = acc[ai][bj][m][1]; float y[8] = {v0[0], v0[1], v0[2], v0[3], v1[0], v1[1], v1[2], v1[3]};
                            if (wc == 0) rope_apply(y, rc[m - mb], fq);
                            *(u32x4*)(O + (size_t)row * DM + bj * 128) = pack8f(y); } } } }
        } else if (pn >= 4 && pn < 8) {
            float* outv = e_out(lds) + (samp ? O_VS - (size_t)NTOK_P * KVW : O_VP) + (pn - 4) * 256 + cw;
#pragma unroll
            for (int ai = 0; ai < 2; ++ai)
#pragma unroll
                for (int m = 0; m < 4; ++m) { const int row = row0 + ai * 128 + m * 16;
                    bf16_t* d = samp ? (bf16_t*)(ws + WS_KVS) + ((size_t)((row - NTOK_P) >> 5) * SKV_SP + PAST + ((row - NTOK_P) & 31)) * 2048 : (bf16_t*)(ws + WS_KV) + (size_t)row * 2048;
#pragma unroll
                    for (int bj = 0; bj < 2; ++bj) { const f32x4 v0 = acc[ai][bj][m][0], v1 = acc[ai][bj][m][1]; const int col = (pn - 4) * 256 + bj * 128 + cw;
                        *(f32x4*)(outv + (size_t)row * KVW + bj * 128) = v0; *(f32x4*)(outv + (size_t)row * KVW + bj * 128 + 4) = v1;
                        *(u32x4*)(d + 1024 + col) = (u32x4){pk2(v0[0], v0[1]), pk2(v0[2], v0[3]), pk2(v1[0], v1[1]), pk2(v1[2], v1[3])}; } }
        } else {
            const bool isk = pn < 4;
            head_sumsq_exchange(acc, 1.0f, lds, wr, wc, fr, fq);
            const float* gp = e_in(lds, isk ? 10 : 11) + cw; const f32x4 g0 = *(const f32x4*)gp, g1 = *(const f32x4*)(gp + 4); const float g[8] = {g0[0], g0[1], g0[2], g0[3], g1[0], g1[1], g1[2], g1[3]};
            float* outp = e_out(lds);
#pragma unroll
            for (int am = 0; am < 4; ++am) { const int ai = am >> 1;
                RopeCS rc[2];
                if (wc == 0) {
#pragma unroll
                    for (int m = 0; m < 2; ++m) rc[m] = rope_load(RT, row_pos(u.pm * 256 + rowl0 + ai * 128 + (2 * (am & 1) + m) * 16), fq); }
                asm volatile("" ::: "memory");
#pragma unroll
                for (int m = 2 * (am & 1); m < 2 * (am & 1) + 2; ++m) { const int rl = rowl0 + ai * 128 + m * 16, row = u.pm * 256 + rl, rs = row - NTOK_P;
#pragma unroll
                    for (int bj = 0; bj < 2; ++bj) { const f32x4 v0 = acc[ai][bj][m][0], v1 = acc[ai][bj][m][1];
                        if (isk || bj == 0) { const float rstd = head_rstd(lds, rl, bj); float y[8];
#pragma unroll
                            for (int e = 0; e < 4; ++e) { y[e] = v0[e] * rstd * g[e]; y[4 + e] = v1[e] * rstd * g[4 + e]; }
                            if (wc == 0) rope_apply(y, rc[m & 1], fq);
                            if (isk) { const int col = pn * 256 + bj * 128 + cw; float* o = outp + (samp ? O_KS + (size_t)rs * KVW : O_KP + (size_t)row * KVW) + col;
                                *(f32x4*)o = (f32x4){y[0], y[1], y[2], y[3]}; *(f32x4*)(o + 4) = (f32x4){y[4], y[5], y[6], y[7]};
                                bf16_t* d = samp ? (bf16_t*)(ws + WS_KVS) + ((size_t)(rs >> 5) * SKV_SP + PAST + (rs & 31)) * 2048 : (bf16_t*)(ws + WS_KV) + (size_t)row * 2048;
                                *(u32x4*)(d + col) = pack8f(y); }
                            else { float* o = outp + (samp ? O_IKS + (size_t)rs * IDXD : O_IKP + (size_t)row * IDXD) + cw;
                                *(f32x4*)o = (f32x4){y[0], y[1], y[2], y[3]}; *(f32x4*)(o + 4) = (f32x4){y[4], y[5], y[6], y[7]};
                                bf16_t* d = samp ? (bf16_t*)(ws + WS_IKS) + ((size_t)(rs >> 5) * SKV_SP + PAST + (rs & 31)) * IDXD : (bf16_t*)(ws + WS_IKB) + (size_t)row * IDXD;
                                *(u32x4*)(d + cw) = pack8f(y); } }
                        else if (wc == 0) { float* o = (float*)(ws + WS_IWF) + (size_t)row * 32 + 8 * fq;
                            *(f32x4*)o = v0 * 0.015625f; *(f32x4*)(o + 4) = v1 * 0.015625f; } } } }
        }
    }
};
struct EpiProjB {
    static constexpr bool PERM = true, MID = false, FP8 = true;
    LAS unsigned char* lds;
    __device__ __forceinline__ void operator()(const f32x4 (&acc)[2][2][4][2], const pg8::Unit& u, int wr, int wc, int fr, int fq) const {
        unsigned char* const ws = e_ws(lds);
        const int seg = u.pn >> 4, pn = u.pn & 15; constexpr float DS = 1.0f / (SXN * SW8);
        const int rowl0 = wr * 64 + fr, row0 = u.pm * 256 + rowl0, cw = wc * 32 + 8 * fq, col0 = pn * 256 + cw;
        if (seg == 0) {
            head_sumsq_exchange(acc, DS * DS, lds, wr, wc, fr, fq);
            const float* gp = e_in(lds, 9) + cw; const f32x4 g0 = *(const f32x4*)gp, g1 = *(const f32x4*)(gp + 4); const float g[8] = {g0[0], g0[1], g0[2], g0[3], g1[0], g1[1], g1[2], g1[3]};
            const f32x2* RT = (const f32x2*)(ws + WS_ROPE); bf16_t* O = (bf16_t*)(ws + WS_Q) + col0;
#pragma unroll
            for (int ai = 0; ai < 2; ++ai) {
                RopeCS rc[4];
                if (wc == 0) {
#pragma unroll
                    for (int m = 0; m < 4; ++m) rc[m] = rope_load(RT, row_pos(u.pm * 256 + rowl0 + ai * 128 + m * 16), fq); }
                asm volatile("" ::: "memory");
#pragma unroll
                for (int m = 0; m < 4; ++m) { const int rl = rowl0 + ai * 128 + m * 16, row = u.pm * 256 + rl;
#pragma unroll
                    for (int bj = 0; bj < 2; ++bj) { const f32x4 v0 = acc[ai][bj][m][0], v1 = acc[ai][bj][m][1]; const float rstd = head_rstd(lds, rl, bj) * DS; float y[8];
#pragma unroll
                        for (int e = 0; e < 4; ++e) { y[e] = v0[e] * rstd * g[e]; y[4 + e] = v1[e] * rstd * g[4 + e]; }
                        if (wc == 0) rope_apply(y, rc[m], fq);
                        *(u32x4*)(O + (size_t)row * DM + bj * 128) = pack8f(y); } } }
        } else {
            bf16_t* O = (bf16_t*)(ws + (seg == 1 ? WS_GY : (seg == 2 ? WS_SGA : WS_SGL))) + col0;
#pragma unroll
            for (int ai = 0; ai < 2; ++ai)
#pragma unroll
                for (int m = 0; m < 4; ++m) { bf16_t* rowp = O + (size_t)(row0 + ai * 128 + m * 16) * DM;
#pragma unroll
                    for (int bj = 0; bj < 2; ++bj) { f32x4 v0 = acc[ai][bj][m][0] * DS, v1 = acc[ai][bj][m][1] * DS;
                        if (seg == 1) {
#pragma unroll
                            for (int e = 0; e < 4; ++e) { v0[e] = gelu_tanh_(v0[e]); v1[e] = gelu_tanh_(v1[e]); } }
                        else {
#pragma unroll
                            for (int e = 0; e < 4; ++e) { v0[e] = sigmoidf_(v0[e]); v1[e] = sigmoidf_(v1[e]); } }
                        *(u32x4*)(rowp + bj * 128) = (u32x4){pk2(v0[0], v0[1]), pk2(v0[2], v0[3]), pk2(v1[0], v1[1]), pk2(v1[2], v1[3])}; } }
        }
    }
};

__device__ __forceinline__ void rope8(float (&y)[8], const f32x2 (&cs)[8], int hl) {
    float p[8];
#pragma unroll
    for (int e = 0; e < 8; ++e) p[e] = __shfl_xor(y[e], 2);
    if (hl < 4) {
#pragma unroll
        for (int e = 0; e < 8; ++e) y[e] = (hl < 2) ? (y[e] * cs[e].x - p[e] * cs[e].y) : (y[e] * cs[e].x + p[e] * cs[e].y);
    }
}
__device__ __forceinline__ float sum16(float s) { s += __shfl_xor(s, 1); s += __shfl_xor(s, 2); s += __shfl_xor(s, 4); s += __shfl_xor(s, 8); return s; }
struct P2Ptrs { unsigned char* ws; float* out; const float* sconv; const float* gq; const float* gk; const float* gi; const float* cw; const float* cb; };
__device__ __forceinline__ void p2_rowinfo(int m, bool& samp, int& ml, int& b, int& t, int& pos) { samp = m >= NTOK_P; ml = samp ? m - NTOK_P : m; b = samp ? (ml >> 5) : (ml >> 12); t = samp ? (ml & 31) : (ml & 4095); pos = samp ? PAST + t : t; }
__device__ __forceinline__ void p2_taskC(const P2Ptrs& P, int item, int lane) {
    const int strip = item >> 3, col = 512 * (item & 7) + 8 * lane, m0 = 16 * strip; bool samp; int ml, b, t0, pos; p2_rowinfo(m0, samp, ml, b, t0, pos);
    const bf16_t* XLb = (const bf16_t*)(P.ws + WS_XL); bf16_t* Ub = (bf16_t*)(P.ws + WS_U);
    float x[19][8];
#pragma unroll
    for (int i = 0; i < 19; ++i) { const int tt = t0 + i - 3;
        if (tt >= 0) unpack8(*(const u32x4*)(XLb + (size_t)(m0 + i - 3) * DM + col), x[i]);
        else if (samp) { const float* sp = P.sconv + ((size_t)b * 3 + i) * DM + col; const f32x4 s0 = *(const f32x4*)sp, s1 = *(const f32x4*)(sp + 4); x[i][0] = s0.x; x[i][1] = s0.y; x[i][2] = s0.z; x[i][3] = s0.w; x[i][4] = s1.x; x[i][5] = s1.y; x[i][6] = s1.z; x[i][7] = s1.w; }
        else {
#pragma unroll
            for (int e = 0; e < 8; ++e) x[i][e] = 0.f; } }
    float w[4][8], cb[8];
#pragma unroll
    for (int e = 0; e < 8; ++e) { cb[e] = P.cb[col + e];
#pragma unroll
        for (int j = 0; j < 4; ++j) w[j][e] = P.cw[(size_t)j * DM + col + e]; }
    const int T = samp ? DEC_T : SEQ;
#pragma unroll
    for (int r = 0; r < 16; ++r) { float u[8];
#pragma unroll
        for (int e = 0; e < 8; ++e) u[e] = cb[e] + x[r][e] * w[0][e] + x[r + 1][e] * w[1][e] + x[r + 2][e] * w[2][e] + x[r + 3][e] * w[3][e];
        *(u32x4*)(Ub + (size_t)(m0 + r) * DM + col) = pack8f(u);
        const int t = t0 + r;
        if (t >= T - 3) { float* oc = P.out + (samp ? O_CONVS : O_CONVP) + ((size_t)b * 3 + (t - (T - 3))) * DM + col;
            *(f32x4*)oc = (f32x4){x[r + 3][0], x[r + 3][1], x[r + 3][2], x[r + 3][3]}; *(f32x4*)(oc + 4) = (f32x4){x[r + 3][4], x[r + 3][5], x[r + 3][6], x[r + 3][7]}; } }
}
__device__ __forceinline__ void p2_phase(Frame& F) {
    P2Ptrs P{ws_ptr(F), out_ptr(F), in_ptr(F, 6), in_ptr(F, 9), in_ptr(F, 10), in_ptr(F, 11), in_ptr(F, 12), in_ptr(F, 13)};
    for (int it = F.gw; it < (MTOK / 16) * 8; it += F.NGW) p2_taskC(P, it, F.lane);
}

__device__ __forceinline__ float expf_(float x) { return __builtin_amdgcn_exp2f(1.4426950408889634f * x); }
__device__ __forceinline__ float softplusf_(float x) { return fmaxf(x, 0.f) + log1pf(expf(-fabsf(x))); }
struct EpiGates {
    static constexpr bool PERM = false, MID = false, FP8 = false;
    LAS unsigned char* lds;
    __device__ __forceinline__ void operator()(const f32x4 (&acc)[2][2][4][2], const pg8::Unit& u, int wr, int wc, int fr, int fq) const {
        unsigned char* const ws = e_ws(lds); const bf16_t* U = (const bf16_t*)(ws + WS_U); const float* ba = e_in(lds, 15); const float* bx = e_in(lds, 17); const float* lam = e_in(lds, 18); unsigned* AB = (unsigned*)(ws + WS_AB);
        const int row0 = u.pm * 256 + wr * 64 + fr, chb = 256 * (u.pn >> 1) + 128 * (u.pn & 1) + 32 * wc + 4 * fq;
        u32x2 uw[2][2][4];
#pragma unroll
        for (int n = 0; n < 2; ++n)
#pragma unroll
            for (int ai = 0; ai < 2; ++ai)
#pragma unroll
                for (int m = 0; m < 4; ++m) uw[n][ai][m] = *(const u32x2*)(U + (size_t)(row0 + ai * 128 + m * 16) * DM + chb + 16 * n);
        asm volatile("" ::: "memory");
#pragma unroll
        for (int n = 0; n < 2; ++n) { const int ch0 = chb + 16 * n;
            const f32x4 ba4 = *(const f32x4*)(ba + ch0), bx4 = *(const f32x4*)(bx + ch0), lm4 = *(const f32x4*)(lam + ch0); float sp[4];
#pragma unroll
            for (int e = 0; e < 4; ++e) sp[e] = 8.0f * softplusf_(-lm4[e]);
#pragma unroll
            for (int ai = 0; ai < 2; ++ai)
#pragma unroll
                for (int m = 0; m < 4; ++m) { const size_t row = (size_t)(row0 + ai * 128 + m * 16); const u32x2 w2 = uw[n][ai][m];
                    const float uu[4] = {bflo(w2.x), bfhi(w2.x), bflo(w2.y), bfhi(w2.y)}; u32x4 o;
#pragma unroll
                    for (int e = 0; e < 4; ++e) { const float r = sigmoidf_(acc[ai][0][m][n][e] + ba4[e]), ig = sigmoidf_(acc[ai][1][m][n][e] + bx4[e]);
                        const float la = -sp[e] * r, em = 1.0f - expf_(2.0f * la);
                        const float bb = __builtin_amdgcn_sqrtf(fmaxf(em, 0.f)) * (ig * uu[e]);
                        const _Float16 hl_ = (_Float16)la, hb_ = (_Float16)bb;
                        o[e] = (unsigned)__builtin_bit_cast(unsigned short, hl_) | ((unsigned)__builtin_bit_cast(unsigned short, hb_) << 16); }
                    *(u32x4*)(AB + row * DM + ch0) = o; } }
    }
};
__device__ __forceinline__ float h_lo(unsigned w) { return (float)__builtin_bit_cast(_Float16, (unsigned short)(w & 0xffffu)); }
__device__ __forceinline__ float h_hi(unsigned w) { return (float)__builtin_bit_cast(_Float16, (unsigned short)(w >> 16)); }
__device__ __forceinline__ void scan_summaries(Frame& F) {
    unsigned char* const ws = ws_ptr(F);
    const unsigned* AB = (const unsigned*)(ws + WS_AB); f32x4* SUM = (f32x4*)(ws + WS_SUM);
    for (int it = F.gw * 64 + F.lane; it < 128 * 2048; it += F.NGW * 64) { const int q = it >> 11, cp = it & 2047;
        const size_t m0 = (size_t)(q >> 6) * SEQ + (size_t)(q & 63) * 64; const unsigned* p = AB + m0 * DM + 2 * cp;
        float al0 = 0.f, al1 = 0.f, h0 = 0.f, h1 = 0.f;
        for (int r0 = 0; r0 < 64; r0 += 16) { u32x2 w[16];
#pragma unroll
            for (int r = 0; r < 16; ++r) w[r] = *(const u32x2*)(p + (size_t)(r0 + r) * DM);
#pragma unroll
            for (int r = 0; r < 16; ++r) { const float la0 = h_lo(w[r].x), la1 = h_lo(w[r].y); al0 += la0; al1 += la1; h0 = expf_(la0) * h0 + h_hi(w[r].x); h1 = expf_(la1) * h1 + h_hi(w[r].y); } }
        SUM[(size_t)q * 2048 + cp] = (f32x4){al0, h0, al1, h1}; }
}
__device__ __forceinline__ void scan_apply(Frame& F) {
    unsigned char* const ws = ws_ptr(F); float* const out = out_ptr(F); const float* const in5 = in_ptr(F, 5);
    const unsigned* AB = (const unsigned*)(ws + WS_AB); const f32x4* SUM = (const f32x4*)(ws + WS_SUM); const bf16_t* GY = (const bf16_t*)(ws + WS_GY); bf16_t* OAL = (bf16_t*)(ws + WS_OAL);
    for (int it = F.gw * 64 + F.lane; it < 144 * 2048; it += F.NGW * 64) { const int q = it >> 11, cp = it & 2047;
        float h0, h1; size_t m0; int nr; float* lout = nullptr;
        if (q < 128) { const int ch = q & 63; m0 = (size_t)(q >> 6) * SEQ + (size_t)ch * 64; nr = 64; h0 = 0.f; h1 = 0.f;
            for (int j = 0; j < ch; ++j) { const f32x4 s = SUM[(size_t)((q & ~63) + j) * 2048 + cp]; h0 = expf_(s.x) * h0 + s.y; h1 = expf_(s.z) * h1 + s.w; }
            if (ch == 63) lout = out + O_LRUP + (size_t)(q >> 6) * DM + 2 * cp; }
        else { const int bs = q - 128; m0 = (size_t)NTOK_P + (size_t)bs * DEC_T; nr = DEC_T; const f32x2 s = *(const f32x2*)(in5 + (size_t)bs * DM + 2 * cp); h0 = s.x; h1 = s.y;
            lout = out + O_LRUS + (size_t)bs * DM + 2 * cp; }
        const unsigned* p = AB + m0 * DM + 2 * cp; const bf16_t* g = GY + m0 * DM + 2 * cp; unsigned char* o = (unsigned char*)OAL + m0 * (2 * DM) + DM + 2 * cp;
        for (int r0 = 0; r0 < nr; r0 += 16) { u32x2 w[16]; unsigned gw_[16];
#pragma unroll
            for (int r = 0; r < 16; ++r) { w[r] = *(const u32x2*)(p + (size_t)(r0 + r) * DM); gw_[r] = *(const unsigned*)(g + (size_t)(r0 + r) * DM); }
            asm volatile("" ::: "memory");
#pragma unroll
            for (int r = 0; r < 16; ++r) { h0 = expf_(h_lo(w[r].x)) * h0 + h_hi(w[r].x); h1 = expf_(h_lo(w[r].y)) * h1 + h_hi(w[r].y);
                *(unsigned short*)(o + (size_t)(r0 + r) * (2 * DM)) = (unsigned short)__builtin_amdgcn_cvt_pk_fp8_f32(h0 * bflo(gw_[r]) * SA_LRU, h1 * bfhi(gw_[r]) * SA_LRU, 0, false); }
            asm volatile("" ::: "memory"); }
        if (lout) *(f32x2*)lout = (f32x2){h0, h1}; }
}


__device__ __forceinline__ int crow_(int r, int hi) { return (r & 3) + 8 * (r >> 2) + 4 * hi; }
struct IdxItem { int m0, qw, nvalid, samp; const bf16_t* kp; float* sp; int sld; };
__device__ __forceinline__ IdxItem idx_decode(int it, unsigned char* ws) {
    IdxItem r; constexpr int NPI = 4 * 16 * 17;
    if (it < NPI) { int g = 15; int rr = it; while (rr >= 8 * (g + 1)) { rr -= 8 * (g + 1); --g; }
        const int seg = rr % (g + 1); rr /= (g + 1); const int cl = rr & 3, b = rr >> 2, chunk = 4 * g + cl;
        r.m0 = b * SEQ + 64 * chunk; r.qw = 8; r.samp = 0; const int nk = (chunk + 1) * 64 - 256 * seg; r.nvalid = nk < 256 ? nk : 256;
        r.kp = (const bf16_t*)(ws + WS_IKB) + ((size_t)b * SEQ + 256 * seg) * IDXD; r.sp = (float*)(ws + WS_SC) + (size_t)r.m0 * SEQ + 256 * seg; r.sld = SEQ; }
    else { const int rr = it - NPI, bs = rr / 9, seg = rr % 9;
        r.m0 = NTOK_P + 32 * bs; r.qw = 4; r.samp = 1; const int nk = SKV_SP - 256 * seg; r.nvalid = nk < 256 ? nk : 256;
        r.kp = (const bf16_t*)(ws + WS_IKS) + ((size_t)bs * SKV_SP + 256 * seg) * IDXD; r.sp = (float*)(ws + WS_SCS) + (size_t)(32 * bs) * SKV_SP + 256 * seg; r.sld = SKV_SP; }
    return r;
}
__device__ __forceinline__ void idx_phase(Frame& F) {
    unsigned char* const ws = ws_ptr(F); unsigned* const ctl = ctl_ptr(F);
    __syncthreads(); const unsigned qsel = F.MISC[16]; __syncthreads(); if (F.tid == 0) F.MISC[16] = qsel + 1u;
    unsigned* qhead = ctl + CW_QIDX + 64 * qsel;
    const bf16_t* IQ = (const bf16_t*)(ws + WS_IQ); const float* IWF = (const float*)(ws + WS_IWF);
    const int tid = F.tid, lane = F.lane, wave = F.wave, c = lane & 31, hi = lane >> 5;
    constexpr int TOTAL = 4 * 16 * 17 + 16 * 9;
    if (tid == 0) { F.MISC[20] = __hip_atomic_fetch_add(qhead, 1u, __ATOMIC_RELAXED, __HIP_MEMORY_SCOPE_AGENT); F.MISC[21] = __hip_atomic_fetch_add(qhead, 1u, __ATOMIC_RELAXED, __HIP_MEMORY_SCOPE_AGENT); }
    __syncthreads();
    int icur = (int)F.MISC[20], inxt = (int)F.MISC[21];
    __syncthreads();
    if (icur >= TOTAL) return;
#define IDX_STAGE(IT, BUF) do { _Pragma("unroll") for (int j = 0; j < 8; ++j) { const int r0 = 32 * j + 4 * wave; if (r0 < (IT).nvalid) { const int key = r0 + (lane >> 4), chunk = (lane & 15) ^ (key & 15); \
        __builtin_amdgcn_global_load_lds((const unsigned*)((IT).kp + (size_t)key * IDXD + 8 * chunk), (LAS unsigned*)(F.lds + RING_OFF + (BUF) * 65536 + r0 * 256), 16, 0, 0); } } } while (0)
    IdxItem cur = idx_decode(icur, ws);
    IDX_STAGE(cur, 0);
    asm volatile("s_waitcnt vmcnt(0)" ::: "memory");
    __syncthreads();
    int p = 0;
    for (;;) {
        const bool has = inxt < TOTAL;
        unsigned inn = 0u;
        if (tid == 0 && has) inn = __hip_atomic_fetch_add(qhead, 1u, __ATOMIC_RELAXED, __HIP_MEMORY_SCOPE_AGENT);
        IdxItem nxt = cur;
        if (has) { nxt = idx_decode(inxt, ws); IDX_STAGE(nxt, p ^ 1); }
        const LAS unsigned char* kb = F.lds + RING_OFF + p * 65536;
        const int nblk = cur.nvalid >> 5, npair = cur.qw >> 1;
#define IDX_LDK(BK, BLK) do { const int key_ = 32 * (BLK) + c; const LAS unsigned char* rowp_ = kb + key_ * 256; const int sw_ = key_ & 15; \
            _Pragma("unroll") for (int d0 = 0; d0 < 8; ++d0) BK[d0] = *(const LAS bf16x8*)(rowp_ + (((2 * d0 + hi) ^ sw_) << 4)); } while (0)
#define IDX_RELU(x) __builtin_amdgcn_fmed3f((x), 0.f, __builtin_inff())
#define IDX_BLOCK(BK, BLK) do { f32x16 a0 = {}, a1 = {}; \
            _Pragma("unroll") for (int d0 = 0; d0 < 8; ++d0) { a0 = __builtin_amdgcn_mfma_f32_32x32x16_bf16(aq[0][d0], BK[d0], a0, 0, 0, 0); a1 = __builtin_amdgcn_mfma_f32_32x32x16_bf16(aq[1][d0], BK[d0], a1, 0, 0, 0); } \
            f32x2 t0v = {0.f, 0.f}, t1v = {0.f, 0.f}; \
            _Pragma("unroll") for (int r = 0; r < 16; r += 2) { \
                const f32x2 w0 = {w[0][r >> 2][r & 3], w[0][r >> 2][(r & 3) + 1]}, w1 = {w[1][r >> 2][r & 3], w[1][r >> 2][(r & 3) + 1]}; \
                t0v = (f32x2){IDX_RELU(a0[r]), IDX_RELU(a0[r + 1])} * w0 + t0v; t1v = (f32x2){IDX_RELU(a1[r]), IDX_RELU(a1[r + 1])} * w1 + t1v; } \
            const float t0 = t0v.x + t0v.y, t1 = t1v.x + t1v.y; \
            auto rr_ = __builtin_amdgcn_permlane32_swap(__float_as_uint(t0), __float_as_uint(t1), false, false);     \
            s0[loff + 32 * (BLK)] = __uint_as_float(rr_[0]) + __uint_as_float(rr_[1]); } while (0)
        for (int pr = 0; pr < npair; ++pr) {
            const int m = cur.m0 + wave * cur.qw + 2 * pr;
            bf16x8 aq[2][8]; f32x4 w[2][4];
#pragma unroll
            for (int q = 0; q < 2; ++q) {
#pragma unroll
                for (int d0 = 0; d0 < 8; ++d0) aq[q][d0] = *(const bf16x8*)(IQ + (size_t)(m + q) * DM + c * IDXD + d0 * 16 + hi * 8);
#pragma unroll
                for (int g = 0; g < 4; ++g) w[q][g] = *(const f32x4*)(IWF + (size_t)(m + q) * 32 + 8 * g + 4 * hi); }
            float* s0 = cur.sp + (size_t)(m - cur.m0) * cur.sld; const int loff = c + (hi ? cur.sld : 0);
            bf16x8 bka[8], bkb[8];
            IDX_LDK(bka, 0);
            for (int blk = 0; blk < nblk; blk += 2) {
                IDX_LDK(bkb, blk + 1);
                IDX_BLOCK(bka, blk);
                if (blk + 2 < nblk) IDX_LDK(bka, blk + 2);
                IDX_BLOCK(bkb, blk + 1); }
        }
#undef IDX_LDK
#undef IDX_BLOCK
#undef IDX_RELU
        if (tid == 0) F.MISC[20 + p] = inn;
        asm volatile("s_waitcnt vmcnt(0)" ::: "memory");
        __syncthreads();
        if (!has) break;
        cur = nxt; inxt = (int)F.MISC[20 + p]; p ^= 1;
    }
#undef IDX_STAGE
}
__device__ __forceinline__ void select_row(Frame& F, int m) {
    unsigned char* const ws = ws_ptr(F);
    const int lane = F.lane;
    const float* sp; int n;
    if (m < NTOK_P) { n = (((m & (SEQ - 1)) >> 6) + 1) * 64; sp = (const float*)(ws + WS_SC) + (size_t)m * SEQ; }
    else { n = SKV_S; sp = (const float*)(ws + WS_SCS) + (size_t)(m - NTOK_P) * SKV_SP; }
    unsigned key[64];
#pragma unroll
    for (int j = 0; j < 64; ++j) { const int idx = 64 * j + lane; key[j] = __float_as_uint(sp[idx < n ? idx : n - 1]); }
    asm volatile("" ::: "memory");
#pragma unroll
    for (int j = 0; j < 64; ++j) { const int idx = 64 * j + lane; const unsigned u = key[j]; const unsigned k = (u & 0x80000000u) ? ~u : (u | 0x80000000u); key[j] = idx < n ? k : 0u; }
    unsigned thr = 1u;
    if (n > TOPK) { unsigned prefix = 0u;
        const int ngrp = (n + 511) >> 9;
        for (int bit = 31; bit >= 0; --bit) { const unsigned cand = prefix | (1u << bit); int c0 = 0, c1 = 0, c2 = 0, c3 = 0;
#pragma unroll
            for (int g = 0; g < 8; ++g) if (g < ngrp) {
#pragma unroll
                for (int j = 8 * g; j < 8 * g + 8; j += 4) { c0 += (key[j] >= cand) ? 1 : 0; c1 += (key[j + 1] >= cand) ? 1 : 0; c2 += (key[j + 2] >= cand) ? 1 : 0; c3 += (key[j + 3] >= cand) ? 1 : 0; } }
            const int cl = (c0 + c1) + (c2 + c3); int cnt = 0;
#pragma unroll
            for (int b = 0; b < 7; ++b) cnt += __builtin_popcountll(__ballot((cl >> b) & 1)) << b;
            if (cnt >= TOPK) prefix = cand;
            if (cnt == TOPK) break; }
        thr = prefix; }
    unsigned long long mine = 0ull;
#pragma unroll
    for (int j = 0; j < 64; ++j) { const unsigned long long bal = __ballot(key[j] >= thr); mine = (lane == j) ? bal : mine; }
    ((unsigned long long*)(ws + WS_BM))[(size_t)m * 64 + lane] = mine;
}
__device__ __forceinline__ void select_phase(Frame& F) {
    volatile LAS unsigned* cnt = F.MISC + 24;
    __syncthreads(); if (F.tid == 0) *cnt = 0u; __syncthreads();
    const int G = F.G, b = (int)blockIdx.x;
    for (;;) {
        unsigned i = 0u; if (F.lane == 0) i = __hip_atomic_fetch_add((LAS unsigned*)cnt, 1u, __ATOMIC_RELAXED, __HIP_MEMORY_SCOPE_WORKGROUP);
        const int q = (int)__builtin_amdgcn_readfirstlane(i) * G + b;
        if (q >= MTOK) break;
        int m;
        if (q < MTOK - NTOK_P) m = NTOK_P + q;
        else { const int t = q - (MTOK - NTOK_P); m = (t & 1) * SEQ + (SEQ - 1 - (t >> 1)); }
        select_row(F, m);
    }
}

namespace att {
constexpr int NW = 8, QBLK = 32, KVBLK = 64, D = 128, KVLD = 2048, QLD = 4096, OLD = 8192;
constexpr float SCALE = 0.08838834764831845f, THR = 8.f;
constexpr int SHM_V = KVBLK * D * 2, SHM_K = KVBLK * D * 2;
constexpr int ATT_LDS = 2 * SHM_V + 2 * SHM_K + NW * 64 * 4 + 64;
typedef short s16x4 __attribute__((ext_vector_type(4)));
#define KSWZ(row, colB) ((row) * 256 + ((colB) ^ (((row) & 7) << 4)))
#define SBAR() __builtin_amdgcn_sched_barrier(0)
__device__ __forceinline__ int v_st(int k, int c) { const int kk = (k & ~0xC) | ((k & 4) << 1) | ((k & 8) >> 1); return ((kk >> 3) * 4 + (c >> 5)) * 512 + ((kk & 7) * 32 + (c & 31)) * 2; }
__device__ __forceinline__ int v_rd_base(int lane) { return ((lane & 3) << 3) | (((lane >> 2) & 3) << 6) | (((lane >> 4) & 1) << 5) | (((lane >> 5) & 1) << 8); }
constexpr int v_rd_off(int d0, int ks, int half) { return d0 * 512 + ks * 4096 + half * 2048; }
__device__ __forceinline__ int crow(int r, int hi) { return (r & 3) + 8 * (r >> 2) + 4 * hi; }
__device__ __forceinline__ bf16x8 load8(const bf16_t* p) { return *reinterpret_cast<const bf16x8*>(p); }
__device__ __forceinline__ void mask_bits(f32x16& p0, f32x16& p1, unsigned long long mw, int hi) {
    const float NEG = -__builtin_inff(); const unsigned lo = (unsigned)mw >> (4 * hi), hw = (unsigned)(mw >> 32) >> (4 * hi);
#pragma unroll
    for (int r = 0; r < 16; ++r) { const int c = (r & 3) + 8 * (r >> 2);
        if (!((lo >> c) & 1u)) p0[r] = NEG;
        if (!((hw >> c) & 1u)) p1[r] = NEG; }
}
__device__ __forceinline__ void partialSM(f32x16& p0, f32x16& p1, float& m_reg, float& mn, float& alpha) {
    float pmax = p0[0]; for (int r = 1; r < 16; ++r) pmax = fmaxf(pmax, p0[r]); for (int r = 0; r < 16; ++r) pmax = fmaxf(pmax, p1[r]);
    { auto rr = __builtin_amdgcn_permlane32_swap(__float_as_uint(pmax), __float_as_uint(pmax), false, false);
      pmax = fmaxf(__uint_as_float(rr[0]), __uint_as_float(rr[1])); }
    constexpr float C2 = 1.4426950408889634f * SCALE;
    if (__builtin_expect(__all((pmax - m_reg) * SCALE <= THR), 1)) { mn = m_reg; alpha = 1.f; }
    else { mn = fmaxf(m_reg, pmax); alpha = __builtin_amdgcn_exp2f((m_reg - mn) * C2); m_reg = mn; }
    const float mnL = -mn * C2;
    for (int r = 0; r < 16; ++r) p0[r] = fmaf(p0[r], C2, mnL); for (int r = 0; r < 16; ++r) p1[r] = fmaf(p1[r], C2, mnL);
    for (int r = 0; r < 16; ++r) p0[r] = __builtin_amdgcn_exp2f(p0[r]);
}
__device__ __forceinline__ void finishSM(f32x16& p0, f32x16& p1, float alpha, float& l_reg, bf16x8& pa0, bf16x8& pa1, bf16x8& pa2, bf16x8& pa3) {
    for (int r = 0; r < 16; ++r) p1[r] = __builtin_amdgcn_exp2f(p1[r]);
    float ps = 0; for (int r = 0; r < 16; ++r) ps += p0[r]; for (int r = 0; r < 16; ++r) ps += p1[r];
    { auto rr = __builtin_amdgcn_permlane32_swap(__float_as_uint(ps), __float_as_uint(ps), false, false);
      ps = __uint_as_float(rr[0]) + __uint_as_float(rr[1]); }
    l_reg = l_reg * alpha + ps;
#define PK4(P, B_, OUT) do { unsigned a0 = pk2(P[B_+0], P[B_+1]), a1 = pk2(P[B_+2], P[B_+3]);                          \
        unsigned b0 = pk2(P[B_+4], P[B_+5]), b1 = pk2(P[B_+6], P[B_+7]);                                             \
        auto r0 = __builtin_amdgcn_permlane32_swap(a0, b0, false, false); auto r1 = __builtin_amdgcn_permlane32_swap(a1, b1, false, false); \
        u32x4 w = {r0[0], r1[0], r0[1], r1[1]}; OUT = *reinterpret_cast<bf16x8*>(&w); } while (0)
    PK4(p0, 0, pa0); PK4(p0, 8, pa1); PK4(p1, 0, pa2); PK4(p1, 8, pa3);
#undef PK4
}
template <int KB>
__device__ __forceinline__ void qkt(f32x16& p0, f32x16& p1, const char* K_lds, int r32, int hi, const bf16x8* qr) {
    p0 = f32x16{}; p1 = f32x16{};
    const char* kb[4];
#pragma unroll
    for (int dd = 0; dd < 4; ++dd) kb[dd] = K_lds + KB * SHM_K + KSWZ(r32, (dd * 16 + hi * 8) * 2);
#pragma unroll
    for (int d0 = 0; d0 < 8; ++d0) { const char* a = kb[d0 & 3] + (d0 >> 2) * 128;
        bf16x8 b0 = *reinterpret_cast<const bf16x8*>(a);
        bf16x8 b1 = *reinterpret_cast<const bf16x8*>(a + 32 * 256);
        p0 = __builtin_amdgcn_mfma_f32_32x32x16_bf16(b0, qr[d0], p0, 0, 0, 0);
        p1 = __builtin_amdgcn_mfma_f32_32x32x16_bf16(b1, qr[d0], p1, 0, 0, 0); }
}
template <int VB>
__device__ __forceinline__ void pv_tile(f32x16* o, int vb0, bf16x8 pa0, bf16x8 pa1, bf16x8 pa2, bf16x8 pa3) {
#define TRRD(dst, off) asm volatile("ds_read_b64_tr_b16 %0, %1 offset:%2" : "=&v"(dst) : "v"(vb0), "i"(off) : "memory")
#define PV_D0(d0) do { s16x4 l0, l1, l2, l3, h0, h1, h2, h3; constexpr int b_ = VB * SHM_V + v_rd_off(d0, 0, 0); \
        TRRD(l0, b_); TRRD(h0, b_ + 2048); TRRD(l1, b_ + 4096); TRRD(h1, b_ + 6144); TRRD(l2, b_ + 8192); TRRD(h2, b_ + 10240); TRRD(l3, b_ + 12288); TRRD(h3, b_ + 14336); \
        asm volatile("s_waitcnt lgkmcnt(0)" ::: "memory"); SBAR();   \
        o[d0] = __builtin_amdgcn_mfma_f32_32x32x16_bf16(pa0, (bf16x8){l0[0], l0[1], l0[2], l0[3], h0[0], h0[1], h0[2], h0[3]}, o[d0], 0, 0, 0);   \
        o[d0] = __builtin_amdgcn_mfma_f32_32x32x16_bf16(pa1, (bf16x8){l1[0], l1[1], l1[2], l1[3], h1[0], h1[1], h1[2], h1[3]}, o[d0], 0, 0, 0);   \
        o[d0] = __builtin_amdgcn_mfma_f32_32x32x16_bf16(pa2, (bf16x8){l2[0], l2[1], l2[2], l2[3], h2[0], h2[1], h2[2], h2[3]}, o[d0], 0, 0, 0);   \
        o[d0] = __builtin_amdgcn_mfma_f32_32x32x16_bf16(pa3, (bf16x8){l3[0], l3[1], l3[2], l3[3], h3[0], h3[1], h3[2], h3[3]}, o[d0], 0, 0, 0); } while (0)
    PV_D0(0); PV_D0(1); PV_D0(2); PV_D0(3);
#undef PV_D0
#undef TRRD
}
struct BlockRef { const bf16_t* K; int m0, g, NT, samp; };
__device__ __forceinline__ const bf16_t* ref_q(const BlockRef& r, const unsigned char* ws) { return (const bf16_t*)(ws + WS_Q) + (size_t)r.m0 * QLD + 4 * r.g * D; }
__device__ __forceinline__ unsigned char* ref_o(const BlockRef& r, unsigned char* ws) { return ws + WS_OAL + (size_t)r.m0 * OLD + 4 * r.g * D; }
__device__ __forceinline__ const char* ref_bm(const BlockRef& r, const unsigned char* ws) { return (const char*)(ws + WS_BM) + (size_t)r.m0 * 512; }
struct Seam { bf16x8 qr[8]; bf16x8 st_v0, st_v1, st_k0, st_k1; };
#define ROW(p, k0, rr) ((p) + (size_t)((k0) + (rr)) * KVLD + sc)
#define VMW() asm volatile("s_waitcnt vmcnt(0)" ::: "memory")
#define VMWN(n) asm volatile("s_waitcnt vmcnt(%0)" :: "i"(n) : "memory")
#define SLOAD_H(Kp, Vp, k0) do { S.st_v0 = load8(ROW(Vp, k0, sr)); S.st_v1 = load8(ROW(Vp, k0, 32 + sr));              \
                         S.st_k0 = load8(ROW(Kp, k0, sr)); S.st_k1 = load8(ROW(Kp, k0, 32 + sr)); } while (0)
#define SWRITE_HK(bf) do { *(bf16x8*)(K_lds + (bf) * SHM_K + kws) = S.st_k0; *(bf16x8*)(K_lds + (bf) * SHM_K + kws + 32 * 256) = S.st_k1; } while (0)
#define SWRITE_HV(bf) do { *(bf16x8*)(V_lds + (bf) * SHM_V + vst0) = S.st_v0; *(bf16x8*)(V_lds + (bf) * SHM_V + vst1) = S.st_v1; } while (0)
#define SWRITE_H(bf) do { SWRITE_HV(bf); SWRITE_HK(bf); } while (0)
__device__ __forceinline__ int q_rowoff(int samp, int wid) { return samp ? 0 : 32 * (wid & 1); }
__device__ __forceinline__ int q_headoff(int samp, int wid) { return samp ? (wid & 3) : (wid >> 1); }
__device__ __forceinline__ void attn_prime(const BlockRef& cur, unsigned char* wsb, char* lds, Seam& S, int wv) {
    const int tid = tid_of(wv);
    const int wid = __builtin_amdgcn_readfirstlane(tid >> 6), lane = tid & 63, r32 = lane & 31, hi = lane >> 5;
    const int sr = tid >> 4, sc = (tid & 15) * 8, kws = KSWZ(sr, sc * 2); char* K_lds = lds + 2 * SHM_V;
    const bf16_t* qp = ref_q(cur, wsb) + (size_t)(q_rowoff(cur.samp, wid) + r32) * QLD + q_headoff(cur.samp, wid) * D + hi * 8;
    for (int d0 = 0; d0 < 8; ++d0) S.qr[d0] = load8(qp + d0 * 16);
    SLOAD_H(cur.K, cur.K + 1024, 0); VMW(); SWRITE_HK(0);
    __syncthreads();
}
__device__ __forceinline__ void attn_block(const BlockRef& cur, const BlockRef& nxt, unsigned char* wsb, char* lds, Seam& S, int wv) {
    const int tid = tid_of(wv);
    const int wid = __builtin_amdgcn_readfirstlane(tid >> 6), lane = tid & 63, r32 = lane & 31, hi = lane >> 5;
    const int NT = cur.NT;
    char* V_lds = lds; char* K_lds = lds + 2 * SHM_V;
    float* ws = (float*)(lds + 2 * SHM_V + 2 * SHM_K) + wid * 64; float* li_l = ws, * al_l = ws + 32;
    float m_reg = -1e30f, l_reg = 0; f32x16 o[4] = {};
    const int sr = tid >> 4, sc = (tid & 15) * 8, vst0 = v_st(sr, sc), vst1 = v_st(32 + sr, sc), kws = KSWZ(sr, sc * 2);
    const int vb0 = (int)(uintptr_t)V_lds + v_rd_base(lane);
    const bf16_t* Kh = cur.K; const bf16_t* Vh = cur.K + 1024;
    const int qro = q_rowoff(cur.samp, wid), qho = q_headoff(cur.samp, wid);
    const char* bmb = ref_bm(cur, wsb); const unsigned bmo = (unsigned)(qro + r32) * 512u;
#define BMW(t) (*(const unsigned long long*)(bmb + bmo + (unsigned)(t) * 8u))
#define RESC(a) do { if (__any((a) < 1.f)) { if (hi == 0) al_l[r32] = (a); asm volatile("s_waitcnt lgkmcnt(0)" ::: "memory");              \
                     for (int d_ = 0; d_ < 4; ++d_) for (int r = 0; r < 16; ++r) o[d_][r] *= al_l[crow(r, hi)]; } } while (0)
#define KBASE(t) ((t) * KVBLK)
    f32x16 pA0, pA1, pB0, pB1; float mnA, mnB, alA, alB; bf16x8 pa0, pa1, pa2, pa3;
    SWRITE_HV(0); SBAR();
    if (NT > 1) SLOAD_H(Kh, Vh, KBASE(1));
    const unsigned long long mw0 = BMW(0);
    SBAR(); qkt<0>(pA0, pA1, K_lds, r32, hi, S.qr);
    mask_bits(pA0, pA1, mw0, hi); partialSM(pA0, pA1, m_reg, mnA, alA);
    if (NT > 1) { VMW(); SWRITE_H(1); }
    __syncthreads();
#define HALF_STEP(PX0, PX1, mnX, alX, PY0, PY1, alY, t, KB, VB, SB) do {                                                      \
        SBAR(); qkt<KB>(PX0, PX1, K_lds, r32, hi, S.qr);                                                                      \
        finishSM(PY0, PY1, alY, l_reg, pa0, pa1, pa2, pa3); SBAR();                                                           \
        const unsigned long long mw_ = BMW(t);                                                                               \
        if ((t) + 1 < NT) { SLOAD_H(Kh, Vh, KBASE((t) + 1)); SBAR(); }                                                        \
        pv_tile<VB>(o, vb0, pa0, pa1, pa2, pa3); mask_bits(PX0, PX1, mw_, hi); partialSM(PX0, PX1, m_reg, mnX, alX);         \
        __syncthreads();                                                                                                      \
        if ((t) + 1 < NT) { VMW(); SWRITE_H(SB); }                                                                            \
        RESC(alX); __syncthreads(); } while (0)
    for (int t = 1; t + 1 < NT; t += 2) {
        HALF_STEP(pB0, pB1, mnB, alB, pA0, pA1, alA, t, 1, 0, 0);
        HALF_STEP(pA0, pA1, mnA, alA, pB0, pB1, alB, t + 1, 0, 1, 1);
    }
    const bool even = (NT & 1) == 0;
    unsigned long long mwT = 0ull;
    if (even) { mwT = BMW(NT - 1); SBAR(); qkt<1>(pB0, pB1, K_lds, r32, hi, S.qr); SBAR(); }
    SLOAD_H(nxt.K, nxt.K + 1024, 0); SBAR();
    { const bf16_t* qp = ref_q(nxt, wsb) + (size_t)(q_rowoff(nxt.samp, wid) + r32) * QLD + q_headoff(nxt.samp, wid) * D + hi * 8;
#pragma unroll
      for (int d0 = 0; d0 < 8; ++d0) S.qr[d0] = load8(qp + d0 * 16); }
    SBAR();
    finishSM(pA0, pA1, alA, l_reg, pa0, pa1, pa2, pa3); SBAR();
    pv_tile<0>(o, vb0, pa0, pa1, pa2, pa3);
    if (even) { mask_bits(pB0, pB1, mwT, hi); partialSM(pB0, pB1, m_reg, mnB, alB); __syncthreads(); RESC(alB);
        finishSM(pB0, pB1, alB, l_reg, pa0, pa1, pa2, pa3); SBAR(); pv_tile<1>(o, vb0, pa0, pa1, pa2, pa3); }
    SBAR(); VMWN(8); SWRITE_HK(0); SBAR();
    if (hi == 0) li_l[r32] = l_reg; asm volatile("s_waitcnt lgkmcnt(0)" ::: "memory");
    float rli[16];
#pragma unroll
    for (int r = 0; r < 16; ++r) rli[r] = __builtin_amdgcn_rcpf(li_l[crow(r, hi)]);
    unsigned char* Ow = ref_o(cur, wsb) + (size_t)qro * OLD + qho * D;
    const bool st_ok = !cur.samp || wid < 4;
#pragma unroll
    for (int r = 0; r < 16; ++r) { const int orow = crow(r, hi);
#pragma unroll
        for (int d0 = 0; d0 < 4; ++d0) { const float v = o[d0][r] * (rli[r] * SA_ATT);
            const float vn = __shfl_xor(v, 1);
            const int h2 = __builtin_amdgcn_cvt_pk_fp8_f32(v, vn, 0, false), h4 = __shfl_xor(h2, 2);
            if (st_ok && (r32 & 3) == 0) *(unsigned*)(Ow + (size_t)orow * OLD + d0 * 32 + r32) = ((unsigned)h2 & 0xffffu) | ((unsigned)h4 << 16); } }
    __syncthreads();
#undef RESC
#undef KBASE
#undef HALF_STEP
#undef BMW
}
#undef ROW
#undef VMW
#undef VMWN
#undef SLOAD_H
#undef SWRITE_HK
#undef SWRITE_HV
#undef SWRITE_H
}
__device__ __forceinline__ att::BlockRef attn_item(unsigned char* ws, int i) {
    att::BlockRef r;
    if (i < 128) { const int bs = i >> 3, g = i & 7; r.m0 = NTOK_P + bs * DEC_T; r.g = g; r.K = (const bf16_t*)(ws + WS_KVS) + (size_t)bs * SKV_SP * 2048 + g * HD; r.NT = SKV_SP / 64; r.samp = 1; }
    else { const int j = i - 128, c = 63 - (j >> 4), b = (j >> 3) & 1, g = j & 7; r.m0 = b * SEQ + c * 64; r.g = g; r.K = (const bf16_t*)(ws + WS_KV) + (size_t)b * SEQ * 2048 + g * HD; r.NT = c + 1; r.samp = 0; }
    return r;
}
__device__ __forceinline__ void attn_phase(Frame& F, char* lds) {
    unsigned char* const ws = ws_ptr(F); unsigned* const ctl = (unsigned*)(ws + WS_CTL);
    constexpr int TOTAL = 128 + 1024;
    volatile LAS unsigned* qw = (volatile LAS unsigned*)(F.lds + RING_OFF + att::ATT_LDS - 64);
    __syncthreads(); const unsigned qsel = F.MISC[17]; __syncthreads(); if (F.tid == 0) F.MISC[17] = qsel + 1u;
    unsigned* qhead = ctl + CW_QATT + 64 * qsel;
    if (F.tid == 0) { qw[0] = __hip_atomic_fetch_add(qhead, 1u, __ATOMIC_RELAXED, __HIP_MEMORY_SCOPE_AGENT); qw[1] = __hip_atomic_fetch_add(qhead, 1u, __ATOMIC_RELAXED, __HIP_MEMORY_SCOPE_AGENT); }
    __syncthreads();
    int i0 = (int)qw[0], i1 = (int)qw[1];
    __syncthreads();
    if (i0 < TOTAL) {
        att::BlockRef cur = attn_item(ws, i0);
        att::Seam S;
        att::attn_prime(cur, ws, lds, S, F.wave);
        for (;;) {
            const bool has = i1 < TOTAL;
            const att::BlockRef nxt = has ? attn_item(ws, i1) : cur;
            if (F.tid == 0 && has) qw[0] = __hip_atomic_fetch_add(qhead, 1u, __ATOMIC_RELAXED, __HIP_MEMORY_SCOPE_AGENT);
            att::attn_block(cur, nxt, ws, lds, S, F.wave);
            if (!has) break;
            __syncthreads();
            i1 = (int)qw[0];
            __syncthreads();
            cur = nxt;
        }
    }
    __syncthreads(); conv_drain(F);
}

struct EpiMix {
    static constexpr bool PERM = true, MID = true, FP8 = true;
    LAS unsigned char* lds;
    __device__ __forceinline__ void mid(f32x4 (&acc)[2][2][4][2], const pg8::Unit& u, int wr, int wc, int fr, int fq) const {
        int row0 = u.pm * 256 + wr * 64 + fr, col0 = u.pn * 256 + wc * 32 + 8 * fq;
        asm volatile("" : "+v"(row0), "+v"(col0));
        unsigned char* const ws = e_ws(lds); const bf16_t* SGA = (const bf16_t*)(ws + WS_SGA); const bf16_t* SGL = (const bf16_t*)(ws + WS_SGL);
#pragma unroll
        for (int ai = 0; ai < 2; ++ai) { u32x4 ga[4][2], gl[4][2];
#pragma unroll
            for (int m = 0; m < 4; ++m)
#pragma unroll
                for (int bj = 0; bj < 2; ++bj) { const size_t off = (size_t)(row0 + ai * 128 + m * 16) * DM + col0 + bj * 128; ga[m][bj] = *(const u32x4*)(SGA + off); gl[m][bj] = *(const u32x4*)(SGL + off); }
            asm volatile("" ::: "memory");
#pragma unroll
            for (int m = 0; m < 4; ++m)
#pragma unroll
                for (int bj = 0; bj < 2; ++bj) { float a[8], l[8]; unpack8(ga[m][bj], a); unpack8(gl[m][bj], l);
#pragma unroll
                    for (int e = 0; e < 4; ++e) { acc[ai][bj][m][0][e] *= a[e] * (SA_LRU / SA_ATT) * __builtin_amdgcn_rcpf(l[e]); acc[ai][bj][m][1][e] *= a[4 + e] * (SA_LRU / SA_ATT) * __builtin_amdgcn_rcpf(l[4 + e]); }
                    asm volatile("" : "+v"(acc[ai][bj][m][0]), "+v"(acc[ai][bj][m][1])); }
            asm volatile("" ::: "memory"); }
    }
    __device__ __forceinline__ void operator()(const f32x4 (&acc)[2][2][4][2], const pg8::Unit& u, int wr, int wc, int fr, int fq) const {
        const int row0 = u.pm * 256 + wr * 64 + fr, col0 = u.pn * 256 + wc * 32 + 8 * fq; constexpr float SC = S_MIX / (SA_LRU * SW8);
        unsigned char* const ws = e_ws(lds); const bf16_t* SGL = (const bf16_t*)(ws + WS_SGL); unsigned char* MIX = ws + WS_MIX;
        u32x4 glr[2][4][2];
#pragma unroll
        for (int ai = 0; ai < 2; ++ai)
#pragma unroll
            for (int m = 0; m < 4; ++m)
#pragma unroll
                for (int bj = 0; bj < 2; ++bj) glr[ai][m][bj] = *(const u32x4*)(SGL + (size_t)(row0 + ai * 128 + m * 16) * DM + col0 + bj * 128);
        asm volatile("" ::: "memory");
#pragma unroll
        for (int ai = 0; ai < 2; ++ai)
#pragma unroll
            for (int m = 0; m < 4; ++m)
#pragma unroll
                for (int bj = 0; bj < 2; ++bj) { const size_t off = (size_t)(row0 + ai * 128 + m * 16) * DM + col0 + bj * 128; float gl[8]; unpack8(glr[ai][m][bj], gl);
                    const f32x4 v0 = acc[ai][bj][m][0], v1 = acc[ai][bj][m][1];
                    if (P9_FP8) { u32x2 w; w.x = pk4_fp8(v0[0] * gl[0] * SC, v0[1] * gl[1] * SC, v0[2] * gl[2] * SC, v0[3] * gl[3] * SC); w.y = pk4_fp8(v1[0] * gl[4] * SC, v1[1] * gl[5] * SC, v1[2] * gl[6] * SC, v1[3] * gl[7] * SC);
                        *(u32x2*)(MIX + off) = w; }
                    else { constexpr float S1 = 1.0f / (SA_LRU * SW8); u32x4 w; w.x = pk2(v0[0] * gl[0] * S1, v0[1] * gl[1] * S1); w.y = pk2(v0[2] * gl[2] * S1, v0[3] * gl[3] * S1); w.z = pk2(v1[0] * gl[4] * S1, v1[1] * gl[5] * S1); w.w = pk2(v1[2] * gl[6] * S1, v1[3] * gl[7] * S1);
                        *(u32x4*)((bf16_t*)MIX + off) = w; } }
    }
};
struct EpiOut {
    static constexpr bool PERM = false, MID = false, FP8 = (P9_FP8 != 0);
    LAS unsigned char* lds;
    __device__ __forceinline__ void operator()(const f32x4 (&acc)[2][2][4][2], const pg8::Unit& u, int wr, int wc, int fr, int fq) const {
        unsigned char* const ws = e_ws(lds); const float* xp = e_in(lds, 0); const float* xs = e_in(lds, 1); const float* gf = e_in(lds, 21);
        float* X1 = (float*)(ws + WS_X1); bf16_t* A2 = (bf16_t*)(ws + WS_A2); LAS float* X = (LAS float*)(lds + XCH_OFF);
        const int row0 = u.pm * 256 + wr * 64 + fr, col0 = u.pn * 256 + wc * 32 + 4 * fq;
        const float* xb = (u.pm < NTOK_P / 256) ? xp : xs - (size_t)NTOK_P * DM;
        f32x4 gv[2][2];
#pragma unroll
        for (int bj = 0; bj < 2; ++bj)
#pragma unroll
            for (int n = 0; n < 2; ++n) gv[bj][n] = *(const f32x4*)(gf + col0 + bj * 128 + n * 16);
#pragma unroll
        for (int ai = 0; ai < 2; ++ai) { f32x4 xv[4][2][2];
#pragma unroll
            for (int m = 0; m < 4; ++m)
#pragma unroll
                for (int bj = 0; bj < 2; ++bj)
#pragma unroll
                    for (int n = 0; n < 2; ++n) xv[m][bj][n] = *(const f32x4*)(xb + (size_t)(row0 + ai * 128 + m * 16) * DM + col0 + bj * 128 + n * 16);
            asm volatile("" ::: "memory");
#pragma unroll
            for (int m = 0; m < 4; ++m) { const size_t row = (size_t)(row0 + ai * 128 + m * 16); const size_t off = row * DM + col0; float s = 0.f;
#pragma unroll
                for (int bj = 0; bj < 2; ++bj)
#pragma unroll
                    for (int n = 0; n < 2; ++n) { const f32x4 x1 = xv[m][bj][n] + acc[ai][bj][m][n] * (P9_FP8 ? 1.0f / (S_MIX * SW8) : 1.0f);
                        *(f32x4*)(X1 + off + bj * 128 + n * 16) = x1; s += (x1[0] * x1[0] + x1[1] * x1[1]) + (x1[2] * x1[2] + x1[3] * x1[3]);
                        const f32x4 y = x1 * gv[bj][n]; u32x2 w; w.x = pk2(y[0], y[1]); w.y = pk2(y[2], y[3]); *(u32x2*)(A2 + off + bj * 128 + n * 16) = w; }
                s += __shfl_xor(s, 16); s += __shfl_xor(s, 32);
                if (fq == 0) X[(ai * 128 + wr * 64 + m * 16 + fr) * 4 + wc] = s; }
            asm volatile("" ::: "memory"); }
        asm volatile("s_waitcnt lgkmcnt(0)" ::: "memory"); __builtin_amdgcn_s_barrier(); asm volatile("" ::: "memory");
        { const int t = (wr * 4 + wc) * 64 + (fq * 16 + fr);
          if (t < 256) { const f32x4 p = *(const LAS f32x4*)(X + t * 4); ((float*)(ws + WS_PSSQ))[(size_t)u.pn * MTOK + u.pm * 256 + t] = (p[0] + p[1]) + (p[2] + p[3]); } }
    }
};
struct EpiGU {
    static constexpr bool PERM = true, MID = false, FP8 = false;
    LAS unsigned char* lds;
    __device__ __forceinline__ void operator()(const f32x4 (&acc)[2][2][4][2], const pg8::Unit& u, int wr, int wc, int fr, int fq) const {
        unsigned char* const ws = e_ws(lds); const float* RSTD = (const float*)(ws + WS_CTL) + CW_SSQ; bf16_t* H = (bf16_t*)(ws + WS_H);
        const int row0 = u.pm * 256 + wr * 64 + fr, col0 = u.pn * 128 + wc * 32 + 8 * fq;
        float rs[2][4];
#pragma unroll
        for (int ai = 0; ai < 2; ++ai)
#pragma unroll
            for (int m = 0; m < 4; ++m) rs[ai][m] = RSTD[row0 + ai * 128 + m * 16];
        asm volatile("" ::: "memory");
#pragma unroll
        for (int ai = 0; ai < 2; ++ai)
#pragma unroll
            for (int m = 0; m < 4; ++m) { const size_t row = (size_t)(row0 + ai * 128 + m * 16);
                const float rstd = rs[ai][m]; float hv[8];
#pragma unroll
                for (int n = 0; n < 2; ++n)
#pragma unroll
                    for (int e = 0; e < 4; ++e) { const float g = acc[ai][0][m][n][e] * rstd, up = acc[ai][1][m][n][e] * rstd; hv[4 * n + e] = g * sigmoidf_(g) * up; }
                *(u32x4*)(H + row * DFF + col0) = pack8f(hv); }
    }
};
struct EpiDown {
    static constexpr bool PERM = false, MID = false, FP8 = false;
    LAS unsigned char* lds;
    __device__ __forceinline__ void operator()(const f32x4 (&acc)[2][2][4][2], const pg8::Unit& u, int wr, int wc, int fr, int fq) const {
        const float* X1 = (const float*)(e_ws(lds) + WS_X1); float* Y = e_out(lds);
        const int row0 = u.pm * 256 + wr * 64 + fr, col0 = u.pn * 256 + wc * 32 + 4 * fq;
#pragma unroll
        for (int ai = 0; ai < 2; ++ai) { f32x4 xv[4][2][2];
#pragma unroll
            for (int m = 0; m < 4; ++m)
#pragma unroll
                for (int bj = 0; bj < 2; ++bj)
#pragma unroll
                    for (int n = 0; n < 2; ++n) xv[m][bj][n] = *(const f32x4*)(X1 + (size_t)(row0 + ai * 128 + m * 16) * DM + col0 + bj * 128 + n * 16);
            asm volatile("" ::: "memory");
#pragma unroll
            for (int m = 0; m < 4; ++m)
#pragma unroll
                for (int bj = 0; bj < 2; ++bj)
#pragma unroll
                    for (int n = 0; n < 2; ++n) *(f32x4*)(Y + (size_t)(row0 + ai * 128 + m * 16) * DM + col0 + bj * 128 + n * 16) = xv[m][bj][n] + acc[ai][bj][m][n];
            asm volatile("" ::: "memory"); }
    }
};

__device__ __forceinline__ f32x4 part_sum(const float* PART, int tile, int s0, int s1, int rr, int cc) {
    f32x4 a = {0.f, 0.f, 0.f, 0.f};
#pragma unroll
    for (int s = 0; s < 8; ++s) if (s >= s0 && s < s1) a += *(const f32x4*)(PART + ((size_t)(tile * 8 + s) * 65536 + (size_t)rr * 256 + cc));
    return a;
}
__device__ __forceinline__ void reduce_mix(Frame& F) {
    unsigned char* const ws = ws_ptr(F); const float* PART = (const float*)(ws + WS_PART);
    const bf16_t* SGA = (const bf16_t*)(ws + WS_SGA); const bf16_t* SGL = (const bf16_t*)(ws + WS_SGL); unsigned char* MIX = ws + WS_MIX;
    for (int it = F.gw * 64 + F.lane; it < NTOK_S * 1024; it += F.NGW * 64) { const int r = it >> 10, col = 4 * (it & 1023), tile = (r >> 8) * 16 + (col >> 8), rr = r & 255, cc = col & 255;
        const f32x4 sA = part_sum(PART, tile, 0, 4, rr, cc), sL = part_sum(PART, tile, 4, 8, rr, cc);
        const size_t off = (size_t)(NTOK_P + r) * DM + col; const u32x2 ga = *(const u32x2*)(SGA + off), gl = *(const u32x2*)(SGL + off);
        constexpr float CA = (P9_FP8 ? S_MIX : 1.0f) / (SA_ATT * SW8), CL = (P9_FP8 ? S_MIX : 1.0f) / (SA_LRU * SW8);
        const float m0 = bflo(ga.x) * sA[0] * CA + bflo(gl.x) * sL[0] * CL, m1 = bfhi(ga.x) * sA[1] * CA + bfhi(gl.x) * sL[1] * CL, m2 = bflo(ga.y) * sA[2] * CA + bflo(gl.y) * sL[2] * CL, m3 = bfhi(ga.y) * sA[3] * CA + bfhi(gl.y) * sL[3] * CL;
        if (P9_FP8) *(unsigned*)(MIX + off) = pk4_fp8(m0, m1, m2, m3); else *(u32x2*)((bf16_t*)MIX + off) = (u32x2){pk2(m0, m1), pk2(m2, m3)}; }
}
__device__ __forceinline__ void reduce_out(Frame& F, bool tail) {
    unsigned char* const ws = ws_ptr(F); const float* PART = (const float*)(ws + WS_PART); const float* xs = in_ptr(F, 1); const float* gf = in_ptr(F, 21);
    float* X1 = (float*)(ws + WS_X1); bf16_t* A2 = (bf16_t*)(ws + WS_A2); float* RSTD = (float*)(ctl_ptr(F) + CW_SSQ); const float* PSSQ = (const float*)(ws + WS_PSSQ);
    for (int r = F.gw * 64 + F.lane; r < (tail ? NTOK_P : MTOK); r += F.NGW * 64) { float ss = 0.f;
#pragma unroll
        for (int j = 0; j < 16; ++j) ss += PSSQ[(size_t)j * MTOK + r];
        RSTD[r] = 1.0f / sqrtf(ss * (1.0f / DM) + EPS); }
    if (tail) for (int r = F.gw; r < NTOK_S; r += F.NGW) { float ss = 0.f;
#pragma unroll 4
        for (int j = 0; j < 16; ++j) { const int col = 4 * F.lane + 256 * j, tile = (r >> 8) * 16 + j, rr = r & 255, cc = 4 * F.lane;
            const f32x4 x1 = *(const f32x4*)(xs + (size_t)r * DM + col) + part_sum(PART, tile, 0, 8, rr, cc) * (P9_FP8 ? 1.0f / (S_MIX * SW8) : 1.0f); const f32x4 gg = *(const f32x4*)(gf + col);
            const size_t off = (size_t)(NTOK_P + r) * DM + col; *(f32x4*)(X1 + off) = x1; ss += (x1[0] * x1[0] + x1[1] * x1[1]) + (x1[2] * x1[2] + x1[3] * x1[3]);
            u32x2 o; o.x = pk2(x1[0] * gg[0], x1[1] * gg[1]); o.y = pk2(x1[2] * gg[2], x1[3] * gg[3]); *(u32x2*)(A2 + off) = o; }
        ss = wave_sum(ss);
        if (F.lane == 0) RSTD[NTOK_P + r] = 1.0f / sqrtf(ss * (1.0f / DM) + EPS); }
}
__device__ __forceinline__ void reduce_down(Frame& F) {
    unsigned char* const ws = ws_ptr(F); const float* PART = (const float*)(ws + WS_PART); const float* X1 = (const float*)(ws + WS_X1); float* Y = out_ptr(F);
    for (int it = F.gw * 64 + F.lane; it < NTOK_S * 1024; it += F.NGW * 64) { const int r = it >> 10, col = 4 * (it & 1023), tile = (r >> 8) * 16 + (col >> 8), rr = r & 255, cc = col & 255;
        const size_t off = (size_t)(NTOK_P + r) * DM + col;
        *(f32x4*)(Y + off) = *(const f32x4*)(X1 + off) + part_sum(PART, tile, 0, 8, rr, cc); }
}

__device__ __forceinline__ void reduce_gu(Frame& F) {
    unsigned char* const ws = ws_ptr(F); const float* PART = (const float*)(ws + WS_PART); const float* RSTD = (const float*)(ws + WS_CTL) + CW_SSQ; bf16_t* H = (bf16_t*)(ws + WS_H);
    constexpr int nM = MTOK / 256, nN = 2 * DFF / 256, NW = nM * nN, RF = NW / 256, REM = NW - RF * 256;
    for (int it = F.gw * 64 + F.lane; it < REM * 256 * 32; it += F.NGW * 64) { const int t = it >> 13, rr = (it >> 5) & 255, cc = 4 * (it & 31);
        int pm, pn; pg8::map_unit(RF * 256 + t, nM, nN, pm, pn);
        const float* p0 = PART + (size_t)(2 * t) * 65536 + (size_t)rr * 256 + cc; const float* p1 = p0 + 65536;
        const f32x4 g = *(const f32x4*)p0 + *(const f32x4*)p1, u = *(const f32x4*)(p0 + 128) + *(const f32x4*)(p1 + 128);
        const size_t row = (size_t)pm * 256 + rr; const float rstd = RSTD[row];
        float h[4];
#pragma unroll
        for (int e = 0; e < 4; ++e) { const float gg = g[e] * rstd; h[e] = gg * sigmoidf_(gg) * (u[e] * rstd); }
        *(u32x2*)(H + row * DFF + pn * 128 + cc) = (u32x2){pk2(h[0], h[1]), pk2(h[2], h[3])}; }
}

__global__ void __launch_bounds__(NTHR, 2) fwd_kernel(Args args) {
    extern __shared__ __attribute__((aligned(16))) unsigned char lds_raw[];
    LAS unsigned char* const ldsb = (LAS unsigned char*)lds_raw;
    int wv0 = __builtin_amdgcn_readfirstlane((int)(threadIdx.x >> 6)); asm volatile("" : "+s"(wv0));
    Frame F = make_frame(ldsb, wv0);
    for (int u = F.tid; u < (LDS_BYTES - LDSCTL_OFF) / 4; u += NTHR) ((LAS unsigned*)(F.lds + LDSCTL_OFF))[u] = 0u;
    __syncthreads();
    if (F.tid == 0) { volatile LAS unsigned* p = (volatile LAS unsigned*)(F.lds + PTR_OFF);
#pragma unroll
        for (int i = 0; i < 25; ++i) { const unsigned long long v = (unsigned long long)args.in[i]; p[2 * i] = (unsigned)v; p[2 * i + 1] = (unsigned)(v >> 32); }
        { const unsigned long long v = (unsigned long long)args.out; p[50] = (unsigned)v; p[51] = (unsigned)(v >> 32); }
        { const unsigned long long v = (unsigned long long)args.ws; p[52] = (unsigned)v; p[53] = (unsigned)(v >> 32); } }
    __syncthreads();
    XcdBarrier bar = xcd_barrier_post(ctl_ptr(F) + CW_BAR, F.MISC + 8, wv0);

#define REP(n, ...) do { __VA_ARGS__; if constexpr ((DBL >> (n)) & 1) { xcd_barrier(bar); __VA_ARGS__; } } while (0)
#define GEMM_PHASE_C(EPI, AOFF, BOFF, LDA, LDB, KK, NN, BD, TAIL, CIDX) do { F = make_frame(ldsb, wv0); unsigned char* const ws = ws_ptr(F); \
        pg8::Gemm g{ws, (AOFF), (BOFF), (LDA), (LDB), (KK)}; pg8::StaticOrder S; S.init(MTOK, (NN), (KK), F.G, (CIDX), (BD), (TAIL)); \
        EPI E{F.lds}; pg8::gemm_phase<EPI, pg8::StaticOrder>(F.lds + RING_OFF, g, S, E, F.wave); } while (0)
#define GEMM_PHASE(EPI, AOFF, BOFF, LDA, LDB, KK, NN, BD, TAIL) GEMM_PHASE_C(EPI, AOFF, BOFF, LDA, LDB, KK, NN, BD, TAIL, (int)blockIdx.x)
    REP(0, F = make_frame(ldsb, wv0); p0_prologue(F));
    xcd_barrier(bar);
    REP(1, GEMM_PHASE(EpiProjA, WS_XN, WS_WI, DM, DM, DM, 41 * 256, 0, 0));
    REP(13, GEMM_PHASE_C(EpiProjB, WS_XN8, WS_WI8, DM / 2, DM / 2, DM / 2, 64 * 256, 0, 0, (int)(gridDim.x - 1 - blockIdx.x)));
    xcd_barrier(bar);
    REP(2, F = make_frame(ldsb, wv0); p2_phase(F));
    xcd_barrier(bar);
    REP(3, GEMM_PHASE(EpiGates, WS_U, WS_WG, DM, 256, 256, 32 * 256, 1, 0));
    REP(10, F = make_frame(ldsb, wv0); idx_phase(F));
    xcd_barrier(bar);
    REP(4, F = make_frame(ldsb, wv0); scan_summaries(F));
    REP(11, F = make_frame(ldsb, wv0); select_phase(F));
    xcd_barrier(bar);
    REP(5, F = make_frame(ldsb, wv0); scan_apply(F));
    REP(12, F = make_frame(ldsb, wv0); attn_phase(F, (char*)lds_raw + RING_OFF));
    xcd_barrier(bar);
    REP(6, GEMM_PHASE(EpiMix, WS_OAL, WS_WB, DM, DM, DM, DM, 0, 1));
    xcd_barrier(bar);
    if (gridDim.x == 256) { F = make_frame(ldsb, wv0); reduce_mix(F); xcd_barrier(bar); }
    GEMM_PHASE(EpiOut, WS_MIX, WS_WO, (P9_FP8 ? DM / 2 : DM), (P9_FP8 ? DM / 2 : DM), (P9_FP8 ? DM / 2 : DM), DM, 0, 1);
    xcd_barrier(bar);
    F = make_frame(ldsb, wv0); reduce_out(F, gridDim.x == 256); xcd_barrier(bar);
    REP(8, GEMM_PHASE(EpiGU, WS_A2, WS_WGU, DM, DM, DM, 2 * DFF, 0, 2));
    xcd_barrier(bar);
    if (gridDim.x == 256) { F = make_frame(ldsb, wv0); reduce_gu(F); xcd_barrier(bar); }
    REP(9, GEMM_PHASE(EpiDown, WS_H, WS_WD, DFF, DFF, DFF, DM, 0, 1));
    if (gridDim.x == 256) { xcd_barrier(bar); F = make_frame(ldsb, wv0); reduce_down(F); }
#undef REP
#undef GEMM_PHASE
#undef GEMM_PHASE_C
}

extern "C" void kernel_launch(void* const* d_in, const int* in_sizes, int n_in, void* d_out, int out_size, void* d_ws, size_t ws_size, hipStream_t stream) {
    static int grid = 0;
    if (grid == 0) {
        if (n_in != 25 || out_size != (int)O_END || ws_size < WS_END) { fprintf(stderr, "kernel_launch: unexpected shapes (n_in %d, out %d, ws %zu; need ws >= %zu); nothing launched\n", n_in, out_size, ws_size, (size_t)WS_END); grid = -1; return; }
        int dev = 0, cus = 0, per_cu = 0;
        if (hipGetDevice(&dev) != hipSuccess || hipDeviceGetAttribute(&cus, hipDeviceAttributeMultiprocessorCount, dev) != hipSuccess) { fprintf(stderr, "kernel_launch: device query failed\n"); grid = -1; return; }
        if (hipFuncSetAttribute((const void*)fwd_kernel, hipFuncAttributeMaxDynamicSharedMemorySize, LDS_BYTES) != hipSuccess) { fprintf(stderr, "kernel_launch: hipFuncSetAttribute failed\n"); grid = -1; return; }
        if (hipOccupancyMaxActiveBlocksPerMultiprocessor(&per_cu, (const void*)fwd_kernel, NTHR, LDS_BYTES) != hipSuccess || per_cu < 1) { fprintf(stderr, "kernel_launch: occupancy query reports %d blocks per CU\n", per_cu); }
        (void)hipGetLastError();
        grid = cus;
    }
    if (grid < 0) return;
    if (hipMemsetAsync((char*)d_ws + WS_CTL, 0, CTL_BYTES, stream) != hipSuccess) { fprintf(stderr, "kernel_launch: memset failed\n"); return; }
    Args a{};
    for (int i = 0; i < 25; ++i) a.in[i] = (const float*)d_in[i];
    a.out = (float*)d_out; a.ws = (unsigned char*)d_ws;
    hipLaunchKernelGGL(fwd_kernel, dim3(grid), dim3(NTHR), LDS_BYTES, stream, a);
    const hipError_t le = hipPeekAtLastError();
    if (le != hipSuccess) fprintf(stderr, "kernel_launch: launch failed: %s\n", hipGetErrorName(le));
}
```

```cpp
#include <hip/hip_runtime.h>
#include <cstdio>
#include <cstdint>

#ifndef DBL
#define DBL 0
#endif
#ifndef P9_FP8
#define P9_FP8 1
#endif
#ifndef FP8_MX
#define FP8_MX 2
#endif
#define LAS __attribute__((address_space(3)))
#define GAS __attribute__((address_space(1)))
typedef unsigned short bf16_t;
typedef short bf16x8 __attribute__((ext_vector_type(8)));
typedef float f32x4 __attribute__((ext_vector_type(4)));
typedef float f32x2 __attribute__((ext_vector_type(2)));
typedef float f32x16 __attribute__((ext_vector_type(16)));
typedef unsigned u32x4 __attribute__((ext_vector_type(4)));
typedef unsigned u32x2 __attribute__((ext_vector_type(2)));
typedef int i32x8 __attribute__((ext_vector_type(8)));

constexpr int DM = 4096, SEQ = 4096, NB_P = 2, NTOK_P = NB_P * SEQ, DEC_B = 16, DEC_T = 32, NTOK_S = DEC_B * DEC_T, MTOK = NTOK_P + NTOK_S;
constexpr int PAST = 2048, SKV_S = PAST + DEC_T, SKV_SP = 2112;
constexpr int NH = 32, NKVH = 8, HD = 128, KVW = NKVH * HD, IDXH = 32, IDXD = 128;
constexpr int DFF = 11008, TOPK = 256;
constexpr int N1 = 105 * 256;
constexpr int N1_SRC = 26784;
constexpr float EPS = 1e-6f;
static_assert(MTOK % 256 == 0 && DFF % 128 == 0, "tiling");

constexpr size_t O_YP = 0, O_YS = O_YP + (size_t)NTOK_P * DM, O_KP = O_YS + (size_t)NTOK_S * DM, O_VP = O_KP + (size_t)NTOK_P * KVW, O_IKP = O_VP + (size_t)NTOK_P * KVW,
                 O_LRUP = O_IKP + (size_t)NTOK_P * IDXD, O_CONVP = O_LRUP + (size_t)NB_P * DM, O_KS = O_CONVP + (size_t)NB_P * 3 * DM, O_VS = O_KS + (size_t)NTOK_S * KVW,
                 O_IKS = O_VS + (size_t)NTOK_S * KVW, O_LRUS = O_IKS + (size_t)NTOK_S * IDXD, O_CONVS = O_LRUS + (size_t)DEC_B * DM, O_END = O_CONVS + (size_t)DEC_B * 3 * DM;
static_assert(O_END == 54886400, "output size");

constexpr size_t al256(size_t x) { return (x + 255) & ~(size_t)255; }
constexpr size_t SZ_ACT = (size_t)MTOK * DM * 2;
constexpr size_t WS_CTL = 0, CTL_BYTES = 1u << 20;
constexpr size_t WS_ROPE = WS_CTL + CTL_BYTES;
constexpr size_t WS_WI = WS_ROPE + (size_t)4096 * 16 * 8;
constexpr size_t WS_WI8 = WS_WI + (size_t)41 * 256 * DM * 2;
constexpr size_t WS_XN8 = WS_WI8 + (size_t)64 * 256 * DM;
static_assert(WS_XN8 + (size_t)MTOK * DM <= WS_WI + (size_t)N1 * DM * 2, "WI region");
constexpr size_t WS_WB = WS_WI + (size_t)N1 * DM * 2;
constexpr size_t WS_WO = WS_WB + (size_t)DM * 2 * DM * 2;
constexpr size_t WS_WGU = WS_WO + (size_t)DM * DM * 2;
constexpr size_t WS_WD = WS_WGU + (size_t)2 * DFF * DM * 2;
constexpr size_t WS_WG = WS_WD + (size_t)DM * DFF * 2;
constexpr size_t WS_XN = WS_WG + (size_t)16 * 512 * 256 * 2;
constexpr size_t WS_Q = WS_XN + SZ_ACT;
constexpr size_t WS_IQ = WS_Q + SZ_ACT;
constexpr size_t WS_XL = WS_IQ + SZ_ACT;
constexpr size_t WS_GY = WS_XL + SZ_ACT;
constexpr size_t WS_SGA = WS_GY + SZ_ACT;
constexpr size_t WS_SGL = WS_SGA + SZ_ACT;
constexpr size_t WS_KV = WS_SGL + SZ_ACT;
constexpr size_t WS_IWK = WS_KV + (size_t)MTOK * 2048 * 2;
constexpr size_t WS_IKB = WS_IWK + (size_t)MTOK * 256 * 2;
constexpr size_t WS_IWF = WS_IKB + (size_t)MTOK * 128 * 2;
constexpr size_t WS_KVS = WS_IWF + (size_t)MTOK * 32 * 4;
constexpr size_t WS_IKS = WS_KVS + (size_t)DEC_B * SKV_SP * 2048 * 2;
constexpr size_t WS_SC = WS_IKS + (size_t)DEC_B * SKV_SP * 128 * 2;
constexpr size_t WS_SCS = WS_SC + (size_t)NTOK_P * SEQ * 4;
constexpr size_t WS_BM = WS_SCS + (size_t)NTOK_S * SKV_SP * 4;
constexpr size_t WS_AB = WS_BM + (size_t)MTOK * 512;
constexpr size_t WS_SUM = WS_AB + (size_t)MTOK * DM * 4;
constexpr size_t WS_OAL = WS_SUM + (size_t)128 * DM * 8;
constexpr size_t WS_END = WS_OAL + 2 * SZ_ACT;
constexpr size_t WS_PSSQ = WS_SUM;
constexpr size_t WS_H = WS_Q, WS_U = WS_XN, WS_MIX = WS_XN, WS_X1 = WS_AB, WS_A2 = WS_SC, WS_PART = WS_SC + SZ_ACT;
static_assert(WS_PART + (size_t)256 * 65536 * 4 <= WS_BM, "partial slots");
static_assert((size_t)MTOK * DFF * 2 <= 3 * SZ_ACT, "H overlay");
static_assert(WS_END <= (size_t)4 * 109707264 * 4, "workspace");

constexpr int CW_BAR = 0;
constexpr int CW_QATT = 4096;
constexpr int CW_QIDX = 4096 + 256;
constexpr int CW_SSQ = 8192;
static_assert((CW_SSQ + 2 * MTOK) * 4 <= (int)CTL_BYTES, "ctl");

__device__ __forceinline__ unsigned pk2(float lo, float hi) { unsigned r; asm volatile("v_cvt_pk_bf16_f32 %0, %1, %2" : "=v"(r) : "v"(lo), "v"(hi)); return r; }
__device__ __forceinline__ float bflo(unsigned w) { return __uint_as_float(w << 16); }
__device__ __forceinline__ float bfhi(unsigned w) { return __uint_as_float(w & 0xffff0000u); }
__device__ __forceinline__ float bf1(bf16_t b) { return __uint_as_float((unsigned)b << 16); }
__device__ __forceinline__ void unpack8(u32x4 w, float (&v)[8]) { v[0] = bflo(w.x); v[1] = bfhi(w.x); v[2] = bflo(w.y); v[3] = bfhi(w.y); v[4] = bflo(w.z); v[5] = bfhi(w.z); v[6] = bflo(w.w); v[7] = bfhi(w.w); }
__device__ __forceinline__ u32x4 pack8f(const float (&v)[8]) { u32x4 w; w.x = pk2(v[0], v[1]); w.y = pk2(v[2], v[3]); w.z = pk2(v[4], v[5]); w.w = pk2(v[6], v[7]); return w; }
__device__ __forceinline__ float sigmoidf_(float x) { return __builtin_amdgcn_rcpf(1.0f + __builtin_amdgcn_exp2f(-1.4426950408889634f * x)); }
__device__ __forceinline__ float gelu_tanh_(float x) {
    const float u = x * (1.0f + 0.044715f * x * x); return x * __builtin_amdgcn_rcpf(1.0f + __builtin_amdgcn_exp2f(-2.0f * 0.7978845608028654f * 1.4426950408889634f * u)); }
constexpr float SW8 = 64.f, SA_ATT = 8.f, SA_LRU = 4.f, S_MIX = 8.f, SXN = 4.f;
__device__ __forceinline__ unsigned pk4_fp8(float a, float b, float c, float d) { int w = __builtin_amdgcn_cvt_pk_fp8_f32(a, b, 0, false); w = __builtin_amdgcn_cvt_pk_fp8_f32(c, d, w, true); return (unsigned)w; }
#define LDS_WAIT() asm volatile("s_waitcnt lgkmcnt(0)" ::: "memory")
#define VM_WAIT() asm volatile("s_waitcnt vmcnt(0)" ::: "memory")

__device__ __forceinline__ int tid_of(int wv) { int l; asm volatile("v_mbcnt_lo_u32_b32 %0, -1, 0\n\tv_mbcnt_hi_u32_b32 %0, -1, %0" : "=v"(l)); return (wv << 6) | l; }
namespace pg8 {
typedef int i32x4_ __attribute__((ext_vector_type(4)));
constexpr int BM = 256, BK = 64, HALF = 128, HTB = HALF * BK * 2, STAGE_BYTES = 8 * HTB, NXCD = 8, WGM = 4;
__host__ __device__ __forceinline__ int lds_byte(int r, int c) { const int st = (r >> 4) * 2 + (c >> 5), rr = r & 15, cc = c & 31, ob = rr * 64 + cc * 2; return st * 1024 + (ob ^ (((ob >> 9) & 1) << 5)); }
__host__ __device__ __forceinline__ void stage_rc(int b, int& R, int& C) { const int st = b / 1024, sb = b % 1024, swz = sb ^ (((sb >> 9) & 1) << 5); R = (st >> 1) * 16 + swz / 64; C = (st & 1) * 32 + (swz % 64) / 2; }
__host__ __device__ __forceinline__ int perm32(int rho) { const int n = rho >> 4, i = rho & 15; return 8 * (i >> 2) + 4 * n + (i & 3); }

struct Unit { int pm, pn, acol, bcol, nt, part; };
struct Gemm { unsigned char* ws; size_t a_off, b_off; int lda, ldb, K; };

__device__ __forceinline__ void map_unit(int L, int nM, int nN, int& pm, int& pn) {
    const int nwg = nM * nN; int wgid = L; { const int q = nwg / NXCD, r = nwg % NXCD, xcd = wgid % NXCD, off = wgid / NXCD; wgid = (xcd < r ? xcd * (q + 1) : r * (q + 1) + (xcd - r) * q) + off; }
    const int nig = WGM * nN, gid = wgid / nig, fm = gid * WGM, gsz = (nM - fm) < WGM ? (nM - fm) : WGM;
    pm = fm + ((wgid % nig) % gsz); pn = (wgid % nig) / gsz;
}
struct StaticOrder {
    int nM, nN, nwg, G, c, blockdiag, ntk, tail;
    __device__ void init(int M, int N, int K, int G_, int c_, int bd = 0, int tail_ = 0) { tail = (G_ == 256) ? tail_ : 0; nM = M / BM - (tail == 1 ? 2 : 0); nN = N / BM; nwg = nM * nN; G = G_; c = c_; blockdiag = bd; ntk = K / BK; }
    __device__ bool next(int i, Unit& u) const {
        const long L = (long)i * G + c; const int rfull = nwg / G;
        const bool t2 = (tail == 2 && i >= rfull);
        const bool tl = (L >= nwg) && !t2;
        if (tl && (tail != 1 || i != rfull)) return false;
        if (t2 && (i > rfull || c >= 2 * (nwg - rfull * G))) return false;
        int pm0, pn0; map_unit(t2 ? rfull * G + (c >> 1) : (tl ? 0 : (int)L), nM, nN, pm0, pn0);
        const int tile = c >> 3, sp = c & 7, npair = ntk >> 1, base = npair >> 3, rem = npair & 7, p0 = sp * base + (sp < rem ? sp : rem), np = base + (sp < rem ? 1 : 0);
        const int pm = tl ? nM + (tile >> 4) : pm0, pn = tl ? (tile & 15) : pn0;
        const int koff = tl ? p0 * 2 * BK : (t2 ? (c & 1) * (ntk >> 1) * BK : 0);
        const int ac = koff + ((!tl && blockdiag) ? 256 * (pn0 >> 1) : 0);
        u = Unit{pm, pn, ac, koff, tl ? 2 * np : (t2 ? (ntk >> 1) : ntk), (tl || t2) ? c : -1};
        return true;
    }
};

template <class Epi, class Sched>
__device__ __forceinline__ void gemm_phase(LAS unsigned char* lds, const Gemm g, const Sched& S, const Epi& E, int wv) {
    const int tid = tid_of(wv);
    const int wid = __builtin_amdgcn_readfirstlane(tid >> 6), lane = tid & 63, wr = wid >> 2, wc = wid & 3, fr = lane & 15, fq = lane >> 4;
    unsigned voffA[2], voffB[2];
#pragma unroll
    for (int i = 0; i < 2; ++i) { int R, C; stage_rc(tid * 16 + i * 8192, R, C); const int Rb = Epi::PERM ? ((R & ~31) + perm32(R & 31)) : R;
        voffA[i] = (unsigned)(R * g.lda + C) * 2u; voffB[i] = (unsigned)(Rb * g.ldb + C) * 2u; }
    const size_t kstep = (size_t)(BK * 2);
    const size_t hstepA = (size_t)HALF * g.lda * 2, hstepB = (size_t)HALF * g.ldb * 2;
    const size_t tstepA = 2 * hstepA, tstepB = 2 * hstepB;
    const unsigned ldsw = (unsigned)wid * 1024u;
    constexpr bool FP8 = Epi::FP8;
    const int aoff = lds_byte(wr * 64 + fr, FP8 ? fq * 16 : fq * 8), boff = lds_byte(wc * 32 + fr, FP8 ? fq * 16 : fq * 8);
#define PG8_SA(b, h) (((b) * 2 + (h)) * HTB)
#define PG8_SB(b, h) ((4 + (b) * 2 + (h)) * HTB)
#define PG8_STAGE(bufoff, gbase, voff) do { _Pragma("unroll") for (int _i = 0; _i < 2; ++_i) \
        __builtin_amdgcn_global_load_lds((const unsigned*)((const char*)(gbase) + (voff)[_i]), (LAS unsigned*)(lds + (bufoff) + ldsw + _i * 8192), 16, 0, 0); } while (0)
#define PG8_P64(v, j) ((long)(((unsigned long)(unsigned)(v)[2 * (j) + 1] << 32) | (unsigned long)(unsigned)(v)[2 * (j)]))
#define PG8_LD32(p) __builtin_shufflevector(*(const LAS i32x4_*)(p), *(const LAS i32x4_*)((p) + 16), 0, 1, 2, 3, 4, 5, 6, 7)
#define PG8_LDA(dst, b, h) do { if constexpr (FP8) { _Pragma("unroll") for (int m = 0; m < 4; ++m) dst##8[m] = PG8_LD32(lds + PG8_SA(b, h) + aoff + m * 2048); } \
        else { _Pragma("unroll") for (int m = 0; m < 4; ++m) _Pragma("unroll") for (int k = 0; k < 2; ++k) dst[m][k] = *(const LAS bf16x8*)(lds + PG8_SA(b, h) + aoff + m * 2048 + k * 1024); } } while (0)
#define PG8_LDB(dst, b, h) do { if constexpr (FP8) { _Pragma("unroll") for (int n = 0; n < 2; ++n) dst##8[n] = PG8_LD32(lds + PG8_SB(b, h) + boff + n * 2048); } \
        else { _Pragma("unroll") for (int n = 0; n < 2; ++n) _Pragma("unroll") for (int k = 0; k < 2; ++k) dst[n][k] = *(const LAS bf16x8*)(lds + PG8_SB(b, h) + boff + n * 2048 + k * 1024); } } while (0)
#define PG8_MMA(ai, bj, At, Bt) do { __builtin_amdgcn_s_setprio(1); _Pragma("unroll") for (int m = 0; m < 4; ++m) _Pragma("unroll") for (int n = 0; n < 2; ++n) { \
        if constexpr (FP8 && FP8_MX == 2) asm volatile("v_mfma_f32_16x16x128_f8f6f4 %0, %1, %2, %0" : "+v"(acc[ai][bj][m][n]) : "v"(Bt##8[n]), "v"(At##8[m])); \
        else if constexpr (FP8 && FP8_MX == 1) acc[ai][bj][m][n] = __builtin_amdgcn_mfma_scale_f32_16x16x128_f8f6f4(Bt##8[n], At##8[m], acc[ai][bj][m][n], 0, 0, 0, 0, 0, 0); \
        else if constexpr (FP8) { _Pragma("unroll") for (int j = 0; j < 4; ++j) acc[ai][bj][m][n] = __builtin_amdgcn_mfma_f32_16x16x32_fp8_fp8(PG8_P64(Bt##8[n], j), PG8_P64(At##8[m], j), acc[ai][bj][m][n], 0, 0, 0); } \
        else { _Pragma("unroll") for (int k = 0; k < 2; ++k) acc[ai][bj][m][n] = __builtin_amdgcn_mfma_f32_16x16x32_bf16(Bt[n][k], At[m][k], acc[ai][bj][m][n], 0, 0, 0); } } __builtin_amdgcn_s_setprio(0); } while (0)
#define PG8_WAIT_V(n) asm volatile("s_waitcnt vmcnt(" #n ")" ::: "memory")
#define PG8_WAIT_L(n) asm volatile("s_waitcnt lgkmcnt(" #n ")" ::: "memory")
#define PG8_BAR __builtin_amdgcn_s_barrier()
#define PG8_SCHED __builtin_amdgcn_sched_barrier(0)
    Unit cur, nxt; int ui = 0;
    if (!S.next(0, cur)) return;
    f32x4 acc[2][2][4][2];
#pragma unroll
    for (int a = 0; a < 2; ++a)
#pragma unroll
        for (int b = 0; b < 2; ++b)
#pragma unroll
            for (int m = 0; m < 4; ++m)
#pragma unroll
                for (int n = 0; n < 2; ++n) acc[a][b][m][n] = (f32x4){0.f, 0.f, 0.f, 0.f};
    bf16x8 At[4][2], B0[2][2], B1[2][2]; i32x8 At8[4], B08[2], B18[2];
    const char* cA = (const char*)g.ws + g.a_off + (size_t)cur.pm * tstepA + (size_t)cur.acol * 2; const char* cB = (const char*)g.ws + g.b_off + (size_t)cur.pn * tstepB + (size_t)cur.bcol * 2;
    PG8_STAGE(PG8_SB(0, 0), cB, voffB); PG8_STAGE(PG8_SB(0, 1), cB + hstepB, voffB); PG8_STAGE(PG8_SA(0, 0), cA, voffA); PG8_STAGE(PG8_SA(0, 1), cA + hstepA, voffA);
    if (wr == 1) PG8_BAR;
    PG8_WAIT_V(2); PG8_BAR;
    PG8_STAGE(PG8_SB(1, 0), cB + kstep, voffB); PG8_STAGE(PG8_SA(1, 0), cA + kstep, voffA); PG8_STAGE(PG8_SB(1, 1), cB + hstepB + kstep, voffB);
    PG8_WAIT_V(6); PG8_BAR;
    for (;;) {
        const bool has_next = S.next(ui + 1, nxt);
        const char* nA = has_next ? (const char*)g.ws + g.a_off + (size_t)nxt.pm * tstepA + (size_t)nxt.acol * 2 : cA; const char* nB = has_next ? (const char*)g.ws + g.b_off + (size_t)nxt.pn * tstepB + (size_t)nxt.bcol * 2 : cB;
        const int nt = cur.nt;
        for (int t = 0; t < nt; t += 2) {
            const bool last = (t == nt - 2);
            const char* a1 = cA + (size_t)(t + 1) * kstep;
            const char* a2 = last ? nA : cA + (size_t)(t + 2) * kstep; const char* b2 = last ? nB : cB + (size_t)(t + 2) * kstep;
            const char* a3 = a2 + kstep; const char* b3 = b2 + kstep;
            if constexpr (Epi::MID) { if (cur.part < 0 && t == (nt >> 1)) { if constexpr (FP8 && FP8_MX == 2) asm volatile("s_nop 15\n\ts_nop 15" ::: "memory"); E.mid(acc, cur, wr, wc, fr, fq); } }
            PG8_LDB(B0, 0, 0); PG8_LDB(B1, 0, 1); PG8_SCHED; PG8_LDA(At, 0, 0); PG8_STAGE(PG8_SA(1, 1), a1 + hstepA, voffA);
            PG8_WAIT_V(8); PG8_WAIT_L(0); PG8_BAR; PG8_MMA(0, 0, At, B0); PG8_MMA(0, 1, At, B1); PG8_BAR; PG8_SCHED;
            PG8_LDA(At, 0, 1); PG8_STAGE(PG8_SB(0, 0), b2, voffB); PG8_STAGE(PG8_SB(0, 1), b2 + hstepB, voffB); PG8_STAGE(PG8_SA(0, 0), a2, voffA);
            PG8_WAIT_V(8); PG8_WAIT_L(0); PG8_BAR; PG8_MMA(1, 0, At, B0); PG8_MMA(1, 1, At, B1); PG8_BAR; PG8_SCHED;
            PG8_LDB(B0, 1, 0); PG8_LDB(B1, 1, 1); PG8_SCHED; PG8_LDA(At, 1, 0); PG8_STAGE(PG8_SA(0, 1), a2 + hstepA, voffA);
            PG8_WAIT_V(8); PG8_WAIT_L(0); PG8_BAR; PG8_MMA(0, 0, At, B0); PG8_MMA(0, 1, At, B1); PG8_BAR; PG8_SCHED;
            PG8_LDA(At, 1, 1); PG8_STAGE(PG8_SB(1, 0), b3, voffB); PG8_STAGE(PG8_SB(1, 1), b3 + hstepB, voffB); PG8_STAGE(PG8_SA(1, 0), a3, voffA);
            PG8_WAIT_V(8); PG8_WAIT_L(0); PG8_BAR; PG8_MMA(1, 0, At, B0); PG8_MMA(1, 1, At, B1); PG8_BAR; PG8_SCHED;
        }
        if (wr == 0) PG8_BAR;
        if constexpr (FP8 && FP8_MX == 2) asm volatile("s_nop 15\n\ts_nop 15" ::: "memory");
        int fr_ = fr, fq_ = fq; asm volatile("" : "+v"(fr_), "+v"(fq_));
        if (cur.part < 0) E(acc, cur, wr, wc, fr_, fq_);
        else {
            float* P = (float*)(g.ws + WS_PART) + (size_t)cur.part * (BM * BM) + (size_t)(wr * 64 + fr_) * BM + wc * 32 + (Epi::PERM ? 8 * fq_ : 4 * fq_);
#pragma unroll
            for (int ai = 0; ai < 2; ++ai)
#pragma unroll
                for (int m = 0; m < 4; ++m)
#pragma unroll
                    for (int bj = 0; bj < 2; ++bj)
#pragma unroll
                        for (int n = 0; n < 2; ++n) *(f32x4*)(P + (size_t)(ai * HALF + m * 16) * BM + bj * HALF + (Epi::PERM ? 4 * n : 16 * n)) = acc[ai][bj][m][n]; }
        if (!has_next) break;
#pragma unroll
        for (int a = 0; a < 2; ++a)
#pragma unroll
            for (int b = 0; b < 2; ++b)
#pragma unroll
                for (int m = 0; m < 4; ++m)
#pragma unroll
                    for (int n = 0; n < 2; ++n) acc[a][b][m][n] = (f32x4){0.f, 0.f, 0.f, 0.f};
        cur = nxt; cA = nA; cB = nB; ++ui;
        if (wr == 1) PG8_BAR;
    }
    PG8_WAIT_V(0);
    PG8_BAR;
#undef PG8_SA
#undef PG8_SB
#undef PG8_STAGE
#undef PG8_LDA
#undef PG8_LDB
#undef PG8_MMA
#undef PG8_LD32
#undef PG8_P64
#undef PG8_WAIT_V
#undef PG8_WAIT_L
#undef PG8_BAR
#undef PG8_SCHED
}
}

#define XB_TMO      128
#define XB_XCNT(j)  (256  + 64 * (j))
#define XB_XSUB(j)  (1280 + 64 * (j))
#define XB_XGEN(j)  (2304 + 64 * (j))
#define XB_TOP      3328
#define XB_TOPGEN   3392
#define XCD_BAR_WORDS 3456
#define XB_SPIN_CAP (1u << 18)
__device__ __forceinline__ unsigned xb_ld(unsigned* p)              { return __hip_atomic_load(p, __ATOMIC_RELAXED, __HIP_MEMORY_SCOPE_AGENT); }
__device__ __forceinline__ unsigned xb_add(unsigned* p, unsigned v) { return __hip_atomic_fetch_add(p, v, __ATOMIC_RELAXED, __HIP_MEMORY_SCOPE_AGENT); }
__device__ __forceinline__ unsigned xb_xcc_id() { return (unsigned)__builtin_amdgcn_s_getreg((3 << 11) | 20) & 0xFu; }
#define XB_SPIN(cond, bar) do { unsigned _sp = 0; while (cond) { __builtin_amdgcn_s_sleep(1); \
    if ((++_sp & 255u) == 0u) { if (xb_ld(&(bar)[XB_TMO])) break; if (_sp > XB_SPIN_CAP) { atomicAdd(&(bar)[XB_TMO], 1u); break; } } } } while (0)
struct XcdBarrier { unsigned* bar; unsigned x; volatile LAS unsigned* st; int wv; };
__device__ __forceinline__ bool xb_leader(int wv) { return wv == 0 && __builtin_amdgcn_mbcnt_hi(~0u, __builtin_amdgcn_mbcnt_lo(~0u, 0u)) == 0u; }
__device__ __forceinline__ XcdBarrier xcd_barrier_post(unsigned* bar, volatile LAS unsigned* st, int wv) {
    XcdBarrier b; b.bar = bar; b.x = xb_xcc_id(); b.st = st; b.wv = wv;
    if (xb_leader(wv)) (void)xb_add(&bar[XB_XCNT(b.x)], 1u);
    return b;
}
__device__ __forceinline__ void xcd_barrier_complete(unsigned* bar, unsigned x, unsigned& nloc, unsigned& nx) {
    const unsigned G = gridDim.x * gridDim.y * gridDim.z;
    unsigned sum, cnt, mine, sp = 0u;
    for (;;) {
        sum = 0u; cnt = 0u; mine = 0u;
#pragma unroll
        for (unsigned j = 0; j < 16; ++j) { const unsigned c = xb_ld(&bar[XB_XCNT(j)]); sum += c; cnt += (c > 0u) ? 1u : 0u; mine = (j == x) ? c : mine; }
        if (sum == G) break;
        __builtin_amdgcn_s_sleep(1);
        if ((++sp & 255u) == 0u) { if (xb_ld(&bar[XB_TMO])) break; if (sp > XB_SPIN_CAP) { atomicAdd(&bar[XB_TMO], 1u); break; } }
    }
    nloc = mine > 0u ? mine : 1u; nx = cnt > 0u ? cnt : 1u;
}
__device__ __forceinline__ void xcd_barrier(const XcdBarrier& b) {
    asm volatile("s_waitcnt vmcnt(0)" ::: "memory");
    __syncthreads();
    if (xb_leader(b.wv)) {
        unsigned* bar = b.bar;
        __builtin_amdgcn_s_waitcnt(0);
        unsigned nloc = b.st[0], nx = b.st[1];
        if (nloc == 0u) { xcd_barrier_complete(bar, b.x, nloc, nx); b.st[0] = nloc; b.st[1] = nx; }
        const unsigned old = xb_add(&bar[XB_XSUB(b.x)], 1u);
        const unsigned gen = old / nloc;
        if (old + 1u == (gen + 1u) * nloc) {
            __builtin_amdgcn_fence(__ATOMIC_RELEASE, "agent");
            asm volatile("s_waitcnt vmcnt(0)" ::: "memory");
            const unsigned og = xb_add(&bar[XB_TOP], 1u);
            const unsigned tg = og / nx;
            if (og + 1u == (tg + 1u) * nx) xb_add(&bar[XB_TOPGEN], 1u);
            else XB_SPIN(xb_ld(&bar[XB_TOPGEN]) == tg, bar);
            __builtin_amdgcn_fence(__ATOMIC_ACQUIRE, "agent");
            xb_add(&bar[XB_XGEN(b.x)], 1u);
            asm volatile("s_waitcnt vmcnt(0)" ::: "memory");
        } else {
            XB_SPIN(xb_ld(&bar[XB_XGEN(b.x)]) == gen, bar);
            __builtin_amdgcn_fence(__ATOMIC_ACQUIRE, "agent");
            asm volatile("s_waitcnt vmcnt(0)" ::: "memory");
        }
    }
    __syncthreads();
}

constexpr int NWAVES = 8, NTHR = 512;
constexpr int RING_OFF = 0, RING_BYTES = 131072;
constexpr int LDSCTL_OFF = RING_BYTES, MISC_OFF = LDSCTL_OFF + 320;
constexpr int LDS_BYTES = 147456;
struct Args { const float* in[25]; float* out; unsigned char* ws; };
constexpr int PTR_OFF = MISC_OFF + 128;
static_assert(PTR_OFF + 28 * 8 <= LDS_BYTES, "LDS map");
struct Frame {
    LAS unsigned char* lds; volatile LAS unsigned* MISC;
    int tid, lane, wave, vcu, G, gw, NGW;
};
__device__ __forceinline__ Frame make_frame(LAS unsigned char* lds, int wv) {
    Frame F; F.lds = lds; F.MISC = (volatile LAS unsigned*)(lds + MISC_OFF);
    const int t = tid_of(wv);
    F.tid = t; F.lane = t & 63; F.wave = wv;
    F.G = gridDim.x; { const int bx = blockIdx.x; F.vcu = (F.G % 8 == 0) ? (bx % 8) * (F.G / 8) + bx / 8 : bx; }
    F.gw = F.vcu * NWAVES + F.wave; F.NGW = F.G * NWAVES; return F;
}
__device__ __forceinline__ unsigned long long ldsb_u64(LAS unsigned char* lds, int i) {
    volatile LAS unsigned* p = (volatile LAS unsigned*)(lds + PTR_OFF) + 2 * i;
    const unsigned lo = __builtin_amdgcn_readfirstlane(p[0]), hi = __builtin_amdgcn_readfirstlane(p[1]);
    return ((unsigned long long)hi << 32) | lo;
}
__device__ __forceinline__ const float* e_in(LAS unsigned char* lds, int i) { return (const float*)(const GAS float*)ldsb_u64(lds, i); }
__device__ __forceinline__ float* e_out(LAS unsigned char* lds) { return (float*)(GAS float*)ldsb_u64(lds, 25); }
__device__ __forceinline__ unsigned char* e_ws(LAS unsigned char* lds) { return (unsigned char*)(GAS unsigned char*)ldsb_u64(lds, 26); }
__device__ __forceinline__ unsigned long long lds_u64(const Frame& F, int i) {
    volatile LAS unsigned* p = (volatile LAS unsigned*)(F.lds + PTR_OFF) + 2 * i;
    const unsigned lo = __builtin_amdgcn_readfirstlane(p[0]), hi = __builtin_amdgcn_readfirstlane(p[1]);
    return ((unsigned long long)hi << 32) | lo;
}
__device__ __forceinline__ const float* in_ptr(const Frame& F, int i) { return (const float*)(const GAS float*)lds_u64(F, i); }
__device__ __forceinline__ float* out_ptr(const Frame& F) { return (float*)(GAS float*)lds_u64(F, 25); }
__device__ __forceinline__ unsigned char* ws_ptr(const Frame& F) { return (unsigned char*)(GAS unsigned char*)lds_u64(F, 26); }
__device__ __forceinline__ unsigned* ctl_ptr(const Frame& F) { return (unsigned*)(ws_ptr(F) + WS_CTL); }

__device__ __forceinline__ void tr_item(const float* src, size_t spitch, int k0, int c0, bf16_t* dst, size_t dpitch, int r0, LAS unsigned* scr, int lane) {
    const int ln = lane & 7, g = lane >> 3;
    if (src == nullptr) {
#pragma unroll
        for (int j = 0; j < 8; ++j) { const int n = 4 * j + (lane >> 4), c = lane & 15; *(u32x4*)(dst + (size_t)(r0 + n) * dpitch + k0 + 8 * c) = (u32x4){0u, 0u, 0u, 0u}; }
        return;
    }
    f32x4 v[16];
#pragma unroll
    for (int i = 0; i < 16; ++i) { const int k = k0 + 16 * (i >> 1) + 2 * g + (i & 1); v[i] = __builtin_nontemporal_load((const f32x4*)(src + (size_t)k * spitch + c0 + 4 * ln)); }
#pragma unroll
    for (int ip = 0; ip < 8; ++ip)
#pragma unroll
        for (int c = 0; c < 4; ++c) scr[(4 * ln + c) * 65 + 8 * ip + g] = pk2(v[2 * ip][c], v[2 * ip + 1][c]);
    LDS_WAIT();
#pragma unroll
    for (int j = 0; j < 8; ++j) { const int n = 4 * j + (lane >> 4), c = lane & 15; const LAS unsigned* s = scr + n * 65 + 4 * c;
        u32x4 o; o.x = s[0]; o.y = s[1]; o.z = s[2]; o.w = s[3];
        *(u32x4*)(dst + (size_t)(r0 + n) * dpitch + k0 + 8 * c) = o; }
    LDS_WAIT();
}
__device__ __forceinline__ void tr_item8(const float* src, size_t spitch, int k0, int c0, unsigned char* dst, size_t dpitch, int r0, float scale, LAS unsigned* scr, int lane) {
    const int ln = lane & 7, g = lane >> 3;
    f32x4 v[16];
#pragma unroll
    for (int i = 0; i < 16; ++i) { const int k = k0 + 32 * (i >> 2) + 4 * g + (i & 3); v[i] = __builtin_nontemporal_load((const f32x4*)(src + (size_t)k * spitch + c0 + 4 * ln)); }
#pragma unroll
    for (int ib = 0; ib < 4; ++ib)
#pragma unroll
        for (int c = 0; c < 4; ++c) scr[(4 * ln + c) * 33 + 8 * ib + g] = pk4_fp8(v[4 * ib][c] * scale, v[4 * ib + 1][c] * scale, v[4 * ib + 2][c] * scale, v[4 * ib + 3][c] * scale);
    LDS_WAIT();
#pragma unroll
    for (int j = 0; j < 4; ++j) { const int n = 8 * j + (lane >> 3), c8 = lane & 7; const LAS unsigned* p = scr + n * 33 + 4 * c8;
        u32x4 o; o.x = p[0]; o.y = p[1]; o.z = p[2]; o.w = p[3];
        *(u32x4*)(dst + (size_t)(r0 + n) * dpitch + k0 + 16 * c8) = o; }
    LDS_WAIT();
}
__device__ __forceinline__ float wave_sum(float v) {
#pragma unroll
    for (int o = 1; o < 64; o <<= 1) v += __shfl_xor(v, o);
    return v;
}
struct TrDesc { const float* src; unsigned char* dst; int spitch, dpitch  ; int k0, c0, r0, f8; };
struct TrPtrs { const float *w_in, *w_branch, *w_out, *w_gate, *w_up, *w_down, *wa, *wx; unsigned char* ws; };
__device__ __forceinline__ TrDesc tr_decode(const TrPtrs& P, int it) {
    constexpr int I0 = 32 * 840, I1 = 64 * 128, I2 = 32 * 128, I3 = 32 * 688, I4 = 86 * 128;
    TrDesc d; int r = it;
    if (r < I0) { const int kb = r / 840, gidx = r % 840, pn = gidx >> 3, gi = gidx & 7; int c0; const float* src = P.w_in;
        if (gidx < 320) c0 = 32 * gidx; else if (gidx < 324) c0 = 10272 + 32 * (gidx - 320); else if (gidx == 324) c0 = 10240; else if (gidx < 328) { c0 = 0; src = nullptr; } else c0 = 32 * gidx - 96;
        const bool f8 = pn < 16 || pn >= 57; const int lt = pn < 16 ? pn : (pn < 24 ? pn - 16 : (pn < 40 ? pn - 16 : (pn < 41 ? 24 : (pn < 57 ? pn - 16 : pn - 41))));
        d = TrDesc{src, P.ws + (f8 ? WS_WI8 : WS_WI), N1_SRC, f8 ? DM : 2 * DM, 128 * kb, c0, 256 * lt + 32 * gi, f8 ? 1 : 0}; return d; } r -= I0;
    if (r < I1) { const int kb = r / 128, gidx = r % 128; d = TrDesc{P.w_branch, P.ws + WS_WB, DM, 2 * DM, 128 * kb, 32 * gidx, 32 * gidx, 1}; return d; } r -= I1;
    if (r < I2) { const int kb = r / 128, gidx = r % 128; d = TrDesc{P.w_out, P.ws + WS_WO, DM, P9_FP8 ? DM : 2 * DM, 128 * kb, 32 * gidx, 32 * gidx, P9_FP8 ? 1 : 0}; return d; } r -= I2;
    if (r < I3) { const int kb = r / 688, gidx = r % 688, pn = gidx >> 3, gi = gidx & 7; d = TrDesc{(gi < 4) ? P.w_gate : P.w_up, P.ws + WS_WGU, DFF, 2 * DM, 128 * kb, 128 * pn + 32 * (gi & 3), 32 * gidx, 0}; return d; } r -= I3;
    if (r < I4) { const int kb = r / 128, gidx = r % 128; d = TrDesc{P.w_down, P.ws + WS_WD, DM, 2 * DFF, 128 * kb, 32 * gidx, 32 * gidx, 0}; return d; } r -= I4;
    { const int kb = r / 256, gidx = r % 256, tn = gidx >> 3, gi = gidx & 7, blk = tn >> 1, hh = tn & 1;
      d = TrDesc{((gi < 4) ? P.wa : P.wx) + (size_t)blk * 65536, P.ws + WS_WG, 256, 512, 128 * kb, 128 * hh + 32 * (gi & 3), 32 * gidx, 0}; return d; }
}
__device__ __forceinline__ void tr_load(const TrDesc& d, f32x4 (&v)[16], int lane) {
    if (d.src == nullptr) return;
    const int ln = lane & 7, g = lane >> 3; const float* p = d.src + d.c0 + 4 * ln;
    if (d.f8) {
#pragma unroll
        for (int i = 0; i < 16; ++i) v[i] = __builtin_nontemporal_load((const f32x4*)(p + (size_t)(d.k0 + 32 * (i >> 2) + 4 * g + (i & 3)) * d.spitch)); }
    else {
#pragma unroll
        for (int i = 0; i < 16; ++i) v[i] = __builtin_nontemporal_load((const f32x4*)(p + (size_t)(d.k0 + 16 * (i >> 1) + 2 * g + (i & 1)) * d.spitch)); }
}
__device__ __forceinline__ void tr_store(const TrDesc& d, const f32x4 (&v)[16], LAS unsigned* scr, int lane) {
    const int ln = lane & 7, g = lane >> 3;
    if (d.f8) {
#pragma unroll
        for (int ib = 0; ib < 4; ++ib)
#pragma unroll
            for (int c = 0; c < 4; ++c) scr[(4 * ln + c) * 33 + 8 * ib + g] = pk4_fp8(v[4 * ib][c] * SW8, v[4 * ib + 1][c] * SW8, v[4 * ib + 2][c] * SW8, v[4 * ib + 3][c] * SW8);
        LDS_WAIT();
#pragma unroll
        for (int j = 0; j < 4; ++j) { const int n = 8 * j + (lane >> 3), c8 = lane & 7; const LAS unsigned* p = scr + n * 33 + 4 * c8;
            *(u32x4*)(d.dst + (size_t)(d.r0 + n) * d.dpitch + d.k0 + 16 * c8) = (u32x4){p[0], p[1], p[2], p[3]}; }
        LDS_WAIT();
    } else if (d.src == nullptr) {
#pragma unroll
        for (int j = 0; j < 8; ++j) { const int n = 4 * j + (lane >> 4), c = lane & 15; *(u32x4*)(d.dst + (size_t)(d.r0 + n) * d.dpitch + 2 * d.k0 + 16 * c) = (u32x4){0u, 0u, 0u, 0u}; }
    } else {
#pragma unroll
        for (int ip = 0; ip < 8; ++ip)
#pragma unroll
            for (int c = 0; c < 4; ++c) scr[(4 * ln + c) * 65 + 8 * ip + g] = pk2(v[2 * ip][c], v[2 * ip + 1][c]);
        LDS_WAIT();
#pragma unroll
        for (int j = 0; j < 8; ++j) { const int n = 4 * j + (lane >> 4), c = lane & 15; const LAS unsigned* p = scr + n * 65 + 4 * c;
            *(u32x4*)(d.dst + (size_t)(d.r0 + n) * d.dpitch + 2 * d.k0 + 16 * c) = (u32x4){p[0], p[1], p[2], p[3]}; }
        LDS_WAIT();
    }
}
constexpr int CONV_BASE = 32 * 840, CONV_N = 64 * 128 + 32 * 128 + 32 * 688 + 86 * 128;
constexpr int CW_QCONV = 4096 + 512;
__device__ __forceinline__ void conv_drain(Frame& F) {
    unsigned char* const ws = ws_ptr(F); unsigned* head = ctl_ptr(F) + CW_QCONV;
    LAS unsigned* scr = (LAS unsigned*)(F.lds + RING_OFF + F.wave * 16384);
    TrPtrs P{in_ptr(F, 8), in_ptr(F, 19), in_ptr(F, 20), in_ptr(F, 22), in_ptr(F, 23), in_ptr(F, 24), in_ptr(F, 14), in_ptr(F, 16), ws};
    constexpr int NQ8 = (CONV_N * 7 / 8) / 8, REST0 = NQ8 * 8, NQ = NQ8 + (CONV_N - REST0) / 2;
    static_assert((CONV_N - REST0) % 2 == 0, "pairs");
    int q = 0; if (F.lane == 0) q = (int)__hip_atomic_fetch_add(head, 1u, __ATOMIC_RELAXED, __HIP_MEMORY_SCOPE_AGENT);
    q = __builtin_amdgcn_readfirstlane(q);
    while (q < NQ) {
        int qn = 0; if (F.lane == 0) qn = (int)__hip_atomic_fetch_add(head, 1u, __ATOMIC_RELAXED, __HIP_MEMORY_SCOPE_AGENT);
        const int i0 = CONV_BASE + (q < NQ8 ? 8 * q : REST0 + 2 * (q - NQ8)), n = q < NQ8 ? 8 : 2;
#pragma unroll 1
        for (int j = 0; j < n; j += 2) {
            const TrDesc da = tr_decode(P, i0 + j), db = tr_decode(P, i0 + j + 1);
            f32x4 va[16], vb[16]; tr_load(da, va, F.lane); tr_load(db, vb, F.lane);
            tr_store(da, va, scr, F.lane); tr_store(db, vb, scr, F.lane);
        }
        q = __builtin_amdgcn_readfirstlane(qn);
    }
}
__device__ __forceinline__ void p0_prologue(Frame& F) {
    unsigned char* const ws = ws_ptr(F); const float* const in0 = in_ptr(F, 0); const float* const in1 = in_ptr(F, 1); const float* const in2 = in_ptr(F, 2); const float* const in3 = in_ptr(F, 3); const float* const in4 = in_ptr(F, 4); const float* const in7 = in_ptr(F, 7); const float* const in8 = in_ptr(F, 8); const float* const in14 = in_ptr(F, 14); const float* const in16 = in_ptr(F, 16); const float* const in19 = in_ptr(F, 19); const float* const in20 = in_ptr(F, 20); const float* const in22 = in_ptr(F, 22); const float* const in23 = in_ptr(F, 23); const float* const in24 = in_ptr(F, 24);
    LAS unsigned* scr = (LAS unsigned*)(F.lds + RING_OFF + F.wave * 16384);
    const int lane = F.lane;
    constexpr int I0 = 32 * 840, I1 = 64 * 128, I2 = 32 * 128, I3 = 32 * 688, I4 = 86 * 128, I5 = 2 * 256;
    constexpr int NITEMS = I0 + I1 + I2 + I3 + I4 + I5;
    bf16_t* WI = (bf16_t*)(ws + WS_WI); bf16_t* WB = (bf16_t*)(ws + WS_WB); bf16_t* WO = (bf16_t*)(ws + WS_WO); bf16_t* WGU = (bf16_t*)(ws + WS_WGU); bf16_t* WD = (bf16_t*)(ws + WS_WD); bf16_t* WG = (bf16_t*)(ws + WS_WG);
    for (int jt = F.gw; jt < NITEMS - CONV_N; jt += F.NGW) { const int it = jt < I0 ? jt : jt + CONV_N;
        int r = it;
        if (r < I0) { const int kb = r / 840, gidx = r % 840, pn = gidx >> 3, gi = gidx & 7; int c0; const float* src = in8;
            if (gidx < 320) c0 = 32 * gidx; else if (gidx < 324) c0 = 10272 + 32 * (gidx - 320); else if (gidx == 324) c0 = 10240; else if (gidx < 328) { c0 = 0; src = nullptr; } else c0 = 32 * gidx - 96;
            const bool f8 = pn < 16 || pn >= 57; const int lt = pn < 16 ? pn : (pn < 24 ? pn - 16 : (pn < 40 ? pn - 16 : (pn < 41 ? 24 : (pn < 57 ? pn - 16 : pn - 41))));
            if (f8) tr_item8(src, N1_SRC, 128 * kb, c0, ws + WS_WI8, DM, 256 * lt + 32 * gi, SW8, scr, lane);
            else tr_item(src, N1_SRC, 128 * kb, c0, WI, DM, 256 * lt + 32 * gi, scr, lane);
            continue; } r -= I0;
        if (r < I1) { const int kb = r / 128, gidx = r % 128; tr_item8(in19, DM, 128 * kb, 32 * gidx, (unsigned char*)WB, 2 * DM, 32 * gidx, SW8, scr, lane); continue; } r -= I1;
        if (r < I2) { const int kb = r / 128, gidx = r % 128;
            if (P9_FP8) tr_item8(in20, DM, 128 * kb, 32 * gidx, (unsigned char*)WO, DM, 32 * gidx, SW8, scr, lane); else tr_item(in20, DM, 128 * kb, 32 * gidx, WO, DM, 32 * gidx, scr, lane);
            continue; } r -= I2;
        if (r < I3) { const int kb = r / 688, gidx = r % 688, pn = gidx >> 3, gi = gidx & 7; const float* src = (gi < 4) ? in22 : in23;
            tr_item(src, DFF, 128 * kb, 128 * pn + 32 * (gi & 3), WGU, DM, 32 * gidx, scr, lane); continue; } r -= I3;
        if (r < I4) { const int kb = r / 128, gidx = r % 128; tr_item(in24, DM, 128 * kb, 32 * gidx, WD, DFF, 32 * gidx, scr, lane); continue; } r -= I4;
        { const int kb = r / 256, gidx = r % 256, tn = gidx >> 3, gi = gidx & 7, blk = tn >> 1, hh = tn & 1; const float* src = ((gi < 4) ? in14 : in16) + (size_t)blk * 65536;
            tr_item(src, 256, 128 * kb, 128 * hh + 32 * (gi & 3), WG, 256, 32 * gidx, scr, lane); }
    }
    {
        bf16_t* XN = (bf16_t*)(ws + WS_XN); const float* gm = in7;
        f32x4 ggv[16];
#pragma unroll
        for (int j = 0; j < 16; ++j) ggv[j] = *(const f32x4*)(gm + 4 * lane + 256 * j);
        for (int m = F.gw; m < MTOK; m += F.NGW) {
            const float* xr = (m < NTOK_P) ? in0 + (size_t)m * DM : in1 + (size_t)(m - NTOK_P) * DM;
            f32x4 v[16]; float s = 0.f;
#pragma unroll
            for (int j = 0; j < 16; ++j) { v[j] = __builtin_nontemporal_load((const f32x4*)(xr + 4 * lane + 256 * j)); s += (v[j].x * v[j].x + v[j].y * v[j].y) + (v[j].z * v[j].z + v[j].w * v[j].w); }
            const float rstd = 1.0f / sqrtf(wave_sum(s) * (1.0f / DM) + EPS);
#pragma unroll
            for (int j = 0; j < 16; ++j) { const f32x4 gg = ggv[j];
                u32x2 o; o.x = pk2(v[j].x * rstd * gg.x, v[j].y * rstd * gg.y); o.y = pk2(v[j].z * rstd * gg.z, v[j].w * rstd * gg.w);
                *(u32x2*)(XN + (size_t)m * DM + 4 * lane + 256 * j) = o;
                *(unsigned*)(ws + WS_XN8 + (size_t)m * DM + 4 * lane + 256 * j) = pk4_fp8(v[j].x * rstd * gg.x * SXN, v[j].y * rstd * gg.y * SXN, v[j].z * rstd * gg.z * SXN, v[j].w * rstd * gg.w * SXN); }
        }
    }
    {
        f32x2* RT = (f32x2*)(ws + WS_ROPE);
        for (int i = F.gw * 64 + lane; i < 4096 * 16; i += F.NGW * 64) { const int pos = i >> 4, j = i & 15;
            const double inv = pow(500000.0, -(double)j / 16.0); const double ang = (double)pos * inv; RT[i] = (f32x2){(float)cos(ang), (float)sin(ang)}; }
    }
    {
        bf16_t* KVS = (bf16_t*)(ws + WS_KVS); bf16_t* IKS = (bf16_t*)(ws + WS_IKS);
        const size_t gt = (size_t)F.gw * 64 + lane, GT = (size_t)F.NGW * 64;
        for (size_t i = gt; i < (size_t)DEC_B * PAST * 128; i += 2 * GT) {
            size_t ia[2]; ia[0] = i; ia[1] = (i + GT < (size_t)DEC_B * PAST * 128) ? i + GT : i;
            f32x4 kk[2][2], vv[2][2];
#pragma unroll
            for (int h = 0; h < 2; ++h) { const size_t row = ia[h] >> 7; const int ch = (int)(ia[h] & 127);
                kk[h][0] = __builtin_nontemporal_load((const f32x4*)(in2 + row * 1024 + 8 * ch)); kk[h][1] = __builtin_nontemporal_load((const f32x4*)(in2 + row * 1024 + 8 * ch + 4));
                vv[h][0] = __builtin_nontemporal_load((const f32x4*)(in3 + row * 1024 + 8 * ch)); vv[h][1] = __builtin_nontemporal_load((const f32x4*)(in3 + row * 1024 + 8 * ch + 4)); }
            asm volatile("" ::: "memory");
#pragma unroll
            for (int h = 0; h < 2; ++h) { const size_t row = ia[h] >> 7; const int ch = (int)(ia[h] & 127); const size_t b = row >> 11, sidx = row & 2047;
                bf16_t* d = KVS + (b * SKV_SP + sidx) * 2048 + 8 * ch;
                *(u32x4*)d = (u32x4){pk2(kk[h][0].x, kk[h][0].y), pk2(kk[h][0].z, kk[h][0].w), pk2(kk[h][1].x, kk[h][1].y), pk2(kk[h][1].z, kk[h][1].w)};
                *(u32x4*)(d + 1024) = (u32x4){pk2(vv[h][0].x, vv[h][0].y), pk2(vv[h][0].z, vv[h][0].w), pk2(vv[h][1].x, vv[h][1].y), pk2(vv[h][1].z, vv[h][1].w)}; }
        }
        for (size_t i = gt; i < (size_t)DEC_B * PAST * 16; i += GT) {
            const size_t row = i >> 4; const int ch = (int)(i & 15); const size_t b = row >> 11, s = row & 2047;
            const f32x4 k0 = *(const f32x4*)(in4 + row * 128 + 8 * ch), k1 = *(const f32x4*)(in4 + row * 128 + 8 * ch + 4);
            *(u32x4*)(IKS + (b * SKV_SP + s) * 128 + 8 * ch) = (u32x4){pk2(k0.x, k0.y), pk2(k0.z, k0.w), pk2(k1.x, k1.y), pk2(k1.z, k1.w)};
        }
        for (size_t i = gt; i < (size_t)DEC_B * 32 * 256; i += GT) {
            const size_t r = i >> 8; const int ch = (int)(i & 255); const size_t b = r >> 5, s = SKV_S + (r & 31);
            *(u32x4*)(KVS + (b * SKV_SP + s) * 2048 + 8 * ch) = (u32x4){0u, 0u, 0u, 0u};
        }
        for (size_t i = gt; i < (size_t)DEC_B * 32 * 16; i += GT) {
            const size_t r = i >> 4; const int ch = (int)(i & 15); const size_t b = r >> 5, s = SKV_S + (r & 31);
            *(u32x4*)(IKS + (b * SKV_SP + s) * 128 + 8 * ch) = (u32x4){0u, 0u, 0u, 0u};
        }
    }
}

constexpr int XCH_OFF = LDSCTL_OFF + 1024;
static_assert(XCH_OFF + 8192 <= LDS_BYTES, "LDS map");
__device__ __forceinline__ void head_sumsq_exchange(const f32x4 (&acc)[2][2][4][2], float ds2, LAS unsigned char* lds, int wr, int wc, int fr, int fq) {
    LAS float* X = (LAS float*)(lds + XCH_OFF);
#pragma unroll
    for (int ai = 0; ai < 2; ++ai)
#pragma unroll
        for (int m = 0; m < 4; ++m)
#pragma unroll
            for (int bj = 0; bj < 2; ++bj) { const f32x4 a = acc[ai][bj][m][0], b = acc[ai][bj][m][1];
                float s = ((a[0] * a[0] + a[1] * a[1]) + (a[2] * a[2] + a[3] * a[3])) + ((b[0] * b[0] + b[1] * b[1]) + (b[2] * b[2] + b[3] * b[3]));
                s += __shfl_xor(s, 16); s += __shfl_xor(s, 32);
                if (fq == 0) X[((ai * 128 + wr * 64 + m * 16 + fr) * 2 + bj) * 4 + wc] = s * ds2; }
    asm volatile("s_waitcnt lgkmcnt(0)" ::: "memory"); __builtin_amdgcn_s_barrier(); asm volatile("" ::: "memory");
}
__device__ __forceinline__ float head_rstd(LAS unsigned char* lds, int rl, int bj) {
    const f32x4 p = *(const LAS f32x4*)(lds + XCH_OFF + ((rl * 2 + bj) * 4) * 4); return 1.0f / sqrtf(((p[0] + p[1]) + (p[2] + p[3])) * (1.0f / 128.0f) + EPS); }
__device__ __forceinline__ void rope_epi(float (&y)[8], const f32x2* RT, int pos, int fq) {
    const f32x4* cp = (const f32x4*)(RT + (size_t)pos * 16 + 8 * (fq & 1)); const f32x4 c0 = cp[0], c1 = cp[1], c2 = cp[2], c3 = cp[3];
    const float cs[8] = {c0[0], c0[2], c1[0], c1[2], c2[0], c2[2], c3[0], c3[2]}, sn[8] = {c0[1], c0[3], c1[1], c1[3], c2[1], c2[3], c3[1], c3[3]};
#pragma unroll
    for (int e = 0; e < 8; ++e) { const float p = __shfl_xor(y[e], 32); y[e] = (fq < 2) ? (y[e] * cs[e] - p * sn[e]) : (y[e] * cs[e] + p * sn[e]); }
}
struct RopeCS { f32x4 c0, c1, c2, c3; };
__device__ __forceinline__ RopeCS rope_load(const f32x2* RT, int pos, int fq) { const f32x4* cp = (const f32x4*)(RT + (size_t)pos * 16 + 8 * (fq & 1)); RopeCS r; r.c0 = cp[0]; r.c1 = cp[1]; r.c2 = cp[2]; r.c3 = cp[3]; return r; }
__device__ __forceinline__ void rope_apply(float (&y)[8], const RopeCS& r, int fq) {
    const float cs[8] = {r.c0[0], r.c0[2], r.c1[0], r.c1[2], r.c2[0], r.c2[2], r.c3[0], r.c3[2]}, sn[8] = {r.c0[1], r.c0[3], r.c1[1], r.c1[3], r.c2[1], r.c2[3], r.c3[1], r.c3[3]};
#pragma unroll
    for (int e = 0; e < 8; ++e) { const float p = __shfl_xor(y[e], 32); y[e] = (fq < 2) ? (y[e] * cs[e] - p * sn[e]) : (y[e] * cs[e] + p * sn[e]); }
}
__device__ __forceinline__ int row_pos(int row) { return row < NTOK_P ? (row & (SEQ - 1)) : PAST + ((row - NTOK_P) & (DEC_T - 1)); }
constexpr int RB = 4;
struct EpiProjA {
    static constexpr bool PERM = true, MID = false, FP8 = false;
    LAS unsigned char* lds;
    __device__ __forceinline__ void operator()(const f32x4 (&acc)[2][2][4][2], const pg8::Unit& u, int wr, int wc, int fr, int fq) const {
        unsigned char* const ws = e_ws(lds); const int pn = u.pn; const bool samp = u.pm >= NTOK_P / 256;
        const int rowl0 = wr * 64 + fr, row0 = u.pm * 256 + rowl0, cw = wc * 32 + 8 * fq;
        const f32x2* RT = (const f32x2*)(ws + WS_ROPE);
        if (pn >= 25) {
            bf16_t* O = (bf16_t*)(ws + WS_XL) + (pn - 25) * 256 + cw;
#pragma unroll
            for (int ai = 0; ai < 2; ++ai)
#pragma unroll
                for (int m = 0; m < 4; ++m)
#pragma unroll
                    for (int bj = 0; bj < 2; ++bj) { const f32x4 v0 = acc[ai][bj][m][0], v1 = acc[ai][bj][m][1];
                        *(u32x4*)(O + (size_t)(row0 + ai * 128 + m * 16) * DM + bj * 128) = (u32x4){pk2(v0[0], v0[1]), pk2(v0[2], v0[3]), pk2(v1[0], v1[1]), pk2(v1[2], v1[3])}; }
        } else if (pn >= 8 && pn < 24) {
            bf16_t* O = (bf16_t*)(ws + WS_IQ) + (pn - 8) * 256 + cw;
#pragma unroll
            for (int ai = 0; ai < 2; ++ai) {
                RopeCS rc[RB];
#pragma unroll
                for (int mb = 0; mb < 4; mb += RB) {
                    if (wc == 0) {
#pragma unroll
                        for (int m = 0; m < RB; ++m) rc[m] = rope_load(RT, row_pos(row0 + ai * 128 + (mb + m) * 16), fq); }
                    asm volatile("" ::: "memory");
#pragma unroll
                    for (int m = mb; m < mb + RB; ++m) { const int row = row0 + ai * 128 + m * 16;
#pragma unroll
                        for (int bj = 0; bj < 2; ++bj) { const f32x4 v0 = acc[ai][bj][m][0], v1 = acc[ai][bj][m][1]; float y[8] = {v0[0], v0[1], v0[2], v0[3], v1[0], v1[1], v1[2], v1[3]};
                            if (wc == 0) rope_apply(y, rc[m - mb], fq);
                            *(u32x4*)(O + (size_t)row * DM + bj * 128) = pack8f(y); } } } }
        } else if (pn >= 4 && pn < 8) {
            float* outv = e_out(lds) + (samp ? O_VS - (size_t)NTOK_P * KVW : O_VP) + (pn - 4) * 256 + cw;
#pragma unroll
            for (int ai = 0; ai < 2; ++ai)
#pragma unroll
                for (int m = 0; m < 4; ++m) { const int row = row0 + ai * 128 + m * 16;
                    bf16_t* d = samp ? (bf16_t*)(ws + WS_KVS) + ((size_t)((row - NTOK_P) >> 5) * SKV_SP + PAST + ((row - NTOK_P) & 31)) * 2048 : (bf16_t*)(ws + WS_KV) + (size_t)row * 2048;
#pragma unroll
                    for (int bj = 0; bj < 2; ++bj) { const f32x4 v0 = acc[ai][bj][m][0], v1 = acc[ai][bj][m][1]; const int col = (pn - 4) * 256 + bj * 128 + cw;
                        *(f32x4*)(outv + (size_t)row * KVW + bj * 128) = v0; *(f32x4*)(outv + (size_t)row * KVW + bj * 128 + 4) = v1;
                        *(u32x4*)(d + 1024 + col) = (u32x4){pk2(v0[0], v0[1]), pk2(v0[2], v0[3]), pk2(v1[0], v1[1]), pk2(v1[2], v1[3])}; } }
        } else {
            const bool isk = pn < 4;
            head_sumsq_exchange(acc, 1.0f, lds, wr, wc, fr, fq);
            const float* gp = e_in(lds, isk ? 10 : 11) + cw; const f32x4 g0 = *(const f32x4*)gp, g1 = *(const f32x4*)(gp + 4); const float g[8] = {g0[0], g0[1], g0[2], g0[3], g1[0], g1[1], g1[2], g1[3]};
            float* outp = e_out(lds);
#pragma unroll
            for (int am = 0; am < 4; ++am) { const int ai = am >> 1;
                RopeCS rc[2];
                if (wc == 0) {
#pragma unroll
                    for (int m = 0; m < 2; ++m) rc[m] = rope_load(RT, row_pos(u.pm * 256 + rowl0 + ai * 128 + (2 * (am & 1) + m) * 16), fq); }
                asm volatile("" ::: "memory");
#pragma unroll
                for (int m = 2 * (am & 1); m < 2 * (am & 1) + 2; ++m) { const int rl = rowl0 + ai * 128 + m * 16, row = u.pm * 256 + rl, rs = row - NTOK_P;
#pragma unroll
                    for (int bj = 0; bj < 2; ++bj) { const f32x4 v0 = acc[ai][bj][m][0], v1 = acc[ai][bj][m][1];
                        if (isk || bj == 0) { const float rstd = head_rstd(lds, rl, bj); float y[8];
#pragma unroll
                            for (int e = 0; e < 4; ++e) { y[e] = v0[e] * rstd * g[e]; y[4 + e] = v1[e] * rstd * g[4 + e]; }
                            if (wc == 0) rope_apply(y, rc[m & 1], fq);
                            if (isk) { const int col = pn * 256 + bj * 128 + cw; float* o = outp + (samp ? O_KS + (size_t)rs * KVW : O_KP + (size_t)row * KVW) + col;
                                *(f32x4*)o = (f32x4){y[0], y[1], y[2], y[3]}; *(f32x4*)(o + 4) = (f32x4){y[4], y[5], y[6], y[7]};
                                bf16_t* d = samp ? (bf16_t*)(ws + WS_KVS) + ((size_t)(rs >> 5) * SKV_SP + PAST + (rs & 31)) * 2048 : (bf16_t*)(ws + WS_KV) + (size_t)row * 2048;
                                *(u32x4*)(d + col) = pack8f(y); }
                            else { float* o = outp + (samp ? O_IKS + (size_t)rs * IDXD : O_IKP + (size_t)row * IDXD) + cw;
                                *(f32x4*)o = (f32x4){y[0], y[1], y[2], y[3]}; *(f32x4*)(o + 4) = (f32x4){y[4], y[5], y[6], y[7]};
                                bf16_t* d = samp ? (bf16_t*)(ws + WS_IKS) + ((size_t)(rs >> 5) * SKV_SP + PAST + (rs & 31)) * IDXD : (bf16_t*)(ws + WS_IKB) + (size_t)row * IDXD;
                                *(u32x4*)(d + cw) = pack8f(y); } }
                        else if (wc == 0) { float* o = (float*)(ws + WS_IWF) + (size_t)row * 32 + 8 * fq;
                            *(f32x4*)o = v0 * 0.015625f; *(f32x4*)(o + 4) = v1 * 0.015625f; } } } }
        }
    }
};
struct EpiProjB {
    static constexpr bool PERM = true, MID = false, FP8 = true;
    LAS unsigned char* lds;
    __device__ __forceinline__ void operator()(const f32x4 (&acc)[2][2][4][2], const pg8::Unit& u, int wr, int wc, int fr, int fq) const {
        unsigned char* const ws = e_ws(lds);
        const int seg = u.pn >> 4, pn = u.pn & 15; constexpr float DS = 1.0f / (SXN * SW8);
        const int rowl0 = wr * 64 + fr, row0 = u.pm * 256 + rowl0, cw = wc * 32 + 8 * fq, col0 = pn * 256 + cw;
        if (seg == 0) {
            head_sumsq_exchange(acc, DS * DS, lds, wr, wc, fr, fq);
            const float* gp = e_in(lds, 9) + cw; const f32x4 g0 = *(const f32x4*)gp, g1 = *(const f32x4*)(gp + 4); const float g[8] = {g0[0], g0[1], g0[2], g0[3], g1[0], g1[1], g1[2], g1[3]};
            const f32x2* RT = (const f32x2*)(ws + WS_ROPE); bf16_t* O = (bf16_t*)(ws + WS_Q) + col0;
#pragma unroll
            for (int ai = 0; ai < 2; ++ai) {
                RopeCS rc[4];
                if (wc == 0) {
#pragma unroll
                    for (int m = 0; m < 4; ++m) rc[m] = rope_load(RT, row_pos(u.pm * 256 + rowl0 + ai * 128 + m * 16), fq); }
                asm volatile("" ::: "memory");
#pragma unroll
                for (int m = 0; m < 4; ++m) { const int rl = rowl0 + ai * 128 + m * 16, row = u.pm * 256 + rl;
#pragma unroll
                    for (int bj = 0; bj < 2; ++bj) { const f32x4 v0 = acc[ai][bj][m][0], v1 = acc[ai][bj][m][1]; const float rstd = head_rstd(lds, rl, bj) * DS; float y[8];
#pragma unroll
                        for (int e = 0; e < 4; ++e) { y[e] = v0[e] * rstd * g[e]; y[4 + e] = v1[e] * rstd * g[4 + e]; }
                        if (wc == 0) rope_apply(y, rc[m], fq);
                        *(u32x4*)(O + (size_t)row * DM + bj * 128) = pack8f(y); } } }
        } else {
            bf16_t* O = (bf16_t*)(ws + (seg == 1 ? WS_GY : (seg == 2 ? WS_SGA : WS_SGL))) + col0;
#pragma unroll
            for (int ai = 0; ai < 2; ++ai)
#pragma unroll
                for (int m = 0; m < 4; ++m) { bf16_t* rowp = O + (size_t)(row0 + ai * 128 + m * 16) * DM;
#pragma unroll
                    for (int bj = 0; bj < 2; ++bj) { f32x4 v0 = acc[ai][bj][m][0] * DS, v1 = acc[ai][bj][m][1] * DS;
                        if (seg == 1) {
#pragma unroll
                            for (int e = 0; e < 4; ++e) { v0[e] = gelu_tanh_(v0[e]); v1[e] = gelu_tanh_(v1[e]); } }
                        else {
#pragma unroll
                            for (int e = 0; e < 4; ++e) { v0[e] = sigmoidf_(v0[e]); v1[e] = sigmoidf_(v1[e]); } }
                        *(u32x4*)(rowp + bj * 128) = (u32x4){pk2(v0[0], v0[1]), pk2(v0[2], v0[3]), pk2(v1[0], v1[1]), pk2(v1[2], v1[3])}; } }
        }
    }
};

__device__ __forceinline__ void rope8(float (&y)[8], const f32x2 (&cs)[8], int hl) {
    float p[8];
#pragma unroll
    for (int e = 0; e < 8; ++e) p[e] = __shfl_xor(y[e], 2);
    if (hl < 4) {
#pragma unroll
        for (int e = 0; e < 8; ++e) y[e] = (hl < 2) ? (y[e] * cs[e].x - p[e] * cs[e].y) : (y[e] * cs[e].x + p[e] * cs[e].y);
    }
}
__device__ __forceinline__ float sum16(float s) { s += __shfl_xor(s, 1); s += __shfl_xor(s, 2); s += __shfl_xor(s, 4); s += __shfl_xor(s, 8); return s; }
struct P2Ptrs { unsigned char* ws; float* out; const float* sconv; const float* gq; const float* gk; const float* gi; const float* cw; const float* cb; };
__device__ __forceinline__ void p2_rowinfo(int m, bool& samp, int& ml, int& b, int& t, int& pos) { samp = m >= NTOK_P; ml = samp ? m - NTOK_P : m; b = samp ? (ml >> 5) : (ml >> 12); t = samp ? (ml & 31) : (ml & 4095); pos = samp ? PAST + t : t; }
__device__ __forceinline__ void p2_taskC(const P2Ptrs& P, int item, int lane) {
    const int strip = item >> 3, col = 512 * (item & 7) + 8 * lane, m0 = 16 * strip; bool samp; int ml, b, t0, pos; p2_rowinfo(m0, samp, ml, b, t0, pos);
    const bf16_t* XLb = (const bf16_t*)(P.ws + WS_XL); bf16_t* Ub = (bf16_t*)(P.ws + WS_U);
    float x[19][8];
#pragma unroll
    for (int i = 0; i < 19; ++i) { const int tt = t0 + i - 3;
        if (tt >= 0) unpack8(*(const u32x4*)(XLb + (size_t)(m0 + i - 3) * DM + col), x[i]);
        else if (samp) { const float* sp = P.sconv + ((size_t)b * 3 + i) * DM + col; const f32x4 s0 = *(const f32x4*)sp, s1 = *(const f32x4*)(sp + 4); x[i][0] = s0.x; x[i][1] = s0.y; x[i][2] = s0.z; x[i][3] = s0.w; x[i][4] = s1.x; x[i][5] = s1.y; x[i][6] = s1.z; x[i][7] = s1.w; }
        else {
#pragma unroll
            for (int e = 0; e < 8; ++e) x[i][e] = 0.f; } }
    float w[4][8], cb[8];
#pragma unroll
    for (int e = 0; e < 8; ++e) { cb[e] = P.cb[col + e];
#pragma unroll
        for (int j = 0; j < 4; ++j) w[j][e] = P.cw[(size_t)j * DM + col + e]; }
    const int T = samp ? DEC_T : SEQ;
#pragma unroll
    for (int r = 0; r < 16; ++r) { float u[8];
#pragma unroll
        for (int e = 0; e < 8; ++e) u[e] = cb[e] + x[r][e] * w[0][e] + x[r + 1][e] * w[1][e] + x[r + 2][e] * w[2][e] + x[r + 3][e] * w[3][e];
        *(u32x4*)(Ub + (size_t)(m0 + r) * DM + col) = pack8f(u);
        const int t = t0 + r;
        if (t >= T - 3) { float* oc = P.out + (samp ? O_CONVS : O_CONVP) + ((size_t)b * 3 + (t - (T - 3))) * DM + col;
            *(f32x4*)oc = (f32x4){x[r + 3][0], x[r + 3][1], x[r + 3][2], x[r + 3][3]}; *(f32x4*)(oc + 4) = (f32x4){x[r + 3][4], x[r + 3][5], x[r + 3][6], x[r + 3][7]}; } }
}
__device__ __forceinline__ void p2_phase(Frame& F) {
    P2Ptrs P{ws_ptr(F), out_ptr(F), in_ptr(F, 6), in_ptr(F, 9), in_ptr(F, 10), in_ptr(F, 11), in_ptr(F, 12), in_ptr(F, 13)};
    for (int it = F.gw; it < (MTOK / 16) * 8; it += F.NGW) p2_taskC(P, it, F.lane);
}

__device__ __forceinline__ float expf_(float x) { return __builtin_amdgcn_exp2f(1.4426950408889634f * x); }
__device__ __forceinline__ float softplusf_(float x) { return fmaxf(x, 0.f) + log1pf(expf(-fabsf(x))); }
struct EpiGates {
    static constexpr bool PERM = false, MID = false, FP8 = false;
    LAS unsigned char* lds;
    __device__ __forceinline__ void operator()(const f32x4 (&acc)[2][2][4][2], const pg8::Unit& u, int wr, int wc, int fr, int fq) const {
        unsigned char* const ws = e_ws(lds); const bf16_t* U = (const bf16_t*)(ws + WS_U); const float* ba = e_in(lds, 15); const float* bx = e_in(lds, 17); const float* lam = e_in(lds, 18); unsigned* AB = (unsigned*)(ws + WS_AB);
        const int row0 = u.pm * 256 + wr * 64 + fr, chb = 256 * (u.pn >> 1) + 128 * (u.pn & 1) + 32 * wc + 4 * fq;
        u32x2 uw[2][2][4];
#pragma unroll
        for (int n = 0; n < 2; ++n)
#pragma unroll
            for (int ai = 0; ai < 2; ++ai)
#pragma unroll
                for (int m = 0; m < 4; ++m) uw[n][ai][m] = *(const u32x2*)(U + (size_t)(row0 + ai * 128 + m * 16) * DM + chb + 16 * n);
        asm volatile("" ::: "memory");
#pragma unroll
        for (int n = 0; n < 2; ++n) { const int ch0 = chb + 16 * n;
            const f32x4 ba4 = *(const f32x4*)(ba + ch0), bx4 = *(const f32x4*)(bx + ch0), lm4 = *(const f32x4*)(lam + ch0); float sp[4];
#pragma unroll
            for (int e = 0; e < 4; ++e) sp[e] = 8.0f * softplusf_(-lm4[e]);
#pragma unroll
            for (int ai = 0; ai < 2; ++ai)
#pragma unroll
                for (int m = 0; m < 4; ++m) { const size_t row = (size_t)(row0 + ai * 128 + m * 16); const u32x2 w2 = uw[n][ai][m];
                    const float uu[4] = {bflo(w2.x), bfhi(w2.x), bflo(w2.y), bfhi(w2.y)}; u32x4 o;
#pragma unroll
                    for (int e = 0; e < 4; ++e) { const float r = sigmoidf_(acc[ai][0][m][n][e] + ba4[e]), ig = sigmoidf_(acc[ai][1][m][n][e] + bx4[e]);
                        const float la = -sp[e] * r, em = 1.0f - expf_(2.0f * la);
                        const float bb = __builtin_amdgcn_sqrtf(fmaxf(em, 0.f)) * (ig * uu[e]);
                        const _Float16 hl_ = (_Float16)la, hb_ = (_Float16)bb;
                        o[e] = (unsigned)__builtin_bit_cast(unsigned short, hl_) | ((unsigned)__builtin_bit_cast(unsigned short, hb_) << 16); }
                    *(u32x4*)(AB + row * DM + ch0) = o; } }
    }
};
__device__ __forceinline__ float h_lo(unsigned w) { return (float)__builtin_bit_cast(_Float16, (unsigned short)(w & 0xffffu)); }
__device__ __forceinline__ float h_hi(unsigned w) { return (float)__builtin_bit_cast(_Float16, (unsigned short)(w >> 16)); }
__device__ __forceinline__ void scan_summaries(Frame& F) {
    unsigned char* const ws = ws_ptr(F);
    const unsigned* AB = (const unsigned*)(ws + WS_AB); f32x4* SUM = (f32x4*)(ws + WS_SUM);
    for (int it = F.gw * 64 + F.lane; it < 128 * 2048; it += F.NGW * 64) { const int q = it >> 11, cp = it & 2047;
        const size_t m0 = (size_t)(q >> 6) * SEQ + (size_t)(q & 63) * 64; const unsigned* p = AB + m0 * DM + 2 * cp;
        float al0 = 0.f, al1 = 0.f, h0 = 0.f, h1 = 0.f;
        for (int r0 = 0; r0 < 64; r0 += 16) { u32x2 w[16];
#pragma unroll
            for (int r = 0; r < 16; ++r) w[r] = *(const u32x2*)(p + (size_t)(r0 + r) * DM);
#pragma unroll
            for (int r = 0; r < 16; ++r) { const float la0 = h_lo(w[r].x), la1 = h_lo(w[r].y); al0 += la0; al1 += la1; h0 = expf_(la0) * h0 + h_hi(w[r].x); h1 = expf_(la1) * h1 + h_hi(w[r].y); } }
        SUM[(size_t)q * 2048 + cp] = (f32x4){al0, h0, al1, h1}; }
}
__device__ __forceinline__ void scan_apply(Frame& F) {
    unsigned char* const ws = ws_ptr(F); float* const out = out_ptr(F); const float* const in5 = in_ptr(F, 5);
    const unsigned* AB = (const unsigned*)(ws + WS_AB); const f32x4* SUM = (const f32x4*)(ws + WS_SUM); const bf16_t* GY = (const bf16_t*)(ws + WS_GY); bf16_t* OAL = (bf16_t*)(ws + WS_OAL);
    for (int it = F.gw * 64 + F.lane; it < 144 * 2048; it += F.NGW * 64) { const int q = it >> 11, cp = it & 2047;
        float h0, h1; size_t m0; int nr; float* lout = nullptr;
        if (q < 128) { const int ch = q & 63; m0 = (size_t)(q >> 6) * SEQ + (size_t)ch * 64; nr = 64; h0 = 0.f; h1 = 0.f;
            for (int j = 0; j < ch; ++j) { const f32x4 s = SUM[(size_t)((q & ~63) + j) * 2048 + cp]; h0 = expf_(s.x) * h0 + s.y; h1 = expf_(s.z) * h1 + s.w; }
            if (ch == 63) lout = out + O_LRUP + (size_t)(q >> 6) * DM + 2 * cp; }
        else { const int bs = q - 128; m0 = (size_t)NTOK_P + (size_t)bs * DEC_T; nr = DEC_T; const f32x2 s = *(const f32x2*)(in5 + (size_t)bs * DM + 2 * cp); h0 = s.x; h1 = s.y;
            lout = out + O_LRUS + (size_t)bs * DM + 2 * cp; }
        const unsigned* p = AB + m0 * DM + 2 * cp; const bf16_t* g = GY + m0 * DM + 2 * cp; unsigned char* o = (unsigned char*)OAL + m0 * (2 * DM) + DM + 2 * cp;
        for (int r0 = 0; r0 < nr; r0 += 16) { u32x2 w[16]; unsigned gw_[16];
#pragma unroll
            for (int r = 0; r < 16; ++r) { w[r] = *(const u32x2*)(p + (size_t)(r0 + r) * DM); gw_[r] = *(const unsigned*)(g + (size_t)(r0 + r) * DM); }
            asm volatile("" ::: "memory");
#pragma unroll
            for (int r = 0; r < 16; ++r) { h0 = expf_(h_lo(w[r].x)) * h0 + h_hi(w[r].x); h1 = expf_(h_lo(w[r].y)) * h1 + h_hi(w[r].y);
                *(unsigned short*)(o + (size_t)(r0 + r) * (2 * DM)) = (unsigned short)__builtin_amdgcn_cvt_pk_fp8_f32(h0 * bflo(gw_[r]) * SA_LRU, h1 * bfhi(gw_[r]) * SA_LRU, 0, false); }
            asm volatile("" ::: "memory"); }
        if (lout) *(f32x2*)lout = (f32x2){h0, h1}; }
}


__device__ __forceinline__ int crow_(int r, int hi) { return (r & 3) + 8 * (r >> 2) + 4 * hi; }
struct IdxItem { int m0, qw, nvalid, samp; const bf16_t* kp; float* sp; int sld; };
__device__ __forceinline__ IdxItem idx_decode(int it, unsigned char* ws) {
    IdxItem r; constexpr int NPI = 4 * 16 * 17;
    if (it < NPI) { int g = 15; int rr = it; while (rr >= 8 * (g + 1)) { rr -= 8 * (g + 1); --g; }
        const int seg = rr % (g + 1); rr /= (g + 1); const int cl = rr & 3, b = rr >> 2, chunk = 4 * g + cl;
        r.m0 = b * SEQ + 64 * chunk; r.qw = 8; r.samp = 0; const int nk = (chunk + 1) * 64 - 256 * seg; r.nvalid = nk < 256 ? nk : 256;
        r.kp = (const bf16_t*)(ws + WS_IKB) + ((size_t)b * SEQ + 256 * seg) * IDXD; r.sp = (float*)(ws + WS_SC) + (size_t)r.m0 * SEQ + 256 * seg; r.sld = SEQ; }
    else { const int rr = it - NPI, bs = rr / 9, seg = rr % 9;
        r.m0 = NTOK_P + 32 * bs; r.qw = 4; r.samp = 1; const int nk = SKV_SP - 256 * seg; r.nvalid = nk < 256 ? nk : 256;
        r.kp = (const bf16_t*)(ws + WS_IKS) + ((size_t)bs * SKV_SP + 256 * seg) * IDXD; r.sp = (float*)(ws + WS_SCS) + (size_t)(32 * bs) * SKV_SP + 256 * seg; r.sld = SKV_SP; }
    return r;
}
__device__ __forceinline__ void idx_phase(Frame& F) {
    unsigned char* const ws = ws_ptr(F); unsigned* const ctl = ctl_ptr(F);
    __syncthreads(); const unsigned qsel = F.MISC[16]; __syncthreads(); if (F.tid == 0) F.MISC[16] = qsel + 1u;
    unsigned* qhead = ctl + CW_QIDX + 64 * qsel;
    const bf16_t* IQ = (const bf16_t*)(ws + WS_IQ); const float* IWF = (const float*)(ws + WS_IWF);
    const int tid = F.tid, lane = F.lane, wave = F.wave, c = lane & 31, hi = lane >> 5;
    constexpr int TOTAL = 4 * 16 * 17 + 16 * 9;
    if (tid == 0) { F.MISC[20] = __hip_atomic_fetch_add(qhead, 1u, __ATOMIC_RELAXED, __HIP_MEMORY_SCOPE_AGENT); F.MISC[21] = __hip_atomic_fetch_add(qhead, 1u, __ATOMIC_RELAXED, __HIP_MEMORY_SCOPE_AGENT); }
    __syncthreads();
    int icur = (int)F.MISC[20], inxt = (int)F.MISC[21];
    __syncthreads();
    if (icur >= TOTAL) return;
#define IDX_STAGE(IT, BUF) do { _Pragma("unroll") for (int j = 0; j < 8; ++j) { const int r0 = 32 * j + 4 * wave; if (r0 < (IT).nvalid) { const int key = r0 + (lane >> 4), chunk = (lane & 15) ^ (key & 15); \
        __builtin_amdgcn_global_load_lds((const unsigned*)((IT).kp + (size_t)key * IDXD + 8 * chunk), (LAS unsigned*)(F.lds + RING_OFF + (BUF) * 65536 + r0 * 256), 16, 0, 0); } } } while (0)
    IdxItem cur = idx_decode(icur, ws);
    IDX_STAGE(cur, 0);
    asm volatile("s_waitcnt vmcnt(0)" ::: "memory");
    __syncthreads();
    int p = 0;
    for (;;) {
        const bool has = inxt < TOTAL;
        unsigned inn = 0u;
        if (tid == 0 && has) inn = __hip_atomic_fetch_add(qhead, 1u, __ATOMIC_RELAXED, __HIP_MEMORY_SCOPE_AGENT);
        IdxItem nxt = cur;
        if (has) { nxt = idx_decode(inxt, ws); IDX_STAGE(nxt, p ^ 1); }
        const LAS unsigned char* kb = F.lds + RING_OFF + p * 65536;
        const int nblk = cur.nvalid >> 5, npair = cur.qw >> 1;
#define IDX_LDK(BK, BLK) do { const int key_ = 32 * (BLK) + c; const LAS unsigned char* rowp_ = kb + key_ * 256; const int sw_ = key_ & 15; \
            _Pragma("unroll") for (int d0 = 0; d0 < 8; ++d0) BK[d0] = *(const LAS bf16x8*)(rowp_ + (((2 * d0 + hi) ^ sw_) << 4)); } while (0)
#define IDX_RELU(x) __builtin_amdgcn_fmed3f((x), 0.f, __builtin_inff())
#define IDX_BLOCK(BK, BLK) do { f32x16 a0 = {}, a1 = {}; \
            _Pragma("unroll") for (int d0 = 0; d0 < 8; ++d0) { a0 = __builtin_amdgcn_mfma_f32_32x32x16_bf16(aq[0][d0], BK[d0], a0, 0, 0, 0); a1 = __builtin_amdgcn_mfma_f32_32x32x16_bf16(aq[1][d0], BK[d0], a1, 0, 0, 0); } \
            f32x2 t0v = {0.f, 0.f}, t1v = {0.f, 0.f}; \
            _Pragma("unroll") for (int r = 0; r < 16; r += 2) { \
                const f32x2 w0 = {w[0][r >> 2][r & 3], w[0][r >> 2][(r & 3) + 1]}, w1 = {w[1][r >> 2][r & 3], w[1][r >> 2][(r & 3) + 1]}; \
                t0v = (f32x2){IDX_RELU(a0[r]), IDX_RELU(a0[r + 1])} * w0 + t0v; t1v = (f32x2){IDX_RELU(a1[r]), IDX_RELU(a1[r + 1])} * w1 + t1v; } \
            const float t0 = t0v.x + t0v.y, t1 = t1v.x + t1v.y; \
            auto rr_ = __builtin_amdgcn_permlane32_swap(__float_as_uint(t0), __float_as_uint(t1), false, false);     \
            s0[loff + 32 * (BLK)] = __uint_as_float(rr_[0]) + __uint_as_float(rr_[1]); } while (0)
        for (int pr = 0; pr < npair; ++pr) {
            const int m = cur.m0 + wave * cur.qw + 2 * pr;
            bf16x8 aq[2][8]; f32x4 w[2][4];
#pragma unroll
            for (int q = 0; q < 2; ++q) {
#pragma unroll
                for (int d0 = 0; d0 < 8; ++d0) aq[q][d0] = *(const bf16x8*)(IQ + (size_t)(m + q) * DM + c * IDXD + d0 * 16 + hi * 8);
#pragma unroll
                for (int g = 0; g < 4; ++g) w[q][g] = *(const f32x4*)(IWF + (size_t)(m + q) * 32 + 8 * g + 4 * hi); }
            float* s0 = cur.sp + (size_t)(m - cur.m0) * cur.sld; const int loff = c + (hi ? cur.sld : 0);
            bf16x8 bka[8], bkb[8];
            IDX_LDK(bka, 0);
            for (int blk = 0; blk < nblk; blk += 2) {
                IDX_LDK(bkb, blk + 1);
                IDX_BLOCK(bka, blk);
                if (blk + 2 < nblk) IDX_LDK(bka, blk + 2);
                IDX_BLOCK(bkb, blk + 1); }
        }
#undef IDX_LDK
#undef IDX_BLOCK
#undef IDX_RELU
        if (tid == 0) F.MISC[20 + p] = inn;
        asm volatile("s_waitcnt vmcnt(0)" ::: "memory");
        __syncthreads();
        if (!has) break;
        cur = nxt; inxt = (int)F.MISC[20 + p]; p ^= 1;
    }
#undef IDX_STAGE
}
__device__ __forceinline__ void select_row(Frame& F, int m) {
    unsigned char* const ws = ws_ptr(F);
    const int lane = F.lane;
    const float* sp; int n;
    if (m < NTOK_P) { n = (((m & (SEQ - 1)) >> 6) + 1) * 64; sp = (const float*)(ws + WS_SC) + (size_t)m * SEQ; }
    else { n = SKV_S; sp = (const float*)(ws + WS_SCS) + (size_t)(m - NTOK_P) * SKV_SP; }
    unsigned key[64];
#pragma unroll
    for (int j = 0; j < 64; ++j) { const int idx = 64 * j + lane; key[j] = __float_as_uint(sp[idx < n ? idx : n - 1]); }
    asm volatile("" ::: "memory");
#pragma unroll
    for (int j = 0; j < 64; ++j) { const int idx = 64 * j + lane; const unsigned u = key[j]; const unsigned k = (u & 0x80000000u) ? ~u : (u | 0x80000000u); key[j] = idx < n ? k : 0u; }
    unsigned thr = 1u;
    if (n > TOPK) { unsigned prefix = 0u;
        const int ngrp = (n + 511) >> 9;
        for (int bit = 31; bit >= 0; --bit) { const unsigned cand = prefix | (1u << bit); int c0 = 0, c1 = 0, c2 = 0, c3 = 0;
#pragma unroll
            for (int g = 0; g < 8; ++g) if (g < ngrp) {
#pragma unroll
                for (int j = 8 * g; j < 8 * g + 8; j += 4) { c0 += (key[j] >= cand) ? 1 : 0; c1 += (key[j + 1] >= cand) ? 1 : 0; c2 += (key[j + 2] >= cand) ? 1 : 0; c3 += (key[j + 3] >= cand) ? 1 : 0; } }
            const int cl = (c0 + c1) + (c2 + c3); int cnt = 0;
#pragma unroll
            for (int b = 0; b < 7; ++b) cnt += __builtin_popcountll(__ballot((cl >> b) & 1)) << b;
            if (cnt >= TOPK) prefix = cand;
            if (cnt == TOPK) break; }
        thr = prefix; }
    unsigned long long mine = 0ull;
#pragma unroll
    for (int j = 0; j < 64; ++j) { const unsigned long long bal = __ballot(key[j] >= thr); mine = (lane == j) ? bal : mine; }
    ((unsigned long long*)(ws + WS_BM))[(size_t)m * 64 + lane] = mine;
}
__device__ __forceinline__ void select_phase(Frame& F) {
    volatile LAS unsigned* cnt = F.MISC + 24;
    __syncthreads(); if (F.tid == 0) *cnt = 0u; __syncthreads();
    const int G = F.G, b = (int)blockIdx.x;
    for (;;) {
        unsigned i = 0u; if (F.lane == 0) i = __hip_atomic_fetch_add((LAS unsigned*)cnt, 1u, __ATOMIC_RELAXED, __HIP_MEMORY_SCOPE_WORKGROUP);
        const int q = (int)__builtin_amdgcn_readfirstlane(i) * G + b;
        if (q >= MTOK) break;
        int m;
        if (q < MTOK - NTOK_P) m = NTOK_P + q;
        else { const int t = q - (MTOK - NTOK_P); m = (t & 1) * SEQ + (SEQ - 1 - (t >> 1)); }
        select_row(F, m);
    }
}

namespace att {
constexpr int NW = 8, QBLK = 32, KVBLK = 64, D = 128, KVLD = 2048, QLD = 4096, OLD = 8192;
constexpr float SCALE = 0.08838834764831845f, THR = 8.f;
constexpr int SHM_V = KVBLK * D * 2, SHM_K = KVBLK * D * 2;
constexpr int ATT_LDS = 2 * SHM_V + 2 * SHM_K + NW * 64 * 4 + 64;
typedef short s16x4 __attribute__((ext_vector_type(4)));
#define KSWZ(row, colB) ((row) * 256 + ((colB) ^ (((row) & 7) << 4)))
#define SBAR() __builtin_amdgcn_sched_barrier(0)
__device__ __forceinline__ int v_st(int k, int c) { const int kk = (k & ~0xC) | ((k & 4) << 1) | ((k & 8) >> 1); return ((kk >> 3) * 4 + (c >> 5)) * 512 + ((kk & 7) * 32 + (c & 31)) * 2; }
__device__ __forceinline__ int v_rd_base(int lane) { return ((lane & 3) << 3) | (((lane >> 2) & 3) << 6) | (((lane >> 4) & 1) << 5) | (((lane >> 5) & 1) << 8); }
constexpr int v_rd_off(int d0, int ks, int half) { return d0 * 512 + ks * 4096 + half * 2048; }
__device__ __forceinline__ int crow(int r, int hi) { return (r & 3) + 8 * (r >> 2) + 4 * hi; }
__device__ __forceinline__ bf16x8 load8(const bf16_t* p) { return *reinterpret_cast<const bf16x8*>(p); }
__device__ __forceinline__ void mask_bits(f32x16& p0, f32x16& p1, unsigned long long mw, int hi) {
    const unsigned lo = (unsigned)mw >> (4 * hi), hw = (unsigned)(mw >> 32) >> (4 * hi); unsigned NEGB = 0xFF800000u; asm volatile("" : "+v"(NEGB));
#define MASK1(P, W, C) do { int m_; float t_ = (P); asm("v_bfe_i32 %0, %1, %2, 1" : "=v"(m_) : "v"(W), "i"(C)); asm("v_bfi_b32 %0, %1, %0, %2" : "+v"(t_) : "v"(m_), "v"(NEGB)); (P) = t_; } while (0)
    asm volatile("s_nop 15\n\ts_nop 3" : "+v"(p0), "+v"(p1));
#pragma unroll
    for (int r = 0; r < 16; ++r) { const int c = (r & 3) + 8 * (r >> 2); MASK1(p0[r], lo, c); MASK1(p1[r], hw, c); }
#undef MASK1
}
__device__ __forceinline__ void partialSM(f32x16& p0, f32x16& p1, float& m_reg, float& mn, float& alpha) {
    float pmax = p0[0]; for (int r = 1; r < 16; ++r) pmax = fmaxf(pmax, p0[r]); for (int r = 0; r < 16; ++r) pmax = fmaxf(pmax, p1[r]);
    { auto rr = __builtin_amdgcn_permlane32_swap(__float_as_uint(pmax), __float_as_uint(pmax), false, false);
      pmax = fmaxf(__uint_as_float(rr[0]), __uint_as_float(rr[1])); }
    constexpr float C2 = 1.4426950408889634f * SCALE;
    if (__builtin_expect(__all((pmax - m_reg) * SCALE <= THR), 1)) { mn = m_reg; alpha = 1.f; }
    else { mn = fmaxf(m_reg, pmax); alpha = __builtin_amdgcn_exp2f((m_reg - mn) * C2); m_reg = mn; }
    const float mnL = -mn * C2;
    for (int r = 0; r < 16; ++r) p0[r] = fmaf(p0[r], C2, mnL); for (int r = 0; r < 16; ++r) p1[r] = fmaf(p1[r], C2, mnL);
    for (int r = 0; r < 16; ++r) p0[r] = __builtin_amdgcn_exp2f(p0[r]);
}
__device__ __forceinline__ void finishSM(f32x16& p0, f32x16& p1, float alpha, float& l_reg, bf16x8& pa0, bf16x8& pa1, bf16x8& pa2, bf16x8& pa3) {
    for (int r = 0; r < 16; ++r) p1[r] = __builtin_amdgcn_exp2f(p1[r]);
    float ps = 0; for (int r = 0; r < 16; ++r) ps += p0[r]; for (int r = 0; r < 16; ++r) ps += p1[r];
    { auto rr = __builtin_amdgcn_permlane32_swap(__float_as_uint(ps), __float_as_uint(ps), false, false);
      ps = __uint_as_float(rr[0]) + __uint_as_float(rr[1]); }
    l_reg = l_reg * alpha + ps;
#define PK4(P, B_, OUT) do { unsigned a0 = pk2(P[B_+0], P[B_+1]), a1 = pk2(P[B_+2], P[B_+3]);                          \
        unsigned b0 = pk2(P[B_+4], P[B_+5]), b1 = pk2(P[B_+6], P[B_+7]);                                             \
        auto r0 = __builtin_amdgcn_permlane32_swap(a0, b0, false, false); auto r1 = __builtin_amdgcn_permlane32_swap(a1, b1, false, false); \
        u32x4 w = {r0[0], r1[0], r0[1], r1[1]}; OUT = *reinterpret_cast<bf16x8*>(&w); } while (0)
    PK4(p0, 0, pa0); PK4(p0, 8, pa1); PK4(p1, 0, pa2); PK4(p1, 8, pa3);
#undef PK4
}
template <int KB>
__device__ __forceinline__ void qkt(f32x16& p0, f32x16& p1, const char* K_lds, int r32, int hi, const bf16x8* qr) {
    p0 = f32x16{}; p1 = f32x16{};
    const char* kb[4];
#pragma unroll
    for (int dd = 0; dd < 4; ++dd) kb[dd] = K_lds + KB * SHM_K + KSWZ(r32, (dd * 16 + hi * 8) * 2);
#pragma unroll
    for (int d0 = 0; d0 < 8; ++d0) { const char* a = kb[d0 & 3] + (d0 >> 2) * 128;
        bf16x8 b0 = *reinterpret_cast<const bf16x8*>(a);
        bf16x8 b1 = *reinterpret_cast<const bf16x8*>(a + 32 * 256);
        p0 = __builtin_amdgcn_mfma_f32_32x32x16_bf16(b0, qr[d0], p0, 0, 0, 0);
        p1 = __builtin_amdgcn_mfma_f32_32x32x16_bf16(b1, qr[d0], p1, 0, 0, 0); }
}
template <int VB>
__device__ __forceinline__ void pv_tile(f32x16* o, int vb0, bf16x8 pa0, bf16x8 pa1, bf16x8 pa2, bf16x8 pa3) {
#define TRRD(dst, off) asm volatile("ds_read_b64_tr_b16 %0, %1 offset:%2" : "=&v"(dst) : "v"(vb0), "i"(off) : "memory")
#define PV_D0(d0) do { s16x4 l0, l1, l2, l3, h0, h1, h2, h3; constexpr int b_ = VB * SHM_V + v_rd_off(d0, 0, 0); \
        TRRD(l0, b_); TRRD(h0, b_ + 2048); TRRD(l1, b_ + 4096); TRRD(h1, b_ + 6144); TRRD(l2, b_ + 8192); TRRD(h2, b_ + 10240); TRRD(l3, b_ + 12288); TRRD(h3, b_ + 14336); \
        asm volatile("s_waitcnt lgkmcnt(0)" ::: "memory"); SBAR();   \
        o[d0] = __builtin_amdgcn_mfma_f32_32x32x16_bf16(pa0, (bf16x8){l0[0], l0[1], l0[2], l0[3], h0[0], h0[1], h0[2], h0[3]}, o[d0], 0, 0, 0);   \
        o[d0] = __builtin_amdgcn_mfma_f32_32x32x16_bf16(pa1, (bf16x8){l1[0], l1[1], l1[2], l1[3], h1[0], h1[1], h1[2], h1[3]}, o[d0], 0, 0, 0);   \
        o[d0] = __builtin_amdgcn_mfma_f32_32x32x16_bf16(pa2, (bf16x8){l2[0], l2[1], l2[2], l2[3], h2[0], h2[1], h2[2], h2[3]}, o[d0], 0, 0, 0);   \
        o[d0] = __builtin_amdgcn_mfma_f32_32x32x16_bf16(pa3, (bf16x8){l3[0], l3[1], l3[2], l3[3], h3[0], h3[1], h3[2], h3[3]}, o[d0], 0, 0, 0); } while (0)
    PV_D0(0); PV_D0(1); PV_D0(2); PV_D0(3);
#undef PV_D0
#undef TRRD
}
struct BlockRef { const bf16_t* K; int m0, g, NT, samp; };
__device__ __forceinline__ const bf16_t* ref_q(const BlockRef& r, const unsigned char* ws) { return (const bf16_t*)(ws + WS_Q) + (size_t)r.m0 * QLD + 4 * r.g * D; }
__device__ __forceinline__ unsigned char* ref_o(const BlockRef& r, unsigned char* ws) { return ws + WS_OAL + (size_t)r.m0 * OLD + 4 * r.g * D; }
__device__ __forceinline__ const char* ref_bm(const BlockRef& r, const unsigned char* ws) { return (const char*)(ws + WS_BM) + (size_t)r.m0 * 512; }
struct Seam { bf16x8 qr[8]; bf16x8 st_v0, st_v1, st_k0, st_k1; };
#define ROW(p, k0, rr) ((p) + (size_t)((k0) + (rr)) * KVLD + sc)
#define VMW() asm volatile("s_waitcnt vmcnt(0)" ::: "memory")
#define VMWN(n) asm volatile("s_waitcnt vmcnt(%0)" :: "i"(n) : "memory")
#define SLOAD_H(Kp, Vp, k0) do { S.st_v0 = load8(ROW(Vp, k0, sr)); S.st_v1 = load8(ROW(Vp, k0, 32 + sr));              \
                         S.st_k0 = load8(ROW(Kp, k0, sr)); S.st_k1 = load8(ROW(Kp, k0, 32 + sr)); } while (0)
#define SWRITE_HK(bf) do { *(bf16x8*)(K_lds + (bf) * SHM_K + kws) = S.st_k0; *(bf16x8*)(K_lds + (bf) * SHM_K + kws + 32 * 256) = S.st_k1; } while (0)
#define SWRITE_HV(bf) do { *(bf16x8*)(V_lds + (bf) * SHM_V + vst0) = S.st_v0; *(bf16x8*)(V_lds + (bf) * SHM_V + vst1) = S.st_v1; } while (0)
#define SWRITE_H(bf) do { SWRITE_HV(bf); SWRITE_HK(bf); } while (0)
__device__ __forceinline__ int q_rowoff(int samp, int wid) { return samp ? 0 : 32 * (wid & 1); }
__device__ __forceinline__ int q_headoff(int samp, int wid) { return samp ? (wid & 3) : (wid >> 1); }
__device__ __forceinline__ void attn_prime(const BlockRef& cur, unsigned char* wsb, char* lds, Seam& S, int wv) {
    const int tid = tid_of(wv);
    const int wid = __builtin_amdgcn_readfirstlane(tid >> 6), lane = tid & 63, r32 = lane & 31, hi = lane >> 5;
    const int sr = tid >> 4, sc = (tid & 15) * 8, kws = KSWZ(sr, sc * 2); char* K_lds = lds + 2 * SHM_V;
    const bf16_t* qp = ref_q(cur, wsb) + (size_t)(q_rowoff(cur.samp, wid) + r32) * QLD + q_headoff(cur.samp, wid) * D + hi * 8;
    for (int d0 = 0; d0 < 8; ++d0) S.qr[d0] = load8(qp + d0 * 16);
    SLOAD_H(cur.K, cur.K + 1024, 0); VMW(); SWRITE_HK(0);
    __syncthreads();
}
__device__ __forceinline__ void attn_block(const BlockRef& cur, const BlockRef& nxt, unsigned char* wsb, char* lds, Seam& S, int wv) {
    const int tid = tid_of(wv);
    const int wid = __builtin_amdgcn_readfirstlane(tid >> 6), lane = tid & 63, r32 = lane & 31, hi = lane >> 5;
    const int NT = cur.NT;
    char* V_lds = lds; char* K_lds = lds + 2 * SHM_V;
    float* ws = (float*)(lds + 2 * SHM_V + 2 * SHM_K) + wid * 64; float* li_l = ws, * al_l = ws + 32;
    float m_reg = -1e30f, l_reg = 0; f32x16 o[4] = {};
    const int sr = tid >> 4, sc = (tid & 15) * 8, vst0 = v_st(sr, sc), vst1 = v_st(32 + sr, sc), kws = KSWZ(sr, sc * 2);
    const int vb0 = (int)(uintptr_t)V_lds + v_rd_base(lane);
    const bf16_t* Kh = cur.K; const bf16_t* Vh = cur.K + 1024;
    const int qro = q_rowoff(cur.samp, wid), qho = q_headoff(cur.samp, wid);
    const char* bmb = ref_bm(cur, wsb); const unsigned bmo = (unsigned)(qro + r32) * 512u;
#define BMW(t) (*(const unsigned long long*)(bmb + bmo + (unsigned)(t) * 8u))
#define RESC(a) do { if (__any((a) < 1.f)) { if (hi == 0) al_l[r32] = (a); asm volatile("s_waitcnt lgkmcnt(0)" ::: "memory");              \
                     for (int d_ = 0; d_ < 4; ++d_) for (int r = 0; r < 16; ++r) o[d_][r] *= al_l[crow(r, hi)]; } } while (0)
#define KBASE(t) ((t) * KVBLK)
    f32x16 pA0, pA1, pB0, pB1; float mnA, mnB, alA, alB; bf16x8 pa0, pa1, pa2, pa3;
    SWRITE_HV(0); SBAR();
    if (NT > 1) SLOAD_H(Kh, Vh, KBASE(1));
    const unsigned long long mw0 = BMW(0);
    SBAR(); qkt<0>(pA0, pA1, K_lds, r32, hi, S.qr);
    mask_bits(pA0, pA1, mw0, hi); partialSM(pA0, pA1, m_reg, mnA, alA);
    if (NT > 1) { VMW(); SWRITE_H(1); }
    __syncthreads();
#define HALF_STEP(PX0, PX1, mnX, alX, PY0, PY1, alY, t, KB, VB, SB) do {                                                      \
        SBAR(); qkt<KB>(PX0, PX1, K_lds, r32, hi, S.qr);                                                                      \
        finishSM(PY0, PY1, alY, l_reg, pa0, pa1, pa2, pa3); SBAR();                                                           \
        const unsigned long long mw_ = BMW(t);                                                                               \
        if ((t) + 1 < NT) { SLOAD_H(Kh, Vh, KBASE((t) + 1)); SBAR(); }                                                        \
        pv_tile<VB>(o, vb0, pa0, pa1, pa2, pa3); mask_bits(PX0, PX1, mw_, hi); partialSM(PX0, PX1, m_reg, mnX, alX);         \
        __syncthreads();                                                                                                      \
        if ((t) + 1 < NT) { VMW(); SWRITE_H(SB); }                                                                            \
        RESC(alX); __syncthreads(); } while (0)
    for (int t = 1; t + 1 < NT; t += 2) {
        HALF_STEP(pB0, pB1, mnB, alB, pA0, pA1, alA, t, 1, 0, 0);
        HALF_STEP(pA0, pA1, mnA, alA, pB0, pB1, alB, t + 1, 0, 1, 1);
    }
    const bool even = (NT & 1) == 0;
    unsigned long long mwT = 0ull;
    if (even) { mwT = BMW(NT - 1); SBAR(); qkt<1>(pB0, pB1, K_lds, r32, hi, S.qr); SBAR(); }
    SLOAD_H(nxt.K, nxt.K + 1024, 0); SBAR();
    { const bf16_t* qp = ref_q(nxt, wsb) + (size_t)(q_rowoff(nxt.samp, wid) + r32) * QLD + q_headoff(nxt.samp, wid) * D + hi * 8;
#pragma unroll
      for (int d0 = 0; d0 < 8; ++d0) S.qr[d0] = load8(qp + d0 * 16); }
    SBAR();
    finishSM(pA0, pA1, alA, l_reg, pa0, pa1, pa2, pa3); SBAR();
    pv_tile<0>(o, vb0, pa0, pa1, pa2, pa3);
    if (even) { mask_bits(pB0, pB1, mwT, hi); partialSM(pB0, pB1, m_reg, mnB, alB); __syncthreads(); RESC(alB);
        finishSM(pB0, pB1, alB, l_reg, pa0, pa1, pa2, pa3); SBAR(); pv_tile<1>(o, vb0, pa0, pa1, pa2, pa3); }
    SBAR(); VMWN(8); SWRITE_HK(0); SBAR();
    if (hi == 0) li_l[r32] = l_reg; asm volatile("s_waitcnt lgkmcnt(0)" ::: "memory");
    float rli[16];
#pragma unroll
    for (int r = 0; r < 16; ++r) rli[r] = __builtin_amdgcn_rcpf(li_l[crow(r, hi)]);
    unsigned char* Ow = ref_o(cur, wsb) + (size_t)qro * OLD + qho * D;
    const bool st_ok = !cur.samp || wid < 4;
#pragma unroll
    for (int r = 0; r < 16; ++r) { const int orow = crow(r, hi);
#pragma unroll
        for (int d0 = 0; d0 < 4; ++d0) { const float v = o[d0][r] * (rli[r] * SA_ATT);
            const float vn = __shfl_xor(v, 1);
            const int h2 = __builtin_amdgcn_cvt_pk_fp8_f32(v, vn, 0, false), h4 = __shfl_xor(h2, 2);
            if (st_ok && (r32 & 3) == 0) *(unsigned*)(Ow + (size_t)orow * OLD + d0 * 32 + r32) = ((unsigned)h2 & 0xffffu) | ((unsigned)h4 << 16); } }
    __syncthreads();
#undef RESC
#undef KBASE
#undef HALF_STEP
#undef BMW
}
#undef ROW
#undef VMW
#undef VMWN
#undef SLOAD_H
#undef SWRITE_HK
#undef SWRITE_HV
#undef SWRITE_H
}
__device__ __forceinline__ att::BlockRef attn_item(unsigned char* ws, int i) {
    att::BlockRef r;
    if (i < 128) { const int bs = i >> 3, g = i & 7; r.m0 = NTOK_P + bs * DEC_T; r.g = g; r.K = (const bf16_t*)(ws + WS_KVS) + (size_t)bs * SKV_SP * 2048 + g * HD; r.NT = SKV_SP / 64; r.samp = 1; }
    else { const int j = i - 128, c = 63 - (j >> 4), b = (j >> 3) & 1, g = j & 7; r.m0 = b * SEQ + c * 64; r.g = g; r.K = (const bf16_t*)(ws + WS_KV) + (size_t)b * SEQ * 2048 + g * HD; r.NT = c + 1; r.samp = 0; }
    return r;
}
__device__ __forceinline__ void attn_phase(Frame& F, char* lds) {
    unsigned char* const ws = ws_ptr(F); unsigned* const ctl = (unsigned*)(ws + WS_CTL);
    constexpr int TOTAL = 128 + 1024;
    volatile LAS unsigned* qw = (volatile LAS unsigned*)(F.lds + RING_OFF + att::ATT_LDS - 64);
    __syncthreads(); const unsigned qsel = F.MISC[17]; __syncthreads(); if (F.tid == 0) F.MISC[17] = qsel + 1u;
    unsigned* qhead = ctl + CW_QATT + 64 * qsel;
    if (F.tid == 0) { qw[0] = __hip_atomic_fetch_add(qhead, 1u, __ATOMIC_RELAXED, __HIP_MEMORY_SCOPE_AGENT); qw[1] = __hip_atomic_fetch_add(qhead, 1u, __ATOMIC_RELAXED, __HIP_MEMORY_SCOPE_AGENT); }
    __syncthreads();
    int i0 = (int)qw[0], i1 = (int)qw[1];
    __syncthreads();
    if (i0 < TOTAL) {
        att::BlockRef cur = attn_item(ws, i0);
        att::Seam S;
        att::attn_prime(cur, ws, lds, S, F.wave);
        for (;;) {
            const bool has = i1 < TOTAL;
            const att::BlockRef nxt = has ? attn_item(ws, i1) : cur;
            if (F.tid == 0 && has) qw[0] = __hip_atomic_fetch_add(qhead, 1u, __ATOMIC_RELAXED, __HIP_MEMORY_SCOPE_AGENT);
            att::attn_block(cur, nxt, ws, lds, S, F.wave);
            if (!has) break;
            __syncthreads();
            i1 = (int)qw[0];
            __syncthreads();
            cur = nxt;
        }
    }
    __syncthreads(); conv_drain(F);
}

struct EpiMix {
    static constexpr bool PERM = true, MID = true, FP8 = true;
    LAS unsigned char* lds;
    __device__ __forceinline__ void mid(f32x4 (&acc)[2][2][4][2], const pg8::Unit& u, int wr, int wc, int fr, int fq) const {
        int row0 = u.pm * 256 + wr * 64 + fr, col0 = u.pn * 256 + wc * 32 + 8 * fq;
        asm volatile("" : "+v"(row0), "+v"(col0));
        unsigned char* const ws = e_ws(lds); const bf16_t* SGA = (const bf16_t*)(ws + WS_SGA); const bf16_t* SGL = (const bf16_t*)(ws + WS_SGL);
#pragma unroll
        for (int ai = 0; ai < 2; ++ai) { u32x4 ga[4][2], gl[4][2];
#pragma unroll
            for (int m = 0; m < 4; ++m)
#pragma unroll
                for (int bj = 0; bj < 2; ++bj) { const size_t off = (size_t)(row0 + ai * 128 + m * 16) * DM + col0 + bj * 128; ga[m][bj] = *(const u32x4*)(SGA + off); gl[m][bj] = *(const u32x4*)(SGL + off); }
            asm volatile("" ::: "memory");
#pragma unroll
            for (int m = 0; m < 4; ++m)
#pragma unroll
                for (int bj = 0; bj < 2; ++bj) { float a[8], l[8]; unpack8(ga[m][bj], a); unpack8(gl[m][bj], l);
#pragma unroll
                    for (int e = 0; e < 4; ++e) { acc[ai][bj][m][0][e] *= a[e] * (SA_LRU / SA_ATT) * __builtin_amdgcn_rcpf(l[e]); acc[ai][bj][m][1][e] *= a[4 + e] * (SA_LRU / SA_ATT) * __builtin_amdgcn_rcpf(l[4 + e]); }
                    asm volatile("" : "+v"(acc[ai][bj][m][0]), "+v"(acc[ai][bj][m][1])); }
            asm volatile("" ::: "memory"); }
    }
    __device__ __forceinline__ void operator()(const f32x4 (&acc)[2][2][4][2], const pg8::Unit& u, int wr, int wc, int fr, int fq) const {
        const int row0 = u.pm * 256 + wr * 64 + fr, col0 = u.pn * 256 + wc * 32 + 8 * fq; constexpr float SC = S_MIX / (SA_LRU * SW8);
        unsigned char* const ws = e_ws(lds); const bf16_t* SGL = (const bf16_t*)(ws + WS_SGL); unsigned char* MIX = ws + WS_MIX;
        u32x4 glr[2][4][2];
#pragma unroll
        for (int ai = 0; ai < 2; ++ai)
#pragma unroll
            for (int m = 0; m < 4; ++m)
#pragma unroll
                for (int bj = 0; bj < 2; ++bj) glr[ai][m][bj] = *(const u32x4*)(SGL + (size_t)(row0 + ai * 128 + m * 16) * DM + col0 + bj * 128);
        asm volatile("" ::: "memory");
#pragma unroll
        for (int ai = 0; ai < 2; ++ai)
#pragma unroll
            for (int m = 0; m < 4; ++m)
#pragma unroll
                for (int bj = 0; bj < 2; ++bj) { const size_t off = (size_t)(row0 + ai * 128 + m * 16) * DM + col0 + bj * 128; float gl[8]; unpack8(glr[ai][m][bj], gl);
                    const f32x4 v0 = acc[ai][bj][m][0], v1 = acc[ai][bj][m][1];
                    if (P9_FP8) { u32x2 w; w.x = pk4_fp8(v0[0] * gl[0] * SC, v0[1] * gl[1] * SC, v0[2] * gl[2] * SC, v0[3] * gl[3] * SC); w.y = pk4_fp8(v1[0] * gl[4] * SC, v1[1] * gl[5] * SC, v1[2] * gl[6] * SC, v1[3] * gl[7] * SC);
                        *(u32x2*)(MIX + off) = w; }
                    else { constexpr float S1 = 1.0f / (SA_LRU * SW8); u32x4 w; w.x = pk2(v0[0] * gl[0] * S1, v0[1] * gl[1] * S1); w.y = pk2(v0[2] * gl[2] * S1, v0[3] * gl[3] * S1); w.z = pk2(v1[0] * gl[4] * S1, v1[1] * gl[5] * S1); w.w = pk2(v1[2] * gl[6] * S1, v1[3] * gl[7] * S1);
                        *(u32x4*)((bf16_t*)MIX + off) = w; } }
    }
};
struct EpiOut {
    static constexpr bool PERM = false, MID = false, FP8 = (P9_FP8 != 0);
    LAS unsigned char* lds;
    __device__ __forceinline__ void operator()(const f32x4 (&acc)[2][2][4][2], const pg8::Unit& u, int wr, int wc, int fr, int fq) const {
        unsigned char* const ws = e_ws(lds); const float* xp = e_in(lds, 0); const float* xs = e_in(lds, 1); const float* gf = e_in(lds, 21);
        float* X1 = (float*)(ws + WS_X1); bf16_t* A2 = (bf16_t*)(ws + WS_A2); LAS float* X = (LAS float*)(lds + XCH_OFF);
        const int row0 = u.pm * 256 + wr * 64 + fr, col0 = u.pn * 256 + wc * 32 + 4 * fq;
        const float* xb = (u.pm < NTOK_P / 256) ? xp : xs - (size_t)NTOK_P * DM;
        f32x4 gv[2][2];
#pragma unroll
        for (int bj = 0; bj < 2; ++bj)
#pragma unroll
            for (int n = 0; n < 2; ++n) gv[bj][n] = *(const f32x4*)(gf + col0 + bj * 128 + n * 16);
#pragma unroll
        for (int ai = 0; ai < 2; ++ai) { f32x4 xv[4][2][2];
#pragma unroll
            for (int m = 0; m < 4; ++m)
#pragma unroll
                for (int bj = 0; bj < 2; ++bj)
#pragma unroll
                    for (int n = 0; n < 2; ++n) xv[m][bj][n] = *(const f32x4*)(xb + (size_t)(row0 + ai * 128 + m * 16) * DM + col0 + bj * 128 + n * 16);
            asm volatile("" ::: "memory");
#pragma unroll
            for (int m = 0; m < 4; ++m) { const size_t row = (size_t)(row0 + ai * 128 + m * 16); const size_t off = row * DM + col0; float s = 0.f;
#pragma unroll
                for (int bj = 0; bj < 2; ++bj)
#pragma unroll
                    for (int n = 0; n < 2; ++n) { const f32x4 x1 = xv[m][bj][n] + acc[ai][bj][m][n] * (P9_FP8 ? 1.0f / (S_MIX * SW8) : 1.0f);
                        *(f32x4*)(X1 + off + bj * 128 + n * 16) = x1; s += (x1[0] * x1[0] + x1[1] * x1[1]) + (x1[2] * x1[2] + x1[3] * x1[3]);
                        const f32x4 y = x1 * gv[bj][n]; u32x2 w; w.x = pk2(y[0], y[1]); w.y = pk2(y[2], y[3]); *(u32x2*)(A2 + off + bj * 128 + n * 16) = w; }
                s += __shfl_xor(s, 16); s += __shfl_xor(s, 32);
                if (fq == 0) X[(ai * 128 + wr * 64 + m * 16 + fr) * 4 + wc] = s; }
            asm volatile("" ::: "memory"); }
        asm volatile("s_waitcnt lgkmcnt(0)" ::: "memory"); __builtin_amdgcn_s_barrier(); asm volatile("" ::: "memory");
        { const int t = (wr * 4 + wc) * 64 + (fq * 16 + fr);
          if (t < 256) { const f32x4 p = *(const LAS f32x4*)(X + t * 4); ((float*)(ws + WS_PSSQ))[(size_t)u.pn * MTOK + u.pm * 256 + t] = (p[0] + p[1]) + (p[2] + p[3]); } }
    }
};
struct EpiGU {
    static constexpr bool PERM = true, MID = false, FP8 = false;
    LAS unsigned char* lds;
    __device__ __forceinline__ void operator()(const f32x4 (&acc)[2][2][4][2], const pg8::Unit& u, int wr, int wc, int fr, int fq) const {
        unsigned char* const ws = e_ws(lds); const float* RSTD = (const float*)(ws + WS_CTL) + CW_SSQ; bf16_t* H = (bf16_t*)(ws + WS_H);
        const int row0 = u.pm * 256 + wr * 64 + fr, col0 = u.pn * 128 + wc * 32 + 8 * fq;
        float rs[2][4];
#pragma unroll
        for (int ai = 0; ai < 2; ++ai)
#pragma unroll
            for (int m = 0; m < 4; ++m) rs[ai][m] = RSTD[row0 + ai * 128 + m * 16];
        asm volatile("" ::: "memory");
#pragma unroll
        for (int ai = 0; ai < 2; ++ai)
#pragma unroll
            for (int m = 0; m < 4; ++m) { const size_t row = (size_t)(row0 + ai * 128 + m * 16);
                const float rstd = rs[ai][m]; float hv[8];
#pragma unroll
                for (int n = 0; n < 2; ++n)
#pragma unroll
                    for (int e = 0; e < 4; ++e) { const float g = acc[ai][0][m][n][e] * rstd, up = acc[ai][1][m][n][e] * rstd; hv[4 * n + e] = g * sigmoidf_(g) * up; }
                *(u32x4*)(H + row * DFF + col0) = pack8f(hv); }
    }
};
struct EpiDown {
    static constexpr bool PERM = false, MID = false, FP8 = false;
    LAS unsigned char* lds;
    __device__ __forceinline__ void operator()(const f32x4 (&acc)[2][2][4][2], const pg8::Unit& u, int wr, int wc, int fr, int fq) const {
        const float* X1 = (const float*)(e_ws(lds) + WS_X1); float* Y = e_out(lds);
        const int row0 = u.pm * 256 + wr * 64 + fr, col0 = u.pn * 256 + wc * 32 + 4 * fq;
#pragma unroll
        for (int ai = 0; ai < 2; ++ai) { f32x4 xv[4][2][2];
#pragma unroll
            for (int m = 0; m < 4; ++m)
#pragma unroll
                for (int bj = 0; bj < 2; ++bj)
#pragma unroll
                    for (int n = 0; n < 2; ++n) xv[m][bj][n] = *(const f32x4*)(X1 + (size_t)(row0 + ai * 128 + m * 16) * DM + col0 + bj * 128 + n * 16);
            asm volatile("" ::: "memory");
#pragma unroll
            for (int m = 0; m < 4; ++m)
#pragma unroll
                for (int bj = 0; bj < 2; ++bj)
#pragma unroll
                    for (int n = 0; n < 2; ++n) *(f32x4*)(Y + (size_t)(row0 + ai * 128 + m * 16) * DM + col0 + bj * 128 + n * 16) = xv[m][bj][n] + acc[ai][bj][m][n];
            asm volatile("" ::: "memory"); }
    }
};

__device__ __forceinline__ f32x4 part_sum(const float* PART, int tile, int s0, int s1, int rr, int cc) {
    f32x4 a = {0.f, 0.f, 0.f, 0.f};
#pragma unroll
    for (int s = 0; s < 8; ++s) if (s >= s0 && s < s1) a += *(const f32x4*)(PART + ((size_t)(tile * 8 + s) * 65536 + (size_t)rr * 256 + cc));
    return a;
}
__device__ __forceinline__ void reduce_mix(Frame& F) {
    unsigned char* const ws = ws_ptr(F); const float* PART = (const float*)(ws + WS_PART);
    const bf16_t* SGA = (const bf16_t*)(ws + WS_SGA); const bf16_t* SGL = (const bf16_t*)(ws + WS_SGL); unsigned char* MIX = ws + WS_MIX;
    for (int it = F.gw * 64 + F.lane; it < NTOK_S * 1024; it += F.NGW * 64) { const int r = it >> 10, col = 4 * (it & 1023), tile = (r >> 8) * 16 + (col >> 8), rr = r & 255, cc = col & 255;
        const f32x4 sA = part_sum(PART, tile, 0, 4, rr, cc), sL = part_sum(PART, tile, 4, 8, rr, cc);
        const size_t off = (size_t)(NTOK_P + r) * DM + col; const u32x2 ga = *(const u32x2*)(SGA + off), gl = *(const u32x2*)(SGL + off);
        constexpr float CA = (P9_FP8 ? S_MIX : 1.0f) / (SA_ATT * SW8), CL = (P9_FP8 ? S_MIX : 1.0f) / (SA_LRU * SW8);
        const float m0 = bflo(ga.x) * sA[0] * CA + bflo(gl.x) * sL[0] * CL, m1 = bfhi(ga.x) * sA[1] * CA + bfhi(gl.x) * sL[1] * CL, m2 = bflo(ga.y) * sA[2] * CA + bflo(gl.y) * sL[2] * CL, m3 = bfhi(ga.y) * sA[3] * CA + bfhi(gl.y) * sL[3] * CL;
        if (P9_FP8) *(unsigned*)(MIX + off) = pk4_fp8(m0, m1, m2, m3); else *(u32x2*)((bf16_t*)MIX + off) = (u32x2){pk2(m0, m1), pk2(m2, m3)}; }
}
__device__ __forceinline__ void reduce_out(Frame& F, bool tail) {
    unsigned char* const ws = ws_ptr(F); const float* PART = (const float*)(ws + WS_PART); const float* xs = in_ptr(F, 1); const float* gf = in_ptr(F, 21);
    float* X1 = (float*)(ws + WS_X1); bf16_t* A2 = (bf16_t*)(ws + WS_A2); float* RSTD = (float*)(ctl_ptr(F) + CW_SSQ); const float* PSSQ = (const float*)(ws + WS_PSSQ);
    for (int r = F.gw * 64 + F.lane; r < (tail ? NTOK_P : MTOK); r += F.NGW * 64) { float ss = 0.f;
#pragma unroll
        for (int j = 0; j < 16; ++j) ss += PSSQ[(size_t)j * MTOK + r];
        RSTD[r] = 1.0f / sqrtf(ss * (1.0f / DM) + EPS); }
    if (tail) for (int r = F.gw; r < NTOK_S; r += F.NGW) { float ss = 0.f;
#pragma unroll 4
        for (int j = 0; j < 16; ++j) { const int col = 4 * F.lane + 256 * j, tile = (r >> 8) * 16 + j, rr = r & 255, cc = 4 * F.lane;
            const f32x4 x1 = *(const f32x4*)(xs + (size_t)r * DM + col) + part_sum(PART, tile, 0, 8, rr, cc) * (P9_FP8 ? 1.0f / (S_MIX * SW8) : 1.0f); const f32x4 gg = *(const f32x4*)(gf + col);
            const size_t off = (size_t)(NTOK_P + r) * DM + col; *(f32x4*)(X1 + off) = x1; ss += (x1[0] * x1[0] + x1[1] * x1[1]) + (x1[2] * x1[2] + x1[3] * x1[3]);
            u32x2 o; o.x = pk2(x1[0] * gg[0], x1[1] * gg[1]); o.y = pk2(x1[2] * gg[2], x1[3] * gg[3]); *(u32x2*)(A2 + off) = o; }
        ss = wave_sum(ss);
        if (F.lane == 0) RSTD[NTOK_P + r] = 1.0f / sqrtf(ss * (1.0f / DM) + EPS); }
}
__device__ __forceinline__ void reduce_down(Frame& F) {
    unsigned char* const ws = ws_ptr(F); const float* PART = (const float*)(ws + WS_PART); const float* X1 = (const float*)(ws + WS_X1); float* Y = out_ptr(F);
    for (int it = F.gw * 64 + F.lane; it < NTOK_S * 1024; it += F.NGW * 64) { const int r = it >> 10, col = 4 * (it & 1023), tile = (r >> 8) * 16 + (col >> 8), rr = r & 255, cc = col & 255;
        const size_t off = (size_t)(NTOK_P + r) * DM + col;
        *(f32x4*)(Y + off) = *(const f32x4*)(X1 + off) + part_sum(PART, tile, 0, 8, rr, cc); }
}

__device__ __forceinline__ void reduce_gu(Frame& F) {
    unsigned char* const ws = ws_ptr(F); const float* PART = (const float*)(ws + WS_PART); const float* RSTD = (const float*)(ws + WS_CTL) + CW_SSQ; bf16_t* H = (bf16_t*)(ws + WS_H);
    constexpr int nM = MTOK / 256, nN = 2 * DFF / 256, NW = nM * nN, RF = NW / 256, REM = NW - RF * 256;
    for (int it = F.gw * 64 + F.lane; it < REM * 256 * 32; it += F.NGW * 64) { const int t = it >> 13, rr = (it >> 5) & 255, cc = 4 * (it & 31);
        int pm, pn; pg8::map_unit(RF * 256 + t, nM, nN, pm, pn);
        const float* p0 = PART + (size_t)(2 * t) * 65536 + (size_t)rr * 256 + cc; const float* p1 = p0 + 65536;
        const f32x4 g = *(const f32x4*)p0 + *(const f32x4*)p1, u = *(const f32x4*)(p0 + 128) + *(const f32x4*)(p1 + 128);
        const size_t row = (size_t)pm * 256 + rr; const float rstd = RSTD[row];
        float h[4];
#pragma unroll
        for (int e = 0; e < 4; ++e) { const float gg = g[e] * rstd; h[e] = gg * sigmoidf_(gg) * (u[e] * rstd); }
        *(u32x2*)(H + row * DFF + pn * 128 + cc) = (u32x2){pk2(h[0], h[1]), pk2(h[2], h[3])}; }
}

__global__ void __launch_bounds__(NTHR, 2) fwd_kernel(Args args) {
    extern __shared__ __attribute__((aligned(16))) unsigned char lds_raw[];
    LAS unsigned char* const ldsb = (LAS unsigned char*)lds_raw;
    int wv0 = __builtin_amdgcn_readfirstlane((int)(threadIdx.x >> 6)); asm volatile("" : "+s"(wv0));
    Frame F = make_frame(ldsb, wv0);
    for (int u = F.tid; u < (LDS_BYTES - LDSCTL_OFF) / 4; u += NTHR) ((LAS unsigned*)(F.lds + LDSCTL_OFF))[u] = 0u;
    __syncthreads();
    if (F.tid == 0) { volatile LAS unsigned* p = (volatile LAS unsigned*)(F.lds + PTR_OFF);
#pragma unroll
        for (int i = 0; i < 25; ++i) { const unsigned long long v = (unsigned long long)args.in[i]; p[2 * i] = (unsigned)v; p[2 * i + 1] = (unsigned)(v >> 32); }
        { const unsigned long long v = (unsigned long long)args.out; p[50] = (unsigned)v; p[51] = (unsigned)(v >> 32); }
        { const unsigned long long v = (unsigned long long)args.ws; p[52] = (unsigned)v; p[53] = (unsigned)(v >> 32); } }
    __syncthreads();
    XcdBarrier bar = xcd_barrier_post(ctl_ptr(F) + CW_BAR, F.MISC + 8, wv0);

#define REP(n, ...) do { __VA_ARGS__; if constexpr ((DBL >> (n)) & 1) { xcd_barrier(bar); __VA_ARGS__; } } while (0)
#define GEMM_PHASE_C(EPI, AOFF, BOFF, LDA, LDB, KK, NN, BD, TAIL, CIDX) do { F = make_frame(ldsb, wv0); unsigned char* const ws = ws_ptr(F); \
        pg8::Gemm g{ws, (AOFF), (BOFF), (LDA), (LDB), (KK)}; pg8::StaticOrder S; S.init(MTOK, (NN), (KK), F.G, (CIDX), (BD), (TAIL)); \
        EPI E{F.lds}; pg8::gemm_phase<EPI, pg8::StaticOrder>(F.lds + RING_OFF, g, S, E, F.wave); } while (0)
#define GEMM_PHASE(EPI, AOFF, BOFF, LDA, LDB, KK, NN, BD, TAIL) GEMM_PHASE_C(EPI, AOFF, BOFF, LDA, LDB, KK, NN, BD, TAIL, (int)blockIdx.x)
    REP(0, F = make_frame(ldsb, wv0); p0_prologue(F));
    xcd_barrier(bar);
    REP(1, GEMM_PHASE(EpiProjA, WS_XN, WS_WI, DM, DM, DM, 41 * 256, 0, 0));
    REP(13, GEMM_PHASE_C(EpiProjB, WS_XN8, WS_WI8, DM / 2, DM / 2, DM / 2, 64 * 256, 0, 0, (int)(gridDim.x - 1 - blockIdx.x)));
    xcd_barrier(bar);
    REP(2, F = make_frame(ldsb, wv0); p2_phase(F));
    xcd_barrier(bar);
    REP(3, GEMM_PHASE(EpiGates, WS_U, WS_WG, DM, 256, 256, 32 * 256, 1, 0));
    REP(10, F = make_frame(ldsb, wv0); idx_phase(F));
    xcd_barrier(bar);
    REP(4, F = make_frame(ldsb, wv0); scan_summaries(F));
    REP(11, F = make_frame(ldsb, wv0); select_phase(F));
    xcd_barrier(bar);
    REP(5, F = make_frame(ldsb, wv0); scan_apply(F));
    REP(12, F = make_frame(ldsb, wv0); attn_phase(F, (char*)lds_raw + RING_OFF));
    xcd_barrier(bar);
    REP(6, GEMM_PHASE(EpiMix, WS_OAL, WS_WB, DM, DM, DM, DM, 0, 1));
    xcd_barrier(bar);
    if (gridDim.x == 256) { F = make_frame(ldsb, wv0); reduce_mix(F); xcd_barrier(bar); }
    GEMM_PHASE(EpiOut, WS_MIX, WS_WO, (P9_FP8 ? DM / 2 : DM), (P9_FP8 ? DM / 2 : DM), (P9_FP8 ? DM / 2 : DM), DM, 0, 1);
    xcd_barrier(bar);
    F = make_frame(ldsb, wv0); reduce_out(F, gridDim.x == 256); xcd_barrier(bar);
    REP(8, GEMM_PHASE(EpiGU, WS_A2, WS_WGU, DM, DM, DM, 2 * DFF, 0, 2));
    xcd_barrier(bar);
    if (gridDim.x == 256) { F = make_frame(ldsb, wv0); reduce_gu(F); xcd_barrier(bar); }
    REP(9, GEMM_PHASE(EpiDown, WS_H, WS_WD, DFF, DFF, DFF, DM, 0, 1));
    if (gridDim.x == 256) { xcd_barrier(bar); F = make_frame(ldsb, wv0); reduce_down(F); }
#undef REP
#undef GEMM_PHASE
#undef GEMM_PHASE_C
}

extern "C" void kernel_launch(void* const* d_in, const int* in_sizes, int n_in, void* d_out, int out_size, void* d_ws, size_t ws_size, hipStream_t stream) {
    static int grid = 0;
    if (grid == 0) {
        if (n_in != 25 || out_size != (int)O_END || ws_size < WS_END) { fprintf(stderr, "kernel_launch: unexpected shapes (n_in %d, out %d, ws %zu; need ws >= %zu); nothing launched\n", n_in, out_size, ws_size, (size_t)WS_END); grid = -1; return; }
        int dev = 0, cus = 0, per_cu = 0;
        if (hipGetDevice(&dev) != hipSuccess || hipDeviceGetAttribute(&cus, hipDeviceAttributeMultiprocessorCount, dev) != hipSuccess) { fprintf(stderr, "kernel_launch: device query failed\n"); grid = -1; return; }
        if (hipFuncSetAttribute((const void*)fwd_kernel, hipFuncAttributeMaxDynamicSharedMemorySize, LDS_BYTES) != hipSuccess) { fprintf(stderr, "kernel_launch: hipFuncSetAttribute failed\n"); grid = -1; return; }
        if (hipOccupancyMaxActiveBlocksPerMultiprocessor(&per_cu, (const void*)fwd_kernel, NTHR, LDS_BYTES) != hipSuccess || per_cu < 1) { fprintf(stderr, "kernel_launch: occupancy query reports %d blocks per CU\n", per_cu); }
        (void)hipGetLastError();
        grid = cus;
    }
    if (grid < 0) return;
    if (hipMemsetAsync((char*)d_ws + WS_CTL, 0, CTL_BYTES, stream) != hipSuccess) { fprintf(stderr, "kernel_launch: memset failed\n"); return; }
    Args a{};
    for (int i = 0; i < 25; ++i) a.in[i] = (const float*)d_in[i];
    a.out = (float*)d_out; a.ws = (unsigned char*)d_ws;
    hipLaunchKernelGGL(fwd_kernel, dim3(grid), dim3(NTHR), LDS_BYTES, stream, a);
    const hipError_t le = hipPeekAtLastError();
    if (le != hipSuccess) fprintf(stderr, "kernel_launch: launch failed: %s\n", hipGetErrorName(le));
}
```

```cpp
#include <hip/hip_runtime.h>
#include <cstdio>
#include <cstdint>

#ifndef DBL
#define DBL 0
#endif
#ifndef P9_FP8
#define P9_FP8 1
#endif
#ifndef FP8_MX
#define FP8_MX 2
#endif
#define LAS __attribute__((address_space(3)))
#define GAS __attribute__((address_space(1)))
typedef unsigned short bf16_t;
typedef short bf16x8 __attribute__((ext_vector_type(8)));
typedef float f32x4 __attribute__((ext_vector_type(4)));
typedef float f32x2 __attribute__((ext_vector_type(2)));
typedef float f32x16 __attribute__((ext_vector_type(16)));
typedef unsigned u32x4 __attribute__((ext_vector_type(4)));
typedef unsigned u32x2 __attribute__((ext_vector_type(2)));
typedef int i32x8 __attribute__((ext_vector_type(8)));

constexpr int DM = 4096, SEQ = 4096, NB_P = 2, NTOK_P = NB_P * SEQ, DEC_B = 16, DEC_T = 32, NTOK_S = DEC_B * DEC_T, MTOK = NTOK_P + NTOK_S;
constexpr int PAST = 2048, SKV_S = PAST + DEC_T, SKV_SP = 2112;
constexpr int NH = 32, NKVH = 8, HD = 128, KVW = NKVH * HD, IDXH = 32, IDXD = 128;
constexpr int DFF = 11008, TOPK = 256;
constexpr int N1 = 105 * 256;
constexpr int N1_SRC = 26784;
constexpr float EPS = 1e-6f;
static_assert(MTOK % 256 == 0 && DFF % 128 == 0, "tiling");

constexpr size_t O_YP = 0, O_YS = O_YP + (size_t)NTOK_P * DM, O_KP = O_YS + (size_t)NTOK_S * DM, O_VP = O_KP + (size_t)NTOK_P * KVW, O_IKP = O_VP + (size_t)NTOK_P * KVW,
                 O_LRUP = O_IKP + (size_t)NTOK_P * IDXD, O_CONVP = O_LRUP + (size_t)NB_P * DM, O_KS = O_CONVP + (size_t)NB_P * 3 * DM, O_VS = O_KS + (size_t)NTOK_S * KVW,
                 O_IKS = O_VS + (size_t)NTOK_S * KVW, O_LRUS = O_IKS + (size_t)NTOK_S * IDXD, O_CONVS = O_LRUS + (size_t)DEC_B * DM, O_END = O_CONVS + (size_t)DEC_B * 3 * DM;
static_assert(O_END == 54886400, "output size");

constexpr size_t al256(size_t x) { return (x + 255) & ~(size_t)255; }
constexpr size_t SZ_ACT = (size_t)MTOK * DM * 2;
constexpr size_t WS_CTL = 0, CTL_BYTES = 1u << 20;
constexpr size_t WS_ROPE = WS_CTL + CTL_BYTES;
constexpr size_t WS_WI = WS_ROPE + (size_t)4096 * 16 * 8;
constexpr size_t WS_WI8 = WS_WI + (size_t)41 * 256 * DM * 2;
constexpr size_t WS_XN8 = WS_WI8 + (size_t)64 * 256 * DM;
static_assert(WS_XN8 + (size_t)MTOK * DM <= WS_WI + (size_t)N1 * DM * 2, "WI region");
constexpr size_t WS_WB = WS_WI + (size_t)N1 * DM * 2;
constexpr size_t WS_WO = WS_WB + (size_t)DM * 2 * DM * 2;
constexpr size_t WS_WGU = WS_WO + (size_t)DM * DM * 2;
constexpr size_t WS_WD = WS_WGU + (size_t)2 * DFF * DM * 2;
constexpr size_t WS_WG = WS_WD + (size_t)DM * DFF * 2;
constexpr size_t WS_XN = WS_WG + (size_t)16 * 512 * 256 * 2;
constexpr size_t WS_Q = WS_XN + SZ_ACT;
constexpr size_t WS_IQ = WS_Q + SZ_ACT;
constexpr size_t WS_XL = WS_IQ + SZ_ACT;
constexpr size_t WS_GY = WS_XL + SZ_ACT;
constexpr size_t WS_SGA = WS_GY + SZ_ACT;
constexpr size_t WS_SGL = WS_SGA + SZ_ACT;
constexpr size_t WS_KV = WS_SGL + SZ_ACT;
constexpr size_t WS_IWK = WS_KV + (size_t)MTOK * 2048 * 2;
constexpr size_t WS_IKB = WS_IWK + (size_t)MTOK * 256 * 2;
constexpr size_t WS_IWF = WS_IKB + (size_t)MTOK * 128 * 2;
constexpr size_t WS_KVS = WS_IWF + (size_t)MTOK * 32 * 4;
constexpr size_t WS_IKS = WS_KVS + (size_t)DEC_B * SKV_SP * 2048 * 2;
constexpr size_t WS_SC = WS_IKS + (size_t)DEC_B * SKV_SP * 128 * 2;
constexpr size_t WS_SCS = WS_SC + (size_t)NTOK_P * SEQ * 4;
constexpr size_t WS_BM = WS_SCS + (size_t)NTOK_S * SKV_SP * 4;
constexpr size_t WS_AB = WS_BM + (size_t)MTOK * 512;
constexpr size_t WS_SUM = WS_AB + (size_t)MTOK * DM * 4;
constexpr size_t WS_OAL = WS_SUM + (size_t)128 * DM * 8;
constexpr size_t WS_END = WS_OAL + 2 * SZ_ACT;
constexpr size_t WS_PSSQ = WS_SUM;
constexpr size_t WS_H = WS_Q, WS_U = WS_XN, WS_MIX = WS_XN, WS_X1 = WS_AB, WS_A2 = WS_SC, WS_PART = WS_SC + SZ_ACT;
static_assert(WS_PART + (size_t)256 * 65536 * 4 <= WS_BM, "partial slots");
static_assert((size_t)MTOK * DFF * 2 <= 3 * SZ_ACT, "H overlay");
static_assert(WS_END <= (size_t)4 * 109707264 * 4, "workspace");

constexpr int CW_BAR = 0;
constexpr int CW_QATT = 4096;
constexpr int CW_QIDX = 4096 + 256;
constexpr int CW_SSQ = 8192;
static_assert((CW_SSQ + 2 * MTOK) * 4 <= (int)CTL_BYTES, "ctl");

__device__ __forceinline__ unsigned pk2(float lo, float hi) { unsigned r; asm volatile("v_cvt_pk_bf16_f32 %0, %1, %2" : "=v"(r) : "v"(lo), "v"(hi)); return r; }
__device__ __forceinline__ float bflo(unsigned w) { return __uint_as_float(w << 16); }
__device__ __forceinline__ float bfhi(unsigned w) { return __uint_as_float(w & 0xffff0000u); }
__device__ __forceinline__ float bf1(bf16_t b) { return __uint_as_float((unsigned)b << 16); }
__device__ __forceinline__ void unpack8(u32x4 w, float (&v)[8]) { v[0] = bflo(w.x); v[1] = bfhi(w.x); v[2] = bflo(w.y); v[3] = bfhi(w.y); v[4] = bflo(w.z); v[5] = bfhi(w.z); v[6] = bflo(w.w); v[7] = bfhi(w.w); }
__device__ __forceinline__ u32x4 pack8f(const float (&v)[8]) { u32x4 w; w.x = pk2(v[0], v[1]); w.y = pk2(v[2], v[3]); w.z = pk2(v[4], v[5]); w.w = pk2(v[6], v[7]); return w; }
__device__ __forceinline__ float sigmoidf_(float x) { return __builtin_amdgcn_rcpf(1.0f + __builtin_amdgcn_exp2f(-1.4426950408889634f * x)); }
__device__ __forceinline__ float gelu_tanh_(float x) {
    const float u = x * (1.0f + 0.044715f * x * x); return x * __builtin_amdgcn_rcpf(1.0f + __builtin_amdgcn_exp2f(-2.0f * 0.7978845608028654f * 1.4426950408889634f * u)); }
constexpr float SW8 = 64.f, SA_ATT = 8.f, SA_LRU = 4.f, S_MIX = 8.f, SXN = 4.f;
__device__ __forceinline__ unsigned pk4_fp8(float a, float b, float c, float d) { int w = __builtin_amdgcn_cvt_pk_fp8_f32(a, b, 0, false); w = __builtin_amdgcn_cvt_pk_fp8_f32(c, d, w, true); return (unsigned)w; }
#define LDS_WAIT() asm volatile("s_waitcnt lgkmcnt(0)" ::: "memory")
#define VM_WAIT() asm volatile("s_waitcnt vmcnt(0)" ::: "memory")

__device__ __forceinline__ int tid_of(int wv) { int l; asm volatile("v_mbcnt_lo_u32_b32 %0, -1, 0\n\tv_mbcnt_hi_u32_b32 %0, -1, %0" : "=v"(l)); return (wv << 6) | l; }
namespace pg8 {
typedef int i32x4_ __attribute__((ext_vector_type(4)));
constexpr int BM = 256, BK = 64, HALF = 128, HTB = HALF * BK * 2, STAGE_BYTES = 8 * HTB, NXCD = 8, WGM = 4;
__host__ __device__ __forceinline__ int lds_byte(int r, int c) { const int st = (r >> 4) * 2 + (c >> 5), rr = r & 15, cc = c & 31, ob = rr * 64 + cc * 2; return st * 1024 + (ob ^ (((ob >> 9) & 1) << 5)); }
__host__ __device__ __forceinline__ void stage_rc(int b, int& R, int& C) { const int st = b / 1024, sb = b % 1024, swz = sb ^ (((sb >> 9) & 1) << 5); R = (st >> 1) * 16 + swz / 64; C = (st & 1) * 32 + (swz % 64) / 2; }
__host__ __device__ __forceinline__ int perm32(int rho) { const int n = rho >> 4, i = rho & 15; return 8 * (i >> 2) + 4 * n + (i & 3); }

struct Unit { int pm, pn, acol, bcol, nt, part; };
struct Gemm { unsigned char* ws; size_t a_off, b_off; int lda, ldb, K; };

__device__ __forceinline__ void map_unit(int L, int nM, int nN, int& pm, int& pn) {
    const int nwg = nM * nN; int wgid = L; { const int q = nwg / NXCD, r = nwg % NXCD, xcd = wgid % NXCD, off = wgid / NXCD; wgid = (xcd < r ? xcd * (q + 1) : r * (q + 1) + (xcd - r) * q) + off; }
    const int nig = WGM * nN, gid = wgid / nig, fm = gid * WGM, gsz = (nM - fm) < WGM ? (nM - fm) : WGM;
    pm = fm + ((wgid % nig) % gsz); pn = (wgid % nig) / gsz;
}
struct StaticOrder {
    int nM, nN, nwg, G, c, blockdiag, ntk, tail;
    __device__ void init(int M, int N, int K, int G_, int c_, int bd = 0, int tail_ = 0) { tail = (G_ == 256) ? tail_ : 0; nM = M / BM - (tail == 1 ? 2 : 0); nN = N / BM; nwg = nM * nN; G = G_; c = c_; blockdiag = bd; ntk = K / BK; }
    __device__ bool next(int i, Unit& u) const {
        const long L = (long)i * G + c; const int rfull = nwg / G;
        const bool t2 = (tail == 2 && i >= rfull);
        const bool tl = (L >= nwg) && !t2;
        if (tl && (tail != 1 || i != rfull)) return false;
        if (t2 && (i > rfull || c >= 2 * (nwg - rfull * G))) return false;
        int pm0, pn0; map_unit(t2 ? rfull * G + (c >> 1) : (tl ? 0 : (int)L), nM, nN, pm0, pn0);
        const int tile = c >> 3, sp = c & 7, npair = ntk >> 1, base = npair >> 3, rem = npair & 7, p0 = sp * base + (sp < rem ? sp : rem), np = base + (sp < rem ? 1 : 0);
        const int pm = tl ? nM + (tile >> 4) : pm0, pn = tl ? (tile & 15) : pn0;
        const int koff = tl ? p0 * 2 * BK : (t2 ? (c & 1) * (ntk >> 1) * BK : 0);
        const int ac = koff + ((!tl && blockdiag) ? 256 * (pn0 >> 1) : 0);
        u = Unit{pm, pn, ac, koff, tl ? 2 * np : (t2 ? (ntk >> 1) : ntk), (tl || t2) ? c : -1};
        return true;
    }
};

template <class Epi, class Sched>
__device__ __forceinline__ void gemm_phase(LAS unsigned char* lds, const Gemm g, const Sched& S, const Epi& E, int wv) {
    const int tid = tid_of(wv);
    const int wid = __builtin_amdgcn_readfirstlane(tid >> 6), lane = tid & 63, wr = wid >> 2, wc = wid & 3, fr = lane & 15, fq = lane >> 4;
    unsigned voffA[2], voffB[2];
#pragma unroll
    for (int i = 0; i < 2; ++i) { int R, C; stage_rc(tid * 16 + i * 8192, R, C); const int Rb = Epi::PERM ? ((R & ~31) + perm32(R & 31)) : R;
        voffA[i] = (unsigned)(R * g.lda + C) * 2u; voffB[i] = (unsigned)(Rb * g.ldb + C) * 2u; }
    const size_t kstep = (size_t)(BK * 2);
    const size_t hstepA = (size_t)HALF * g.lda * 2, hstepB = (size_t)HALF * g.ldb * 2;
    const size_t tstepA = 2 * hstepA, tstepB = 2 * hstepB;
    const unsigned ldsw = (unsigned)wid * 1024u;
    constexpr bool FP8 = Epi::FP8;
    const int aoff = lds_byte(wr * 64 + fr, FP8 ? fq * 16 : fq * 8), boff = lds_byte(wc * 32 + fr, FP8 ? fq * 16 : fq * 8);
#define PG8_SA(b, h) (((b) * 2 + (h)) * HTB)
#define PG8_SB(b, h) ((4 + (b) * 2 + (h)) * HTB)
#define PG8_STAGE(bufoff, gbase, voff) do { _Pragma("unroll") for (int _i = 0; _i < 2; ++_i) \
        __builtin_amdgcn_global_load_lds((const unsigned*)((const char*)(gbase) + (voff)[_i]), (LAS unsigned*)(lds + (bufoff) + ldsw + _i * 8192), 16, 0, 0); } while (0)
#define PG8_P64(v, j) ((long)(((unsigned long)(unsigned)(v)[2 * (j) + 1] << 32) | (unsigned long)(unsigned)(v)[2 * (j)]))
#define PG8_LD32(p) __builtin_shufflevector(*(const LAS i32x4_*)(p), *(const LAS i32x4_*)((p) + 16), 0, 1, 2, 3, 4, 5, 6, 7)
#define PG8_LDA(dst, b, h) do { if constexpr (FP8) { _Pragma("unroll") for (int m = 0; m < 4; ++m) dst##8[m] = PG8_LD32(lds + PG8_SA(b, h) + aoff + m * 2048); } \
        else { _Pragma("unroll") for (int m = 0; m < 4; ++m) _Pragma("unroll") for (int k = 0; k < 2; ++k) dst[m][k] = *(const LAS bf16x8*)(lds + PG8_SA(b, h) + aoff + m * 2048 + k * 1024); } } while (0)
#define PG8_LDB(dst, b, h) do { if constexpr (FP8) { _Pragma("unroll") for (int n = 0; n < 2; ++n) dst##8[n] = PG8_LD32(lds + PG8_SB(b, h) + boff + n * 2048); } \
        else { _Pragma("unroll") for (int n = 0; n < 2; ++n) _Pragma("unroll") for (int k = 0; k < 2; ++k) dst[n][k] = *(const LAS bf16x8*)(lds + PG8_SB(b, h) + boff + n * 2048 + k * 1024); } } while (0)
#define PG8_MMA(ai, bj, At, Bt) do { __builtin_amdgcn_s_setprio(1); _Pragma("unroll") for (int m = 0; m < 4; ++m) _Pragma("unroll") for (int n = 0; n < 2; ++n) { \
        if constexpr (FP8 && FP8_MX == 2) asm volatile("v_mfma_f32_16x16x128_f8f6f4 %0, %1, %2, %0" : "+v"(acc[ai][bj][m][n]) : "v"(Bt##8[n]), "v"(At##8[m])); \
        else if constexpr (FP8 && FP8_MX == 1) acc[ai][bj][m][n] = __builtin_amdgcn_mfma_scale_f32_16x16x128_f8f6f4(Bt##8[n], At##8[m], acc[ai][bj][m][n], 0, 0, 0, 0, 0, 0); \
        else if constexpr (FP8) { _Pragma("unroll") for (int j = 0; j < 4; ++j) acc[ai][bj][m][n] = __builtin_amdgcn_mfma_f32_16x16x32_fp8_fp8(PG8_P64(Bt##8[n], j), PG8_P64(At##8[m], j), acc[ai][bj][m][n], 0, 0, 0); } \
        else { _Pragma("unroll") for (int k = 0; k < 2; ++k) acc[ai][bj][m][n] = __builtin_amdgcn_mfma_f32_16x16x32_bf16(Bt[n][k], At[m][k], acc[ai][bj][m][n], 0, 0, 0); } } __builtin_amdgcn_s_setprio(0); } while (0)
#define PG8_WAIT_V(n) asm volatile("s_waitcnt vmcnt(" #n ")" ::: "memory")
#define PG8_WAIT_L(n) asm volatile("s_waitcnt lgkmcnt(" #n ")" ::: "memory")
#define PG8_BAR __builtin_amdgcn_s_barrier()
#define PG8_SCHED __builtin_amdgcn_sched_barrier(0)
    Unit cur, nxt; int ui = 0;
    if (!S.next(0, cur)) return;
    f32x4 acc[2][2][4][2];
#pragma unroll
    for (int a = 0; a < 2; ++a)
#pragma unroll
        for (int b = 0; b < 2; ++b)
#pragma unroll
            for (int m = 0; m < 4; ++m)
#pragma unroll
                for (int n = 0; n < 2; ++n) acc[a][b][m][n] = (f32x4){0.f, 0.f, 0.f, 0.f};
    bf16x8 At[4][2], B0[2][2], B1[2][2]; i32x8 At8[4], B08[2], B18[2];
    const char* cA = (const char*)g.ws + g.a_off + (size_t)cur.pm * tstepA + (size_t)cur.acol * 2; const char* cB = (const char*)g.ws + g.b_off + (size_t)cur.pn * tstepB + (size_t)cur.bcol * 2;
    PG8_STAGE(PG8_SB(0, 0), cB, voffB); PG8_STAGE(PG8_SB(0, 1), cB + hstepB, voffB); PG8_STAGE(PG8_SA(0, 0), cA, voffA); PG8_STAGE(PG8_SA(0, 1), cA + hstepA, voffA);
    if (wr == 1) PG8_BAR;
    PG8_WAIT_V(2); PG8_BAR;
    PG8_STAGE(PG8_SB(1, 0), cB + kstep, voffB); PG8_STAGE(PG8_SA(1, 0), cA + kstep, voffA); PG8_STAGE(PG8_SB(1, 1), cB + hstepB + kstep, voffB);
    PG8_WAIT_V(6); PG8_BAR;
    for (;;) {
        const bool has_next = S.next(ui + 1, nxt);
        const char* nA = has_next ? (const char*)g.ws + g.a_off + (size_t)nxt.pm * tstepA + (size_t)nxt.acol * 2 : cA; const char* nB = has_next ? (const char*)g.ws + g.b_off + (size_t)nxt.pn * tstepB + (size_t)nxt.bcol * 2 : cB;
        const int nt = cur.nt;
        for (int t = 0; t < nt; t += 2) {
            const bool last = (t == nt - 2);
            const char* a1 = cA + (size_t)(t + 1) * kstep;
            const char* a2 = last ? nA : cA + (size_t)(t + 2) * kstep; const char* b2 = last ? nB : cB + (size_t)(t + 2) * kstep;
            const char* a3 = a2 + kstep; const char* b3 = b2 + kstep;
            if constexpr (Epi::MID) { if (cur.part < 0 && t == (nt >> 1)) { if constexpr (FP8 && FP8_MX == 2) asm volatile("s_nop 15\n\ts_nop 15" ::: "memory"); E.mid(acc, cur, wr, wc, fr, fq); } }
            PG8_LDB(B0, 0, 0); PG8_LDB(B1, 0, 1); PG8_SCHED; PG8_LDA(At, 0, 0); PG8_STAGE(PG8_SA(1, 1), a1 + hstepA, voffA);
            PG8_WAIT_V(8); PG8_WAIT_L(0); PG8_BAR; PG8_MMA(0, 0, At, B0); PG8_MMA(0, 1, At, B1); PG8_BAR; PG8_SCHED;
            PG8_LDA(At, 0, 1); PG8_STAGE(PG8_SB(0, 0), b2, voffB); PG8_STAGE(PG8_SB(0, 1), b2 + hstepB, voffB); PG8_STAGE(PG8_SA(0, 0), a2, voffA);
            PG8_WAIT_V(8); PG8_WAIT_L(0); PG8_BAR; PG8_MMA(1, 0, At, B0); PG8_MMA(1, 1, At, B1); PG8_BAR; PG8_SCHED;
            PG8_LDB(B0, 1, 0); PG8_LDB(B1, 1, 1); PG8_SCHED; PG8_LDA(At, 1, 0); PG8_STAGE(PG8_SA(0, 1), a2 + hstepA, voffA);
            PG8_WAIT_V(8); PG8_WAIT_L(0); PG8_BAR; PG8_MMA(0, 0, At, B0); PG8_MMA(0, 1, At, B1); PG8_BAR; PG8_SCHED;
            PG8_LDA(At, 1, 1); PG8_STAGE(PG8_SB(1, 0), b3, voffB); PG8_STAGE(PG8_SB(1, 1), b3 + hstepB, voffB); PG8_STAGE(PG8_SA(1, 0), a3, voffA);
            PG8_WAIT_V(8); PG8_WAIT_L(0); PG8_BAR; PG8_MMA(1, 0, At, B0); PG8_MMA(1, 1, At, B1); PG8_BAR; PG8_SCHED;
        }
        if (wr == 0) PG8_BAR;
        if constexpr (FP8 && FP8_MX == 2) asm volatile("s_nop 15\n\ts_nop 15" ::: "memory");
        int fr_ = fr, fq_ = fq; asm volatile("" : "+v"(fr_), "+v"(fq_));
        if (cur.part < 0) E(acc, cur, wr, wc, fr_, fq_);
        else {
            float* P = (float*)(g.ws + WS_PART) + (size_t)cur.part * (BM * BM) + (size_t)(wr * 64 + fr_) * BM + wc * 32 + (Epi::PERM ? 8 * fq_ : 4 * fq_);
#pragma unroll
            for (int ai = 0; ai < 2; ++ai)
#pragma unroll
                for (int m = 0; m < 4; ++m)
#pragma unroll
                    for (int bj = 0; bj < 2; ++bj)
#pragma unroll
                        for (int n = 0; n < 2; ++n) *(f32x4*)(P + (size_t)(ai * HALF + m * 16) * BM + bj * HALF + (Epi::PERM ? 4 * n : 16 * n)) = acc[ai][bj][m][n]; }
        if (!has_next) break;
#pragma unroll
        for (int a = 0; a < 2; ++a)
#pragma unroll
            for (int b = 0; b < 2; ++b)
#pragma unroll
                for (int m = 0; m < 4; ++m)
#pragma unroll
                    for (int n = 0; n < 2; ++n) acc[a][b][m][n] = (f32x4){0.f, 0.f, 0.f, 0.f};
        cur = nxt; cA = nA; cB = nB; ++ui;
        if (wr == 1) PG8_BAR;
    }
    PG8_WAIT_V(0);
    PG8_BAR;
#undef PG8_SA
#undef PG8_SB
#undef PG8_STAGE
#undef PG8_LDA
#undef PG8_LDB
#undef PG8_MMA
#undef PG8_LD32
#undef PG8_P64
#undef PG8_WAIT_V
#undef PG8_WAIT_L
#undef PG8_BAR
#undef PG8_SCHED
}
}

#define XB_TMO      128
#define XB_XCNT(j)  (256  + 64 * (j))
#define XB_XSUB(j)  (1280 + 64 * (j))
#define XB_XGEN(j)  (2304 + 64 * (j))
#define XB_TOP      3328
#define XB_TOPGEN   3392
#define XCD_BAR_WORDS 3456
#define XB_SPIN_CAP (1u << 18)
__device__ __forceinline__ unsigned xb_ld(unsigned* p)              { return __hip_atomic_load(p, __ATOMIC_RELAXED, __HIP_MEMORY_SCOPE_AGENT); }
__device__ __forceinline__ unsigned xb_add(unsigned* p, unsigned v) { return __hip_atomic_fetch_add(p, v, __ATOMIC_RELAXED, __HIP_MEMORY_SCOPE_AGENT); }
__device__ __forceinline__ unsigned xb_xcc_id() { return (unsigned)__builtin_amdgcn_s_getreg((3 << 11) | 20) & 0xFu; }
#define XB_SPIN(cond, bar) do { unsigned _sp = 0; while (cond) { __builtin_amdgcn_s_sleep(1); \
    if ((++_sp & 255u) == 0u) { if (xb_ld(&(bar)[XB_TMO])) break; if (_sp > XB_SPIN_CAP) { atomicAdd(&(bar)[XB_TMO], 1u); break; } } } } while (0)
struct XcdBarrier { unsigned* bar; unsigned x; volatile LAS unsigned* st; int wv; };
__device__ __forceinline__ bool xb_leader(int wv) { return wv == 0 && __builtin_amdgcn_mbcnt_hi(~0u, __builtin_amdgcn_mbcnt_lo(~0u, 0u)) == 0u; }
__device__ __forceinline__ XcdBarrier xcd_barrier_post(unsigned* bar, volatile LAS unsigned* st, int wv) {
    XcdBarrier b; b.bar = bar; b.x = xb_xcc_id(); b.st = st; b.wv = wv;
    if (xb_leader(wv)) (void)xb_add(&bar[XB_XCNT(b.x)], 1u);
    return b;
}
__device__ __forceinline__ void xcd_barrier_complete(unsigned* bar, unsigned x, unsigned& nloc, unsigned& nx) {
    const unsigned G = gridDim.x * gridDim.y * gridDim.z;
    unsigned sum, cnt, mine, sp = 0u;
    for (;;) {
        sum = 0u; cnt = 0u; mine = 0u;
#pragma unroll
        for (unsigned j = 0; j < 16; ++j) { const unsigned c = xb_ld(&bar[XB_XCNT(j)]); sum += c; cnt += (c > 0u) ? 1u : 0u; mine = (j == x) ? c : mine; }
        if (sum == G) break;
        __builtin_amdgcn_s_sleep(1);
        if ((++sp & 255u) == 0u) { if (xb_ld(&bar[XB_TMO])) break; if (sp > XB_SPIN_CAP) { atomicAdd(&bar[XB_TMO], 1u); break; } }
    }
    nloc = mine > 0u ? mine : 1u; nx = cnt > 0u ? cnt : 1u;
}
__device__ __forceinline__ void xcd_barrier(const XcdBarrier& b) {
    asm volatile("s_waitcnt vmcnt(0)" ::: "memory");
    __syncthreads();
    if (xb_leader(b.wv)) {
        unsigned* bar = b.bar;
        __builtin_amdgcn_s_waitcnt(0);
        unsigned nloc = b.st[0], nx = b.st[1];
        if (nloc == 0u) { xcd_barrier_complete(bar, b.x, nloc, nx); b.st[0] = nloc; b.st[1] = nx; }
        const unsigned old = xb_add(&bar[XB_XSUB(b.x)], 1u);
        const unsigned gen = old / nloc;
        if (old + 1u == (gen + 1u) * nloc) {
            __builtin_amdgcn_fence(__ATOMIC_RELEASE, "agent");
            asm volatile("s_waitcnt vmcnt(0)" ::: "memory");
            const unsigned og = xb_add(&bar[XB_TOP], 1u);
            const unsigned tg = og / nx;
            if (og + 1u == (tg + 1u) * nx) xb_add(&bar[XB_TOPGEN], 1u);
            else XB_SPIN(xb_ld(&bar[XB_TOPGEN]) == tg, bar);
            __builtin_amdgcn_fence(__ATOMIC_ACQUIRE, "agent");
            xb_add(&bar[XB_XGEN(b.x)], 1u);
            asm volatile("s_waitcnt vmcnt(0)" ::: "memory");
        } else {
            XB_SPIN(xb_ld(&bar[XB_XGEN(b.x)]) == gen, bar);
            __builtin_amdgcn_fence(__ATOMIC_ACQUIRE, "agent");
            asm volatile("s_waitcnt vmcnt(0)" ::: "memory");
        }
    }
    __syncthreads();
}

constexpr int NWAVES = 8, NTHR = 512;
constexpr int RING_OFF = 0, RING_BYTES = 131072;
constexpr int LDSCTL_OFF = RING_BYTES, MISC_OFF = LDSCTL_OFF + 320;
constexpr int LDS_BYTES = 147456;
struct Args { const float* in[25]; float* out; unsigned char* ws; };
constexpr int PTR_OFF = MISC_OFF + 128;
static_assert(PTR_OFF + 28 * 8 <= LDS_BYTES, "LDS map");
struct Frame {
    LAS unsigned char* lds; volatile LAS unsigned* MISC;
    int tid, lane, wave, vcu, G, gw, NGW;
};
__device__ __forceinline__ Frame make_frame(LAS unsigned char* lds, int wv) {
    Frame F; F.lds = lds; F.MISC = (volatile LAS unsigned*)(lds + MISC_OFF);
    const int t = tid_of(wv);
    F.tid = t; F.lane = t & 63; F.wave = wv;
    F.G = gridDim.x; { const int bx = blockIdx.x; F.vcu = (F.G % 8 == 0) ? (bx % 8) * (F.G / 8) + bx / 8 : bx; }
    F.gw = F.vcu * NWAVES + F.wave; F.NGW = F.G * NWAVES; return F;
}
__device__ __forceinline__ unsigned long long ldsb_u64(LAS unsigned char* lds, int i) {
    volatile LAS unsigned* p = (volatile LAS unsigned*)(lds + PTR_OFF) + 2 * i;
    const unsigned lo = __builtin_amdgcn_readfirstlane(p[0]), hi = __builtin_amdgcn_readfirstlane(p[1]);
    return ((unsigned long long)hi << 32) | lo;
}
__device__ __forceinline__ const float* e_in(LAS unsigned char* lds, int i) { return (const float*)(const GAS float*)ldsb_u64(lds, i); }
__device__ __forceinline__ float* e_out(LAS unsigned char* lds) { return (float*)(GAS float*)ldsb_u64(lds, 25); }
__device__ __forceinline__ unsigned char* e_ws(LAS unsigned char* lds) { return (unsigned char*)(GAS unsigned char*)ldsb_u64(lds, 26); }
__device__ __forceinline__ unsigned long long lds_u64(const Frame& F, int i) {
    volatile LAS unsigned* p = (volatile LAS unsigned*)(F.lds + PTR_OFF) + 2 * i;
    const unsigned lo = __builtin_amdgcn_readfirstlane(p[0]), hi = __builtin_amdgcn_readfirstlane(p[1]);
    return ((unsigned long long)hi << 32) | lo;
}
__device__ __forceinline__ const float* in_ptr(const Frame& F, int i) { return (const float*)(const GAS float*)lds_u64(F, i); }
__device__ __forceinline__ float* out_ptr(const Frame& F) { return (float*)(GAS float*)lds_u64(F, 25); }
__device__ __forceinline__ unsigned char* ws_ptr(const Frame& F) { return (unsigned char*)(GAS unsigned char*)lds_u64(F, 26); }
__device__ __forceinline__ unsigned* ctl_ptr(const Frame& F) { return (unsigned*)(ws_ptr(F) + WS_CTL); }

__device__ __forceinline__ void tr_item(const float* src, size_t spitch, int k0, int c0, bf16_t* dst, size_t dpitch, int r0, LAS unsigned* scr, int lane) {
    const int ln = lane & 7, g = lane >> 3;
    if (src == nullptr) {
#pragma unroll
        for (int j = 0; j < 8; ++j) { const int n = 4 * j + (lane >> 4), c = lane & 15; *(u32x4*)(dst + (size_t)(r0 + n) * dpitch + k0 + 8 * c) = (u32x4){0u, 0u, 0u, 0u}; }
        return;
    }
    f32x4 v[16];
#pragma unroll
    for (int i = 0; i < 16; ++i) { const int k = k0 + 16 * (i >> 1) + 2 * g + (i & 1); v[i] = __builtin_nontemporal_load((const f32x4*)(src + (size_t)k * spitch + c0 + 4 * ln)); }
#pragma unroll
    for (int ip = 0; ip < 8; ++ip)
#pragma unroll
        for (int c = 0; c < 4; ++c) scr[(4 * ln + c) * 65 + 8 * ip + g] = pk2(v[2 * ip][c], v[2 * ip + 1][c]);
    LDS_WAIT();
#pragma unroll
    for (int j = 0; j < 8; ++j) { const int n = 4 * j + (lane >> 4), c = lane & 15; const LAS unsigned* s = scr + n * 65 + 4 * c;
        u32x4 o; o.x = s[0]; o.y = s[1]; o.z = s[2]; o.w = s[3];
        *(u32x4*)(dst + (size_t)(r0 + n) * dpitch + k0 + 8 * c) = o; }
    LDS_WAIT();
}
__device__ __forceinline__ void tr_item8(const float* src, size_t spitch, int k0, int c0, unsigned char* dst, size_t dpitch, int r0, float scale, LAS unsigned* scr, int lane) {
    const int ln = lane & 7, g = lane >> 3;
    f32x4 v[16];
#pragma unroll
    for (int i = 0; i < 16; ++i) { const int k = k0 + 32 * (i >> 2) + 4 * g + (i & 3); v[i] = __builtin_nontemporal_load((const f32x4*)(src + (size_t)k * spitch + c0 + 4 * ln)); }
#pragma unroll
    for (int ib = 0; ib < 4; ++ib)
#pragma unroll
        for (int c = 0; c < 4; ++c) scr[(4 * ln + c) * 33 + 8 * ib + g] = pk4_fp8(v[4 * ib][c] * scale, v[4 * ib + 1][c] * scale, v[4 * ib + 2][c] * scale, v[4 * ib + 3][c] * scale);
    LDS_WAIT();
#pragma unroll
    for (int j = 0; j < 4; ++j) { const int n = 8 * j + (lane >> 3), c8 = lane & 7; const LAS unsigned* p = scr + n * 33 + 4 * c8;
        u32x4 o; o.x = p[0]; o.y = p[1]; o.z = p[2]; o.w = p[3];
        *(u32x4*)(dst + (size_t)(r0 + n) * dpitch + k0 + 16 * c8) = o; }
    LDS_WAIT();
}
__device__ __forceinline__ float wave_sum(float v) {
#pragma unroll
    for (int o = 1; o < 64; o <<= 1) v += __shfl_xor(v, o);
    return v;
}
struct TrDesc { const float* src; unsigned char* dst; int spitch, dpitch  ; int k0, c0, r0, f8; };
struct TrPtrs { const float *w_in, *w_branch, *w_out, *w_gate, *w_up, *w_down, *wa, *wx; unsigned char* ws; };
__device__ __forceinline__ TrDesc tr_decode(const TrPtrs& P, int it) {
    constexpr int I0 = 32 * 840, I1 = 64 * 128, I2 = 32 * 128, I3 = 32 * 688, I4 = 86 * 128;
    TrDesc d; int r = it;
    if (r < I0) { const int kb = r / 840, gidx = r % 840, pn = gidx >> 3, gi = gidx & 7; int c0; const float* src = P.w_in;
        if (gidx < 320) c0 = 32 * gidx; else if (gidx < 324) c0 = 10272 + 32 * (gidx - 320); else if (gidx == 324) c0 = 10240; else if (gidx < 328) { c0 = 0; src = nullptr; } else c0 = 32 * gidx - 96;
        const bool f8 = pn < 16 || pn >= 57; const int lt = pn < 16 ? pn : (pn < 24 ? pn - 16 : (pn < 40 ? pn - 16 : (pn < 41 ? 24 : (pn < 57 ? pn - 16 : pn - 41))));
        d = TrDesc{src, P.ws + (f8 ? WS_WI8 : WS_WI), N1_SRC, f8 ? DM : 2 * DM, 128 * kb, c0, 256 * lt + 32 * gi, f8 ? 1 : 0}; return d; } r -= I0;
    if (r < I1) { const int kb = r / 128, gidx = r % 128; d = TrDesc{P.w_branch, P.ws + WS_WB, DM, 2 * DM, 128 * kb, 32 * gidx, 32 * gidx, 1}; return d; } r -= I1;
    if (r < I2) { const int kb = r / 128, gidx = r % 128; d = TrDesc{P.w_out, P.ws + WS_WO, DM, P9_FP8 ? DM : 2 * DM, 128 * kb, 32 * gidx, 32 * gidx, P9_FP8 ? 1 : 0}; return d; } r -= I2;
    if (r < I3) { const int kb = r / 688, gidx = r % 688, pn = gidx >> 3, gi = gidx & 7; d = TrDesc{(gi < 4) ? P.w_gate : P.w_up, P.ws + WS_WGU, DFF, 2 * DM, 128 * kb, 128 * pn + 32 * (gi & 3), 32 * gidx, 0}; return d; } r -= I3;
    if (r < I4) { const int kb = r / 128, gidx = r % 128; d = TrDesc{P.w_down, P.ws + WS_WD, DM, 2 * DFF, 128 * kb, 32 * gidx, 32 * gidx, 0}; return d; } r -= I4;
    { const int kb = r / 256, gidx = r % 256, tn = gidx >> 3, gi = gidx & 7, blk = tn >> 1, hh = tn & 1;
      d = TrDesc{((gi < 4) ? P.wa : P.wx) + (size_t)blk * 65536, P.ws + WS_WG, 256, 512, 128 * kb, 128 * hh + 32 * (gi & 3), 32 * gidx, 0}; return d; }
}
__device__ __forceinline__ void tr_load(const TrDesc& d, f32x4 (&v)[16], int lane) {
    if (d.src == nullptr) return;
    const int ln = lane & 7, g = lane >> 3; const float* p = d.src + d.c0 + 4 * ln;
    if (d.f8) {
#pragma unroll
        for (int i = 0; i < 16; ++i) v[i] = __builtin_nontemporal_load((const f32x4*)(p + (size_t)(d.k0 + 32 * (i >> 2) + 4 * g + (i & 3)) * d.spitch)); }
    else {
#pragma unroll
        for (int i = 0; i < 16; ++i) v[i] = __builtin_nontemporal_load((const f32x4*)(p + (size_t)(d.k0 + 16 * (i >> 1) + 2 * g + (i & 1)) * d.spitch)); }
}
__device__ __forceinline__ void tr_store(const TrDesc& d, const f32x4 (&v)[16], LAS unsigned* scr, int lane) {
    const int ln = lane & 7, g = lane >> 3;
    if (d.f8) {
#pragma unroll
        for (int ib = 0; ib < 4; ++ib)
#pragma unroll
            for (int c = 0; c < 4; ++c) scr[(4 * ln + c) * 33 + 8 * ib + g] = pk4_fp8(v[4 * ib][c] * SW8, v[4 * ib + 1][c] * SW8, v[4 * ib + 2][c] * SW8, v[4 * ib + 3][c] * SW8);
        LDS_WAIT();
#pragma unroll
        for (int j = 0; j < 4; ++j) { const int n = 8 * j + (lane >> 3), c8 = lane & 7; const LAS unsigned* p = scr + n * 33 + 4 * c8;
            *(u32x4*)(d.dst + (size_t)(d.r0 + n) * d.dpitch + d.k0 + 16 * c8) = (u32x4){p[0], p[1], p[2], p[3]}; }
        LDS_WAIT();
    } else if (d.src == nullptr) {
#pragma unroll
        for (int j = 0; j < 8; ++j) { const int n = 4 * j + (lane >> 4), c = lane & 15; *(u32x4*)(d.dst + (size_t)(d.r0 + n) * d.dpitch + 2 * d.k0 + 16 * c) = (u32x4){0u, 0u, 0u, 0u}; }
    } else {
#pragma unroll
        for (int ip = 0; ip < 8; ++ip)
#pragma unroll
            for (int c = 0; c < 4; ++c) scr[(4 * ln + c) * 65 + 8 * ip + g] = pk2(v[2 * ip][c], v[2 * ip + 1][c]);
        LDS_WAIT();
#pragma unroll
        for (int j = 0; j < 8; ++j) { const int n = 4 * j + (lane >> 4), c = lane & 15; const LAS unsigned* p = scr + n * 65 + 4 * c;
            *(u32x4*)(d.dst + (size_t)(d.r0 + n) * d.dpitch + 2 * d.k0 + 16 * c) = (u32x4){p[0], p[1], p[2], p[3]}; }
        LDS_WAIT();
    }
}
constexpr int CONV_BASE = 32 * 840, CONV_N = 64 * 128 + 32 * 128 + 32 * 688 + 86 * 128;
constexpr int CW_QCONV = 4096 + 512;
__device__ __forceinline__ void conv_drain(Frame& F) {
    unsigned char* const ws = ws_ptr(F); unsigned* head = ctl_ptr(F) + CW_QCONV;
    LAS unsigned* scr = (LAS unsigned*)(F.lds + RING_OFF + F.wave * 16384);
    TrPtrs P{in_ptr(F, 8), in_ptr(F, 19), in_ptr(F, 20), in_ptr(F, 22), in_ptr(F, 23), in_ptr(F, 24), in_ptr(F, 14), in_ptr(F, 16), ws};
    constexpr int NQ8 = (CONV_N * 7 / 8) / 8, REST0 = NQ8 * 8, NQ = NQ8 + (CONV_N - REST0) / 2;
    static_assert((CONV_N - REST0) % 2 == 0, "pairs");
    int q = 0; if (F.lane == 0) q = (int)__hip_atomic_fetch_add(head, 1u, __ATOMIC_RELAXED, __HIP_MEMORY_SCOPE_AGENT);
    q = __builtin_amdgcn_readfirstlane(q);
    while (q < NQ) {
        int qn = 0; if (F.lane == 0) qn = (int)__hip_atomic_fetch_add(head, 1u, __ATOMIC_RELAXED, __HIP_MEMORY_SCOPE_AGENT);
        const int i0 = CONV_BASE + (q < NQ8 ? 8 * q : REST0 + 2 * (q - NQ8)), n = q < NQ8 ? 8 : 2;
#pragma unroll 1
        for (int j = 0; j < n; j += 2) {
            const TrDesc da = tr_decode(P, i0 + j), db = tr_decode(P, i0 + j + 1);
            f32x4 va[16], vb[16]; tr_load(da, va, F.lane); tr_load(db, vb, F.lane);
            tr_store(da, va, scr, F.lane); tr_store(db, vb, scr, F.lane);
        }
        q = __builtin_amdgcn_readfirstlane(qn);
    }
}
__device__ __forceinline__ void p0_prologue(Frame& F) {
    unsigned char* const ws = ws_ptr(F); const float* const in0 = in_ptr(F, 0); const float* const in1 = in_ptr(F, 1); const float* const in2 = in_ptr(F, 2); const float* const in3 = in_ptr(F, 3); const float* const in4 = in_ptr(F, 4); const float* const in7 = in_ptr(F, 7); const float* const in8 = in_ptr(F, 8); const float* const in14 = in_ptr(F, 14); const float* const in16 = in_ptr(F, 16); const float* const in19 = in_ptr(F, 19); const float* const in20 = in_ptr(F, 20); const float* const in22 = in_ptr(F, 22); const float* const in23 = in_ptr(F, 23); const float* const in24 = in_ptr(F, 24);
    LAS unsigned* scr = (LAS unsigned*)(F.lds + RING_OFF + F.wave * 16384);
    const int lane = F.lane;
    constexpr int I0 = 32 * 840, I1 = 64 * 128, I2 = 32 * 128, I3 = 32 * 688, I4 = 86 * 128, I5 = 2 * 256;
    constexpr int NITEMS = I0 + I1 + I2 + I3 + I4 + I5;
    bf16_t* WI = (bf16_t*)(ws + WS_WI); bf16_t* WB = (bf16_t*)(ws + WS_WB); bf16_t* WO = (bf16_t*)(ws + WS_WO); bf16_t* WGU = (bf16_t*)(ws + WS_WGU); bf16_t* WD = (bf16_t*)(ws + WS_WD); bf16_t* WG = (bf16_t*)(ws + WS_WG);
    for (int jt = F.gw; jt < NITEMS - CONV_N; jt += F.NGW) { const int it = jt < I0 ? jt : jt + CONV_N;
        int r = it;
        if (r < I0) { const int kb = r / 840, gidx = r % 840, pn = gidx >> 3, gi = gidx & 7; int c0; const float* src = in8;
            if (gidx < 320) c0 = 32 * gidx; else if (gidx < 324) c0 = 10272 + 32 * (gidx - 320); else if (gidx == 324) c0 = 10240; else if (gidx < 328) { c0 = 0; src = nullptr; } else c0 = 32 * gidx - 96;
            const bool f8 = pn < 16 || pn >= 57; const int lt = pn < 16 ? pn : (pn < 24 ? pn - 16 : (pn < 40 ? pn - 16 : (pn < 41 ? 24 : (pn < 57 ? pn - 16 : pn - 41))));
            if (f8) tr_item8(src, N1_SRC, 128 * kb, c0, ws + WS_WI8, DM, 256 * lt + 32 * gi, SW8, scr, lane);
            else tr_item(src, N1_SRC, 128 * kb, c0, WI, DM, 256 * lt + 32 * gi, scr, lane);
            continue; } r -= I0;
        if (r < I1) { const int kb = r / 128, gidx = r % 128; tr_item8(in19, DM, 128 * kb, 32 * gidx, (unsigned char*)WB, 2 * DM, 32 * gidx, SW8, scr, lane); continue; } r -= I1;
        if (r < I2) { const int kb = r / 128, gidx = r % 128;
            if (P9_FP8) tr_item8(in20, DM, 128 * kb, 32 * gidx, (unsigned char*)WO, DM, 32 * gidx, SW8, scr, lane); else tr_item(in20, DM, 128 * kb, 32 * gidx, WO, DM, 32 * gidx, scr, lane);
            continue; } r -= I2;
        if (r < I3) { const int kb = r / 688, gidx = r % 688, pn = gidx >> 3, gi = gidx & 7; const float* src = (gi < 4) ? in22 : in23;
            tr_item(src, DFF, 128 * kb, 128 * pn + 32 * (gi & 3), WGU, DM, 32 * gidx, scr, lane); continue; } r -= I3;
        if (r < I4) { const int kb = r / 128, gidx = r % 128; tr_item(in24, DM, 128 * kb, 32 * gidx, WD, DFF, 32 * gidx, scr, lane); continue; } r -= I4;
        { const int kb = r / 256, gidx = r % 256, tn = gidx >> 3, gi = gidx & 7, blk = tn >> 1, hh = tn & 1; const float* src = ((gi < 4) ? in14 : in16) + (size_t)blk * 65536;
            tr_item(src, 256, 128 * kb, 128 * hh + 32 * (gi & 3), WG, 256, 32 * gidx, scr, lane); }
    }
    {
        bf16_t* XN = (bf16_t*)(ws + WS_XN); const float* gm = in7;
        f32x4 ggv[16];
#pragma unroll
        for (int j = 0; j < 16; ++j) ggv[j] = *(const f32x4*)(gm + 4 * lane + 256 * j);
        for (int m = F.gw; m < MTOK; m += F.NGW) {
            const float* xr = (m < NTOK_P) ? in0 + (size_t)m * DM : in1 + (size_t)(m - NTOK_P) * DM;
            f32x4 v[16]; float s = 0.f;
#pragma unroll
            for (int j = 0; j < 16; ++j) { v[j] = __builtin_nontemporal_load((const f32x4*)(xr + 4 * lane + 256 * j)); s += (v[j].x * v[j].x + v[j].y * v[j].y) + (v[j].z * v[j].z + v[j].w * v[j].w); }
            const float rstd = 1.0f / sqrtf(wave_sum(s) * (1.0f / DM) + EPS);
#pragma unroll
            for (int j = 0; j < 16; ++j) { const f32x4 gg = ggv[j];
                u32x2 o; o.x = pk2(v[j].x * rstd * gg.x, v[j].y * rstd * gg.y); o.y = pk2(v[j].z * rstd * gg.z, v[j].w * rstd * gg.w);
                *(u32x2*)(XN + (size_t)m * DM + 4 * lane + 256 * j) = o;
                *(unsigned*)(ws + WS_XN8 + (size_t)m * DM + 4 * lane + 256 * j) = pk4_fp8(v[j].x * rstd * gg.x * SXN, v[j].y * rstd * gg.y * SXN, v[j].z * rstd * gg.z * SXN, v[j].w * rstd * gg.w * SXN); }
        }
    }
    {
        f32x2* RT = (f32x2*)(ws + WS_ROPE);
        for (int i = F.gw * 64 + lane; i < 4096 * 16; i += F.NGW * 64) { const int pos = i >> 4, j = i & 15;
            const double inv = pow(500000.0, -(double)j / 16.0); const double ang = (double)pos * inv; RT[i] = (f32x2){(float)cos(ang), (float)sin(ang)}; }
    }
    {
        bf16_t* KVS = (bf16_t*)(ws + WS_KVS); bf16_t* IKS = (bf16_t*)(ws + WS_IKS);
        const size_t gt = (size_t)F.gw * 64 + lane, GT = (size_t)F.NGW * 64;
        for (size_t i = gt; i < (size_t)DEC_B * PAST * 128; i += 2 * GT) {
            size_t ia[2]; ia[0] = i; ia[1] = (i + GT < (size_t)DEC_B * PAST * 128) ? i + GT : i;
            f32x4 kk[2][2], vv[2][2];
#pragma unroll
            for (int h = 0; h < 2; ++h) { const size_t row = ia[h] >> 7; const int ch = (int)(ia[h] & 127);
                kk[h][0] = __builtin_nontemporal_load((const f32x4*)(in2 + row * 1024 + 8 * ch)); kk[h][1] = __builtin_nontemporal_load((const f32x4*)(in2 + row * 1024 + 8 * ch + 4));
                vv[h][0] = __builtin_nontemporal_load((const f32x4*)(in3 + row * 1024 + 8 * ch)); vv[h][1] = __builtin_nontemporal_load((const f32x4*)(in3 + row * 1024 + 8 * ch + 4)); }
            asm volatile("" ::: "memory");
#pragma unroll
            for (int h = 0; h < 2; ++h) { const size_t row = ia[h] >> 7; const int ch = (int)(ia[h] & 127); const size_t b = row >> 11, sidx = row & 2047;
                bf16_t* d = KVS + (b * SKV_SP + sidx) * 2048 + 8 * ch;
                *(u32x4*)d = (u32x4){pk2(kk[h][0].x, kk[h][0].y), pk2(kk[h][0].z, kk[h][0].w), pk2(kk[h][1].x, kk[h][1].y), pk2(kk[h][1].z, kk[h][1].w)};
                *(u32x4*)(d + 1024) = (u32x4){pk2(vv[h][0].x, vv[h][0].y), pk2(vv[h][0].z, vv[h][0].w), pk2(vv[h][1].x, vv[h][1].y), pk2(vv[h][1].z, vv[h][1].w)}; }
        }
        for (size_t i = gt; i < (size_t)DEC_B * PAST * 16; i += GT) {
            const size_t row = i >> 4; const int ch = (int)(i & 15); const size_t b = row >> 11, s = row & 2047;
            const f32x4 k0 = *(const f32x4*)(in4 + row * 128 + 8 * ch), k1 = *(const f32x4*)(in4 + row * 128 + 8 * ch + 4);
            *(u32x4*)(IKS + (b * SKV_SP + s) * 128 + 8 * ch) = (u32x4){pk2(k0.x, k0.y), pk2(k0.z, k0.w), pk2(k1.x, k1.y), pk2(k1.z, k1.w)};
        }
        for (size_t i = gt; i < (size_t)DEC_B * 32 * 256; i += GT) {
            const size_t r = i >> 8; const int ch = (int)(i & 255); const size_t b = r >> 5, s = SKV_S + (r & 31);
            *(u32x4*)(KVS + (b * SKV_SP + s) * 2048 + 8 * ch) = (u32x4){0u, 0u, 0u, 0u};
        }
        for (size_t i = gt; i < (size_t)DEC_B * 32 * 16; i += GT) {
            const size_t r = i >> 4; const int ch = (int)(i & 15); const size_t b = r >> 5, s = SKV_S + (r & 31);
            *(u32x4*)(IKS + (b * SKV_SP + s) * 128 + 8 * ch) = (u32x4){0u, 0u, 0u, 0u};
        }
    }
}

constexpr int XCH_OFF = LDSCTL_OFF + 1024;
static_assert(XCH_OFF + 8192 <= LDS_BYTES, "LDS map");
__device__ __forceinline__ void head_sumsq_exchange(const f32x4 (&acc)[2][2][4][2], float ds2, LAS unsigned char* lds, int wr, int wc, int fr, int fq) {
    LAS float* X = (LAS float*)(lds + XCH_OFF);
#pragma unroll
    for (int ai = 0; ai < 2; ++ai)
#pragma unroll
        for (int m = 0; m < 4; ++m)
#pragma unroll
            for (int bj = 0; bj < 2; ++bj) { const f32x4 a = acc[ai][bj][m][0], b = acc[ai][bj][m][1];
                float s = ((a[0] * a[0] + a[1] * a[1]) + (a[2] * a[2] + a[3] * a[3])) + ((b[0] * b[0] + b[1] * b[1]) + (b[2] * b[2] + b[3] * b[3]));
                s += __shfl_xor(s, 16); s += __shfl_xor(s, 32);
                if (fq == 0) X[((ai * 128 + wr * 64 + m * 16 + fr) * 2 + bj) * 4 + wc] = s * ds2; }
    asm volatile("s_waitcnt lgkmcnt(0)" ::: "memory"); __builtin_amdgcn_s_barrier(); asm volatile("" ::: "memory");
}
__device__ __forceinline__ float head_rstd(LAS unsigned char* lds, int rl, int bj) {
    const f32x4 p = *(const LAS f32x4*)(lds + XCH_OFF + ((rl * 2 + bj) * 4) * 4); return 1.0f / sqrtf(((p[0] + p[1]) + (p[2] + p[3])) * (1.0f / 128.0f) + EPS); }
__device__ __forceinline__ void rope_epi(float (&y)[8], const f32x2* RT, int pos, int fq) {
    const f32x4* cp = (const f32x4*)(RT + (size_t)pos * 16 + 8 * (fq & 1)); const f32x4 c0 = cp[0], c1 = cp[1], c2 = cp[2], c3 = cp[3];
    const float cs[8] = {c0[0], c0[2], c1[0], c1[2], c2[0], c2[2], c3[0], c3[2]}, sn[8] = {c0[1], c0[3], c1[1], c1[3], c2[1], c2[3], c3[1], c3[3]};
#pragma unroll
    for (int e = 0; e < 8; ++e) { const float p = __shfl_xor(y[e], 32); y[e] = (fq < 2) ? (y[e] * cs[e] - p * sn[e]) : (y[e] * cs[e] + p * sn[e]); }
}
struct RopeCS { f32x4 c0, c1, c2, c3; };
__device__ __forceinline__ RopeCS rope_load(const f32x2* RT, int pos, int fq) { const f32x4* cp = (const f32x4*)(RT + (size_t)pos * 16 + 8 * (fq & 1)); RopeCS r; r.c0 = cp[0]; r.c1 = cp[1]; r.c2 = cp[2]; r.c3 = cp[3]; return r; }
__device__ __forceinline__ void rope_apply(float (&y)[8], const RopeCS& r, int fq) {
    const float cs[8] = {r.c0[0], r.c0[2], r.c1[0], r.c1[2], r.c2[0], r.c2[2], r.c3[0], r.c3[2]}, sn[8] = {r.c0[1], r.c0[3], r.c1[1], r.c1[3], r.c2[1], r.c2[3], r.c3[1], r.c3[3]};
#pragma unroll
    for (int e = 0; e < 8; ++e) { const float p = __shfl_xor(y[e], 32); y[e] = (fq < 2) ? (y[e] * cs[e] - p * sn[e]) : (y[e] * cs[e] + p * sn[e]); }
}
__device__ __forceinline__ int row_pos(int row) { return row < NTOK_P ? (row & (SEQ - 1)) : PAST + ((row - NTOK_P) & (DEC_T - 1)); }
constexpr int RB = 4;
struct EpiProjA {
    static constexpr bool PERM = true, MID = false, FP8 = false;
    LAS unsigned char* lds;
    __device__ __forceinline__ void operator()(const f32x4 (&acc)[2][2][4][2], const pg8::Unit& u, int wr, int wc, int fr, int fq) const {
        unsigned char* const ws = e_ws(lds); const int pn = u.pn; const bool samp = u.pm >= NTOK_P / 256;
        const int rowl0 = wr * 64 + fr, row0 = u.pm * 256 + rowl0, cw = wc * 32 + 8 * fq;
        const f32x2* RT = (const f32x2*)(ws + WS_ROPE);
        if (pn >= 25) {
            bf16_t* O = (bf16_t*)(ws + WS_XL) + (pn - 25) * 256 + cw;
#pragma unroll
            for (int ai = 0; ai < 2; ++ai)
#pragma unroll
                for (int m = 0; m < 4; ++m)
#pragma unroll
                    for (int bj = 0; bj < 2; ++bj) { const f32x4 v0 = acc[ai][bj][m][0], v1 = acc[ai][bj][m][1];
                        *(u32x4*)(O + (size_t)(row0 + ai * 128 + m * 16) * DM + bj * 128) = (u32x4){pk2(v0[0], v0[1]), pk2(v0[2], v0[3]), pk2(v1[0], v1[1]), pk2(v1[2], v1[3])}; }
        } else if (pn >= 8 && pn < 24) {
            bf16_t* O = (bf16_t*)(ws + WS_IQ) + (pn - 8) * 256 + cw;
#pragma unroll
            for (int ai = 0; ai < 2; ++ai) {
                RopeCS rc[RB];
#pragma unroll
                for (int mb = 0; mb < 4; mb += RB) {
                    if (wc == 0) {
#pragma unroll
                        for (int m = 0; m < RB; ++m) rc[m] = rope_load(RT, row_pos(row0 + ai * 128 + (mb + m) * 16), fq); }
                    asm volatile("" ::: "memory");
#pragma unroll
                    for (int m = mb; m < mb + RB; ++m) { const int row = row0 + ai * 128 + m * 16;
#pragma unroll
                        for (int bj = 0; bj < 2; ++bj) { const f32x4 v0 = acc[ai][bj][m][0], v1 = acc[ai][bj][m][1]; float y[8] = {v0[0], v0[1], v0[2], v0[3], v1[0], v1[1], v1[2], v1[3]};
                            if (wc == 0) rope_apply(y, rc[m - mb], fq);
                            *(u32x4*)(O + (size_t)row * DM + bj * 128) = pack8f(y); } } } }
        } else if (pn >= 4 && pn < 8) {
            float* outv = e_out(lds) + (samp ? O_VS - (size_t)NTOK_P * KVW : O_VP) + (pn - 4) * 256 + cw;
#pragma unroll
            for (int ai = 0; ai < 2; ++ai)
#pragma unroll
                for (int m = 0; m < 4; ++m) { const int row = row0 + ai * 128 + m * 16;
                    bf16_t* d = samp ? (bf16_t*)(ws + WS_KVS) + ((size_t)((row - NTOK_P) >> 5) * SKV_SP + PAST + ((row - NTOK_P) & 31)) * 2048 : (bf16_t*)(ws + WS_KV) + (size_t)row * 2048;
#pragma unroll
                    for (int bj = 0; bj < 2; ++bj) { const f32x4 v0 = acc[ai][bj][m][0], v1 = acc[ai][bj][m][1]; const int col = (pn - 4) * 256 + bj * 128 + cw;
                        *(f32x4*)(outv + (size_t)row * KVW + bj * 128) = v0; *(f32x4*)(outv + (size_t)row * KVW + bj * 128 + 4) = v1;
                        *(u32x4*)(d + 1024 + col) = (u32x4){pk2(v0[0], v0[1]), pk2(v0[2], v0[3]), pk2(v1[0], v1[1]), pk2(v1[2], v1[3])}; } }
        } else {
            const bool isk = pn < 4;
            head_sumsq_exchange(acc, 1.0f, lds, wr, wc, fr, fq);
            const float* gp = e_in(lds, isk ? 10 : 11) + cw; const f32x4 g0 = *(const f32x4*)gp, g1 = *(const f32x4*)(gp + 4); const float g[8] = {g0[0], g0[1], g0[2], g0[3], g1[0], g1[1], g1[2], g1[3]};
            float* outp = e_out(lds);
#pragma unroll
            for (int am = 0; am < 4; ++am) { const int ai = am >> 1;
                RopeCS rc[2];
                if (wc == 0) {
#pragma unroll
                    for (int m = 0; m < 2; ++m) rc[m] = rope_load(RT, row_pos(u.pm * 256 + rowl0 + ai * 128 + (2 * (am & 1) + m) * 16), fq); }
                asm volatile("" ::: "memory");
#pragma unroll
                for (int m = 2 * (am & 1); m < 2 * (am & 1) + 2; ++m) { const int rl = rowl0 + ai * 128 + m * 16, row = u.pm * 256 + rl, rs = row - NTOK_P;
#pragma unroll
                    for (int bj = 0; bj < 2; ++bj) { const f32x4 v0 = acc[ai][bj][m][0], v1 = acc[ai][bj][m][1];
                        if (isk || bj == 0) { const float rstd = head_rstd(lds, rl, bj); float y[8];
#pragma unroll
                            for (int e = 0; e < 4; ++e) { y[e] = v0[e] * rstd * g[e]; y[4 + e] = v1[e] * rstd * g[4 + e]; }
                            if (wc == 0) rope_apply(y, rc[m & 1], fq);
                            if (isk) { const int col = pn * 256 + bj * 128 + cw; float* o = outp + (samp ? O_KS + (size_t)rs * KVW : O_KP + (size_t)row * KVW) + col;
                                *(f32x4*)o = (f32x4){y[0], y[1], y[2], y[3]}; *(f32x4*)(o + 4) = (f32x4){y[4], y[5], y[6], y[7]};
                                bf16_t* d = samp ? (bf16_t*)(ws + WS_KVS) + ((size_t)(rs >> 5) * SKV_SP + PAST + (rs & 31)) * 2048 : (bf16_t*)(ws + WS_KV) + (size_t)row * 2048;
                                *(u32x4*)(d + col) = pack8f(y); }
                            else { float* o = outp + (samp ? O_IKS + (size_t)rs * IDXD : O_IKP + (size_t)row * IDXD) + cw;
                                *(f32x4*)o = (f32x4){y[0], y[1], y[2], y[3]}; *(f32x4*)(o + 4) = (f32x4){y[4], y[5], y[6], y[7]};
                                bf16_t* d = samp ? (bf16_t*)(ws + WS_IKS) + ((size_t)(rs >> 5) * SKV_SP + PAST + (rs & 31)) * IDXD : (bf16_t*)(ws + WS_IKB) + (size_t)row * IDXD;
                                *(u32x4*)(d + cw) = pack8f(y); } }
                        else if (wc == 0) { float* o = (float*)(ws + WS_IWF) + (size_t)row * 32 + 8 * fq;
                            *(f32x4*)o = v0 * 0.015625f; *(f32x4*)(o + 4) = v1 * 0.015625f; } } } }
        }
    }
};
struct EpiProjB {
    static constexpr bool PERM = true, MID = false, FP8 = true;
    LAS unsigned char* lds;
    __device__ __forceinline__ void operator()(const f32x4 (&acc)[2][2][4][2], const pg8::Unit& u, int wr, int wc, int fr, int fq) const {
        unsigned char* const ws = e_ws(lds);
        const int seg = u.pn >> 4, pn = u.pn & 15; constexpr float DS = 1.0f / (SXN * SW8);
        const int rowl0 = wr * 64 + fr, row0 = u.pm * 256 + rowl0, cw = wc * 32 + 8 * fq, col0 = pn * 256 + cw;
        if (seg == 0) {
            head_sumsq_exchange(acc, DS * DS, lds, wr, wc, fr, fq);
            const float* gp = e_in(lds, 9) + cw; const f32x4 g0 = *(const f32x4*)gp, g1 = *(const f32x4*)(gp + 4); const float g[8] = {g0[0], g0[1], g0[2], g0[3], g1[0], g1[1], g1[2], g1[3]};
            const f32x2* RT = (const f32x2*)(ws + WS_ROPE); bf16_t* O = (bf16_t*)(ws + WS_Q) + col0;
#pragma unroll
            for (int ai = 0; ai < 2; ++ai) {
                RopeCS rc[4];
                if (wc == 0) {
#pragma unroll
                    for (int m = 0; m < 4; ++m) rc[m] = rope_load(RT, row_pos(u.pm * 256 + rowl0 + ai * 128 + m * 16), fq); }
                asm volatile("" ::: "memory");
#pragma unroll
                for (int m = 0; m < 4; ++m) { const int rl = rowl0 + ai * 128 + m * 16, row = u.pm * 256 + rl;
#pragma unroll
                    for (int bj = 0; bj < 2; ++bj) { const f32x4 v0 = acc[ai][bj][m][0], v1 = acc[ai][bj][m][1]; const float rstd = head_rstd(lds, rl, bj) * DS; float y[8];
#pragma unroll
                        for (int e = 0; e < 4; ++e) { y[e] = v0[e] * rstd * g[e]; y[4 + e] = v1[e] * rstd * g[4 + e]; }
                        if (wc == 0) rope_apply(y, rc[m], fq);
                        *(u32x4*)(O + (size_t)row * DM + bj * 128) = pack8f(y); } } }
        } else {
            bf16_t* O = (bf16_t*)(ws + (seg == 1 ? WS_GY : (seg == 2 ? WS_SGA : WS_SGL))) + col0;
#pragma unroll
            for (int ai = 0; ai < 2; ++ai)
#pragma unroll
                for (int m = 0; m < 4; ++m) { bf16_t* rowp = O + (size_t)(row0 + ai * 128 + m * 16) * DM;
#pragma unroll
                    for (int bj = 0; bj < 2; ++bj) { f32x4 v0 = acc[ai][bj][m][0] * DS, v1 = acc[ai][bj][m][1] * DS;
                        if (seg == 1) {
#pragma unroll
                            for (int e = 0; e < 4; ++e) { v0[e] = gelu_tanh_(v0[e]); v1[e] = gelu_tanh_(v1[e]); } }
                        else {
#pragma unroll
                            for (int e = 0; e < 4; ++e) { v0[e] = sigmoidf_(v0[e]); v1[e] = sigmoidf_(v1[e]); } }
                        *(u32x4*)(rowp + bj * 128) = (u32x4){pk2(v0[0], v0[1]), pk2(v0[2], v0[3]), pk2(v1[0], v1[1]), pk2(v1[2], v1[3])}; } }
        }
    }
};

__device__ __forceinline__ void rope8(float (&y)[8], const f32x2 (&cs)[8], int hl) {
    float p[8];
#pragma unroll
    for (int e = 0; e < 8; ++e) p[e] = __shfl_xor(y[e], 2);
    if (hl < 4) {
#pragma unroll
        for (int e = 0; e < 8; ++e) y[e] = (hl < 2) ? (y[e] * cs[e].x - p[e] * cs[e].y) : (y[e] * cs[e].x + p[e] * cs[e].y);
    }
}
__device__ __forceinline__ float sum16(float s) { s += __shfl_xor(s, 1); s += __shfl_xor(s, 2); s += __shfl_xor(s, 4); s += __shfl_xor(s, 8); return s; }
struct P2Ptrs { unsigned char* ws; float* out; const float* sconv; const float* gq; const float* gk; const float* gi; const float* cw; const float* cb; };
__device__ __forceinline__ void p2_rowinfo(int m, bool& samp, int& ml, int& b, int& t, int& pos) { samp = m >= NTOK_P; ml = samp ? m - NTOK_P : m; b = samp ? (ml >> 5) : (ml >> 12); t = samp ? (ml & 31) : (ml & 4095); pos = samp ? PAST + t : t; }
__device__ __forceinline__ void p2_taskC(const P2Ptrs& P, int item, int lane) {
    const int strip = item >> 3, col = 512 * (item & 7) + 8 * lane, m0 = 16 * strip; bool samp; int ml, b, t0, pos; p2_rowinfo(m0, samp, ml, b, t0, pos);
    const bf16_t* XLb = (const bf16_t*)(P.ws + WS_XL); bf16_t* Ub = (bf16_t*)(P.ws + WS_U);
    float x[19][8];
#pragma unroll
    for (int i = 0; i < 19; ++i) { const int tt = t0 + i - 3;
        if (tt >= 0) unpack8(*(const u32x4*)(XLb + (size_t)(m0 + i - 3) * DM + col), x[i]);
        else if (samp) { const float* sp = P.sconv + ((size_t)b * 3 + i) * DM + col; const f32x4 s0 = *(const f32x4*)sp, s1 = *(const f32x4*)(sp + 4); x[i][0] = s0.x; x[i][1] = s0.y; x[i][2] = s0.z; x[i][3] = s0.w; x[i][4] = s1.x; x[i][5] = s1.y; x[i][6] = s1.z; x[i][7] = s1.w; }
        else {
#pragma unroll
            for (int e = 0; e < 8; ++e) x[i][e] = 0.f; } }
    float w[4][8], cb[8];
#pragma unroll
    for (int e = 0; e < 8; ++e) { cb[e] = P.cb[col + e];
#pragma unroll
        for (int j = 0; j < 4; ++j) w[j][e] = P.cw[(size_t)j * DM + col + e]; }
    const int T = samp ? DEC_T : SEQ;
#pragma unroll
    for (int r = 0; r < 16; ++r) { float u[8];
#pragma unroll
        for (int e = 0; e < 8; ++e) u[e] = cb[e] + x[r][e] * w[0][e] + x[r + 1][e] * w[1][e] + x[r + 2][e] * w[2][e] + x[r + 3][e] * w[3][e];
        *(u32x4*)(Ub + (size_t)(m0 + r) * DM + col) = pack8f(u);
        const int t = t0 + r;
        if (t >= T - 3) { float* oc = P.out + (samp ? O_CONVS : O_CONVP) + ((size_t)b * 3 + (t - (T - 3))) * DM + col;
            *(f32x4*)oc = (f32x4){x[r + 3][0], x[r + 3][1], x[r + 3][2], x[r + 3][3]}; *(f32x4*)(oc + 4) = (f32x4){x[r + 3][4], x[r + 3][5], x[r + 3][6], x[r + 3][7]}; } }
}
__device__ __forceinline__ void p2_phase(Frame& F) {
    P2Ptrs P{ws_ptr(F), out_ptr(F), in_ptr(F, 6), in_ptr(F, 9), in_ptr(F, 10), in_ptr(F, 11), in_ptr(F, 12), in_ptr(F, 13)};
    for (int it = F.gw; it < (MTOK / 16) * 8; it += F.NGW) p2_taskC(P, it, F.lane);
}

__device__ __forceinline__ float expf_(float x) { return __builtin_amdgcn_exp2f(1.4426950408889634f * x); }
__device__ __forceinline__ float softplusf_(float x) { return fmaxf(x, 0.f) + log1pf(expf(-fabsf(x))); }
struct EpiGates {
    static constexpr bool PERM = false, MID = false, FP8 = false;
    LAS unsigned char* lds;
    __device__ __forceinline__ void operator()(const f32x4 (&acc)[2][2][4][2], const pg8::Unit& u, int wr, int wc, int fr, int fq) const {
        unsigned char* const ws = e_ws(lds); const bf16_t* U = (const bf16_t*)(ws + WS_U); const float* ba = e_in(lds, 15); const float* bx = e_in(lds, 17); const float* lam = e_in(lds, 18); unsigned* AB = (unsigned*)(ws + WS_AB);
        const int row0 = u.pm * 256 + wr * 64 + fr, chb = 256 * (u.pn >> 1) + 128 * (u.pn & 1) + 32 * wc + 4 * fq;
        u32x2 uw[2][2][4];
#pragma unroll
        for (int n = 0; n < 2; ++n)
#pragma unroll
            for (int ai = 0; ai < 2; ++ai)
#pragma unroll
                for (int m = 0; m < 4; ++m) uw[n][ai][m] = *(const u32x2*)(U + (size_t)(row0 + ai * 128 + m * 16) * DM + chb + 16 * n);
        asm volatile("" ::: "memory");
#pragma unroll
        for (int n = 0; n < 2; ++n) { const int ch0 = chb + 16 * n;
            const f32x4 ba4 = *(const f32x4*)(ba + ch0), bx4 = *(const f32x4*)(bx + ch0), lm4 = *(const f32x4*)(lam + ch0); float sp[4];
#pragma unroll
            for (int e = 0; e < 4; ++e) sp[e] = 8.0f * softplusf_(-lm4[e]);
#pragma unroll
            for (int ai = 0; ai < 2; ++ai)
#pragma unroll
                for (int m = 0; m < 4; ++m) { const size_t row = (size_t)(row0 + ai * 128 + m * 16); const u32x2 w2 = uw[n][ai][m];
                    const float uu[4] = {bflo(w2.x), bfhi(w2.x), bflo(w2.y), bfhi(w2.y)}; u32x4 o;
#pragma unroll
                    for (int e = 0; e < 4; ++e) { const float r = sigmoidf_(acc[ai][0][m][n][e] + ba4[e]), ig = sigmoidf_(acc[ai][1][m][n][e] + bx4[e]);
                        const float la = -sp[e] * r, em = 1.0f - expf_(2.0f * la);
                        const float bb = __builtin_amdgcn_sqrtf(fmaxf(em, 0.f)) * (ig * uu[e]);
                        const _Float16 hl_ = (_Float16)la, hb_ = (_Float16)bb;
                        o[e] = (unsigned)__builtin_bit_cast(unsigned short, hl_) | ((unsigned)__builtin_bit_cast(unsigned short, hb_) << 16); }
                    *(u32x4*)(AB + row * DM + ch0) = o; } }
    }
};
__device__ __forceinline__ float h_lo(unsigned w) { return (float)__builtin_bit_cast(_Float16, (unsigned short)(w & 0xffffu)); }
__device__ __forceinline__ float h_hi(unsigned w) { return (float)__builtin_bit_cast(_Float16, (unsigned short)(w >> 16)); }
__device__ __forceinline__ void scan_summaries(Frame& F) {
    unsigned char* const ws = ws_ptr(F);
    const unsigned* AB = (const unsigned*)(ws + WS_AB); f32x4* SUM = (f32x4*)(ws + WS_SUM);
    for (int it = F.gw * 64 + F.lane; it < 128 * 2048; it += F.NGW * 64) { const int q = it >> 11, cp = it & 2047;
        const size_t m0 = (size_t)(q >> 6) * SEQ + (size_t)(q & 63) * 64; const unsigned* p = AB + m0 * DM + 2 * cp;
        float al0 = 0.f, al1 = 0.f, h0 = 0.f, h1 = 0.f;
        for (int r0 = 0; r0 < 64; r0 += 16) { u32x2 w[16];
#pragma unroll
            for (int r = 0; r < 16; ++r) w[r] = *(const u32x2*)(p + (size_t)(r0 + r) * DM);
#pragma unroll
            for (int r = 0; r < 16; ++r) { const float la0 = h_lo(w[r].x), la1 = h_lo(w[r].y); al0 += la0; al1 += la1; h0 = expf_(la0) * h0 + h_hi(w[r].x); h1 = expf_(la1) * h1 + h_hi(w[r].y); } }
        SUM[(size_t)q * 2048 + cp] = (f32x4){al0, h0, al1, h1}; }
}
__device__ __forceinline__ void scan_apply(Frame& F) {
    unsigned char* const ws = ws_ptr(F); float* const out = out_ptr(F); const float* const in5 = in_ptr(F, 5);
    const unsigned* AB = (const unsigned*)(ws + WS_AB); const f32x4* SUM = (const f32x4*)(ws + WS_SUM); const bf16_t* GY = (const bf16_t*)(ws + WS_GY); bf16_t* OAL = (bf16_t*)(ws + WS_OAL);
    for (int it = F.gw * 64 + F.lane; it < 144 * 2048; it += F.NGW * 64) { const int q = it >> 11, cp = it & 2047;
        float h0, h1; size_t m0; int nr; float* lout = nullptr;
        if (q < 128) { const int ch = q & 63; m0 = (size_t)(q >> 6) * SEQ + (size_t)ch * 64; nr = 64; h0 = 0.f; h1 = 0.f;
            const f32x4* sq = SUM + (size_t)(q & ~63) * 2048 + cp;
            for (int j0 = 0; j0 < ch; j0 += 16) { f32x4 sv[16];
#pragma unroll
                for (int r = 0; r < 16; ++r) { const int j = (j0 + r < ch) ? j0 + r : ch - 1; sv[r] = sq[(size_t)j * 2048]; }
                asm volatile("" ::: "memory");
#pragma unroll
                for (int r = 0; r < 16; ++r) if (j0 + r < ch) { h0 = expf_(sv[r].x) * h0 + sv[r].y; h1 = expf_(sv[r].z) * h1 + sv[r].w; } }
            if (ch == 63) lout = out + O_LRUP + (size_t)(q >> 6) * DM + 2 * cp; }
        else { const int bs = q - 128; m0 = (size_t)NTOK_P + (size_t)bs * DEC_T; nr = DEC_T; const f32x2 s = *(const f32x2*)(in5 + (size_t)bs * DM + 2 * cp); h0 = s.x; h1 = s.y;
            lout = out + O_LRUS + (size_t)bs * DM + 2 * cp; }
        const unsigned* p = AB + m0 * DM + 2 * cp; const bf16_t* g = GY + m0 * DM + 2 * cp; unsigned char* o = (unsigned char*)OAL + m0 * (2 * DM) + DM + 2 * cp;
        for (int r0 = 0; r0 < nr; r0 += 16) { u32x2 w[16]; unsigned gw_[16];
#pragma unroll
            for (int r = 0; r < 16; ++r) { w[r] = *(const u32x2*)(p + (size_t)(r0 + r) * DM); gw_[r] = *(const unsigned*)(g + (size_t)(r0 + r) * DM); }
            asm volatile("" ::: "memory");
#pragma unroll
            for (int r = 0; r < 16; ++r) { h0 = expf_(h_lo(w[r].x)) * h0 + h_hi(w[r].x); h1 = expf_(h_lo(w[r].y)) * h1 + h_hi(w[r].y);
                *(unsigned short*)(o + (size_t)(r0 + r) * (2 * DM)) = (unsigned short)__builtin_amdgcn_cvt_pk_fp8_f32(h0 * bflo(gw_[r]) * SA_LRU, h1 * bfhi(gw_[r]) * SA_LRU, 0, false); }
            asm volatile("" ::: "memory"); }
        if (lout) *(f32x2*)lout = (f32x2){h0, h1}; }
}


__device__ __forceinline__ int crow_(int r, int hi) { return (r & 3) + 8 * (r >> 2) + 4 * hi; }
struct IdxItem { int m0, qw, nvalid, samp; const bf16_t* kp; float* sp; int sld; };
__device__ __forceinline__ IdxItem idx_decode(int it, unsigned char* ws) {
    IdxItem r; constexpr int NPI = 4 * 16 * 17;
    if (it < NPI) { int g = 15; int rr = it; while (rr >= 8 * (g + 1)) { rr -= 8 * (g + 1); --g; }
        const int seg = rr % (g + 1); rr /= (g + 1); const int cl = rr & 3, b = rr >> 2, chunk = 4 * g + cl;
        r.m0 = b * SEQ + 64 * chunk; r.qw = 8; r.samp = 0; const int nk = (chunk + 1) * 64 - 256 * seg; r.nvalid = nk < 256 ? nk : 256;
        r.kp = (const bf16_t*)(ws + WS_IKB) + ((size_t)b * SEQ + 256 * seg) * IDXD; r.sp = (float*)(ws + WS_SC) + (size_t)r.m0 * SEQ + 256 * seg; r.sld = SEQ; }
    else { const int rr = it - NPI, bs = rr / 9, seg = rr % 9;
        r.m0 = NTOK_P + 32 * bs; r.qw = 4; r.samp = 1; const int nk = SKV_SP - 256 * seg; r.nvalid = nk < 256 ? nk : 256;
        r.kp = (const bf16_t*)(ws + WS_IKS) + ((size_t)bs * SKV_SP + 256 * seg) * IDXD; r.sp = (float*)(ws + WS_SCS) + (size_t)(32 * bs) * SKV_SP + 256 * seg; r.sld = SKV_SP; }
    return r;
}
__device__ __forceinline__ void idx_phase(Frame& F) {
    unsigned char* const ws = ws_ptr(F); unsigned* const ctl = ctl_ptr(F);
    __syncthreads(); const unsigned qsel = F.MISC[16]; __syncthreads(); if (F.tid == 0) F.MISC[16] = qsel + 1u;
    unsigned* qhead = ctl + CW_QIDX + 64 * qsel;
    const bf16_t* IQ = (const bf16_t*)(ws + WS_IQ); const float* IWF = (const float*)(ws + WS_IWF);
    const int tid = F.tid, lane = F.lane, wave = F.wave, c = lane & 31, hi = lane >> 5;
    constexpr int TOTAL = 4 * 16 * 17 + 16 * 9;
    if (tid == 0) { F.MISC[20] = __hip_atomic_fetch_add(qhead, 1u, __ATOMIC_RELAXED, __HIP_MEMORY_SCOPE_AGENT); F.MISC[21] = __hip_atomic_fetch_add(qhead, 1u, __ATOMIC_RELAXED, __HIP_MEMORY_SCOPE_AGENT); }
    __syncthreads();
    int icur = (int)F.MISC[20], inxt = (int)F.MISC[21];
    __syncthreads();
    if (icur >= TOTAL) return;
#define IDX_STAGE(IT, BUF) do { _Pragma("unroll") for (int j = 0; j < 8; ++j) { const int r0 = 32 * j + 4 * wave; if (r0 < (IT).nvalid) { const int key = r0 + (lane >> 4), chunk = (lane & 15) ^ (key & 15); \
        __builtin_amdgcn_global_load_lds((const unsigned*)((IT).kp + (size_t)key * IDXD + 8 * chunk), (LAS unsigned*)(F.lds + RING_OFF + (BUF) * 65536 + r0 * 256), 16, 0, 0); } } } while (0)
    IdxItem cur = idx_decode(icur, ws);
    IDX_STAGE(cur, 0);
    asm volatile("s_waitcnt vmcnt(0)" ::: "memory");
    __syncthreads();
    int p = 0;
    for (;;) {
        const bool has = inxt < TOTAL;
        unsigned inn = 0u;
        if (tid == 0 && has) inn = __hip_atomic_fetch_add(qhead, 1u, __ATOMIC_RELAXED, __HIP_MEMORY_SCOPE_AGENT);
        IdxItem nxt = cur;
        if (has) { nxt = idx_decode(inxt, ws); IDX_STAGE(nxt, p ^ 1); }
        const LAS unsigned char* kb = F.lds + RING_OFF + p * 65536;
        const int nblk = cur.nvalid >> 5, npair = cur.qw >> 1;
#define IDX_LDK(BK, BLK) do { const int key_ = 32 * (BLK) + c; const LAS unsigned char* rowp_ = kb + key_ * 256; const int sw_ = key_ & 15; \
            _Pragma("unroll") for (int d0 = 0; d0 < 8; ++d0) BK[d0] = *(const LAS bf16x8*)(rowp_ + (((2 * d0 + hi) ^ sw_) << 4)); } while (0)
#define IDX_RELU(x) __builtin_amdgcn_fmed3f((x), 0.f, __builtin_inff())
#define IDX_BLOCK(BK, BLK) do { f32x16 a0 = {}, a1 = {}; \
            _Pragma("unroll") for (int d0 = 0; d0 < 8; ++d0) { a0 = __builtin_amdgcn_mfma_f32_32x32x16_bf16(aq[0][d0], BK[d0], a0, 0, 0, 0); a1 = __builtin_amdgcn_mfma_f32_32x32x16_bf16(aq[1][d0], BK[d0], a1, 0, 0, 0); } \
            f32x2 t0v = {0.f, 0.f}, t1v = {0.f, 0.f}; \
            _Pragma("unroll") for (int r = 0; r < 16; r += 2) { \
                const f32x2 w0 = {w[0][r >> 2][r & 3], w[0][r >> 2][(r & 3) + 1]}, w1 = {w[1][r >> 2][r & 3], w[1][r >> 2][(r & 3) + 1]}; \
                t0v = (f32x2){IDX_RELU(a0[r]), IDX_RELU(a0[r + 1])} * w0 + t0v; t1v = (f32x2){IDX_RELU(a1[r]), IDX_RELU(a1[r + 1])} * w1 + t1v; } \
            const float t0 = t0v.x + t0v.y, t1 = t1v.x + t1v.y; \
            auto rr_ = __builtin_amdgcn_permlane32_swap(__float_as_uint(t0), __float_as_uint(t1), false, false);     \
            s0[loff + 32 * (BLK)] = __uint_as_float(rr_[0]) + __uint_as_float(rr_[1]); } while (0)
        for (int pr = 0; pr < npair; ++pr) {
            const int m = cur.m0 + wave * cur.qw + 2 * pr;
            bf16x8 aq[2][8]; f32x4 w[2][4];
#pragma unroll
            for (int q = 0; q < 2; ++q) {
#pragma unroll
                for (int d0 = 0; d0 < 8; ++d0) aq[q][d0] = *(const bf16x8*)(IQ + (size_t)(m + q) * DM + c * IDXD + d0 * 16 + hi * 8);
#pragma unroll
                for (int g = 0; g < 4; ++g) w[q][g] = *(const f32x4*)(IWF + (size_t)(m + q) * 32 + 8 * g + 4 * hi); }
            float* s0 = cur.sp + (size_t)(m - cur.m0) * cur.sld; const int loff = c + (hi ? cur.sld : 0);
            bf16x8 bka[8], bkb[8];
            IDX_LDK(bka, 0);
            for (int blk = 0; blk < nblk; blk += 2) {
                IDX_LDK(bkb, blk + 1);
                IDX_BLOCK(bka, blk);
                if (blk + 2 < nblk) IDX_LDK(bka, blk + 2);
                IDX_BLOCK(bkb, blk + 1); }
        }
#undef IDX_LDK
#undef IDX_BLOCK
#undef IDX_RELU
        if (tid == 0) F.MISC[20 + p] = inn;
        asm volatile("s_waitcnt vmcnt(0)" ::: "memory");
        __syncthreads();
        if (!has) break;
        cur = nxt; inxt = (int)F.MISC[20 + p]; p ^= 1;
    }
#undef IDX_STAGE
}
__device__ __forceinline__ void select_row(Frame& F, int m) {
    unsigned char* const ws = ws_ptr(F);
    const int lane = F.lane;
    const float* sp; int n;
    if (m < NTOK_P) { n = (((m & (SEQ - 1)) >> 6) + 1) * 64; sp = (const float*)(ws + WS_SC) + (size_t)m * SEQ; }
    else { n = SKV_S; sp = (const float*)(ws + WS_SCS) + (size_t)(m - NTOK_P) * SKV_SP; }
    unsigned key[64];
#pragma unroll
    for (int j = 0; j < 64; ++j) { const int idx = 64 * j + lane; key[j] = __float_as_uint(sp[idx < n ? idx : n - 1]); }
    asm volatile("" ::: "memory");
#pragma unroll
    for (int j = 0; j < 64; ++j) { const int idx = 64 * j + lane; const unsigned u = key[j]; const unsigned k = (u & 0x80000000u) ? ~u : (u | 0x80000000u); key[j] = idx < n ? k : 0u; }
    unsigned thr = 1u;
    if (n > TOPK) { unsigned prefix = 0u;
        const int ngrp = (n + 511) >> 9;
        for (int bit = 31; bit >= 0; --bit) { const unsigned cand = prefix | (1u << bit); int c0 = 0, c1 = 0, c2 = 0, c3 = 0;
#pragma unroll
            for (int g = 0; g < 8; ++g) if (g < ngrp) {
#pragma unroll
                for (int j = 8 * g; j < 8 * g + 8; j += 4) { c0 += (key[j] >= cand) ? 1 : 0; c1 += (key[j + 1] >= cand) ? 1 : 0; c2 += (key[j + 2] >= cand) ? 1 : 0; c3 += (key[j + 3] >= cand) ? 1 : 0; } }
            const int cl = (c0 + c1) + (c2 + c3); int cnt = 0;
#pragma unroll
            for (int b = 0; b < 7; ++b) cnt += __builtin_popcountll(__ballot((cl >> b) & 1)) << b;
            if (cnt >= TOPK) prefix = cand;
            if (cnt == TOPK) break; }
        thr = prefix; }
    unsigned long long mine = 0ull;
#pragma unroll
    for (int j = 0; j < 64; ++j) { const unsigned long long bal = __ballot(key[j] >= thr); mine = (lane == j) ? bal : mine; }
    ((unsigned long long*)(ws + WS_BM))[(size_t)m * 64 + lane] = mine;
}
__device__ __forceinline__ void select_phase(Frame& F) {
    volatile LAS unsigned* cnt = F.MISC + 24;
    __syncthreads(); if (F.tid == 0) *cnt = 0u; __syncthreads();
    const int G = F.G, b = (int)blockIdx.x;
    for (;;) {
        unsigned i = 0u; if (F.lane == 0) i = __hip_atomic_fetch_add((LAS unsigned*)cnt, 1u, __ATOMIC_RELAXED, __HIP_MEMORY_SCOPE_WORKGROUP);
        const int q = (int)__builtin_amdgcn_readfirstlane(i) * G + b;
        if (q >= MTOK) break;
        int m;
        if (q < MTOK - NTOK_P) m = NTOK_P + q;
        else { const int t = q - (MTOK - NTOK_P); m = (t & 1) * SEQ + (SEQ - 1 - (t >> 1)); }
        select_row(F, m);
    }
}

namespace att {
constexpr int NW = 8, QBLK = 32, KVBLK = 64, D = 128, KVLD = 2048, QLD = 4096, OLD = 8192;
constexpr float SCALE = 0.08838834764831845f, THR = 8.f;
constexpr int SHM_V = KVBLK * D * 2, SHM_K = KVBLK * D * 2;
constexpr int ATT_LDS = 2 * SHM_V + 2 * SHM_K + NW * 64 * 4 + 64;
typedef short s16x4 __attribute__((ext_vector_type(4)));
#define KSWZ(row, colB) ((row) * 256 + ((colB) ^ (((row) & 7) << 4)))
#define SBAR() __builtin_amdgcn_sched_barrier(0)
__device__ __forceinline__ int v_st(int k, int c) { const int kk = (k & ~0xC) | ((k & 4) << 1) | ((k & 8) >> 1); return ((kk >> 3) * 4 + (c >> 5)) * 512 + ((kk & 7) * 32 + (c & 31)) * 2; }
__device__ __forceinline__ int v_rd_base(int lane) { return ((lane & 3) << 3) | (((lane >> 2) & 3) << 6) | (((lane >> 4) & 1) << 5) | (((lane >> 5) & 1) << 8); }
constexpr int v_rd_off(int d0, int ks, int half) { return d0 * 512 + ks * 4096 + half * 2048; }
__device__ __forceinline__ int crow(int r, int hi) { return (r & 3) + 8 * (r >> 2) + 4 * hi; }
__device__ __forceinline__ bf16x8 load8(const bf16_t* p) { return *reinterpret_cast<const bf16x8*>(p); }
__device__ __forceinline__ void mask_bits(f32x16& p0, f32x16& p1, unsigned long long mw, int hi) {
    const unsigned lo = (unsigned)mw >> (4 * hi), hw = (unsigned)(mw >> 32) >> (4 * hi); unsigned NEGB = 0xFF800000u; asm volatile("" : "+v"(NEGB));
#define MASK1(P, W, C) do { int m_; float t_ = (P); asm("v_bfe_i32 %0, %1, %2, 1" : "=v"(m_) : "v"(W), "i"(C)); asm("v_bfi_b32 %0, %1, %0, %2" : "+v"(t_) : "v"(m_), "v"(NEGB)); (P) = t_; } while (0)
    asm volatile("s_nop 15\n\ts_nop 3" : "+v"(p0), "+v"(p1));
#pragma unroll
    for (int r = 0; r < 16; ++r) { const int c = (r & 3) + 8 * (r >> 2); MASK1(p0[r], lo, c); MASK1(p1[r], hw, c); }
#undef MASK1
}
__device__ __forceinline__ void partialSM(f32x16& p0, f32x16& p1, float& m_reg, float& mn, float& alpha) {
    float pmax = p0[0]; for (int r = 1; r < 16; ++r) pmax = fmaxf(pmax, p0[r]); for (int r = 0; r < 16; ++r) pmax = fmaxf(pmax, p1[r]);
    { auto rr = __builtin_amdgcn_permlane32_swap(__float_as_uint(pmax), __float_as_uint(pmax), false, false);
      pmax = fmaxf(__uint_as_float(rr[0]), __uint_as_float(rr[1])); }
    constexpr float C2 = 1.4426950408889634f * SCALE;
    if (__builtin_expect(__all((pmax - m_reg) * SCALE <= THR), 1)) { mn = m_reg; alpha = 1.f; }
    else { mn = fmaxf(m_reg, pmax); alpha = __builtin_amdgcn_exp2f((m_reg - mn) * C2); m_reg = mn; }
    const float mnL = -mn * C2;
    for (int r = 0; r < 16; ++r) p0[r] = fmaf(p0[r], C2, mnL); for (int r = 0; r < 16; ++r) p1[r] = fmaf(p1[r], C2, mnL);
    for (int r = 0; r < 16; ++r) p0[r] = __builtin_amdgcn_exp2f(p0[r]);
}
__device__ __forceinline__ void finishSM(f32x16& p0, f32x16& p1, float alpha, float& l_reg, bf16x8& pa0, bf16x8& pa1, bf16x8& pa2, bf16x8& pa3) {
    for (int r = 0; r < 16; ++r) p1[r] = __builtin_amdgcn_exp2f(p1[r]);
    float ps = 0; for (int r = 0; r < 16; ++r) ps += p0[r]; for (int r = 0; r < 16; ++r) ps += p1[r];
    { auto rr = __builtin_amdgcn_permlane32_swap(__float_as_uint(ps), __float_as_uint(ps), false, false);
      ps = __uint_as_float(rr[0]) + __uint_as_float(rr[1]); }
    l_reg = l_reg * alpha + ps;
#define PK4(P, B_, OUT) do { unsigned a0 = pk2(P[B_+0], P[B_+1]), a1 = pk2(P[B_+2], P[B_+3]);                          \
        unsigned b0 = pk2(P[B_+4], P[B_+5]), b1 = pk2(P[B_+6], P[B_+7]);                                             \
        auto r0 = __builtin_amdgcn_permlane32_swap(a0, b0, false, false); auto r1 = __builtin_amdgcn_permlane32_swap(a1, b1, false, false); \
        u32x4 w = {r0[0], r1[0], r0[1], r1[1]}; OUT = *reinterpret_cast<bf16x8*>(&w); } while (0)
    PK4(p0, 0, pa0); PK4(p0, 8, pa1); PK4(p1, 0, pa2); PK4(p1, 8, pa3);
#undef PK4
}
template <int KB>
__device__ __forceinline__ void qkt(f32x16& p0, f32x16& p1, const char* K_lds, int r32, int hi, const bf16x8* qr) {
    p0 = f32x16{}; p1 = f32x16{};
    const char* kb[4];
#pragma unroll
    for (int dd = 0; dd < 4; ++dd) kb[dd] = K_lds + KB * SHM_K + KSWZ(r32, (dd * 16 + hi * 8) * 2);
#pragma unroll
    for (int d0 = 0; d0 < 8; ++d0) { const char* a = kb[d0 & 3] + (d0 >> 2) * 128;
        bf16x8 b0 = *reinterpret_cast<const bf16x8*>(a);
        bf16x8 b1 = *reinterpret_cast<const bf16x8*>(a + 32 * 256);
        p0 = __builtin_amdgcn_mfma_f32_32x32x16_bf16(b0, qr[d0], p0, 0, 0, 0);
        p1 = __builtin_amdgcn_mfma_f32_32x32x16_bf16(b1, qr[d0], p1, 0, 0, 0); }
}
template <int VB>
__device__ __forceinline__ void pv_tile(f32x16* o, int vb0, bf16x8 pa0, bf16x8 pa1, bf16x8 pa2, bf16x8 pa3) {
#define TRRD(dst, off) asm volatile("ds_read_b64_tr_b16 %0, %1 offset:%2" : "=&v"(dst) : "v"(vb0), "i"(off) : "memory")
#define PV_D0(d0) do { s16x4 l0, l1, l2, l3, h0, h1, h2, h3; constexpr int b_ = VB * SHM_V + v_rd_off(d0, 0, 0); \
        TRRD(l0, b_); TRRD(h0, b_ + 2048); TRRD(l1, b_ + 4096); TRRD(h1, b_ + 6144); TRRD(l2, b_ + 8192); TRRD(h2, b_ + 10240); TRRD(l3, b_ + 12288); TRRD(h3, b_ + 14336); \
        asm volatile("s_waitcnt lgkmcnt(0)" ::: "memory"); SBAR();   \
        o[d0] = __builtin_amdgcn_mfma_f32_32x32x16_bf16(pa0, (bf16x8){l0[0], l0[1], l0[2], l0[3], h0[0], h0[1], h0[2], h0[3]}, o[d0], 0, 0, 0);   \
        o[d0] = __builtin_amdgcn_mfma_f32_32x32x16_bf16(pa1, (bf16x8){l1[0], l1[1], l1[2], l1[3], h1[0], h1[1], h1[2], h1[3]}, o[d0], 0, 0, 0);   \
        o[d0] = __builtin_amdgcn_mfma_f32_32x32x16_bf16(pa2, (bf16x8){l2[0], l2[1], l2[2], l2[3], h2[0], h2[1], h2[2], h2[3]}, o[d0], 0, 0, 0);   \
        o[d0] = __builtin_amdgcn_mfma_f32_32x32x16_bf16(pa3, (bf16x8){l3[0], l3[1], l3[2], l3[3], h3[0], h3[1], h3[2], h3[3]}, o[d0], 0, 0, 0); } while (0)
    PV_D0(0); PV_D0(1); PV_D0(2); PV_D0(3);
#undef PV_D0
#undef TRRD
}
struct BlockRef { const bf16_t* K; int m0, g, NT, samp; };
__device__ __forceinline__ const bf16_t* ref_q(const BlockRef& r, const unsigned char* ws) { return (const bf16_t*)(ws + WS_Q) + (size_t)r.m0 * QLD + 4 * r.g * D; }
__device__ __forceinline__ unsigned char* ref_o(const BlockRef& r, unsigned char* ws) { return ws + WS_OAL + (size_t)r.m0 * OLD + 4 * r.g * D; }
__device__ __forceinline__ const char* ref_bm(const BlockRef& r, const unsigned char* ws) { return (const char*)(ws + WS_BM) + (size_t)r.m0 * 512; }
struct Seam { bf16x8 qr[8]; bf16x8 st_v0, st_v1, st_k0, st_k1; };
#define ROW(p, k0, rr) ((p) + (size_t)((k0) + (rr)) * KVLD + sc)
#define VMW() asm volatile("s_waitcnt vmcnt(0)" ::: "memory")
#define VMWN(n) asm volatile("s_waitcnt vmcnt(%0)" :: "i"(n) : "memory")
#define SLOAD_H(Kp, Vp, k0) do { S.st_v0 = load8(ROW(Vp, k0, sr)); S.st_v1 = load8(ROW(Vp, k0, 32 + sr));              \
                         S.st_k0 = load8(ROW(Kp, k0, sr)); S.st_k1 = load8(ROW(Kp, k0, 32 + sr)); } while (0)
#define SWRITE_HK(bf) do { *(bf16x8*)(K_lds + (bf) * SHM_K + kws) = S.st_k0; *(bf16x8*)(K_lds + (bf) * SHM_K + kws + 32 * 256) = S.st_k1; } while (0)
#define SWRITE_HV(bf) do { *(bf16x8*)(V_lds + (bf) * SHM_V + vst0) = S.st_v0; *(bf16x8*)(V_lds + (bf) * SHM_V + vst1) = S.st_v1; } while (0)
#define SWRITE_H(bf) do { SWRITE_HV(bf); SWRITE_HK(bf); } while (0)
__device__ __forceinline__ int q_rowoff(int samp, int wid) { return samp ? 0 : 32 * (wid & 1); }
__device__ __forceinline__ int q_headoff(int samp, int wid) { return samp ? (wid & 3) : (wid >> 1); }
__device__ __forceinline__ void attn_prime(const BlockRef& cur, unsigned char* wsb, char* lds, Seam& S, int wv) {
    const int tid = tid_of(wv);
    const int wid = __builtin_amdgcn_readfirstlane(tid >> 6), lane = tid & 63, r32 = lane & 31, hi = lane >> 5;
    const int sr = tid >> 4, sc = (tid & 15) * 8, kws = KSWZ(sr, sc * 2); char* K_lds = lds + 2 * SHM_V;
    const bf16_t* qp = ref_q(cur, wsb) + (size_t)(q_rowoff(cur.samp, wid) + r32) * QLD + q_headoff(cur.samp, wid) * D + hi * 8;
    for (int d0 = 0; d0 < 8; ++d0) S.qr[d0] = load8(qp + d0 * 16);
    SLOAD_H(cur.K, cur.K + 1024, 0); VMW(); SWRITE_HK(0);
    __syncthreads();
}
__device__ __forceinline__ void attn_block(const BlockRef& cur, const BlockRef& nxt, unsigned char* wsb, char* lds, Seam& S, int wv) {
    const int tid = tid_of(wv);
    const int wid = __builtin_amdgcn_readfirstlane(tid >> 6), lane = tid & 63, r32 = lane & 31, hi = lane >> 5;
    const int NT = cur.NT;
    char* V_lds = lds; char* K_lds = lds + 2 * SHM_V;
    float* ws = (float*)(lds + 2 * SHM_V + 2 * SHM_K) + wid * 64; float* li_l = ws, * al_l = ws + 32;
    float m_reg = -1e30f, l_reg = 0; f32x16 o[4] = {};
    const int sr = tid >> 4, sc = (tid & 15) * 8, vst0 = v_st(sr, sc), vst1 = v_st(32 + sr, sc), kws = KSWZ(sr, sc * 2);
    const int vb0 = (int)(uintptr_t)V_lds + v_rd_base(lane);
    const bf16_t* Kh = cur.K; const bf16_t* Vh = cur.K + 1024;
    const int qro = q_rowoff(cur.samp, wid), qho = q_headoff(cur.samp, wid);
    const char* bmb = ref_bm(cur, wsb); const unsigned bmo = (unsigned)(qro + r32) * 512u;
#define BMW(t) (*(const unsigned long long*)(bmb + bmo + (unsigned)(t) * 8u))
#define RESC(a) do { if (__any((a) < 1.f)) { if (hi == 0) al_l[r32] = (a); asm volatile("s_waitcnt lgkmcnt(0)" ::: "memory");              \
                     for (int d_ = 0; d_ < 4; ++d_) for (int r = 0; r < 16; ++r) o[d_][r] *= al_l[crow(r, hi)]; } } while (0)
#define KBASE(t) ((t) * KVBLK)
    f32x16 pA0, pA1, pB0, pB1; float mnA, mnB, alA, alB; bf16x8 pa0, pa1, pa2, pa3;
    SWRITE_HV(0); SBAR();
    if (NT > 1) SLOAD_H(Kh, Vh, KBASE(1));
    const unsigned long long mw0 = BMW(0);
    SBAR(); qkt<0>(pA0, pA1, K_lds, r32, hi, S.qr);
    mask_bits(pA0, pA1, mw0, hi); partialSM(pA0, pA1, m_reg, mnA, alA);
    if (NT > 1) { VMW(); SWRITE_H(1); }
    __syncthreads();
#define HALF_STEP(PX0, PX1, mnX, alX, PY0, PY1, alY, t, KB, VB, SB) do {                                                      \
        SBAR(); qkt<KB>(PX0, PX1, K_lds, r32, hi, S.qr);                                                                      \
        finishSM(PY0, PY1, alY, l_reg, pa0, pa1, pa2, pa3); SBAR();                                                           \
        const unsigned long long mw_ = BMW(t);                                                                               \
        if ((t) + 1 < NT) { SLOAD_H(Kh, Vh, KBASE((t) + 1)); SBAR(); }                                                        \
        pv_tile<VB>(o, vb0, pa0, pa1, pa2, pa3); mask_bits(PX0, PX1, mw_, hi); partialSM(PX0, PX1, m_reg, mnX, alX);         \
        __syncthreads();                                                                                                      \
        if ((t) + 1 < NT) { VMW(); SWRITE_H(SB); }                                                                            \
        RESC(alX); __syncthreads(); } while (0)
    for (int t = 1; t + 1 < NT; t += 2) {
        HALF_STEP(pB0, pB1, mnB, alB, pA0, pA1, alA, t, 1, 0, 0);
        HALF_STEP(pA0, pA1, mnA, alA, pB0, pB1, alB, t + 1, 0, 1, 1);
    }
    const bool even = (NT & 1) == 0;
    unsigned long long mwT = 0ull;
    if (even) { mwT = BMW(NT - 1); SBAR(); qkt<1>(pB0, pB1, K_lds, r32, hi, S.qr); SBAR(); }
    SLOAD_H(nxt.K, nxt.K + 1024, 0); SBAR();
    { const bf16_t* qp = ref_q(nxt, wsb) + (size_t)(q_rowoff(nxt.samp, wid) + r32) * QLD + q_headoff(nxt.samp, wid) * D + hi * 8;
#pragma unroll
      for (int d0 = 0; d0 < 8; ++d0) S.qr[d0] = load8(qp + d0 * 16); }
    SBAR();
    finishSM(pA0, pA1, alA, l_reg, pa0, pa1, pa2, pa3); SBAR();
    pv_tile<0>(o, vb0, pa0, pa1, pa2, pa3);
    if (even) { mask_bits(pB0, pB1, mwT, hi); partialSM(pB0, pB1, m_reg, mnB, alB); __syncthreads(); RESC(alB);
        finishSM(pB0, pB1, alB, l_reg, pa0, pa1, pa2, pa3); SBAR(); pv_tile<1>(o, vb0, pa0, pa1, pa2, pa3); }
    SBAR(); VMWN(8); SWRITE_HK(0); SBAR();
    if (hi == 0) li_l[r32] = l_reg; asm volatile("s_waitcnt lgkmcnt(0)" ::: "memory");
    float rli[16];
#pragma unroll
    for (int r = 0; r < 16; ++r) rli[r] = __builtin_amdgcn_rcpf(li_l[crow(r, hi)]);
    unsigned char* Ow = ref_o(cur, wsb) + (size_t)qro * OLD + qho * D;
    const bool st_ok = !cur.samp || wid < 4;
#pragma unroll
    for (int r = 0; r < 16; ++r) { const int orow = crow(r, hi);
#pragma unroll
        for (int d0 = 0; d0 < 4; ++d0) { const float v = o[d0][r] * (rli[r] * SA_ATT);
            const float vn = __shfl_xor(v, 1);
            const int h2 = __builtin_amdgcn_cvt_pk_fp8_f32(v, vn, 0, false), h4 = __shfl_xor(h2, 2);
            if (st_ok && (r32 & 3) == 0) *(unsigned*)(Ow + (size_t)orow * OLD + d0 * 32 + r32) = ((unsigned)h2 & 0xffffu) | ((unsigned)h4 << 16); } }
    __syncthreads();
#undef RESC
#undef KBASE
#undef HALF_STEP
#undef BMW
}
#undef ROW
#undef VMW
#undef VMWN
#undef SLOAD_H
#undef SWRITE_HK
#undef SWRITE_HV
#undef SWRITE_H
}
__device__ __forceinline__ att::BlockRef attn_item(unsigned char* ws, int i) {
    att::BlockRef r;
    if (i < 128) { const int bs = i >> 3, g = i & 7; r.m0 = NTOK_P + bs * DEC_T; r.g = g; r.K = (const bf16_t*)(ws + WS_KVS) + (size_t)bs * SKV_SP * 2048 + g * HD; r.NT = SKV_SP / 64; r.samp = 1; }
    else { const int j = i - 128, c = 63 - (j >> 4), b = (j >> 3) & 1, g = j & 7; r.m0 = b * SEQ + c * 64; r.g = g; r.K = (const bf16_t*)(ws + WS_KV) + (size_t)b * SEQ * 2048 + g * HD; r.NT = c + 1; r.samp = 0; }
    return r;
}
__device__ __forceinline__ void attn_phase(Frame& F, char* lds) {
    unsigned char* const ws = ws_ptr(F); unsigned* const ctl = (unsigned*)(ws + WS_CTL);
    constexpr int TOTAL = 128 + 1024;
    volatile LAS unsigned* qw = (volatile LAS unsigned*)(F.lds + RING_OFF + att::ATT_LDS - 64);
    __syncthreads(); const unsigned qsel = F.MISC[17]; __syncthreads(); if (F.tid == 0) F.MISC[17] = qsel + 1u;
    unsigned* qhead = ctl + CW_QATT + 64 * qsel;
    if (F.tid == 0) { qw[0] = __hip_atomic_fetch_add(qhead, 1u, __ATOMIC_RELAXED, __HIP_MEMORY_SCOPE_AGENT); qw[1] = __hip_atomic_fetch_add(qhead, 1u, __ATOMIC_RELAXED, __HIP_MEMORY_SCOPE_AGENT); }
    __syncthreads();
    int i0 = (int)qw[0], i1 = (int)qw[1];
    __syncthreads();
    if (i0 < TOTAL) {
        att::BlockRef cur = attn_item(ws, i0);
        att::Seam S;
        att::attn_prime(cur, ws, lds, S, F.wave);
        for (;;) {
            const bool has = i1 < TOTAL;
            const att::BlockRef nxt = has ? attn_item(ws, i1) : cur;
            if (F.tid == 0 && has) qw[0] = __hip_atomic_fetch_add(qhead, 1u, __ATOMIC_RELAXED, __HIP_MEMORY_SCOPE_AGENT);
            att::attn_block(cur, nxt, ws, lds, S, F.wave);
            if (!has) break;
            __syncthreads();
            i1 = (int)qw[0];
            __syncthreads();
            cur = nxt;
        }
    }
    __syncthreads(); conv_drain(F);
}

struct EpiMix {
    static constexpr bool PERM = true, MID = true, FP8 = true;
    LAS unsigned char* lds;
    __device__ __forceinline__ void mid(f32x4 (&acc)[2][2][4][2], const pg8::Unit& u, int wr, int wc, int fr, int fq) const {
        int row0 = u.pm * 256 + wr * 64 + fr, col0 = u.pn * 256 + wc * 32 + 8 * fq;
        asm volatile("" : "+v"(row0), "+v"(col0));
        unsigned char* const ws = e_ws(lds); const bf16_t* SGA = (const bf16_t*)(ws + WS_SGA); const bf16_t* SGL = (const bf16_t*)(ws + WS_SGL);
#pragma unroll
        for (int ai = 0; ai < 2; ++ai) { u32x4 ga[4][2], gl[4][2];
#pragma unroll
            for (int m = 0; m < 4; ++m)
#pragma unroll
                for (int bj = 0; bj < 2; ++bj) { const size_t off = (size_t)(row0 + ai * 128 + m * 16) * DM + col0 + bj * 128; ga[m][bj] = *(const u32x4*)(SGA + off); gl[m][bj] = *(const u32x4*)(SGL + off); }
            asm volatile("" ::: "memory");
#pragma unroll
            for (int m = 0; m < 4; ++m)
#pragma unroll
                for (int bj = 0; bj < 2; ++bj) { float a[8], l[8]; unpack8(ga[m][bj], a); unpack8(gl[m][bj], l);
#pragma unroll
                    for (int e = 0; e < 4; ++e) { acc[ai][bj][m][0][e] *= a[e] * (SA_LRU / SA_ATT) * __builtin_amdgcn_rcpf(l[e]); acc[ai][bj][m][1][e] *= a[4 + e] * (SA_LRU / SA_ATT) * __builtin_amdgcn_rcpf(l[4 + e]); }
                    asm volatile("" : "+v"(acc[ai][bj][m][0]), "+v"(acc[ai][bj][m][1])); }
            asm volatile("" ::: "memory"); }
    }
    __device__ __forceinline__ void operator()(const f32x4 (&acc)[2][2][4][2], const pg8::Unit& u, int wr, int wc, int fr, int fq) const {
        const int row0 = u.pm * 256 + wr * 64 + fr, col0 = u.pn * 256 + wc * 32 + 8 * fq; constexpr float SC = S_MIX / (SA_LRU * SW8);
        unsigned char* const ws = e_ws(lds); const bf16_t* SGL = (const bf16_t*)(ws + WS_SGL); unsigned char* MIX = ws + WS_MIX;
        u32x4 glr[2][4][2];
#pragma unroll
        for (int ai = 0; ai < 2; ++ai)
#pragma unroll
            for (int m = 0; m < 4; ++m)
#pragma unroll
                for (int bj = 0; bj < 2; ++bj) glr[ai][m][bj] = *(const u32x4*)(SGL + (size_t)(row0 + ai * 128 + m * 16) * DM + col0 + bj * 128);
        asm volatile("" ::: "memory");
#pragma unroll
        for (int ai = 0; ai < 2; ++ai)
#pragma unroll
            for (int m = 0; m < 4; ++m)
#pragma unroll
                for (int bj = 0; bj < 2; ++bj) { const size_t off = (size_t)(row0 + ai * 128 + m * 16) * DM + col0 + bj * 128; float gl[8]; unpack8(glr[ai][m][bj], gl);
                    const f32x4 v0 = acc[ai][bj][m][0], v1 = acc[ai][bj][m][1];
                    if (P9_FP8) { u32x2 w; w.x = pk4_fp8(v0[0] * gl[0] * SC, v0[1] * gl[1] * SC, v0[2] * gl[2] * SC, v0[3] * gl[3] * SC); w.y = pk4_fp8(v1[0] * gl[4] * SC, v1[1] * gl[5] * SC, v1[2] * gl[6] * SC, v1[3] * gl[7] * SC);
                        *(u32x2*)(MIX + off) = w; }
                    else { constexpr float S1 = 1.0f / (SA_LRU * SW8); u32x4 w; w.x = pk2(v0[0] * gl[0] * S1, v0[1] * gl[1] * S1); w.y = pk2(v0[2] * gl[2] * S1, v0[3] * gl[3] * S1); w.z = pk2(v1[0] * gl[4] * S1, v1[1] * gl[5] * S1); w.w = pk2(v1[2] * gl[6] * S1, v1[3] * gl[7] * S1);
                        *(u32x4*)((bf16_t*)MIX + off) = w; } }
    }
};
struct EpiOut {
    static constexpr bool PERM = false, MID = false, FP8 = (P9_FP8 != 0);
    LAS unsigned char* lds;
    __device__ __forceinline__ void operator()(const f32x4 (&acc)[2][2][4][2], const pg8::Unit& u, int wr, int wc, int fr, int fq) const {
        unsigned char* const ws = e_ws(lds); const float* xp = e_in(lds, 0); const float* xs = e_in(lds, 1); const float* gf = e_in(lds, 21);
        float* X1 = (float*)(ws + WS_X1); bf16_t* A2 = (bf16_t*)(ws + WS_A2); LAS float* X = (LAS float*)(lds + XCH_OFF);
        const int row0 = u.pm * 256 + wr * 64 + fr, col0 = u.pn * 256 + wc * 32 + 4 * fq;
        const float* xb = (u.pm < NTOK_P / 256) ? xp : xs - (size_t)NTOK_P * DM;
        f32x4 gv[2][2];
#pragma unroll
        for (int bj = 0; bj < 2; ++bj)
#pragma unroll
            for (int n = 0; n < 2; ++n) gv[bj][n] = *(const f32x4*)(gf + col0 + bj * 128 + n * 16);
#pragma unroll
        for (int ai = 0; ai < 2; ++ai) { f32x4 xv[4][2][2];
#pragma unroll
            for (int m = 0; m < 4; ++m)
#pragma unroll
                for (int bj = 0; bj < 2; ++bj)
#pragma unroll
                    for (int n = 0; n < 2; ++n) xv[m][bj][n] = *(const f32x4*)(xb + (size_t)(row0 + ai * 128 + m * 16) * DM + col0 + bj * 128 + n * 16);
            asm volatile("" ::: "memory");
#pragma unroll
            for (int m = 0; m < 4; ++m) { const size_t row = (size_t)(row0 + ai * 128 + m * 16); const size_t off = row * DM + col0; float s = 0.f;
#pragma unroll
                for (int bj = 0; bj < 2; ++bj)
#pragma unroll
                    for (int n = 0; n < 2; ++n) { const f32x4 x1 = xv[m][bj][n] + acc[ai][bj][m][n] * (P9_FP8 ? 1.0f / (S_MIX * SW8) : 1.0f);
                        *(f32x4*)(X1 + off + bj * 128 + n * 16) = x1; s += (x1[0] * x1[0] + x1[1] * x1[1]) + (x1[2] * x1[2] + x1[3] * x1[3]);
                        const f32x4 y = x1 * gv[bj][n]; u32x2 w; w.x = pk2(y[0], y[1]); w.y = pk2(y[2], y[3]); *(u32x2*)(A2 + off + bj * 128 + n * 16) = w; }
                s += __shfl_xor(s, 16); s += __shfl_xor(s, 32);
                if (fq == 0) X[(ai * 128 + wr * 64 + m * 16 + fr) * 4 + wc] = s; }
            asm volatile("" ::: "memory"); }
        asm volatile("s_waitcnt lgkmcnt(0)" ::: "memory"); __builtin_amdgcn_s_barrier(); asm volatile("" ::: "memory");
        { const int t = (wr * 4 + wc) * 64 + (fq * 16 + fr);
          if (t < 256) { const f32x4 p = *(const LAS f32x4*)(X + t * 4); ((float*)(ws + WS_PSSQ))[(size_t)u.pn * MTOK + u.pm * 256 + t] = (p[0] + p[1]) + (p[2] + p[3]); } }
    }
};
struct EpiGU {
    static constexpr bool PERM = true, MID = false, FP8 = false;
    LAS unsigned char* lds;
    __device__ __forceinline__ void operator()(const f32x4 (&acc)[2][2][4][2], const pg8::Unit& u, int wr, int wc, int fr, int fq) const {
        unsigned char* const ws = e_ws(lds); const float* RSTD = (const float*)(ws + WS_CTL) + CW_SSQ; bf16_t* H = (bf16_t*)(ws + WS_H);
        const int row0 = u.pm * 256 + wr * 64 + fr, col0 = u.pn * 128 + wc * 32 + 8 * fq;
        float rs[2][4];
#pragma unroll
        for (int ai = 0; ai < 2; ++ai)
#pragma unroll
            for (int m = 0; m < 4; ++m) rs[ai][m] = RSTD[row0 + ai * 128 + m * 16];
        asm volatile("" ::: "memory");
#pragma unroll
        for (int ai = 0; ai < 2; ++ai)
#pragma unroll
            for (int m = 0; m < 4; ++m) { const size_t row = (size_t)(row0 + ai * 128 + m * 16);
                const float rstd = rs[ai][m]; float hv[8];
#pragma unroll
                for (int n = 0; n < 2; ++n)
#pragma unroll
                    for (int e = 0; e < 4; ++e) { const float g = acc[ai][0][m][n][e] * rstd, up = acc[ai][1][m][n][e] * rstd; hv[4 * n + e] = g * sigmoidf_(g) * up; }
                *(u32x4*)(H + row * DFF + col0) = pack8f(hv); }
    }
};
struct EpiDown {
    static constexpr bool PERM = false, MID = false, FP8 = false;
    LAS unsigned char* lds;
    __device__ __forceinline__ void operator()(const f32x4 (&acc)[2][2][4][2], const pg8::Unit& u, int wr, int wc, int fr, int fq) const {
        const float* X1 = (const float*)(e_ws(lds) + WS_X1); float* Y = e_out(lds);
        const int row0 = u.pm * 256 + wr * 64 + fr, col0 = u.pn * 256 + wc * 32 + 4 * fq;
#pragma unroll
        for (int ai = 0; ai < 2; ++ai) { f32x4 xv[4][2][2];
#pragma unroll
            for (int m = 0; m < 4; ++m)
#pragma unroll
                for (int bj = 0; bj < 2; ++bj)
#pragma unroll
                    for (int n = 0; n < 2; ++n) xv[m][bj][n] = *(const f32x4*)(X1 + (size_t)(row0 + ai * 128 + m * 16) * DM + col0 + bj * 128 + n * 16);
            asm volatile("" ::: "memory");
#pragma unroll
            for (int m = 0; m < 4; ++m)
#pragma unroll
                for (int bj = 0; bj < 2; ++bj)
#pragma unroll
                    for (int n = 0; n < 2; ++n) *(f32x4*)(Y + (size_t)(row0 + ai * 128 + m * 16) * DM + col0 + bj * 128 + n * 16) = xv[m][bj][n] + acc[ai][bj][m][n];
            asm volatile("" ::: "memory"); }
    }
};

__device__ __forceinline__ f32x4 part_sum(const float* PART, int tile, int s0, int s1, int rr, int cc) {
    f32x4 a = {0.f, 0.f, 0.f, 0.f};
#pragma unroll
    for (int s = 0; s < 8; ++s) if (s >= s0 && s < s1) a += *(const f32x4*)(PART + ((size_t)(tile * 8 + s) * 65536 + (size_t)rr * 256 + cc));
    return a;
}
__device__ __forceinline__ void reduce_mix(Frame& F) {
    unsigned char* const ws = ws_ptr(F); const float* PART = (const float*)(ws + WS_PART);
    const bf16_t* SGA = (const bf16_t*)(ws + WS_SGA); const bf16_t* SGL = (const bf16_t*)(ws + WS_SGL); unsigned char* MIX = ws + WS_MIX;
    for (int it = F.gw * 64 + F.lane; it < NTOK_S * 1024; it += F.NGW * 64) { const int r = it >> 10, col = 4 * (it & 1023), tile = (r >> 8) * 16 + (col >> 8), rr = r & 255, cc = col & 255;
        const f32x4 sA = part_sum(PART, tile, 0, 4, rr, cc), sL = part_sum(PART, tile, 4, 8, rr, cc);
        const size_t off = (size_t)(NTOK_P + r) * DM + col; const u32x2 ga = *(const u32x2*)(SGA + off), gl = *(const u32x2*)(SGL + off);
        constexpr float CA = (P9_FP8 ? S_MIX : 1.0f) / (SA_ATT * SW8), CL = (P9_FP8 ? S_MIX : 1.0f) / (SA_LRU * SW8);
        const float m0 = bflo(ga.x) * sA[0] * CA + bflo(gl.x) * sL[0] * CL, m1 = bfhi(ga.x) * sA[1] * CA + bfhi(gl.x) * sL[1] * CL, m2 = bflo(ga.y) * sA[2] * CA + bflo(gl.y) * sL[2] * CL, m3 = bfhi(ga.y) * sA[3] * CA + bfhi(gl.y) * sL[3] * CL;
        if (P9_FP8) *(unsigned*)(MIX + off) = pk4_fp8(m0, m1, m2, m3); else *(u32x2*)((bf16_t*)MIX + off) = (u32x2){pk2(m0, m1), pk2(m2, m3)}; }
}
__device__ __forceinline__ void reduce_out(Frame& F, bool tail) {
    unsigned char* const ws = ws_ptr(F); const float* PART = (const float*)(ws + WS_PART); const float* xs = in_ptr(F, 1); const float* gf = in_ptr(F, 21);
    float* X1 = (float*)(ws + WS_X1); bf16_t* A2 = (bf16_t*)(ws + WS_A2); float* RSTD = (float*)(ctl_ptr(F) + CW_SSQ); const float* PSSQ = (const float*)(ws + WS_PSSQ);
    for (int r = F.gw * 64 + F.lane; r < (tail ? NTOK_P : MTOK); r += F.NGW * 64) { float ss = 0.f;
#pragma unroll
        for (int j = 0; j < 16; ++j) ss += PSSQ[(size_t)j * MTOK + r];
        RSTD[r] = 1.0f / sqrtf(ss * (1.0f / DM) + EPS); }
    if (tail) for (int r = F.gw; r < NTOK_S; r += F.NGW) { float ss = 0.f;
#pragma unroll 4
        for (int j = 0; j < 16; ++j) { const int col = 4 * F.lane + 256 * j, tile = (r >> 8) * 16 + j, rr = r & 255, cc = 4 * F.lane;
            const f32x4 x1 = *(const f32x4*)(xs + (size_t)r * DM + col) + part_sum(PART, tile, 0, 8, rr, cc) * (P9_FP8 ? 1.0f / (S_MIX * SW8) : 1.0f); const f32x4 gg = *(const f32x4*)(gf + col);
            const size_t off = (size_t)(NTOK_P + r) * DM + col; *(f32x4*)(X1 + off) = x1; ss += (x1[0] * x1[0] + x1[1] * x1[1]) + (x1[2] * x1[2] + x1[3] * x1[3]);
            u32x2 o; o.x = pk2(x1[0] * gg[0], x1[1] * gg[1]); o.y = pk2(x1[2] * gg[2], x1[3] * gg[3]); *(u32x2*)(A2 + off) = o; }
        ss = wave_sum(ss);
        if (F.lane == 0) RSTD[NTOK_P + r] = 1.0f / sqrtf(ss * (1.0f / DM) + EPS); }
}
__device__ __forceinline__ void reduce_down(Frame& F) {
    unsigned char* const ws = ws_ptr(F); const float* PART = (const float*)(ws + WS_PART); const float* X1 = (const float*)(ws + WS_X1); float* Y = out_ptr(F);
    for (int it = F.gw * 64 + F.lane; it < NTOK_S * 1024; it += F.NGW * 64) { const int r = it >> 10, col = 4 * (it & 1023), tile = (r >> 8) * 16 + (col >> 8), rr = r & 255, cc = col & 255;
        const size_t off = (size_t)(NTOK_P + r) * DM + col;
        *(f32x4*)(Y + off) = *(const f32x4*)(X1 + off) + part_sum(PART, tile, 0, 8, rr, cc); }
}

__device__ __forceinline__ void reduce_gu(Frame& F) {
    unsigned char* const ws = ws_ptr(F); const float* PART = (const float*)(ws + WS_PART); const float* RSTD = (const float*)(ws + WS_CTL) + CW_SSQ; bf16_t* H = (bf16_t*)(ws + WS_H);
    constexpr int nM = MTOK / 256, nN = 2 * DFF / 256, NW = nM * nN, RF = NW / 256, REM = NW - RF * 256;
    for (int it = F.gw * 64 + F.lane; it < REM * 256 * 32; it += F.NGW * 64) { const int t = it >> 13, rr = (it >> 5) & 255, cc = 4 * (it & 31);
        int pm, pn; pg8::map_unit(RF * 256 + t, nM, nN, pm, pn);
        const float* p0 = PART + (size_t)(2 * t) * 65536 + (size_t)rr * 256 + cc; const float* p1 = p0 + 65536;
        const f32x4 g = *(const f32x4*)p0 + *(const f32x4*)p1, u = *(const f32x4*)(p0 + 128) + *(const f32x4*)(p1 + 128);
        const size_t row = (size_t)pm * 256 + rr; const float rstd = RSTD[row];
        float h[4];
#pragma unroll
        for (int e = 0; e < 4; ++e) { const float gg = g[e] * rstd; h[e] = gg * sigmoidf_(gg) * (u[e] * rstd); }
        *(u32x2*)(H + row * DFF + pn * 128 + cc) = (u32x2){pk2(h[0], h[1]), pk2(h[2], h[3])}; }
}

__global__ void __launch_bounds__(NTHR, 2) fwd_kernel(Args args) {
    extern __shared__ __attribute__((aligned(16))) unsigned char lds_raw[];
    LAS unsigned char* const ldsb = (LAS unsigned char*)lds_raw;
    int wv0 = __builtin_amdgcn_readfirstlane((int)(threadIdx.x >> 6)); asm volatile("" : "+s"(wv0));
    Frame F = make_frame(ldsb, wv0);
    for (int u = F.tid; u < (LDS_BYTES - LDSCTL_OFF) / 4; u += NTHR) ((LAS unsigned*)(F.lds + LDSCTL_OFF))[u] = 0u;
    __syncthreads();
    if (F.tid == 0) { volatile LAS unsigned* p = (volatile LAS unsigned*)(F.lds + PTR_OFF);
#pragma unroll
        for (int i = 0; i < 25; ++i) { const unsigned long long v = (unsigned long long)args.in[i]; p[2 * i] = (unsigned)v; p[2 * i + 1] = (unsigned)(v >> 32); }
        { const unsigned long long v = (unsigned long long)args.out; p[50] = (unsigned)v; p[51] = (unsigned)(v >> 32); }
        { const unsigned long long v = (unsigned long long)args.ws; p[52] = (unsigned)v; p[53] = (unsigned)(v >> 32); } }
    __syncthreads();
    XcdBarrier bar = xcd_barrier_post(ctl_ptr(F) + CW_BAR, F.MISC + 8, wv0);

#define REP(n, ...) do { __VA_ARGS__; if constexpr ((DBL >> (n)) & 1) { xcd_barrier(bar); __VA_ARGS__; } } while (0)
#define GEMM_PHASE_C(EPI, AOFF, BOFF, LDA, LDB, KK, NN, BD, TAIL, CIDX) do { F = make_frame(ldsb, wv0); unsigned char* const ws = ws_ptr(F); \
        pg8::Gemm g{ws, (AOFF), (BOFF), (LDA), (LDB), (KK)}; pg8::StaticOrder S; S.init(MTOK, (NN), (KK), F.G, (CIDX), (BD), (TAIL)); \
        EPI E{F.lds}; pg8::gemm_phase<EPI, pg8::StaticOrder>(F.lds + RING_OFF, g, S, E, F.wave); } while (0)
#define GEMM_PHASE(EPI, AOFF, BOFF, LDA, LDB, KK, NN, BD, TAIL) GEMM_PHASE_C(EPI, AOFF, BOFF, LDA, LDB, KK, NN, BD, TAIL, (int)blockIdx.x)
    REP(0, F = make_frame(ldsb, wv0); p0_prologue(F));
    xcd_barrier(bar);
    REP(1, GEMM_PHASE(EpiProjA, WS_XN, WS_WI, DM, DM, DM, 41 * 256, 0, 0));
    REP(13, GEMM_PHASE_C(EpiProjB, WS_XN8, WS_WI8, DM / 2, DM / 2, DM / 2, 64 * 256, 0, 0, (int)(gridDim.x - 1 - blockIdx.x)));
    xcd_barrier(bar);
    REP(2, F = make_frame(ldsb, wv0); p2_phase(F));
    xcd_barrier(bar);
    REP(3, GEMM_PHASE(EpiGates, WS_U, WS_WG, DM, 256, 256, 32 * 256, 1, 0));
    REP(10, F = make_frame(ldsb, wv0); idx_phase(F));
    xcd_barrier(bar);
    REP(4, F = make_frame(ldsb, wv0); scan_summaries(F));
    REP(11, F = make_frame(ldsb, wv0); select_phase(F));
    xcd_barrier(bar);
    REP(5, F = make_frame(ldsb, wv0); scan_apply(F));
    REP(12, F = make_frame(ldsb, wv0); attn_phase(F, (char*)lds_raw + RING_OFF));
    xcd_barrier(bar);
    REP(6, GEMM_PHASE(EpiMix, WS_OAL, WS_WB, DM, DM, DM, DM, 0, 1));
    xcd_barrier(bar);
    if (gridDim.x == 256) { F = make_frame(ldsb, wv0); reduce_mix(F); xcd_barrier(bar); }
    GEMM_PHASE(EpiOut, WS_MIX, WS_WO, (P9_FP8 ? DM / 2 : DM), (P9_FP8 ? DM / 2 : DM), (P9_FP8 ? DM / 2 : DM), DM, 0, 1);
    xcd_barrier(bar);
    F = make_frame(ldsb, wv0); reduce_out(F, gridDim.x == 256); xcd_barrier(bar);
    REP(8, GEMM_PHASE(EpiGU, WS_A2, WS_WGU, DM, DM, DM, 2 * DFF, 0, 2));
    xcd_barrier(bar);
    if (gridDim.x == 256) { F = make_frame(ldsb, wv0); reduce_gu(F); xcd_barrier(bar); }
    REP(9, GEMM_PHASE(EpiDown, WS_H, WS_WD, DFF, DFF, DFF, DM, 0, 1));
    if (gridDim.x == 256) { xcd_barrier(bar); F = make_frame(ldsb, wv0); reduce_down(F); }
#undef REP
#undef GEMM_PHASE
#undef GEMM_PHASE_C
}

extern "C" void kernel_launch(void* const* d_in, const int* in_sizes, int n_in, void* d_out, int out_size, void* d_ws, size_t ws_size, hipStream_t stream) {
    static int grid = 0;
    if (grid == 0) {
        if (n_in != 25 || out_size != (int)O_END || ws_size < WS_END) { fprintf(stderr, "kernel_launch: unexpected shapes (n_in %d, out %d, ws %zu; need ws >= %zu); nothing launched\n", n_in, out_size, ws_size, (size_t)WS_END); grid = -1; return; }
        int dev = 0, cus = 0, per_cu = 0;
        if (hipGetDevice(&dev) != hipSuccess || hipDeviceGetAttribute(&cus, hipDeviceAttributeMultiprocessorCount, dev) != hipSuccess) { fprintf(stderr, "kernel_launch: device query failed\n"); grid = -1; return; }
        if (hipFuncSetAttribute((const void*)fwd_kernel, hipFuncAttributeMaxDynamicSharedMemorySize, LDS_BYTES) != hipSuccess) { fprintf(stderr, "kernel_launch: hipFuncSetAttribute failed\n"); grid = -1; return; }
        if (hipOccupancyMaxActiveBlocksPerMultiprocessor(&per_cu, (const void*)fwd_kernel, NTHR, LDS_BYTES) != hipSuccess || per_cu < 1) { fprintf(stderr, "kernel_launch: occupancy query reports %d blocks per CU\n", per_cu); }
        (void)hipGetLastError();
        grid = cus;
    }
    if (grid < 0) return;
    if (hipMemsetAsync((char*)d_ws + WS_CTL, 0, CTL_BYTES, stream) != hipSuccess) { fprintf(stderr, "kernel_launch: memset failed\n"); return; }
    Args a{};
    for (int i = 0; i < 25; ++i) a.in[i] = (const float*)d_in[i];
    a.out = (float*)d_out; a.ws = (unsigned char*)d_ws;
    hipLaunchKernelGGL(fwd_kernel, dim3(grid), dim3(NTHR), LDS_BYTES, stream, a);
    const hipError_t le = hipPeekAtLastError();
    if (le != hipSuccess) fprintf(stderr, "kernel_launch: launch failed: %s\n", hipGetErrorName(le));
}
```

```cpp
#include <hip/hip_runtime.h>
#include <cstdio>
#include <cstdint>

#ifndef DBL
#define DBL 0
#endif
#ifndef P9_FP8
#define P9_FP8 1
#endif
#ifndef FP8_MX
#define FP8_MX 2
#endif
#define LAS __attribute__((address_space(3)))
#define GAS __attribute__((address_space(1)))
typedef unsigned short bf16_t;
typedef short bf16x8 __attribute__((ext_vector_type(8)));
typedef float f32x4 __attribute__((ext_vector_type(4)));
typedef float f32x2 __attribute__((ext_vector_type(2)));
typedef float f32x16 __attribute__((ext_vector_type(16)));
typedef unsigned u32x4 __attribute__((ext_vector_type(4)));
typedef unsigned u32x2 __attribute__((ext_vector_type(2)));
typedef int i32x8 __attribute__((ext_vector_type(8)));

constexpr int DM = 4096, SEQ = 4096, NB_P = 2, NTOK_P = NB_P * SEQ, DEC_B = 16, DEC_T = 32, NTOK_S = DEC_B * DEC_T, MTOK = NTOK_P + NTOK_S;
constexpr int PAST = 2048, SKV_S = PAST + DEC_T, SKV_SP = 2112;
constexpr int NH = 32, NKVH = 8, HD = 128, KVW = NKVH * HD, IDXH = 32, IDXD = 128;
constexpr int DFF = 11008, TOPK = 256;
constexpr int N1 = 105 * 256;
constexpr int N1_SRC = 26784;
constexpr float EPS = 1e-6f;
static_assert(MTOK % 256 == 0 && DFF % 128 == 0, "tiling");

constexpr size_t O_YP = 0, O_YS = O_YP + (size_t)NTOK_P * DM, O_KP = O_YS + (size_t)NTOK_S * DM, O_VP = O_KP + (size_t)NTOK_P * KVW, O_IKP = O_VP + (size_t)NTOK_P * KVW,
                 O_LRUP = O_IKP + (size_t)NTOK_P * IDXD, O_CONVP = O_LRUP + (size_t)NB_P * DM, O_KS = O_CONVP + (size_t)NB_P * 3 * DM, O_VS = O_KS + (size_t)NTOK_S * KVW,
                 O_IKS = O_VS + (size_t)NTOK_S * KVW, O_LRUS = O_IKS + (size_t)NTOK_S * IDXD, O_CONVS = O_LRUS + (size_t)DEC_B * DM, O_END = O_CONVS + (size_t)DEC_B * 3 * DM;
static_assert(O_END == 54886400, "output size");

constexpr size_t al256(size_t x) { return (x + 255) & ~(size_t)255; }
constexpr size_t SZ_ACT = (size_t)MTOK * DM * 2;
constexpr size_t WS_CTL = 0, CTL_BYTES = 1u << 20;
constexpr size_t WS_ROPE = WS_CTL + CTL_BYTES;
constexpr size_t WS_WI = WS_ROPE + (size_t)4096 * 16 * 8;
constexpr size_t WS_WI8 = WS_WI + (size_t)41 * 256 * DM * 2;
constexpr size_t WS_XN8 = WS_WI8 + (size_t)64 * 256 * DM;
static_assert(WS_XN8 + (size_t)MTOK * DM <= WS_WI + (size_t)N1 * DM * 2, "WI region");
constexpr size_t WS_WB = WS_WI + (size_t)N1 * DM * 2;
constexpr size_t WS_WO = WS_WB + (size_t)DM * 2 * DM * 2;
constexpr size_t WS_WGU = WS_WO + (size_t)DM * DM * 2;
constexpr size_t WS_WD = WS_WGU + (size_t)2 * DFF * DM * 2;
constexpr size_t WS_WG = WS_WD + (size_t)DM * DFF * 2;
constexpr size_t WS_XN = WS_WG + (size_t)16 * 512 * 256 * 2;
constexpr size_t WS_Q = WS_XN + SZ_ACT;
constexpr size_t WS_IQ = WS_Q + SZ_ACT;
constexpr size_t WS_XL = WS_IQ + SZ_ACT;
constexpr size_t WS_GY = WS_XL + SZ_ACT;
constexpr size_t WS_SGA = WS_GY + SZ_ACT;
constexpr size_t WS_SGL = WS_SGA + SZ_ACT;
constexpr size_t WS_KV = WS_SGL + SZ_ACT;
constexpr size_t WS_IWK = WS_KV + (size_t)MTOK * 2048 * 2;
constexpr size_t WS_IKB = WS_IWK + (size_t)MTOK * 256 * 2;
constexpr size_t WS_IWF = WS_IKB + (size_t)MTOK * 128 * 2;
constexpr size_t WS_KVS = WS_IWF + (size_t)MTOK * 32 * 4;
constexpr size_t WS_IKS = WS_KVS + (size_t)DEC_B * SKV_SP * 2048 * 2;
constexpr size_t WS_SC = WS_IKS + (size_t)DEC_B * SKV_SP * 128 * 2;
constexpr size_t WS_SCS = WS_SC + (size_t)NTOK_P * SEQ * 4;
constexpr size_t WS_BM = WS_SCS + (size_t)NTOK_S * SKV_SP * 4;
constexpr size_t WS_AB = WS_BM + (size_t)MTOK * 512;
constexpr size_t WS_SUM = WS_AB + (size_t)MTOK * DM * 4;
constexpr size_t WS_OAL = WS_SUM + (size_t)128 * DM * 8;
constexpr size_t WS_END = WS_OAL + 2 * SZ_ACT;
constexpr size_t WS_PSSQ = WS_SUM;
constexpr size_t WS_H = WS_Q, WS_U = WS_XN, WS_MIX = WS_XN, WS_X1 = WS_AB, WS_A2 = WS_SC, WS_PART = WS_SC + SZ_ACT;
static_assert(WS_PART + (size_t)256 * 65536 * 4 <= WS_BM, "partial slots");
static_assert((size_t)MTOK * DFF * 2 <= 3 * SZ_ACT, "H overlay");
static_assert(WS_END <= (size_t)4 * 109707264 * 4, "workspace");

constexpr int CW_BAR = 0;
constexpr int CW_QATT = 4096;
constexpr int CW_QIDX = 4096 + 256;
constexpr int CW_SSQ = 8192;
static_assert((CW_SSQ + 2 * MTOK) * 4 <= (int)CTL_BYTES, "ctl");

__device__ __forceinline__ unsigned pk2(float lo, float hi) { unsigned r; asm volatile("v_cvt_pk_bf16_f32 %0, %1, %2" : "=v"(r) : "v"(lo), "v"(hi)); return r; }
__device__ __forceinline__ float bflo(unsigned w) { return __uint_as_float(w << 16); }
__device__ __forceinline__ float bfhi(unsigned w) { return __uint_as_float(w & 0xffff0000u); }
__device__ __forceinline__ float bf1(bf16_t b) { return __uint_as_float((unsigned)b << 16); }
__device__ __forceinline__ void unpack8(u32x4 w, float (&v)[8]) { v[0] = bflo(w.x); v[1] = bfhi(w.x); v[2] = bflo(w.y); v[3] = bfhi(w.y); v[4] = bflo(w.z); v[5] = bfhi(w.z); v[6] = bflo(w.w); v[7] = bfhi(w.w); }
__device__ __forceinline__ u32x4 pack8f(const float (&v)[8]) { u32x4 w; w.x = pk2(v[0], v[1]); w.y = pk2(v[2], v[3]); w.z = pk2(v[4], v[5]); w.w = pk2(v[6], v[7]); return w; }
__device__ __forceinline__ float sigmoidf_(float x) { return __builtin_amdgcn_rcpf(1.0f + __builtin_amdgcn_exp2f(-1.4426950408889634f * x)); }
__device__ __forceinline__ float gelu_tanh_(float x) {
    const float u = x * (1.0f + 0.044715f * x * x); return x * __builtin_amdgcn_rcpf(1.0f + __builtin_amdgcn_exp2f(-2.0f * 0.7978845608028654f * 1.4426950408889634f * u)); }
constexpr float SW8 = 64.f, SA_ATT = 8.f, SA_LRU = 4.f, S_MIX = 8.f, SXN = 4.f;
__device__ __forceinline__ unsigned pk4_fp8(float a, float b, float c, float d) { int w = __builtin_amdgcn_cvt_pk_fp8_f32(a, b, 0, false); w = __builtin_amdgcn_cvt_pk_fp8_f32(c, d, w, true); return (unsigned)w; }
#define LDS_WAIT() asm volatile("s_waitcnt lgkmcnt(0)" ::: "memory")
#define VM_WAIT() asm volatile("s_waitcnt vmcnt(0)" ::: "memory")

__device__ __forceinline__ int tid_of(int wv) { int l; asm volatile("v_mbcnt_lo_u32_b32 %0, -1, 0\n\tv_mbcnt_hi_u32_b32 %0, -1, %0" : "=v"(l)); return (wv << 6) | l; }
namespace pg8 {
typedef int i32x4_ __attribute__((ext_vector_type(4)));
constexpr int BM = 256, BK = 64, HALF = 128, HTB = HALF * BK * 2, STAGE_BYTES = 8 * HTB, NXCD = 8, WGM = 4;
__host__ __device__ __forceinline__ int lds_byte(int r, int c) { const int st = (r >> 4) * 2 + (c >> 5), rr = r & 15, cc = c & 31, ob = rr * 64 + cc * 2; return st * 1024 + (ob ^ (((ob >> 9) & 1) << 5)); }
__host__ __device__ __forceinline__ void stage_rc(int b, int& R, int& C) { const int st = b / 1024, sb = b % 1024, swz = sb ^ (((sb >> 9) & 1) << 5); R = (st >> 1) * 16 + swz / 64; C = (st & 1) * 32 + (swz % 64) / 2; }
__host__ __device__ __forceinline__ int perm32(int rho) { const int n = rho >> 4, i = rho & 15; return 8 * (i >> 2) + 4 * n + (i & 3); }

struct Unit { int pm, pn, acol, bcol, nt, part; };
struct Gemm { unsigned char* ws; size_t a_off, b_off; int lda, ldb, K; };

__device__ __forceinline__ void map_unit(int L, int nM, int nN, int& pm, int& pn) {
    const int nwg = nM * nN; int wgid = L; { const int q = nwg / NXCD, r = nwg % NXCD, xcd = wgid % NXCD, off = wgid / NXCD; wgid = (xcd < r ? xcd * (q + 1) : r * (q + 1) + (xcd - r) * q) + off; }
    const int nig = WGM * nN, gid = wgid / nig, fm = gid * WGM, gsz = (nM - fm) < WGM ? (nM - fm) : WGM;
    pm = fm + ((wgid % nig) % gsz); pn = (wgid % nig) / gsz;
}
struct StaticOrder {
    int nM, nN, nwg, G, c, blockdiag, ntk, tail;
    __device__ void init(int M, int N, int K, int G_, int c_, int bd = 0, int tail_ = 0) { tail = (G_ == 256) ? tail_ : 0; nM = M / BM - (tail == 1 ? 2 : 0); nN = N / BM; nwg = nM * nN; G = G_; c = c_; blockdiag = bd; ntk = K / BK; }
    __device__ bool next(int i, Unit& u) const {
        const long L = (long)i * G + c; const int rfull = nwg / G;
        const bool t2 = (tail == 2 && i >= rfull);
        const bool tl = (L >= nwg) && !t2;
        if (tl && (tail != 1 || i != rfull)) return false;
        if (t2 && (i > rfull || c >= 2 * (nwg - rfull * G))) return false;
        int pm0, pn0; map_unit(t2 ? rfull * G + (c >> 1) : (tl ? 0 : (int)L), nM, nN, pm0, pn0);
        const int tile = c >> 3, sp = c & 7, npair = ntk >> 1, base = npair >> 3, rem = npair & 7, p0 = sp * base + (sp < rem ? sp : rem), np = base + (sp < rem ? 1 : 0);
        const int pm = tl ? nM + (tile >> 4) : pm0, pn = tl ? (tile & 15) : pn0;
        const int koff = tl ? p0 * 2 * BK : (t2 ? (c & 1) * (ntk >> 1) * BK : 0);
        const int ac = koff + ((!tl && blockdiag) ? 256 * (pn0 >> 1) : 0);
        u = Unit{pm, pn, ac, koff, tl ? 2 * np : (t2 ? (ntk >> 1) : ntk), (tl || t2) ? c : -1};
        return true;
    }
};

template <class Epi, class Sched>
__device__ __forceinline__ void gemm_phase(LAS unsigned char* lds, const Gemm g, const Sched& S, const Epi& E, int wv) {
    const int tid = tid_of(wv);
    const int wid = __builtin_amdgcn_readfirstlane(tid >> 6), lane = tid & 63, wr = wid >> 2, wc = wid & 3, fr = lane & 15, fq = lane >> 4;
    unsigned voffA[2], voffB[2];
#pragma unroll
    for (int i = 0; i < 2; ++i) { int R, C; stage_rc(tid * 16 + i * 8192, R, C); const int Rb = Epi::PERM ? ((R & ~31) + perm32(R & 31)) : R;
        voffA[i] = (unsigned)(R * g.lda + C) * 2u; voffB[i] = (unsigned)(Rb * g.ldb + C) * 2u; }
    const size_t kstep = (size_t)(BK * 2);
    const size_t hstepA = (size_t)HALF * g.lda * 2, hstepB = (size_t)HALF * g.ldb * 2;
    const size_t tstepA = 2 * hstepA, tstepB = 2 * hstepB;
    const unsigned ldsw = (unsigned)wid * 1024u;
    constexpr bool FP8 = Epi::FP8;
    const int aoff = lds_byte(wr * 64 + fr, FP8 ? fq * 16 : fq * 8), boff = lds_byte(wc * 32 + fr, FP8 ? fq * 16 : fq * 8);
#define PG8_SA(b, h) (((b) * 2 + (h)) * HTB)
#define PG8_SB(b, h) ((4 + (b) * 2 + (h)) * HTB)
#define PG8_STAGE(bufoff, gbase, voff) do { _Pragma("unroll") for (int _i = 0; _i < 2; ++_i) \
        __builtin_amdgcn_global_load_lds((const unsigned*)((const char*)(gbase) + (voff)[_i]), (LAS unsigned*)(lds + (bufoff) + ldsw + _i * 8192), 16, 0, 0); } while (0)
#define PG8_P64(v, j) ((long)(((unsigned long)(unsigned)(v)[2 * (j) + 1] << 32) | (unsigned long)(unsigned)(v)[2 * (j)]))
#define PG8_LD32(p) __builtin_shufflevector(*(const LAS i32x4_*)(p), *(const LAS i32x4_*)((p) + 16), 0, 1, 2, 3, 4, 5, 6, 7)
#define PG8_LDA(dst, b, h) do { if constexpr (FP8) { _Pragma("unroll") for (int m = 0; m < 4; ++m) dst##8[m] = PG8_LD32(lds + PG8_SA(b, h) + aoff + m * 2048); } \
        else { _Pragma("unroll") for (int m = 0; m < 4; ++m) _Pragma("unroll") for (int k = 0; k < 2; ++k) dst[m][k] = *(const LAS bf16x8*)(lds + PG8_SA(b, h) + aoff + m * 2048 + k * 1024); } } while (0)
#define PG8_LDB(dst, b, h) do { if constexpr (FP8) { _Pragma("unroll") for (int n = 0; n < 2; ++n) dst##8[n] = PG8_LD32(lds + PG8_SB(b, h) + boff + n * 2048); } \
        else { _Pragma("unroll") for (int n = 0; n < 2; ++n) _Pragma("unroll") for (int k = 0; k < 2; ++k) dst[n][k] = *(const LAS bf16x8*)(lds + PG8_SB(b, h) + boff + n * 2048 + k * 1024); } } while (0)
#define PG8_MMA(ai, bj, At, Bt) do { __builtin_amdgcn_s_setprio(1); _Pragma("unroll") for (int m = 0; m < 4; ++m) _Pragma("unroll") for (int n = 0; n < 2; ++n) { \
        if constexpr (FP8 && FP8_MX == 2) asm volatile("v_mfma_f32_16x16x128_f8f6f4 %0, %1, %2, %0" : "+v"(acc[ai][bj][m][n]) : "v"(Bt##8[n]), "v"(At##8[m])); \
        else if constexpr (FP8 && FP8_MX == 1) acc[ai][bj][m][n] = __builtin_amdgcn_mfma_scale_f32_16x16x128_f8f6f4(Bt##8[n], At##8[m], acc[ai][bj][m][n], 0, 0, 0, 0, 0, 0); \
        else if constexpr (FP8) { _Pragma("unroll") for (int j = 0; j < 4; ++j) acc[ai][bj][m][n] = __builtin_amdgcn_mfma_f32_16x16x32_fp8_fp8(PG8_P64(Bt##8[n], j), PG8_P64(At##8[m], j), acc[ai][bj][m][n], 0, 0, 0); } \
        else { _Pragma("unroll") for (int k = 0; k < 2; ++k) acc[ai][bj][m][n] = __builtin_amdgcn_mfma_f32_16x16x32_bf16(Bt[n][k], At[m][k], acc[ai][bj][m][n], 0, 0, 0); } } __builtin_amdgcn_s_setprio(0); } while (0)
#define PG8_WAIT_V(n) asm volatile("s_waitcnt vmcnt(" #n ")" ::: "memory")
#define PG8_WAIT_L(n) asm volatile("s_waitcnt lgkmcnt(" #n ")" ::: "memory")
#define PG8_BAR __builtin_amdgcn_s_barrier()
#define PG8_SCHED __builtin_amdgcn_sched_barrier(0)
    Unit cur, nxt; int ui = 0;
    if (!S.next(0, cur)) return;
    f32x4 acc[2][2][4][2];
#pragma unroll
    for (int a = 0; a < 2; ++a)
#pragma unroll
        for (int b = 0; b < 2; ++b)
#pragma unroll
            for (int m = 0; m < 4; ++m)
#pragma unroll
                for (int n = 0; n < 2; ++n) acc[a][b][m][n] = (f32x4){0.f, 0.f, 0.f, 0.f};
    bf16x8 At[4][2], B0[2][2], B1[2][2]; i32x8 At8[4], B08[2], B18[2];
    const char* cA = (const char*)g.ws + g.a_off + (size_t)cur.pm * tstepA + (size_t)cur.acol * 2; const char* cB = (const char*)g.ws + g.b_off + (size_t)cur.pn * tstepB + (size_t)cur.bcol * 2;
    PG8_STAGE(PG8_SB(0, 0), cB, voffB); PG8_STAGE(PG8_SB(0, 1), cB + hstepB, voffB); PG8_STAGE(PG8_SA(0, 0), cA, voffA); PG8_STAGE(PG8_SA(0, 1), cA + hstepA, voffA);
    if (wr == 1) PG8_BAR;
    PG8_WAIT_V(2); PG8_BAR;
    PG8_STAGE(PG8_SB(1, 0), cB + kstep, voffB); PG8_STAGE(PG8_SA(1, 0), cA + kstep, voffA); PG8_STAGE(PG8_SB(1, 1), cB + hstepB + kstep, voffB);
    PG8_WAIT_V(6); PG8_BAR;
    for (;;) {
        const bool has_next = S.next(ui + 1, nxt);
        const char* nA = has_next ? (const char*)g.ws + g.a_off + (size_t)nxt.pm * tstepA + (size_t)nxt.acol * 2 : cA; const char* nB = has_next ? (const char*)g.ws + g.b_off + (size_t)nxt.pn * tstepB + (size_t)nxt.bcol * 2 : cB;
        const int nt = cur.nt;
        for (int t = 0; t < nt; t += 2) {
            const bool last = (t == nt - 2);
            const char* a1 = cA + (size_t)(t + 1) * kstep;
            const char* a2 = last ? nA : cA + (size_t)(t + 2) * kstep; const char* b2 = last ? nB : cB + (size_t)(t + 2) * kstep;
            const char* a3 = a2 + kstep; const char* b3 = b2 + kstep;
            if constexpr (Epi::MID) { if (cur.part < 0 && t == (nt >> 1)) { if constexpr (FP8 && FP8_MX == 2) asm volatile("s_nop 15\n\ts_nop 15" ::: "memory"); E.mid(acc, cur, wr, wc, fr, fq); } }
            PG8_LDB(B0, 0, 0); PG8_LDB(B1, 0, 1); PG8_SCHED; PG8_LDA(At, 0, 0); PG8_STAGE(PG8_SA(1, 1), a1 + hstepA, voffA);
            PG8_WAIT_V(8); PG8_WAIT_L(0); PG8_BAR; PG8_MMA(0, 0, At, B0); PG8_MMA(0, 1, At, B1); PG8_BAR; PG8_SCHED;
            PG8_LDA(At, 0, 1); PG8_STAGE(PG8_SB(0, 0), b2, voffB); PG8_STAGE(PG8_SB(0, 1), b2 + hstepB, voffB); PG8_STAGE(PG8_SA(0, 0), a2, voffA);
            PG8_WAIT_V(8); PG8_WAIT_L(0); PG8_BAR; PG8_MMA(1, 0, At, B0); PG8_MMA(1, 1, At, B1); PG8_BAR; PG8_SCHED;
            PG8_LDB(B0, 1, 0); PG8_LDB(B1, 1, 1); PG8_SCHED; PG8_LDA(At, 1, 0); PG8_STAGE(PG8_SA(0, 1), a2 + hstepA, voffA);
            PG8_WAIT_V(8); PG8_WAIT_L(0); PG8_BAR; PG8_MMA(0, 0, At, B0); PG8_MMA(0, 1, At, B1); PG8_BAR; PG8_SCHED;
            PG8_LDA(At, 1, 1); PG8_STAGE(PG8_SB(1, 0), b3, voffB); PG8_STAGE(PG8_SB(1, 1), b3 + hstepB, voffB); PG8_STAGE(PG8_SA(1, 0), a3, voffA);
            PG8_WAIT_V(8); PG8_WAIT_L(0); PG8_BAR; PG8_MMA(1, 0, At, B0); PG8_MMA(1, 1, At, B1); PG8_BAR; PG8_SCHED;
        }
        if (wr == 0) PG8_BAR;
        if constexpr (FP8 && FP8_MX == 2) asm volatile("s_nop 15\n\ts_nop 15" ::: "memory");
        int fr_ = fr, fq_ = fq; asm volatile("" : "+v"(fr_), "+v"(fq_));
        if (cur.part < 0) E(acc, cur, wr, wc, fr_, fq_);
        else {
            float* P = (float*)(g.ws + WS_PART) + (size_t)cur.part * (BM * BM) + (size_t)(wr * 64 + fr_) * BM + wc * 32 + (Epi::PERM ? 8 * fq_ : 4 * fq_);
#pragma unroll
            for (int ai = 0; ai < 2; ++ai)
#pragma unroll
                for (int m = 0; m < 4; ++m)
#pragma unroll
                    for (int bj = 0; bj < 2; ++bj)
#pragma unroll
                        for (int n = 0; n < 2; ++n) *(f32x4*)(P + (size_t)(ai * HALF + m * 16) * BM + bj * HALF + (Epi::PERM ? 4 * n : 16 * n)) = acc[ai][bj][m][n]; }
        if (!has_next) break;
#pragma unroll
        for (int a = 0; a < 2; ++a)
#pragma unroll
            for (int b = 0; b < 2; ++b)
#pragma unroll
                for (int m = 0; m < 4; ++m)
#pragma unroll
                    for (int n = 0; n < 2; ++n) acc[a][b][m][n] = (f32x4){0.f, 0.f, 0.f, 0.f};
        cur = nxt; cA = nA; cB = nB; ++ui;
        if (wr == 1) PG8_BAR;
    }
    PG8_WAIT_V(0);
    PG8_BAR;
#undef PG8_SA
#undef PG8_SB
#undef PG8_STAGE
#undef PG8_LDA
#undef PG8_LDB
#undef PG8_MMA
#undef PG8_LD32
#undef PG8_P64
#undef PG8_WAIT_V
#undef PG8_WAIT_L
#undef PG8_BAR
#undef PG8_SCHED
}
}

#define XB_TMO      128
#define XB_XCNT(j)  (256  + 64 * (j))
#define XB_XSUB(j)  (1280 + 64 * (j))
#define XB_XGEN(j)  (2304 + 64 * (j))
#define XB_TOP      3328
#define XB_TOPGEN   3392
#define XCD_BAR_WORDS 3456
#define XB_SPIN_CAP (1u << 18)
__device__ __forceinline__ unsigned xb_ld(unsigned* p)              { return __hip_atomic_load(p, __ATOMIC_RELAXED, __HIP_MEMORY_SCOPE_AGENT); }
__device__ __forceinline__ unsigned xb_add(unsigned* p, unsigned v) { return __hip_atomic_fetch_add(p, v, __ATOMIC_RELAXED, __HIP_MEMORY_SCOPE_AGENT); }
__device__ __forceinline__ unsigned xb_xcc_id() { return (unsigned)__builtin_amdgcn_s_getreg((3 << 11) | 20) & 0xFu; }
#define XB_SPIN(cond, bar) do { unsigned _sp = 0; while (cond) { __builtin_amdgcn_s_sleep(1); \
    if ((++_sp & 255u) == 0u) { if (xb_ld(&(bar)[XB_TMO])) break; if (_sp > XB_SPIN_CAP) { atomicAdd(&(bar)[XB_TMO], 1u); break; } } } } while (0)
struct XcdBarrier { unsigned* bar; unsigned x; volatile LAS unsigned* st; int wv; };
__device__ __forceinline__ bool xb_leader(int wv) { return wv == 0 && __builtin_amdgcn_mbcnt_hi(~0u, __builtin_amdgcn_mbcnt_lo(~0u, 0u)) == 0u; }
__device__ __forceinline__ XcdBarrier xcd_barrier_post(unsigned* bar, volatile LAS unsigned* st, int wv) {
    XcdBarrier b; b.bar = bar; b.x = xb_xcc_id(); b.st = st; b.wv = wv;
    if (xb_leader(wv)) (void)xb_add(&bar[XB_XCNT(b.x)], 1u);
    return b;
}
__device__ __forceinline__ void xcd_barrier_complete(unsigned* bar, unsigned x, unsigned& nloc, unsigned& nx) {
    const unsigned G = gridDim.x * gridDim.y * gridDim.z;
    unsigned sum, cnt, mine, sp = 0u;
    for (;;) {
        sum = 0u; cnt = 0u; mine = 0u;
#pragma unroll
        for (unsigned j = 0; j < 16; ++j) { const unsigned c = xb_ld(&bar[XB_XCNT(j)]); sum += c; cnt += (c > 0u) ? 1u : 0u; mine = (j == x) ? c : mine; }
        if (sum == G) break;
        __builtin_amdgcn_s_sleep(1);
        if ((++sp & 255u) == 0u) { if (xb_ld(&bar[XB_TMO])) break; if (sp > XB_SPIN_CAP) { atomicAdd(&bar[XB_TMO], 1u); break; } }
    }
    nloc = mine > 0u ? mine : 1u; nx = cnt > 0u ? cnt : 1u;
}
__device__ __forceinline__ void xcd_barrier(const XcdBarrier& b) {
    asm volatile("s_waitcnt vmcnt(0)" ::: "memory");
    __syncthreads();
    if (xb_leader(b.wv)) {
        unsigned* bar = b.bar;
        __builtin_amdgcn_s_waitcnt(0);
        unsigned nloc = b.st[0], nx = b.st[1];
        if (nloc == 0u) { xcd_barrier_complete(bar, b.x, nloc, nx); b.st[0] = nloc; b.st[1] = nx; }
        const unsigned old = xb_add(&bar[XB_XSUB(b.x)], 1u);
        const unsigned gen = old / nloc;
        if (old + 1u == (gen + 1u) * nloc) {
            __builtin_amdgcn_fence(__ATOMIC_RELEASE, "agent");
            asm volatile("s_waitcnt vmcnt(0)" ::: "memory");
            const unsigned og = xb_add(&bar[XB_TOP], 1u);
            const unsigned tg = og / nx;
            if (og + 1u == (tg + 1u) * nx) xb_add(&bar[XB_TOPGEN], 1u);
            else XB_SPIN(xb_ld(&bar[XB_TOPGEN]) == tg, bar);
            __builtin_amdgcn_fence(__ATOMIC_ACQUIRE, "agent");
            xb_add(&bar[XB_XGEN(b.x)], 1u);
            asm volatile("s_waitcnt vmcnt(0)" ::: "memory");
        } else {
            XB_SPIN(xb_ld(&bar[XB_XGEN(b.x)]) == gen, bar);
            __builtin_amdgcn_fence(__ATOMIC_ACQUIRE, "agent");
            asm volatile("s_waitcnt vmcnt(0)" ::: "memory");
        }
    }
    __syncthreads();
}

constexpr int NWAVES = 8, NTHR = 512;
constexpr int RING_OFF = 0, RING_BYTES = 131072;
constexpr int LDSCTL_OFF = RING_BYTES, MISC_OFF = LDSCTL_OFF + 320;
constexpr int LDS_BYTES = 147456;
struct Args { const float* in[25]; float* out; unsigned char* ws; };
constexpr int PTR_OFF = MISC_OFF + 128;
static_assert(PTR_OFF + 28 * 8 <= LDS_BYTES, "LDS map");
struct Frame {
    LAS unsigned char* lds; volatile LAS unsigned* MISC;
    int tid, lane, wave, vcu, G, gw, NGW;
};
__device__ __forceinline__ Frame make_frame(LAS unsigned char* lds, int wv) {
    Frame F; F.lds = lds; F.MISC = (volatile LAS unsigned*)(lds + MISC_OFF);
    const int t = tid_of(wv);
    F.tid = t; F.lane = t & 63; F.wave = wv;
    F.G = gridDim.x; { const int bx = blockIdx.x; F.vcu = (F.G % 8 == 0) ? (bx % 8) * (F.G / 8) + bx / 8 : bx; }
    F.gw = F.vcu * NWAVES + F.wave; F.NGW = F.G * NWAVES; return F;
}
__device__ __forceinline__ unsigned long long ldsb_u64(LAS unsigned char* lds, int i) {
    volatile LAS unsigned* p = (volatile LAS unsigned*)(lds + PTR_OFF) + 2 * i;
    const unsigned lo = __builtin_amdgcn_readfirstlane(p[0]), hi = __builtin_amdgcn_readfirstlane(p[1]);
    return ((unsigned long long)hi << 32) | lo;
}
__device__ __forceinline__ const float* e_in(LAS unsigned char* lds, int i) { return (const float*)(const GAS float*)ldsb_u64(lds, i); }
__device__ __forceinline__ float* e_out(LAS unsigned char* lds) { return (float*)(GAS float*)ldsb_u64(lds, 25); }
__device__ __forceinline__ unsigned char* e_ws(LAS unsigned char* lds) { return (unsigned char*)(GAS unsigned char*)ldsb_u64(lds, 26); }
__device__ __forceinline__ unsigned long long lds_u64(const Frame& F, int i) {
    volatile LAS unsigned* p = (volatile LAS unsigned*)(F.lds + PTR_OFF) + 2 * i;
    const unsigned lo = __builtin_amdgcn_readfirstlane(p[0]), hi = __builtin_amdgcn_readfirstlane(p[1]);
    return ((unsigned long long)hi << 32) | lo;
}
__device__ __forceinline__ const float* in_ptr(const Frame& F, int i) { return (const float*)(const GAS float*)lds_u64(F, i); }
__device__ __forceinline__ float* out_ptr(const Frame& F) { return (float*)(GAS float*)lds_u64(F, 25); }
__device__ __forceinline__ unsigned char* ws_ptr(const Frame& F) { return (unsigned char*)(GAS unsigned char*)lds_u64(F, 26); }
__device__ __forceinline__ unsigned* ctl_ptr(const Frame& F) { return (unsigned*)(ws_ptr(F) + WS_CTL); }

__device__ __forceinline__ void tr_item(const float* src, size_t spitch, int k0, int c0, bf16_t* dst, size_t dpitch, int r0, LAS unsigned* scr, int lane) {
    const int ln = lane & 7, g = lane >> 3;
    if (src == nullptr) {
#pragma unroll
        for (int j = 0; j < 8; ++j) { const int n = 4 * j + (lane >> 4), c = lane & 15; *(u32x4*)(dst + (size_t)(r0 + n) * dpitch + k0 + 8 * c) = (u32x4){0u, 0u, 0u, 0u}; }
        return;
    }
    f32x4 v[16];
#pragma unroll
    for (int i = 0; i < 16; ++i) { const int k = k0 + 16 * (i >> 1) + 2 * g + (i & 1); v[i] = __builtin_nontemporal_load((const f32x4*)(src + (size_t)k * spitch + c0 + 4 * ln)); }
#pragma unroll
    for (int ip = 0; ip < 8; ++ip)
#pragma unroll
        for (int c = 0; c < 4; ++c) scr[(4 * ln + c) * 65 + 8 * ip + g] = pk2(v[2 * ip][c], v[2 * ip + 1][c]);
    LDS_WAIT();
#pragma unroll
    for (int j = 0; j < 8; ++j) { const int n = 4 * j + (lane >> 4), c = lane & 15; const LAS unsigned* s = scr + n * 65 + 4 * c;
        u32x4 o; o.x = s[0]; o.y = s[1]; o.z = s[2]; o.w = s[3];
        *(u32x4*)(dst + (size_t)(r0 + n) * dpitch + k0 + 8 * c) = o; }
    LDS_WAIT();
}
__device__ __forceinline__ void tr_item8(const float* src, size_t spitch, int k0, int c0, unsigned char* dst, size_t dpitch, int r0, float scale, LAS unsigned* scr, int lane) {
    const int ln = lane & 7, g = lane >> 3;
    f32x4 v[16];
#pragma unroll
    for (int i = 0; i < 16; ++i) { const int k = k0 + 32 * (i >> 2) + 4 * g + (i & 3); v[i] = __builtin_nontemporal_load((const f32x4*)(src + (size_t)k * spitch + c0 + 4 * ln)); }
#pragma unroll
    for (int ib = 0; ib < 4; ++ib)
#pragma unroll
        for (int c = 0; c < 4; ++c) scr[(4 * ln + c) * 33 + 8 * ib + g] = pk4_fp8(v[4 * ib][c] * scale, v[4 * ib + 1][c] * scale, v[4 * ib + 2][c] * scale, v[4 * ib + 3][c] * scale);
    LDS_WAIT();
#pragma unroll
    for (int j = 0; j < 4; ++j) { const int n = 8 * j + (lane >> 3), c8 = lane & 7; const LAS unsigned* p = scr + n * 33 + 4 * c8;
        u32x4 o; o.x = p[0]; o.y = p[1]; o.z = p[2]; o.w = p[3];
        *(u32x4*)(dst + (size_t)(r0 + n) * dpitch + k0 + 16 * c8) = o; }
    LDS_WAIT();
}
__device__ __forceinline__ float wave_sum(float v) {
#pragma unroll
    for (int o = 1; o < 64; o <<= 1) v += __shfl_xor(v, o);
    return v;
}
struct TrDesc { const float* src; unsigned char* dst; int spitch, dpitch  ; int k0, c0, r0, f8; };
struct TrPtrs { const float *w_in, *w_branch, *w_out, *w_gate, *w_up, *w_down, *wa, *wx; unsigned char* ws; };
__device__ __forceinline__ TrDesc tr_decode(const TrPtrs& P, int it) {
    constexpr int I0 = 32 * 840, I1 = 64 * 128, I2 = 32 * 128, I3 = 32 * 688, I4 = 86 * 128;
    TrDesc d; int r = it;
    if (r < I0) { const int kb = r / 840, gidx = r % 840, pn = gidx >> 3, gi = gidx & 7; int c0; const float* src = P.w_in;
        if (gidx < 320) c0 = 32 * gidx; else if (gidx < 324) c0 = 10272 + 32 * (gidx - 320); else if (gidx == 324) c0 = 10240; else if (gidx < 328) { c0 = 0; src = nullptr; } else c0 = 32 * gidx - 96;
        const bool f8 = pn < 16 || pn >= 57; const int lt = pn < 16 ? pn : (pn < 24 ? pn - 16 : (pn < 40 ? pn - 16 : (pn < 41 ? 24 : (pn < 57 ? pn - 16 : pn - 41))));
        d = TrDesc{src, P.ws + (f8 ? WS_WI8 : WS_WI), N1_SRC, f8 ? DM : 2 * DM, 128 * kb, c0, 256 * lt + 32 * gi, f8 ? 1 : 0}; return d; } r -= I0;
    if (r < I1) { const int kb = r / 128, gidx = r % 128; d = TrDesc{P.w_branch, P.ws + WS_WB, DM, 2 * DM, 128 * kb, 32 * gidx, 32 * gidx, 1}; return d; } r -= I1;
    if (r < I2) { const int kb = r / 128, gidx = r % 128; d = TrDesc{P.w_out, P.ws + WS_WO, DM, P9_FP8 ? DM : 2 * DM, 128 * kb, 32 * gidx, 32 * gidx, P9_FP8 ? 1 : 0}; return d; } r -= I2;
    if (r < I3) { const int kb = r / 688, gidx = r % 688, pn = gidx >> 3, gi = gidx & 7; d = TrDesc{(gi < 4) ? P.w_gate : P.w_up, P.ws + WS_WGU, DFF, 2 * DM, 128 * kb, 128 * pn + 32 * (gi & 3), 32 * gidx, 0}; return d; } r -= I3;
    if (r < I4) { const int kb = r / 128, gidx = r % 128; d = TrDesc{P.w_down, P.ws + WS_WD, DM, 2 * DFF, 128 * kb, 32 * gidx, 32 * gidx, 0}; return d; } r -= I4;
    { const int kb = r / 256, gidx = r % 256, tn = gidx >> 3, gi = gidx & 7, blk = tn >> 1, hh = tn & 1;
      d = TrDesc{((gi < 4) ? P.wa : P.wx) + (size_t)blk * 65536, P.ws + WS_WG, 256, 512, 128 * kb, 128 * hh + 32 * (gi & 3), 32 * gidx, 0}; return d; }
}
__device__ __forceinline__ void tr_load(const TrDesc& d, f32x4 (&v)[16], int lane) {
    if (d.src == nullptr) return;
    const int ln = lane & 7, g = lane >> 3; const float* p = d.src + d.c0 + 4 * ln;
    if (d.f8) {
#pragma unroll
        for (int i = 0; i < 16; ++i) v[i] = __builtin_nontemporal_load((const f32x4*)(p + (size_t)(d.k0 + 32 * (i >> 2) + 4 * g + (i & 3)) * d.spitch)); }
    else {
#pragma unroll
        for (int i = 0; i < 16; ++i) v[i] = __builtin_nontemporal_load((const f32x4*)(p + (size_t)(d.k0 + 16 * (i >> 1) + 2 * g + (i & 1)) * d.spitch)); }
}
__device__ __forceinline__ void tr_store(const TrDesc& d, const f32x4 (&v)[16], LAS unsigned* scr, int lane) {
    const int ln = lane & 7, g = lane >> 3;
    if (d.f8) {
#pragma unroll
        for (int ib = 0; ib < 4; ++ib)
#pragma unroll
            for (int c = 0; c < 4; ++c) scr[(4 * ln + c) * 33 + 8 * ib + g] = pk4_fp8(v[4 * ib][c] * SW8, v[4 * ib + 1][c] * SW8, v[4 * ib + 2][c] * SW8, v[4 * ib + 3][c] * SW8);
        LDS_WAIT();
#pragma unroll
        for (int j = 0; j < 4; ++j) { const int n = 8 * j + (lane >> 3), c8 = lane & 7; const LAS unsigned* p = scr + n * 33 + 4 * c8;
            *(u32x4*)(d.dst + (size_t)(d.r0 + n) * d.dpitch + d.k0 + 16 * c8) = (u32x4){p[0], p[1], p[2], p[3]}; }
        LDS_WAIT();
    } else if (d.src == nullptr) {
#pragma unroll
        for (int j = 0; j < 8; ++j) { const int n = 4 * j + (lane >> 4), c = lane & 15; *(u32x4*)(d.dst + (size_t)(d.r0 + n) * d.dpitch + 2 * d.k0 + 16 * c) = (u32x4){0u, 0u, 0u, 0u}; }
    } else {
#pragma unroll
        for (int ip = 0; ip < 8; ++ip)
#pragma unroll
            for (int c = 0; c < 4; ++c) scr[(4 * ln + c) * 65 + 8 * ip + g] = pk2(v[2 * ip][c], v[2 * ip + 1][c]);
        LDS_WAIT();
#pragma unroll
        for (int j = 0; j < 8; ++j) { const int n = 4 * j + (lane >> 4), c = lane & 15; const LAS unsigned* p = scr + n * 65 + 4 * c;
            *(u32x4*)(d.dst + (size_t)(d.r0 + n) * d.dpitch + 2 * d.k0 + 16 * c) = (u32x4){p[0], p[1], p[2], p[3]}; }
        LDS_WAIT();
    }
}
constexpr int CONV_BASE = 32 * 840, CONV_N = 64 * 128 + 32 * 128 + 32 * 688 + 86 * 128;
constexpr int CW_QCONV = 4096 + 512;
__device__ __forceinline__ void conv_drain(Frame& F) {
    unsigned char* const ws = ws_ptr(F); unsigned* head = ctl_ptr(F) + CW_QCONV;
    LAS unsigned* scr = (LAS unsigned*)(F.lds + RING_OFF + F.wave * 16384);
    TrPtrs P{in_ptr(F, 8), in_ptr(F, 19), in_ptr(F, 20), in_ptr(F, 22), in_ptr(F, 23), in_ptr(F, 24), in_ptr(F, 14), in_ptr(F, 16), ws};
    constexpr int NQ8 = (CONV_N * 7 / 8) / 8, REST0 = NQ8 * 8, NQ = NQ8 + (CONV_N - REST0) / 2;
    static_assert((CONV_N - REST0) % 2 == 0, "pairs");
    int q = 0; if (F.lane == 0) q = (int)__hip_atomic_fetch_add(head, 1u, __ATOMIC_RELAXED, __HIP_MEMORY_SCOPE_AGENT);
    q = __builtin_amdgcn_readfirstlane(q);
    while (q < NQ) {
        int qn = 0; if (F.lane == 0) qn = (int)__hip_atomic_fetch_add(head, 1u, __ATOMIC_RELAXED, __HIP_MEMORY_SCOPE_AGENT);
        const int i0 = CONV_BASE + (q < NQ8 ? 8 * q : REST0 + 2 * (q - NQ8)), n = q < NQ8 ? 8 : 2;
#pragma unroll 1
        for (int j = 0; j < n; j += 2) {
            const TrDesc da = tr_decode(P, i0 + j), db = tr_decode(P, i0 + j + 1);
            f32x4 va[16], vb[16]; tr_load(da, va, F.lane); tr_load(db, vb, F.lane);
            tr_store(da, va, scr, F.lane); tr_store(db, vb, scr, F.lane);
        }
        q = __builtin_amdgcn_readfirstlane(qn);
    }
}
__device__ __forceinline__ void p0_prologue(Frame& F) {
    unsigned char* const ws = ws_ptr(F); const float* const in0 = in_ptr(F, 0); const float* const in1 = in_ptr(F, 1); const float* const in2 = in_ptr(F, 2); const float* const in3 = in_ptr(F, 3); const float* const in4 = in_ptr(F, 4); const float* const in7 = in_ptr(F, 7); const float* const in8 = in_ptr(F, 8); const float* const in14 = in_ptr(F, 14); const float* const in16 = in_ptr(F, 16); const float* const in19 = in_ptr(F, 19); const float* const in20 = in_ptr(F, 20); const float* const in22 = in_ptr(F, 22); const float* const in23 = in_ptr(F, 23); const float* const in24 = in_ptr(F, 24);
    LAS unsigned* scr = (LAS unsigned*)(F.lds + RING_OFF + F.wave * 16384);
    const int lane = F.lane;
    constexpr int I0 = 32 * 840, I1 = 64 * 128, I2 = 32 * 128, I3 = 32 * 688, I4 = 86 * 128, I5 = 2 * 256;
    constexpr int NITEMS = I0 + I1 + I2 + I3 + I4 + I5;
    bf16_t* WI = (bf16_t*)(ws + WS_WI); bf16_t* WB = (bf16_t*)(ws + WS_WB); bf16_t* WO = (bf16_t*)(ws + WS_WO); bf16_t* WGU = (bf16_t*)(ws + WS_WGU); bf16_t* WD = (bf16_t*)(ws + WS_WD); bf16_t* WG = (bf16_t*)(ws + WS_WG);
    for (int jt = F.gw; jt < NITEMS - CONV_N; jt += F.NGW) { const int it = jt < I0 ? jt : jt + CONV_N;
        int r = it;
        if (r < I0) { const int kb = r / 840, gidx = r % 840, pn = gidx >> 3, gi = gidx & 7; int c0; const float* src = in8;
            if (gidx < 320) c0 = 32 * gidx; else if (gidx < 324) c0 = 10272 + 32 * (gidx - 320); else if (gidx == 324) c0 = 10240; else if (gidx < 328) { c0 = 0; src = nullptr; } else c0 = 32 * gidx - 96;
            const bool f8 = pn < 16 || pn >= 57; const int lt = pn < 16 ? pn : (pn < 24 ? pn - 16 : (pn < 40 ? pn - 16 : (pn < 41 ? 24 : (pn < 57 ? pn - 16 : pn - 41))));
            if (f8) tr_item8(src, N1_SRC, 128 * kb, c0, ws + WS_WI8, DM, 256 * lt + 32 * gi, SW8, scr, lane);
            else tr_item(src, N1_SRC, 128 * kb, c0, WI, DM, 256 * lt + 32 * gi, scr, lane);
            continue; } r -= I0;
        if (r < I1) { const int kb = r / 128, gidx = r % 128; tr_item8(in19, DM, 128 * kb, 32 * gidx, (unsigned char*)WB, 2 * DM, 32 * gidx, SW8, scr, lane); continue; } r -= I1;
        if (r < I2) { const int kb = r / 128, gidx = r % 128;
            if (P9_FP8) tr_item8(in20, DM, 128 * kb, 32 * gidx, (unsigned char*)WO, DM, 32 * gidx, SW8, scr, lane); else tr_item(in20, DM, 128 * kb, 32 * gidx, WO, DM, 32 * gidx, scr, lane);
            continue; } r -= I2;
        if (r < I3) { const int kb = r / 688, gidx = r % 688, pn = gidx >> 3, gi = gidx & 7; const float* src = (gi < 4) ? in22 : in23;
            tr_item(src, DFF, 128 * kb, 128 * pn + 32 * (gi & 3), WGU, DM, 32 * gidx, scr, lane); continue; } r -= I3;
        if (r < I4) { const int kb = r / 128, gidx = r % 128; tr_item(in24, DM, 128 * kb, 32 * gidx, WD, DFF, 32 * gidx, scr, lane); continue; } r -= I4;
        { const int kb = r / 256, gidx = r % 256, tn = gidx >> 3, gi = gidx & 7, blk = tn >> 1, hh = tn & 1; const float* src = ((gi < 4) ? in14 : in16) + (size_t)blk * 65536;
            tr_item(src, 256, 128 * kb, 128 * hh + 32 * (gi & 3), WG, 256, 32 * gidx, scr, lane); }
    }
    {
        bf16_t* XN = (bf16_t*)(ws + WS_XN); const float* gm = in7;
        f32x4 ggv[16];
#pragma unroll
        for (int j = 0; j < 16; ++j) ggv[j] = *(const f32x4*)(gm + 4 * lane + 256 * j);
        for (int m = F.gw; m < MTOK; m += F.NGW) {
            const float* xr = (m < NTOK_P) ? in0 + (size_t)m * DM : in1 + (size_t)(m - NTOK_P) * DM;
            f32x4 v[16]; float s = 0.f;
#pragma unroll
            for (int j = 0; j < 16; ++j) { v[j] = __builtin_nontemporal_load((const f32x4*)(xr + 4 * lane + 256 * j)); s += (v[j].x * v[j].x + v[j].y * v[j].y) + (v[j].z * v[j].z + v[j].w * v[j].w); }
            const float rstd = 1.0f / sqrtf(wave_sum(s) * (1.0f / DM) + EPS);
#pragma unroll
            for (int j = 0; j < 16; ++j) { const f32x4 gg = ggv[j];
                u32x2 o; o.x = pk2(v[j].x * rstd * gg.x, v[j].y * rstd * gg.y); o.y = pk2(v[j].z * rstd * gg.z, v[j].w * rstd * gg.w);
                *(u32x2*)(XN + (size_t)m * DM + 4 * lane + 256 * j) = o;
                *(unsigned*)(ws + WS_XN8 + (size_t)m * DM + 4 * lane + 256 * j) = pk4_fp8(v[j].x * rstd * gg.x * SXN, v[j].y * rstd * gg.y * SXN, v[j].z * rstd * gg.z * SXN, v[j].w * rstd * gg.w * SXN); }
        }
    }
    {
        f32x2* RT = (f32x2*)(ws + WS_ROPE);
        for (int i = F.gw * 64 + lane; i < 4096 * 16; i += F.NGW * 64) { const int pos = i >> 4, j = i & 15;
            const double inv = pow(500000.0, -(double)j / 16.0); const double ang = (double)pos * inv; RT[i] = (f32x2){(float)cos(ang), (float)sin(ang)}; }
    }
    {
        bf16_t* KVS = (bf16_t*)(ws + WS_KVS); bf16_t* IKS = (bf16_t*)(ws + WS_IKS);
        const size_t gt = (size_t)F.gw * 64 + lane, GT = (size_t)F.NGW * 64;
        for (size_t i = gt; i < (size_t)DEC_B * PAST * 128; i += 2 * GT) {
            size_t ia[2]; ia[0] = i; ia[1] = (i + GT < (size_t)DEC_B * PAST * 128) ? i + GT : i;
            f32x4 kk[2][2], vv[2][2];
#pragma unroll
            for (int h = 0; h < 2; ++h) { const size_t row = ia[h] >> 7; const int ch = (int)(ia[h] & 127);
                kk[h][0] = __builtin_nontemporal_load((const f32x4*)(in2 + row * 1024 + 8 * ch)); kk[h][1] = __builtin_nontemporal_load((const f32x4*)(in2 + row * 1024 + 8 * ch + 4));
                vv[h][0] = __builtin_nontemporal_load((const f32x4*)(in3 + row * 1024 + 8 * ch)); vv[h][1] = __builtin_nontemporal_load((const f32x4*)(in3 + row * 1024 + 8 * ch + 4)); }
            asm volatile("" ::: "memory");
#pragma unroll
            for (int h = 0; h < 2; ++h) { const size_t row = ia[h] >> 7; const int ch = (int)(ia[h] & 127); const size_t b = row >> 11, sidx = row & 2047;
                bf16_t* d = KVS + (b * SKV_SP + sidx) * 2048 + 8 * ch;
                *(u32x4*)d = (u32x4){pk2(kk[h][0].x, kk[h][0].y), pk2(kk[h][0].z, kk[h][0].w), pk2(kk[h][1].x, kk[h][1].y), pk2(kk[h][1].z, kk[h][1].w)};
                *(u32x4*)(d + 1024) = (u32x4){pk2(vv[h][0].x, vv[h][0].y), pk2(vv[h][0].z, vv[h][0].w), pk2(vv[h][1].x, vv[h][1].y), pk2(vv[h][1].z, vv[h][1].w)}; }
        }
        for (size_t i = gt; i < (size_t)DEC_B * PAST * 16; i += GT) {
            const size_t row = i >> 4; const int ch = (int)(i & 15); const size_t b = row >> 11, s = row & 2047;
            const f32x4 k0 = *(const f32x4*)(in4 + row * 128 + 8 * ch), k1 = *(const f32x4*)(in4 + row * 128 + 8 * ch + 4);
            *(u32x4*)(IKS + (b * SKV_SP + s) * 128 + 8 * ch) = (u32x4){pk2(k0.x, k0.y), pk2(k0.z, k0.w), pk2(k1.x, k1.y), pk2(k1.z, k1.w)};
        }
        for (size_t i = gt; i < (size_t)DEC_B * 32 * 256; i += GT) {
            const size_t r = i >> 8; const int ch = (int)(i & 255); const size_t b = r >> 5, s = SKV_S + (r & 31);
            *(u32x4*)(KVS + (b * SKV_SP + s) * 2048 + 8 * ch) = (u32x4){0u, 0u, 0u, 0u};
        }
        for (size_t i = gt; i < (size_t)DEC_B * 32 * 16; i += GT) {
            const size_t r = i >> 4; const int ch = (int)(i & 15); const size_t b = r >> 5, s = SKV_S + (r & 31);
            *(u32x4*)(IKS + (b * SKV_SP + s) * 128 + 8 * ch) = (u32x4){0u, 0u, 0u, 0u};
        }
    }
}

constexpr int XCH_OFF = LDSCTL_OFF + 1024;
static_assert(XCH_OFF + 8192 <= LDS_BYTES, "LDS map");
__device__ __forceinline__ void head_sumsq_exchange(const f32x4 (&acc)[2][2][4][2], float ds2, LAS unsigned char* lds, int wr, int wc, int fr, int fq) {
    LAS float* X = (LAS float*)(lds + XCH_OFF);
#pragma unroll
    for (int ai = 0; ai < 2; ++ai)
#pragma unroll
        for (int m = 0; m < 4; ++m)
#pragma unroll
            for (int bj = 0; bj < 2; ++bj) { const f32x4 a = acc[ai][bj][m][0], b = acc[ai][bj][m][1];
                float s = ((a[0] * a[0] + a[1] * a[1]) + (a[2] * a[2] + a[3] * a[3])) + ((b[0] * b[0] + b[1] * b[1]) + (b[2] * b[2] + b[3] * b[3]));
                s += __shfl_xor(s, 16); s += __shfl_xor(s, 32);
                if (fq == 0) X[((ai * 128 + wr * 64 + m * 16 + fr) * 2 + bj) * 4 + wc] = s * ds2; }
    asm volatile("s_waitcnt lgkmcnt(0)" ::: "memory"); __builtin_amdgcn_s_barrier(); asm volatile("" ::: "memory");
}
__device__ __forceinline__ float head_rstd(LAS unsigned char* lds, int rl, int bj) {
    const f32x4 p = *(const LAS f32x4*)(lds + XCH_OFF + ((rl * 2 + bj) * 4) * 4); return 1.0f / sqrtf(((p[0] + p[1]) + (p[2] + p[3])) * (1.0f / 128.0f) + EPS); }
__device__ __forceinline__ void rope_epi(float (&y)[8], const f32x2* RT, int pos, int fq) {
    const f32x4* cp = (const f32x4*)(RT + (size_t)pos * 16 + 8 * (fq & 1)); const f32x4 c0 = cp[0], c1 = cp[1], c2 = cp[2], c3 = cp[3];
    const float cs[8] = {c0[0], c0[2], c1[0], c1[2], c2[0], c2[2], c3[0], c3[2]}, sn[8] = {c0[1], c0[3], c1[1], c1[3], c2[1], c2[3], c3[1], c3[3]};
#pragma unroll
    for (int e = 0; e < 8; ++e) { const float p = __shfl_xor(y[e], 32); y[e] = (fq < 2) ? (y[e] * cs[e] - p * sn[e]) : (y[e] * cs[e] + p * sn[e]); }
}
struct RopeCS { f32x4 c0, c1, c2, c3; };
__device__ __forceinline__ RopeCS rope_load(const f32x2* RT, int pos, int fq) { const f32x4* cp = (const f32x4*)(RT + (size_t)pos * 16 + 8 * (fq & 1)); RopeCS r; r.c0 = cp[0]; r.c1 = cp[1]; r.c2 = cp[2]; r.c3 = cp[3]; return r; }
__device__ __forceinline__ void rope_apply(float (&y)[8], const RopeCS& r, int fq) {
    const float cs[8] = {r.c0[0], r.c0[2], r.c1[0], r.c1[2], r.c2[0], r.c2[2], r.c3[0], r.c3[2]}, sn[8] = {r.c0[1], r.c0[3], r.c1[1], r.c1[3], r.c2[1], r.c2[3], r.c3[1], r.c3[3]};
#pragma unroll
    for (int e = 0; e < 8; ++e) { const float p = __shfl_xor(y[e], 32); y[e] = (fq < 2) ? (y[e] * cs[e] - p * sn[e]) : (y[e] * cs[e] + p * sn[e]); }
}
__device__ __forceinline__ int row_pos(int row) { return row < NTOK_P ? (row & (SEQ - 1)) : PAST + ((row - NTOK_P) & (DEC_T - 1)); }
constexpr int RB = 4;
struct EpiProjA {
    static constexpr bool PERM = true, MID = false, FP8 = false;
    LAS unsigned char* lds;
    __device__ __forceinline__ void operator()(const f32x4 (&acc)[2][2][4][2], const pg8::Unit& u, int wr, int wc, int fr, int fq) const {
        unsigned char* const ws = e_ws(lds); const int pn = u.pn; const bool samp = u.pm >= NTOK_P / 256;
        const int rowl0 = wr * 64 + fr, row0 = u.pm * 256 + rowl0, cw = wc * 32 + 8 * fq;
        const f32x2* RT = (const f32x2*)(ws + WS_ROPE);
        if (pn >= 25) {
            bf16_t* O = (bf16_t*)(ws + WS_XL) + (pn - 25) * 256 + cw;
#pragma unroll
            for (int ai = 0; ai < 2; ++ai)
#pragma unroll
                for (int m = 0; m < 4; ++m)
#pragma unroll
                    for (int bj = 0; bj < 2; ++bj) { const f32x4 v0 = acc[ai][bj][m][0], v1 = acc[ai][bj][m][1];
                        *(u32x4*)(O + (size_t)(row0 + ai * 128 + m * 16) * DM + bj * 128) = (u32x4){pk2(v0[0], v0[1]), pk2(v0[2], v0[3]), pk2(v1[0], v1[1]), pk2(v1[2], v1[3])}; }
        } else if (pn >= 8 && pn < 24) {
            bf16_t* O = (bf16_t*)(ws + WS_IQ) + (pn - 8) * 256 + cw;
#pragma unroll
            for (int ai = 0; ai < 2; ++ai) {
                RopeCS rc[RB];
#pragma unroll
                for (int mb = 0; mb < 4; mb += RB) {
                    if (wc == 0) {
#pragma unroll
                        for (int m = 0; m < RB; ++m) rc[m] = rope_load(RT, row_pos(row0 + ai * 128 + (mb + m) * 16), fq); }
                    asm volatile("" ::: "memory");
#pragma unroll
                    for (int m = mb; m < mb + RB; ++m) { const int row = row0 + ai * 128 + m * 16;
#pragma unroll
                        for (int bj = 0; bj < 2; ++bj) { const f32x4 v0 = acc[ai][bj][m][0], v1 = acc[ai][bj][m][1]; float y[8] = {v0[0], v0[1], v0[2], v0[3], v1[0], v1[1], v1[2], v1[3]};
                            if (wc == 0) rope_apply(y, rc[m - mb], fq);
                            *(u32x4*)(O + (size_t)row * DM + bj * 128) = pack8f(y); } } } }
        } else if (pn >= 4 && pn < 8) {
            float* outv = e_out(lds) + (samp ? O_VS - (size_t)NTOK_P * KVW : O_VP) + (pn - 4) * 256 + cw;
#pragma unroll
            for (int ai = 0; ai < 2; ++ai)
#pragma unroll
                for (int m = 0; m < 4; ++m) { const int row = row0 + ai * 128 + m * 16;
                    bf16_t* d = samp ? (bf16_t*)(ws + WS_KVS) + ((size_t)((row - NTOK_P) >> 5) * SKV_SP + PAST + ((row - NTOK_P) & 31)) * 2048 : (bf16_t*)(ws + WS_KV) + (size_t)row * 2048;
#pragma unroll
                    for (int bj = 0; bj < 2; ++bj) { const f32x4 v0 = acc[ai][bj][m][0], v1 = acc[ai][bj][m][1]; const int col = (pn - 4) * 256 + bj * 128 + cw;
                        *(f32x4*)(outv + (size_t)row * KVW + bj * 128) = v0; *(f32x4*)(outv + (size_t)row * KVW + bj * 128 + 4) = v1;
                        *(u32x4*)(d + 1024 + col) = (u32x4){pk2(v0[0], v0[1]), pk2(v0[2], v0[3]), pk2(v1[0], v1[1]), pk2(v1[2], v1[3])}; } }
        } else {
            const bool isk = pn < 4;
            head_sumsq_exchange(acc, 1.0f, lds, wr, wc, fr, fq);
            const float* gp = e_in(lds, isk ? 10 : 11) + cw; const f32x4 g0 = *(const f32x4*)gp, g1 = *(const f32x4*)(gp + 4); const float g[8] = {g0[0], g0[1], g0[2], g0[3], g1[0], g1[1], g1[2], g1[3]};
            float* outp = e_out(lds);
#pragma unroll
            for (int am = 0; am < 4; ++am) { const int ai = am >> 1;
                RopeCS rc[2];
                if (wc == 0) {
#pragma unroll
                    for (int m = 0; m < 2; ++m) rc[m] = rope_load(RT, row_pos(u.pm * 256 + rowl0 + ai * 128 + (2 * (am & 1) + m) * 16), fq); }
                asm volatile("" ::: "memory");
#pragma unroll
                for (int m = 2 * (am & 1); m < 2 * (am & 1) + 2; ++m) { const int rl = rowl0 + ai * 128 + m * 16, row = u.pm * 256 + rl, rs = row - NTOK_P;
#pragma unroll
                    for (int bj = 0; bj < 2; ++bj) { const f32x4 v0 = acc[ai][bj][m][0], v1 = acc[ai][bj][m][1];
                        if (isk || bj == 0) { const float rstd = head_rstd(lds, rl, bj); float y[8];
#pragma unroll
                            for (int e = 0; e < 4; ++e) { y[e] = v0[e] * rstd * g[e]; y[4 + e] = v1[e] * rstd * g[4 + e]; }
                            if (wc == 0) rope_apply(y, rc[m & 1], fq);
                            if (isk) { const int col = pn * 256 + bj * 128 + cw; float* o = outp + (samp ? O_KS + (size_t)rs * KVW : O_KP + (size_t)row * KVW) + col;
                                *(f32x4*)o = (f32x4){y[0], y[1], y[2], y[3]}; *(f32x4*)(o + 4) = (f32x4){y[4], y[5], y[6], y[7]};
                                bf16_t* d = samp ? (bf16_t*)(ws + WS_KVS) + ((size_t)(rs >> 5) * SKV_SP + PAST + (rs & 31)) * 2048 : (bf16_t*)(ws + WS_KV) + (size_t)row * 2048;
                                *(u32x4*)(d + col) = pack8f(y); }
                            else { float* o = outp + (samp ? O_IKS + (size_t)rs * IDXD : O_IKP + (size_t)row * IDXD) + cw;
                                *(f32x4*)o = (f32x4){y[0], y[1], y[2], y[3]}; *(f32x4*)(o + 4) = (f32x4){y[4], y[5], y[6], y[7]};
                                bf16_t* d = samp ? (bf16_t*)(ws + WS_IKS) + ((size_t)(rs >> 5) * SKV_SP + PAST + (rs & 31)) * IDXD : (bf16_t*)(ws + WS_IKB) + (size_t)row * IDXD;
                                *(u32x4*)(d + cw) = pack8f(y); } }
                        else if (wc == 0) { float* o = (float*)(ws + WS_IWF) + (size_t)row * 32 + 8 * fq;
                            *(f32x4*)o = v0 * 0.015625f; *(f32x4*)(o + 4) = v1 * 0.015625f; } } } }
        }
    }
};
struct EpiProjB {
    static constexpr bool PERM = true, MID = false, FP8 = true;
    LAS unsigned char* lds;
    __device__ __forceinline__ void operator()(const f32x4 (&acc)[2][2][4][2], const pg8::Unit& u, int wr, int wc, int fr, int fq) const {
        unsigned char* const ws = e_ws(lds);
        const int seg = u.pn >> 4, pn = u.pn & 15; constexpr float DS = 1.0f / (SXN * SW8);
        const int rowl0 = wr * 64 + fr, row0 = u.pm * 256 + rowl0, cw = wc * 32 + 8 * fq, col0 = pn * 256 + cw;
        if (seg == 0) {
            head_sumsq_exchange(acc, DS * DS, lds, wr, wc, fr, fq);
            const float* gp = e_in(lds, 9) + cw; const f32x4 g0 = *(const f32x4*)gp, g1 = *(const f32x4*)(gp + 4); const float g[8] = {g0[0], g0[1], g0[2], g0[3], g1[0], g1[1], g1[2], g1[3]};
            const f32x2* RT = (const f32x2*)(ws + WS_ROPE); bf16_t* O = (bf16_t*)(ws + WS_Q) + col0;
#pragma unroll
            for (int ai = 0; ai < 2; ++ai) {
                RopeCS rc[4];
                if (wc == 0) {
#pragma unroll
                    for (int m = 0; m < 4; ++m) rc[m] = rope_load(RT, row_pos(u.pm * 256 + rowl0 + ai * 128 + m * 16), fq); }
                asm volatile("" ::: "memory");
#pragma unroll
                for (int m = 0; m < 4; ++m) { const int rl = rowl0 + ai * 128 + m * 16, row = u.pm * 256 + rl;
#pragma unroll
                    for (int bj = 0; bj < 2; ++bj) { const f32x4 v0 = acc[ai][bj][m][0], v1 = acc[ai][bj][m][1]; const float rstd = head_rstd(lds, rl, bj) * DS; float y[8];
#pragma unroll
                        for (int e = 0; e < 4; ++e) { y[e] = v0[e] * rstd * g[e]; y[4 + e] = v1[e] * rstd * g[4 + e]; }
                        if (wc == 0) rope_apply(y, rc[m], fq);
                        *(u32x4*)(O + (size_t)row * DM + bj * 128) = pack8f(y); } } }
        } else {
            bf16_t* O = (bf16_t*)(ws + (seg == 1 ? WS_GY : (seg == 2 ? WS_SGA : WS_SGL))) + col0;
#pragma unroll
            for (int ai = 0; ai < 2; ++ai)
#pragma unroll
                for (int m = 0; m < 4; ++m) { bf16_t* rowp = O + (size_t)(row0 + ai * 128 + m * 16) * DM;
#pragma unroll
                    for (int bj = 0; bj < 2; ++bj) { f32x4 v0 = acc[ai][bj][m][0] * DS, v1 = acc[ai][bj][m][1] * DS;
                        if (seg == 1) {
#pragma unroll
                            for (int e = 0; e < 4; ++e) { v0[e] = gelu_tanh_(v0[e]); v1[e] = gelu_tanh_(v1[e]); } }
                        else {
#pragma unroll
                            for (int e = 0; e < 4; ++e) { v0[e] = sigmoidf_(v0[e]); v1[e] = sigmoidf_(v1[e]); } }
                        *(u32x4*)(rowp + bj * 128) = (u32x4){pk2(v0[0], v0[1]), pk2(v0[2], v0[3]), pk2(v1[0], v1[1]), pk2(v1[2], v1[3])}; } }
        }
    }
};

__device__ __forceinline__ void rope8(float (&y)[8], const f32x2 (&cs)[8], int hl) {
    float p[8];
#pragma unroll
    for (int e = 0; e < 8; ++e) p[e] = __shfl_xor(y[e], 2);
    if (hl < 4) {
#pragma unroll
        for (int e = 0; e < 8; ++e) y[e] = (hl < 2) ? (y[e] * cs[e].x - p[e] * cs[e].y) : (y[e] * cs[e].x + p[e] * cs[e].y);
    }
}
__device__ __forceinline__ float sum16(float s) { s += __shfl_xor(s, 1); s += __shfl_xor(s, 2); s += __shfl_xor(s, 4); s += __shfl_xor(s, 8); return s; }
struct P2Ptrs { unsigned char* ws; float* out; const float* sconv; const float* gq; const float* gk; const float* gi; const float* cw; const float* cb; };
__device__ __forceinline__ void p2_rowinfo(int m, bool& samp, int& ml, int& b, int& t, int& pos) { samp = m >= NTOK_P; ml = samp ? m - NTOK_P : m; b = samp ? (ml >> 5) : (ml >> 12); t = samp ? (ml & 31) : (ml & 4095); pos = samp ? PAST + t : t; }
__device__ __forceinline__ void p2_taskC(const P2Ptrs& P, int item, int lane) {
    const int strip = item >> 3, col = 512 * (item & 7) + 8 * lane, m0 = 16 * strip; bool samp; int ml, b, t0, pos; p2_rowinfo(m0, samp, ml, b, t0, pos);
    const bf16_t* XLb = (const bf16_t*)(P.ws + WS_XL); bf16_t* Ub = (bf16_t*)(P.ws + WS_U);
    float x[19][8];
#pragma unroll
    for (int i = 0; i < 19; ++i) { const int tt = t0 + i - 3;
        if (tt >= 0) unpack8(*(const u32x4*)(XLb + (size_t)(m0 + i - 3) * DM + col), x[i]);
        else if (samp) { const float* sp = P.sconv + ((size_t)b * 3 + i) * DM + col; const f32x4 s0 = *(const f32x4*)sp, s1 = *(const f32x4*)(sp + 4); x[i][0] = s0.x; x[i][1] = s0.y; x[i][2] = s0.z; x[i][3] = s0.w; x[i][4] = s1.x; x[i][5] = s1.y; x[i][6] = s1.z; x[i][7] = s1.w; }
        else {
#pragma unroll
            for (int e = 0; e < 8; ++e) x[i][e] = 0.f; } }
    float w[4][8], cb[8];
#pragma unroll
    for (int e = 0; e < 8; ++e) { cb[e] = P.cb[col + e];
#pragma unroll
        for (int j = 0; j < 4; ++j) w[j][e] = P.cw[(size_t)j * DM + col + e]; }
    const int T = samp ? DEC_T : SEQ;
#pragma unroll
    for (int r = 0; r < 16; ++r) { float u[8];
#pragma unroll
        for (int e = 0; e < 8; ++e) u[e] = cb[e] + x[r][e] * w[0][e] + x[r + 1][e] * w[1][e] + x[r + 2][e] * w[2][e] + x[r + 3][e] * w[3][e];
        *(u32x4*)(Ub + (size_t)(m0 + r) * DM + col) = pack8f(u);
        const int t = t0 + r;
        if (t >= T - 3) { float* oc = P.out + (samp ? O_CONVS : O_CONVP) + ((size_t)b * 3 + (t - (T - 3))) * DM + col;
            *(f32x4*)oc = (f32x4){x[r + 3][0], x[r + 3][1], x[r + 3][2], x[r + 3][3]}; *(f32x4*)(oc + 4) = (f32x4){x[r + 3][4], x[r + 3][5], x[r + 3][6], x[r + 3][7]}; } }
}
__device__ __forceinline__ void p2_phase(Frame& F) {
    P2Ptrs P{ws_ptr(F), out_ptr(F), in_ptr(F, 6), in_ptr(F, 9), in_ptr(F, 10), in_ptr(F, 11), in_ptr(F, 12), in_ptr(F, 13)};
    for (int it = F.gw; it < (MTOK / 16) * 8; it += F.NGW) p2_taskC(P, it, F.lane);
}

__device__ __forceinline__ float expf_(float x) { return __builtin_amdgcn_exp2f(1.4426950408889634f * x); }
__device__ __forceinline__ float softplusf_(float x) { return fmaxf(x, 0.f) + log1pf(expf(-fabsf(x))); }
struct EpiGates {
    static constexpr bool PERM = false, MID = false, FP8 = false;
    LAS unsigned char* lds;
    __device__ __forceinline__ void operator()(const f32x4 (&acc)[2][2][4][2], const pg8::Unit& u, int wr, int wc, int fr, int fq) const {
        unsigned char* const ws = e_ws(lds); const bf16_t* U = (const bf16_t*)(ws + WS_U); const float* ba = e_in(lds, 15); const float* bx = e_in(lds, 17); const float* lam = e_in(lds, 18); unsigned* AB = (unsigned*)(ws + WS_AB);
        const int row0 = u.pm * 256 + wr * 64 + fr, chb = 256 * (u.pn >> 1) + 128 * (u.pn & 1) + 32 * wc + 4 * fq;
        u32x2 uw[2][2][4];
#pragma unroll
        for (int n = 0; n < 2; ++n)
#pragma unroll
            for (int ai = 0; ai < 2; ++ai)
#pragma unroll
                for (int m = 0; m < 4; ++m) uw[n][ai][m] = *(const u32x2*)(U + (size_t)(row0 + ai * 128 + m * 16) * DM + chb + 16 * n);
        asm volatile("" ::: "memory");
#pragma unroll
        for (int n = 0; n < 2; ++n) { const int ch0 = chb + 16 * n;
            const f32x4 ba4 = *(const f32x4*)(ba + ch0), bx4 = *(const f32x4*)(bx + ch0), lm4 = *(const f32x4*)(lam + ch0); float sp[4];
#pragma unroll
            for (int e = 0; e < 4; ++e) sp[e] = 8.0f * softplusf_(-lm4[e]);
#pragma unroll
            for (int ai = 0; ai < 2; ++ai)
#pragma unroll
                for (int m = 0; m < 4; ++m) { const size_t row = (size_t)(row0 + ai * 128 + m * 16); const u32x2 w2 = uw[n][ai][m];
                    const float uu[4] = {bflo(w2.x), bfhi(w2.x), bflo(w2.y), bfhi(w2.y)}; u32x4 o;
#pragma unroll
                    for (int e = 0; e < 4; ++e) { const float r = sigmoidf_(acc[ai][0][m][n][e] + ba4[e]), ig = sigmoidf_(acc[ai][1][m][n][e] + bx4[e]);
                        const float la = -sp[e] * r, em = 1.0f - expf_(2.0f * la);
                        const float bb = __builtin_amdgcn_sqrtf(fmaxf(em, 0.f)) * (ig * uu[e]);
                        const _Float16 hl_ = (_Float16)la, hb_ = (_Float16)bb;
                        o[e] = (unsigned)__builtin_bit_cast(unsigned short, hl_) | ((unsigned)__builtin_bit_cast(unsigned short, hb_) << 16); }
                    *(u32x4*)(AB + row * DM + ch0) = o; } }
    }
};
__device__ __forceinline__ float h_lo(unsigned w) { return (float)__builtin_bit_cast(_Float16, (unsigned short)(w & 0xffffu)); }
__device__ __forceinline__ float h_hi(unsigned w) { return (float)__builtin_bit_cast(_Float16, (unsigned short)(w >> 16)); }
__device__ __forceinline__ void scan_summaries(Frame& F) {
    unsigned char* const ws = ws_ptr(F);
    const unsigned* AB = (const unsigned*)(ws + WS_AB); f32x4* SUM = (f32x4*)(ws + WS_SUM);
    for (int it = F.gw * 64 + F.lane; it < 128 * 2048; it += F.NGW * 64) { const int q = it >> 11, cp = it & 2047;
        const size_t m0 = (size_t)(q >> 6) * SEQ + (size_t)(q & 63) * 64; const unsigned* p = AB + m0 * DM + 2 * cp;
        float al0 = 0.f, al1 = 0.f, h0 = 0.f, h1 = 0.f;
        for (int r0 = 0; r0 < 64; r0 += 16) { u32x2 w[16];
#pragma unroll
            for (int r = 0; r < 16; ++r) w[r] = *(const u32x2*)(p + (size_t)(r0 + r) * DM);
#pragma unroll
            for (int r = 0; r < 16; ++r) { const float la0 = h_lo(w[r].x), la1 = h_lo(w[r].y); al0 += la0; al1 += la1; h0 = expf_(la0) * h0 + h_hi(w[r].x); h1 = expf_(la1) * h1 + h_hi(w[r].y); } }
        SUM[(size_t)q * 2048 + cp] = (f32x4){al0, h0, al1, h1}; }
}
__device__ __forceinline__ void scan_apply(Frame& F) {
    unsigned char* const ws = ws_ptr(F); float* const out = out_ptr(F); const float* const in5 = in_ptr(F, 5);
    const unsigned* AB = (const unsigned*)(ws + WS_AB); const f32x4* SUM = (const f32x4*)(ws + WS_SUM); const bf16_t* GY = (const bf16_t*)(ws + WS_GY); bf16_t* OAL = (bf16_t*)(ws + WS_OAL);
    for (int it = F.gw * 64 + F.lane; it < 144 * 2048; it += F.NGW * 64) { const int q = it >> 11, cp = it & 2047;
        float h0, h1; size_t m0; int nr; float* lout = nullptr;
        if (q < 128) { const int ch = q & 63; m0 = (size_t)(q >> 6) * SEQ + (size_t)ch * 64; nr = 64; h0 = 0.f; h1 = 0.f;
            const f32x4* sq = SUM + (size_t)(q & ~63) * 2048 + cp;
            for (int j0 = 0; j0 < ch; j0 += 16) { f32x4 sv[16];
#pragma unroll
                for (int r = 0; r < 16; ++r) { const int j = (j0 + r < ch) ? j0 + r : ch - 1; sv[r] = sq[(size_t)j * 2048]; }
                asm volatile("" ::: "memory");
#pragma unroll
                for (int r = 0; r < 16; ++r) if (j0 + r < ch) { h0 = expf_(sv[r].x) * h0 + sv[r].y; h1 = expf_(sv[r].z) * h1 + sv[r].w; } }
            if (ch == 63) lout = out + O_LRUP + (size_t)(q >> 6) * DM + 2 * cp; }
        else { const int bs = q - 128; m0 = (size_t)NTOK_P + (size_t)bs * DEC_T; nr = DEC_T; const f32x2 s = *(const f32x2*)(in5 + (size_t)bs * DM + 2 * cp); h0 = s.x; h1 = s.y;
            lout = out + O_LRUS + (size_t)bs * DM + 2 * cp; }
        const unsigned* p = AB + m0 * DM + 2 * cp; const bf16_t* g = GY + m0 * DM + 2 * cp; unsigned char* o = (unsigned char*)OAL + m0 * (2 * DM) + DM + 2 * cp;
        for (int r0 = 0; r0 < nr; r0 += 16) { u32x2 w[16]; unsigned gw_[16];
#pragma unroll
            for (int r = 0; r < 16; ++r) { w[r] = *(const u32x2*)(p + (size_t)(r0 + r) * DM); gw_[r] = *(const unsigned*)(g + (size_t)(r0 + r) * DM); }
            asm volatile("" ::: "memory");
#pragma unroll
            for (int r = 0; r < 16; ++r) { h0 = expf_(h_lo(w[r].x)) * h0 + h_hi(w[r].x); h1 = expf_(h_lo(w[r].y)) * h1 + h_hi(w[r].y);
                *(unsigned short*)(o + (size_t)(r0 + r) * (2 * DM)) = (unsigned short)__builtin_amdgcn_cvt_pk_fp8_f32(h0 * bflo(gw_[r]) * SA_LRU, h1 * bfhi(gw_[r]) * SA_LRU, 0, false); }
            asm volatile("" ::: "memory"); }
        if (lout) *(f32x2*)lout = (f32x2){h0, h1}; }
}


__device__ __forceinline__ int crow_(int r, int hi) { return (r & 3) + 8 * (r >> 2) + 4 * hi; }
struct IdxItem { int m0, qw, nvalid, samp; const bf16_t* kp; float* sp; int sld; };
__device__ __forceinline__ IdxItem idx_decode(int it, unsigned char* ws) {
    IdxItem r; constexpr int NPI = 4 * 16 * 17;
    if (it < NPI) { int g = 15; int rr = it; while (rr >= 8 * (g + 1)) { rr -= 8 * (g + 1); --g; }
        const int seg = rr % (g + 1); rr /= (g + 1); const int cl = rr & 3, b = rr >> 2, chunk = 4 * g + cl;
        r.m0 = b * SEQ + 64 * chunk; r.qw = 8; r.samp = 0; const int nk = (chunk + 1) * 64 - 256 * seg; r.nvalid = nk < 256 ? nk : 256;
        r.kp = (const bf16_t*)(ws + WS_IKB) + ((size_t)b * SEQ + 256 * seg) * IDXD; r.sp = (float*)(ws + WS_SC) + (size_t)r.m0 * SEQ + 256 * seg; r.sld = SEQ; }
    else { const int rr = it - NPI, bs = rr / 9, seg = rr % 9;
        r.m0 = NTOK_P + 32 * bs; r.qw = 4; r.samp = 1; const int nk = SKV_SP - 256 * seg; r.nvalid = nk < 256 ? nk : 256;
        r.kp = (const bf16_t*)(ws + WS_IKS) + ((size_t)bs * SKV_SP + 256 * seg) * IDXD; r.sp = (float*)(ws + WS_SCS) + (size_t)(32 * bs) * SKV_SP + 256 * seg; r.sld = SKV_SP; }
    return r;
}
__device__ __forceinline__ void idx_phase(Frame& F) {
    unsigned char* const ws = ws_ptr(F); unsigned* const ctl = ctl_ptr(F);
    __syncthreads(); const unsigned qsel = F.MISC[16]; __syncthreads(); if (F.tid == 0) F.MISC[16] = qsel + 1u;
    unsigned* qhead = ctl + CW_QIDX + 64 * qsel;
    const bf16_t* IQ = (const bf16_t*)(ws + WS_IQ); const float* IWF = (const float*)(ws + WS_IWF);
    const int tid = F.tid, lane = F.lane, wave = F.wave, c = lane & 31, hi = lane >> 5;
    constexpr int TOTAL = 4 * 16 * 17 + 16 * 9;
    if (tid == 0) { F.MISC[20] = __hip_atomic_fetch_add(qhead, 1u, __ATOMIC_RELAXED, __HIP_MEMORY_SCOPE_AGENT); F.MISC[21] = __hip_atomic_fetch_add(qhead, 1u, __ATOMIC_RELAXED, __HIP_MEMORY_SCOPE_AGENT); }
    __syncthreads();
    int icur = (int)F.MISC[20], inxt = (int)F.MISC[21];
    __syncthreads();
    if (icur >= TOTAL) return;
#define IDX_STAGE(IT, BUF) do { _Pragma("unroll") for (int j = 0; j < 8; ++j) { const int r0 = 32 * j + 4 * wave; if (r0 < (IT).nvalid) { const int key = r0 + (lane >> 4), chunk = (lane & 15) ^ (key & 15); \
        __builtin_amdgcn_global_load_lds((const unsigned*)((IT).kp + (size_t)key * IDXD + 8 * chunk), (LAS unsigned*)(F.lds + RING_OFF + (BUF) * 65536 + r0 * 256), 16, 0, 0); } } } while (0)
    IdxItem cur = idx_decode(icur, ws);
    IDX_STAGE(cur, 0);
    asm volatile("s_waitcnt vmcnt(0)" ::: "memory");
    __syncthreads();
    int p = 0;
    for (;;) {
        const bool has = inxt < TOTAL;
        unsigned inn = 0u;
        if (tid == 0 && has) inn = __hip_atomic_fetch_add(qhead, 1u, __ATOMIC_RELAXED, __HIP_MEMORY_SCOPE_AGENT);
        IdxItem nxt = cur;
        if (has) { nxt = idx_decode(inxt, ws); IDX_STAGE(nxt, p ^ 1); }
        const LAS unsigned char* kb = F.lds + RING_OFF + p * 65536;
        const int nblk = cur.nvalid >> 5, npair = cur.qw >> 1;
#define IDX_LDK(BK, BLK) do { const int key_ = 32 * (BLK) + c; const LAS unsigned char* rowp_ = kb + key_ * 256; const int sw_ = key_ & 15; \
            _Pragma("unroll") for (int d0 = 0; d0 < 8; ++d0) BK[d0] = *(const LAS bf16x8*)(rowp_ + (((2 * d0 + hi) ^ sw_) << 4)); } while (0)
#define IDX_RELU(x) __int_as_float(max(__float_as_int(x), 0))
#define IDX_FMAC(acc_, x_, w_) do { const float xv_ = (x_), wv_ = (w_); asm("v_fmac_f32 %0, %1, %2" : "+v"(acc_) : "v"(xv_), "v"(wv_)); } while (0)
#define IDX_BLOCK(BK, BLK) do { f32x16 a0 = {}, a1 = {}; \
            _Pragma("unroll") for (int d0 = 0; d0 < 8; ++d0) { a0 = __builtin_amdgcn_mfma_f32_32x32x16_bf16(aq[0][d0], BK[d0], a0, 0, 0, 0); a1 = __builtin_amdgcn_mfma_f32_32x32x16_bf16(aq[1][d0], BK[d0], a1, 0, 0, 0); } \
            float t0a = 0.f, t0b = 0.f, t1a = 0.f, t1b = 0.f;     \
            _Pragma("unroll") for (int r = 0; r < 16; r += 2) { \
                IDX_FMAC(t0a, IDX_RELU(a0[r]), w[0][r >> 2][r & 3]); IDX_FMAC(t0b, IDX_RELU(a0[r + 1]), w[0][r >> 2][(r & 3) + 1]); \
                IDX_FMAC(t1a, IDX_RELU(a1[r]), w[1][r >> 2][r & 3]); IDX_FMAC(t1b, IDX_RELU(a1[r + 1]), w[1][r >> 2][(r & 3) + 1]); } \
            const float t0 = t0a + t0b, t1 = t1a + t1b; \
            auto rr_ = __builtin_amdgcn_permlane32_swap(__float_as_uint(t0), __float_as_uint(t1), false, false);     \
            s0[loff + 32 * (BLK)] = __uint_as_float(rr_[0]) + __uint_as_float(rr_[1]); } while (0)
        for (int pr = 0; pr < npair; ++pr) {
            const int m = cur.m0 + wave * cur.qw + 2 * pr;
            bf16x8 aq[2][8]; f32x4 w[2][4];
#pragma unroll
            for (int q = 0; q < 2; ++q) {
#pragma unroll
                for (int d0 = 0; d0 < 8; ++d0) aq[q][d0] = *(const bf16x8*)(IQ + (size_t)(m + q) * DM + c * IDXD + d0 * 16 + hi * 8);
#pragma unroll
                for (int g = 0; g < 4; ++g) w[q][g] = *(const f32x4*)(IWF + (size_t)(m + q) * 32 + 8 * g + 4 * hi); }
            float* s0 = cur.sp + (size_t)(m - cur.m0) * cur.sld; const int loff = c + (hi ? cur.sld : 0);
            bf16x8 bka[8], bkb[8];
            IDX_LDK(bka, 0);
            for (int blk = 0; blk < nblk; blk += 2) {
                IDX_LDK(bkb, blk + 1);
                IDX_BLOCK(bka, blk);
                if (blk + 2 < nblk) IDX_LDK(bka, blk + 2);
                IDX_BLOCK(bkb, blk + 1); }
        }
#undef IDX_LDK
#undef IDX_BLOCK
#undef IDX_RELU
#undef IDX_FMAC
        if (tid == 0) F.MISC[20 + p] = inn;
        asm volatile("s_waitcnt vmcnt(0)" ::: "memory");
        __syncthreads();
        if (!has) break;
        cur = nxt; inxt = (int)F.MISC[20 + p]; p ^= 1;
    }
#undef IDX_STAGE
}
__device__ __forceinline__ void select_row(Frame& F, int m) {
    unsigned char* const ws = ws_ptr(F);
    const int lane = F.lane;
    const float* sp; int n;
    if (m < NTOK_P) { n = (((m & (SEQ - 1)) >> 6) + 1) * 64; sp = (const float*)(ws + WS_SC) + (size_t)m * SEQ; }
    else { n = SKV_S; sp = (const float*)(ws + WS_SCS) + (size_t)(m - NTOK_P) * SKV_SP; }
    unsigned key[64];
#pragma unroll
    for (int j = 0; j < 64; ++j) { const int idx = 64 * j + lane; key[j] = __float_as_uint(sp[idx < n ? idx : n - 1]); }
    asm volatile("" ::: "memory");
#pragma unroll
    for (int j = 0; j < 64; ++j) { const int idx = 64 * j + lane; const unsigned u = key[j]; const unsigned k = (u & 0x80000000u) ? ~u : (u | 0x80000000u); key[j] = idx < n ? k : 0u; }
    unsigned thr = 1u;
    if (n > TOPK) { unsigned prefix = 0u;
        const int ngrp = (n + 511) >> 9;
        for (int bit = 31; bit >= 0; --bit) { const unsigned cand = prefix | (1u << bit); int c0 = 0, c1 = 0, c2 = 0, c3 = 0;
#pragma unroll
            for (int g = 0; g < 8; ++g) if (g < ngrp) {
#pragma unroll
                for (int j = 8 * g; j < 8 * g + 8; j += 4) { c0 += (key[j] >= cand) ? 1 : 0; c1 += (key[j + 1] >= cand) ? 1 : 0; c2 += (key[j + 2] >= cand) ? 1 : 0; c3 += (key[j + 3] >= cand) ? 1 : 0; } }
            const int cl = (c0 + c1) + (c2 + c3); int cnt = 0;
#pragma unroll
            for (int b = 0; b < 7; ++b) cnt += __builtin_popcountll(__ballot((cl >> b) & 1)) << b;
            if (cnt >= TOPK) prefix = cand;
            if (cnt == TOPK) break; }
        thr = prefix; }
    unsigned long long mine = 0ull;
#pragma unroll
    for (int j = 0; j < 64; ++j) { const unsigned long long bal = __ballot(key[j] >= thr); mine = (lane == j) ? bal : mine; }
    ((unsigned long long*)(ws + WS_BM))[(size_t)m * 64 + lane] = mine;
}
__device__ __forceinline__ void select_phase(Frame& F) {
    volatile LAS unsigned* cnt = F.MISC + 24;
    __syncthreads(); if (F.tid == 0) *cnt = 0u; __syncthreads();
    const int G = F.G, b = (int)blockIdx.x;
    for (;;) {
        unsigned i = 0u; if (F.lane == 0) i = __hip_atomic_fetch_add((LAS unsigned*)cnt, 1u, __ATOMIC_RELAXED, __HIP_MEMORY_SCOPE_WORKGROUP);
        const int q = (int)__builtin_amdgcn_readfirstlane(i) * G + b;
        if (q >= MTOK) break;
        int m;
        if (q < MTOK - NTOK_P) m = NTOK_P + q;
        else { const int t = q - (MTOK - NTOK_P); m = (t & 1) * SEQ + (SEQ - 1 - (t >> 1)); }
        select_row(F, m);
    }
}

namespace att {
constexpr int NW = 8, QBLK = 32, KVBLK = 64, D = 128, KVLD = 2048, QLD = 4096, OLD = 8192;
constexpr float SCALE = 0.08838834764831845f, THR = 8.f;
constexpr int SHM_V = KVBLK * D * 2, SHM_K = KVBLK * D * 2;
constexpr int ATT_LDS = 2 * SHM_V + 2 * SHM_K + NW * 64 * 4 + 64;
typedef short s16x4 __attribute__((ext_vector_type(4)));
#define KSWZ(row, colB) ((row) * 256 + ((colB) ^ (((row) & 7) << 4)))
#define SBAR() __builtin_amdgcn_sched_barrier(0)
__device__ __forceinline__ int v_st(int k, int c) { const int kk = (k & ~0xC) | ((k & 4) << 1) | ((k & 8) >> 1); return ((kk >> 3) * 4 + (c >> 5)) * 512 + ((kk & 7) * 32 + (c & 31)) * 2; }
__device__ __forceinline__ int v_rd_base(int lane) { return ((lane & 3) << 3) | (((lane >> 2) & 3) << 6) | (((lane >> 4) & 1) << 5) | (((lane >> 5) & 1) << 8); }
constexpr int v_rd_off(int d0, int ks, int half) { return d0 * 512 + ks * 4096 + half * 2048; }
__device__ __forceinline__ int crow(int r, int hi) { return (r & 3) + 8 * (r >> 2) + 4 * hi; }
__device__ __forceinline__ bf16x8 load8(const bf16_t* p) { return *reinterpret_cast<const bf16x8*>(p); }
__device__ __forceinline__ void mask_bits(f32x16& p0, f32x16& p1, unsigned long long mw, int hi) {
    const unsigned lo = (unsigned)mw >> (4 * hi), hw = (unsigned)(mw >> 32) >> (4 * hi); unsigned NEGB = 0xFF800000u; asm volatile("" : "+v"(NEGB));
#define MASK1(P, W, C) do { int m_; float t_ = (P); asm("v_bfe_i32 %0, %1, %2, 1" : "=v"(m_) : "v"(W), "i"(C)); asm("v_bfi_b32 %0, %1, %0, %2" : "+v"(t_) : "v"(m_), "v"(NEGB)); (P) = t_; } while (0)
    asm volatile("s_nop 15\n\ts_nop 3" : "+v"(p0), "+v"(p1));
#pragma unroll
    for (int r = 0; r < 16; ++r) { const int c = (r & 3) + 8 * (r >> 2); MASK1(p0[r], lo, c); MASK1(p1[r], hw, c); }
#undef MASK1
}
__device__ __forceinline__ void partialSM(f32x16& p0, f32x16& p1, float& m_reg, float& mn, float& alpha) {
    float pmax = p0[0]; for (int r = 1; r < 16; ++r) pmax = fmaxf(pmax, p0[r]); for (int r = 0; r < 16; ++r) pmax = fmaxf(pmax, p1[r]);
    { auto rr = __builtin_amdgcn_permlane32_swap(__float_as_uint(pmax), __float_as_uint(pmax), false, false);
      pmax = fmaxf(__uint_as_float(rr[0]), __uint_as_float(rr[1])); }
    constexpr float C2 = 1.4426950408889634f * SCALE;
    if (__builtin_expect(__all((pmax - m_reg) * SCALE <= THR), 1)) { mn = m_reg; alpha = 1.f; }
    else { mn = fmaxf(m_reg, pmax); alpha = __builtin_amdgcn_exp2f((m_reg - mn) * C2); m_reg = mn; }
    const float mnL = -mn * C2;
    for (int r = 0; r < 16; ++r) p0[r] = fmaf(p0[r], C2, mnL); for (int r = 0; r < 16; ++r) p1[r] = fmaf(p1[r], C2, mnL);
    for (int r = 0; r < 16; ++r) p0[r] = __builtin_amdgcn_exp2f(p0[r]);
}
__device__ __forceinline__ void finishSM(f32x16& p0, f32x16& p1, float alpha, float& l_reg, bf16x8& pa0, bf16x8& pa1, bf16x8& pa2, bf16x8& pa3) {
    for (int r = 0; r < 16; ++r) p1[r] = __builtin_amdgcn_exp2f(p1[r]);
    float ps = 0; for (int r = 0; r < 16; ++r) ps += p0[r]; for (int r = 0; r < 16; ++r) ps += p1[r];
    { auto rr = __builtin_amdgcn_permlane32_swap(__float_as_uint(ps), __float_as_uint(ps), false, false);
      ps = __uint_as_float(rr[0]) + __uint_as_float(rr[1]); }
    l_reg = l_reg * alpha + ps;
#define PK4(P, B_, OUT) do { unsigned a0 = pk2(P[B_+0], P[B_+1]), a1 = pk2(P[B_+2], P[B_+3]);                          \
        unsigned b0 = pk2(P[B_+4], P[B_+5]), b1 = pk2(P[B_+6], P[B_+7]);                                             \
        auto r0 = __builtin_amdgcn_permlane32_swap(a0, b0, false, false); auto r1 = __builtin_amdgcn_permlane32_swap(a1, b1, false, false); \
        u32x4 w = {r0[0], r1[0], r0[1], r1[1]}; OUT = *reinterpret_cast<bf16x8*>(&w); } while (0)
    PK4(p0, 0, pa0); PK4(p0, 8, pa1); PK4(p1, 0, pa2); PK4(p1, 8, pa3);
#undef PK4
}
template <int KB>
__device__ __forceinline__ void qkt(f32x16& p0, f32x16& p1, const char* K_lds, int r32, int hi, const bf16x8* qr) {
    p0 = f32x16{}; p1 = f32x16{};
    const char* kb[4];
#pragma unroll
    for (int dd = 0; dd < 4; ++dd) kb[dd] = K_lds + KB * SHM_K + KSWZ(r32, (dd * 16 + hi * 8) * 2);
#pragma unroll
    for (int d0 = 0; d0 < 8; ++d0) { const char* a = kb[d0 & 3] + (d0 >> 2) * 128;
        bf16x8 b0 = *reinterpret_cast<const bf16x8*>(a);
        bf16x8 b1 = *reinterpret_cast<const bf16x8*>(a + 32 * 256);
        p0 = __builtin_amdgcn_mfma_f32_32x32x16_bf16(b0, qr[d0], p0, 0, 0, 0);
        p1 = __builtin_amdgcn_mfma_f32_32x32x16_bf16(b1, qr[d0], p1, 0, 0, 0); }
}
template <int VB>
__device__ __forceinline__ void pv_tile(f32x16* o, int vb0, bf16x8 pa0, bf16x8 pa1, bf16x8 pa2, bf16x8 pa3) {
#define TRRD(dst, off) asm volatile("ds_read_b64_tr_b16 %0, %1 offset:%2" : "=&v"(dst) : "v"(vb0), "i"(off) : "memory")
#define PV_D0(d0) do { s16x4 l0, l1, l2, l3, h0, h1, h2, h3; constexpr int b_ = VB * SHM_V + v_rd_off(d0, 0, 0); \
        TRRD(l0, b_); TRRD(h0, b_ + 2048); TRRD(l1, b_ + 4096); TRRD(h1, b_ + 6144); TRRD(l2, b_ + 8192); TRRD(h2, b_ + 10240); TRRD(l3, b_ + 12288); TRRD(h3, b_ + 14336); \
        asm volatile("s_waitcnt lgkmcnt(0)" ::: "memory"); SBAR();   \
        o[d0] = __builtin_amdgcn_mfma_f32_32x32x16_bf16(pa0, (bf16x8){l0[0], l0[1], l0[2], l0[3], h0[0], h0[1], h0[2], h0[3]}, o[d0], 0, 0, 0);   \
        o[d0] = __builtin_amdgcn_mfma_f32_32x32x16_bf16(pa1, (bf16x8){l1[0], l1[1], l1[2], l1[3], h1[0], h1[1], h1[2], h1[3]}, o[d0], 0, 0, 0);   \
        o[d0] = __builtin_amdgcn_mfma_f32_32x32x16_bf16(pa2, (bf16x8){l2[0], l2[1], l2[2], l2[3], h2[0], h2[1], h2[2], h2[3]}, o[d0], 0, 0, 0);   \
        o[d0] = __builtin_amdgcn_mfma_f32_32x32x16_bf16(pa3, (bf16x8){l3[0], l3[1], l3[2], l3[3], h3[0], h3[1], h3[2], h3[3]}, o[d0], 0, 0, 0); } while (0)
    PV_D0(0); PV_D0(1); PV_D0(2); PV_D0(3);
#undef PV_D0
#undef TRRD
}
struct BlockRef { const bf16_t* K; int m0, g, NT, samp; };
__device__ __forceinline__ const bf16_t* ref_q(const BlockRef& r, const unsigned char* ws) { return (const bf16_t*)(ws + WS_Q) + (size_t)r.m0 * QLD + 4 * r.g * D; }
__device__ __forceinline__ unsigned char* ref_o(const BlockRef& r, unsigned char* ws) { return ws + WS_OAL + (size_t)r.m0 * OLD + 4 * r.g * D; }
__device__ __forceinline__ const char* ref_bm(const BlockRef& r, const unsigned char* ws) { return (const char*)(ws + WS_BM) + (size_t)r.m0 * 512; }
struct Seam { bf16x8 qr[8]; bf16x8 st_v0, st_v1, st_k0, st_k1; };
#define ROW(p, k0, rr) ((p) + (size_t)((k0) + (rr)) * KVLD + sc)
#define VMW() asm volatile("s_waitcnt vmcnt(0)" ::: "memory")
#define VMWN(n) asm volatile("s_waitcnt vmcnt(%0)" :: "i"(n) : "memory")
#define SLOAD_H(Kp, Vp, k0) do { S.st_v0 = load8(ROW(Vp, k0, sr)); S.st_v1 = load8(ROW(Vp, k0, 32 + sr));              \
                         S.st_k0 = load8(ROW(Kp, k0, sr)); S.st_k1 = load8(ROW(Kp, k0, 32 + sr)); } while (0)
#define SWRITE_HK(bf) do { *(bf16x8*)(K_lds + (bf) * SHM_K + kws) = S.st_k0; *(bf16x8*)(K_lds + (bf) * SHM_K + kws + 32 * 256) = S.st_k1; } while (0)
#define SWRITE_HV(bf) do { *(bf16x8*)(V_lds + (bf) * SHM_V + vst0) = S.st_v0; *(bf16x8*)(V_lds + (bf) * SHM_V + vst1) = S.st_v1; } while (0)
#define SWRITE_H(bf) do { SWRITE_HV(bf); SWRITE_HK(bf); } while (0)
__device__ __forceinline__ int q_rowoff(int samp, int wid) { return samp ? 0 : 32 * (wid & 1); }
__device__ __forceinline__ int q_headoff(int samp, int wid) { return samp ? (wid & 3) : (wid >> 1); }
__device__ __forceinline__ void attn_prime(const BlockRef& cur, unsigned char* wsb, char* lds, Seam& S, int wv) {
    const int tid = tid_of(wv);
    const int wid = __builtin_amdgcn_readfirstlane(tid >> 6), lane = tid & 63, r32 = lane & 31, hi = lane >> 5;
    const int sr = tid >> 4, sc = (tid & 15) * 8, kws = KSWZ(sr, sc * 2); char* K_lds = lds + 2 * SHM_V;
    const bf16_t* qp = ref_q(cur, wsb) + (size_t)(q_rowoff(cur.samp, wid) + r32) * QLD + q_headoff(cur.samp, wid) * D + hi * 8;
    for (int d0 = 0; d0 < 8; ++d0) S.qr[d0] = load8(qp + d0 * 16);
    SLOAD_H(cur.K, cur.K + 1024, 0); VMW(); SWRITE_HK(0);
    __syncthreads();
}
__device__ __forceinline__ void attn_block(const BlockRef& cur, const BlockRef& nxt, unsigned char* wsb, char* lds, Seam& S, int wv) {
    const int tid = tid_of(wv);
    const int wid = __builtin_amdgcn_readfirstlane(tid >> 6), lane = tid & 63, r32 = lane & 31, hi = lane >> 5;
    const int NT = cur.NT;
    char* V_lds = lds; char* K_lds = lds + 2 * SHM_V;
    float* ws = (float*)(lds + 2 * SHM_V + 2 * SHM_K) + wid * 64; float* li_l = ws, * al_l = ws + 32;
    float m_reg = -1e30f, l_reg = 0; f32x16 o[4] = {};
    const int sr = tid >> 4, sc = (tid & 15) * 8, vst0 = v_st(sr, sc), vst1 = v_st(32 + sr, sc), kws = KSWZ(sr, sc * 2);
    const int vb0 = (int)(uintptr_t)V_lds + v_rd_base(lane);
    const bf16_t* Kh = cur.K; const bf16_t* Vh = cur.K + 1024;
    const int qro = q_rowoff(cur.samp, wid), qho = q_headoff(cur.samp, wid);
    const char* bmb = ref_bm(cur, wsb); const unsigned bmo = (unsigned)(qro + r32) * 512u;
#define BMW(t) (*(const unsigned long long*)(bmb + bmo + (unsigned)(t) * 8u))
#define RESC(a) do { if (__any((a) < 1.f)) { if (hi == 0) al_l[r32] = (a); asm volatile("s_waitcnt lgkmcnt(0)" ::: "memory");              \
                     for (int d_ = 0; d_ < 4; ++d_) for (int r = 0; r < 16; ++r) o[d_][r] *= al_l[crow(r, hi)]; } } while (0)
#define KBASE(t) ((t) * KVBLK)
    f32x16 pA0, pA1, pB0, pB1; float mnA, mnB, alA, alB; bf16x8 pa0, pa1, pa2, pa3;
    SWRITE_HV(0); SBAR();
    if (NT > 1) SLOAD_H(Kh, Vh, KBASE(1));
    const unsigned long long mw0 = BMW(0);
    SBAR(); qkt<0>(pA0, pA1, K_lds, r32, hi, S.qr);
    mask_bits(pA0, pA1, mw0, hi); partialSM(pA0, pA1, m_reg, mnA, alA);
    if (NT > 1) { VMW(); SWRITE_H(1); }
    __syncthreads();
#define HALF_STEP(PX0, PX1, mnX, alX, PY0, PY1, alY, t, KB, VB, SB) do {                                                      \
        SBAR(); qkt<KB>(PX0, PX1, K_lds, r32, hi, S.qr);                                                                      \
        finishSM(PY0, PY1, alY, l_reg, pa0, pa1, pa2, pa3); SBAR();                                                           \
        const unsigned long long mw_ = BMW(t);                                                                               \
        if ((t) + 1 < NT) { SLOAD_H(Kh, Vh, KBASE((t) + 1)); SBAR(); }                                                        \
        pv_tile<VB>(o, vb0, pa0, pa1, pa2, pa3); mask_bits(PX0, PX1, mw_, hi); partialSM(PX0, PX1, m_reg, mnX, alX);         \
        __syncthreads();                                                                                                      \
        if ((t) + 1 < NT) { VMW(); SWRITE_H(SB); }                                                                            \
        RESC(alX); __syncthreads(); } while (0)
    for (int t = 1; t + 1 < NT; t += 2) {
        HALF_STEP(pB0, pB1, mnB, alB, pA0, pA1, alA, t, 1, 0, 0);
        HALF_STEP(pA0, pA1, mnA, alA, pB0, pB1, alB, t + 1, 0, 1, 1);
    }
    const bool even = (NT & 1) == 0;
    unsigned long long mwT = 0ull;
    if (even) { mwT = BMW(NT - 1); SBAR(); qkt<1>(pB0, pB1, K_lds, r32, hi, S.qr); SBAR(); }
    SLOAD_H(nxt.K, nxt.K + 1024, 0); SBAR();
    { const bf16_t* qp = ref_q(nxt, wsb) + (size_t)(q_rowoff(nxt.samp, wid) + r32) * QLD + q_headoff(nxt.samp, wid) * D + hi * 8;
#pragma unroll
      for (int d0 = 0; d0 < 8; ++d0) S.qr[d0] = load8(qp + d0 * 16); }
    SBAR();
    finishSM(pA0, pA1, alA, l_reg, pa0, pa1, pa2, pa3); SBAR();
    pv_tile<0>(o, vb0, pa0, pa1, pa2, pa3);
    if (even) { mask_bits(pB0, pB1, mwT, hi); partialSM(pB0, pB1, m_reg, mnB, alB); __syncthreads(); RESC(alB);
        finishSM(pB0, pB1, alB, l_reg, pa0, pa1, pa2, pa3); SBAR(); pv_tile<1>(o, vb0, pa0, pa1, pa2, pa3); }
    SBAR(); VMWN(8); SWRITE_HK(0); SBAR();
    if (hi == 0) li_l[r32] = l_reg; asm volatile("s_waitcnt lgkmcnt(0)" ::: "memory");
    float rli[16];
#pragma unroll
    for (int r = 0; r < 16; ++r) rli[r] = __builtin_amdgcn_rcpf(li_l[crow(r, hi)]);
    unsigned char* Ow = ref_o(cur, wsb) + (size_t)qro * OLD + qho * D;
    const bool st_ok = !cur.samp || wid < 4;
#pragma unroll
    for (int r = 0; r < 16; ++r) { const int orow = crow(r, hi);
#pragma unroll
        for (int d0 = 0; d0 < 4; ++d0) { const float v = o[d0][r] * (rli[r] * SA_ATT);
            const float vn = __shfl_xor(v, 1);
            const int h2 = __builtin_amdgcn_cvt_pk_fp8_f32(v, vn, 0, false), h4 = __shfl_xor(h2, 2);
            if (st_ok && (r32 & 3) == 0) *(unsigned*)(Ow + (size_t)orow * OLD + d0 * 32 + r32) = ((unsigned)h2 & 0xffffu) | ((unsigned)h4 << 16); } }
    __syncthreads();
#undef RESC
#undef KBASE
#undef HALF_STEP
#undef BMW
}
#undef ROW
#undef VMW
#undef VMWN
#undef SLOAD_H
#undef SWRITE_HK
#undef SWRITE_HV
#undef SWRITE_H
}
__device__ __forceinline__ att::BlockRef attn_item(unsigned char* ws, int i) {
    att::BlockRef r;
    if (i < 128) { const int bs = i >> 3, g = i & 7; r.m0 = NTOK_P + bs * DEC_T; r.g = g; r.K = (const bf16_t*)(ws + WS_KVS) + (size_t)bs * SKV_SP * 2048 + g * HD; r.NT = SKV_SP / 64; r.samp = 1; }
    else { const int j = i - 128, c = 63 - (j >> 4), b = (j >> 3) & 1, g = j & 7; r.m0 = b * SEQ + c * 64; r.g = g; r.K = (const bf16_t*)(ws + WS_KV) + (size_t)b * SEQ * 2048 + g * HD; r.NT = c + 1; r.samp = 0; }
    return r;
}
__device__ __forceinline__ void attn_phase(Frame& F, char* lds) {
    unsigned char* const ws = ws_ptr(F); unsigned* const ctl = (unsigned*)(ws + WS_CTL);
    constexpr int TOTAL = 128 + 1024;
    volatile LAS unsigned* qw = (volatile LAS unsigned*)(F.lds + RING_OFF + att::ATT_LDS - 64);
    __syncthreads(); const unsigned qsel = F.MISC[17]; __syncthreads(); if (F.tid == 0) F.MISC[17] = qsel + 1u;
    unsigned* qhead = ctl + CW_QATT + 64 * qsel;
    if (F.tid == 0) { qw[0] = __hip_atomic_fetch_add(qhead, 1u, __ATOMIC_RELAXED, __HIP_MEMORY_SCOPE_AGENT); qw[1] = __hip_atomic_fetch_add(qhead, 1u, __ATOMIC_RELAXED, __HIP_MEMORY_SCOPE_AGENT); }
    __syncthreads();
    int i0 = (int)qw[0], i1 = (int)qw[1];
    __syncthreads();
    if (i0 < TOTAL) {
        att::BlockRef cur = attn_item(ws, i0);
        att::Seam S;
        att::attn_prime(cur, ws, lds, S, F.wave);
        for (;;) {
            const bool has = i1 < TOTAL;
            const att::BlockRef nxt = has ? attn_item(ws, i1) : cur;
            if (F.tid == 0 && has) qw[0] = __hip_atomic_fetch_add(qhead, 1u, __ATOMIC_RELAXED, __HIP_MEMORY_SCOPE_AGENT);
            att::attn_block(cur, nxt, ws, lds, S, F.wave);
            if (!has) break;
            __syncthreads();
            i1 = (int)qw[0];
            __syncthreads();
            cur = nxt;
        }
    }
    __syncthreads(); conv_drain(F);
}

struct EpiMix {
    static constexpr bool PERM = true, MID = true, FP8 = true;
    LAS unsigned char* lds;
    __device__ __forceinline__ void mid(f32x4 (&acc)[2][2][4][2], const pg8::Unit& u, int wr, int wc, int fr, int fq) const {
        int row0 = u.pm * 256 + wr * 64 + fr, col0 = u.pn * 256 + wc * 32 + 8 * fq;
        asm volatile("" : "+v"(row0), "+v"(col0));
        unsigned char* const ws = e_ws(lds); const bf16_t* SGA = (const bf16_t*)(ws + WS_SGA); const bf16_t* SGL = (const bf16_t*)(ws + WS_SGL);
#pragma unroll
        for (int ai = 0; ai < 2; ++ai) { u32x4 ga[4][2], gl[4][2];
#pragma unroll
            for (int m = 0; m < 4; ++m)
#pragma unroll
                for (int bj = 0; bj < 2; ++bj) { const size_t off = (size_t)(row0 + ai * 128 + m * 16) * DM + col0 + bj * 128; ga[m][bj] = *(const u32x4*)(SGA + off); gl[m][bj] = *(const u32x4*)(SGL + off); }
            asm volatile("" ::: "memory");
#pragma unroll
            for (int m = 0; m < 4; ++m)
#pragma unroll
                for (int bj = 0; bj < 2; ++bj) { float a[8], l[8]; unpack8(ga[m][bj], a); unpack8(gl[m][bj], l);
#pragma unroll
                    for (int e = 0; e < 4; ++e) { acc[ai][bj][m][0][e] *= a[e] * (SA_LRU / SA_ATT) * __builtin_amdgcn_rcpf(l[e]); acc[ai][bj][m][1][e] *= a[4 + e] * (SA_LRU / SA_ATT) * __builtin_amdgcn_rcpf(l[4 + e]); }
                    asm volatile("" : "+v"(acc[ai][bj][m][0]), "+v"(acc[ai][bj][m][1])); }
            asm volatile("" ::: "memory"); }
    }
    __device__ __forceinline__ void operator()(const f32x4 (&acc)[2][2][4][2], const pg8::Unit& u, int wr, int wc, int fr, int fq) const {
        const int row0 = u.pm * 256 + wr * 64 + fr, col0 = u.pn * 256 + wc * 32 + 8 * fq; constexpr float SC = S_MIX / (SA_LRU * SW8);
        unsigned char* const ws = e_ws(lds); const bf16_t* SGL = (const bf16_t*)(ws + WS_SGL); unsigned char* MIX = ws + WS_MIX;
        u32x4 glr[2][4][2];
#pragma unroll
        for (int ai = 0; ai < 2; ++ai)
#pragma unroll
            for (int m = 0; m < 4; ++m)
#pragma unroll
                for (int bj = 0; bj < 2; ++bj) glr[ai][m][bj] = *(const u32x4*)(SGL + (size_t)(row0 + ai * 128 + m * 16) * DM + col0 + bj * 128);
        asm volatile("" ::: "memory");
#pragma unroll
        for (int ai = 0; ai < 2; ++ai)
#pragma unroll
            for (int m = 0; m < 4; ++m)
#pragma unroll
                for (int bj = 0; bj < 2; ++bj) { const size_t off = (size_t)(row0 + ai * 128 + m * 16) * DM + col0 + bj * 128; float gl[8]; unpack8(glr[ai][m][bj], gl);
                    const f32x4 v0 = acc[ai][bj][m][0], v1 = acc[ai][bj][m][1];
                    if (P9_FP8) { u32x2 w; w.x = pk4_fp8(v0[0] * gl[0] * SC, v0[1] * gl[1] * SC, v0[2] * gl[2] * SC, v0[3] * gl[3] * SC); w.y = pk4_fp8(v1[0] * gl[4] * SC, v1[1] * gl[5] * SC, v1[2] * gl[6] * SC, v1[3] * gl[7] * SC);
                        *(u32x2*)(MIX + off) = w; }
                    else { constexpr float S1 = 1.0f / (SA_LRU * SW8); u32x4 w; w.x = pk2(v0[0] * gl[0] * S1, v0[1] * gl[1] * S1); w.y = pk2(v0[2] * gl[2] * S1, v0[3] * gl[3] * S1); w.z = pk2(v1[0] * gl[4] * S1, v1[1] * gl[5] * S1); w.w = pk2(v1[2] * gl[6] * S1, v1[3] * gl[7] * S1);
                        *(u32x4*)((bf16_t*)MIX + off) = w; } }
    }
};
struct EpiOut {
    static constexpr bool PERM = false, MID = false, FP8 = (P9_FP8 != 0);
    LAS unsigned char* lds;
    __device__ __forceinline__ void operator()(const f32x4 (&acc)[2][2][4][2], const pg8::Unit& u, int wr, int wc, int fr, int fq) const {
        unsigned char* const ws = e_ws(lds); const float* xp = e_in(lds, 0); const float* xs = e_in(lds, 1); const float* gf = e_in(lds, 21);
        float* X1 = (float*)(ws + WS_X1); bf16_t* A2 = (bf16_t*)(ws + WS_A2); LAS float* X = (LAS float*)(lds + XCH_OFF);
        const int row0 = u.pm * 256 + wr * 64 + fr, col0 = u.pn * 256 + wc * 32 + 4 * fq;
        const float* xb = (u.pm < NTOK_P / 256) ? xp : xs - (size_t)NTOK_P * DM;
        f32x4 gv[2][2];
#pragma unroll
        for (int bj = 0; bj < 2; ++bj)
#pragma unroll
            for (int n = 0; n < 2; ++n) gv[bj][n] = *(const f32x4*)(gf + col0 + bj * 128 + n * 16);
#pragma unroll
        for (int ai = 0; ai < 2; ++ai) { f32x4 xv[4][2][2];
#pragma unroll
            for (int m = 0; m < 4; ++m)
#pragma unroll
                for (int bj = 0; bj < 2; ++bj)
#pragma unroll
                    for (int n = 0; n < 2; ++n) xv[m][bj][n] = *(const f32x4*)(xb + (size_t)(row0 + ai * 128 + m * 16) * DM + col0 + bj * 128 + n * 16);
            asm volatile("" ::: "memory");
#pragma unroll
            for (int m = 0; m < 4; ++m) { const size_t row = (size_t)(row0 + ai * 128 + m * 16); const size_t off = row * DM + col0; float s = 0.f;
#pragma unroll
                for (int bj = 0; bj < 2; ++bj)
#pragma unroll
                    for (int n = 0; n < 2; ++n) { const f32x4 x1 = xv[m][bj][n] + acc[ai][bj][m][n] * (P9_FP8 ? 1.0f / (S_MIX * SW8) : 1.0f);
                        *(f32x4*)(X1 + off + bj * 128 + n * 16) = x1; s += (x1[0] * x1[0] + x1[1] * x1[1]) + (x1[2] * x1[2] + x1[3] * x1[3]);
                        const f32x4 y = x1 * gv[bj][n]; u32x2 w; w.x = pk2(y[0], y[1]); w.y = pk2(y[2], y[3]); *(u32x2*)(A2 + off + bj * 128 + n * 16) = w; }
                s += __shfl_xor(s, 16); s += __shfl_xor(s, 32);
                if (fq == 0) X[(ai * 128 + wr * 64 + m * 16 + fr) * 4 + wc] = s; }
            asm volatile("" ::: "memory"); }
        asm volatile("s_waitcnt lgkmcnt(0)" ::: "memory"); __builtin_amdgcn_s_barrier(); asm volatile("" ::: "memory");
        { const int t = (wr * 4 + wc) * 64 + (fq * 16 + fr);
          if (t < 256) { const f32x4 p = *(const LAS f32x4*)(X + t * 4); ((float*)(ws + WS_PSSQ))[(size_t)u.pn * MTOK + u.pm * 256 + t] = (p[0] + p[1]) + (p[2] + p[3]); } }
    }
};
struct EpiGU {
    static constexpr bool PERM = true, MID = false, FP8 = false;
    LAS unsigned char* lds;
    __device__ __forceinline__ void operator()(const f32x4 (&acc)[2][2][4][2], const pg8::Unit& u, int wr, int wc, int fr, int fq) const {
        unsigned char* const ws = e_ws(lds); const float* RSTD = (const float*)(ws + WS_CTL) + CW_SSQ; bf16_t* H = (bf16_t*)(ws + WS_H);
        const int row0 = u.pm * 256 + wr * 64 + fr, col0 = u.pn * 128 + wc * 32 + 8 * fq;
        float rs[2][4];
#pragma unroll
        for (int ai = 0; ai < 2; ++ai)
#pragma unroll
            for (int m = 0; m < 4; ++m) rs[ai][m] = RSTD[row0 + ai * 128 + m * 16];
        asm volatile("" ::: "memory");
#pragma unroll
        for (int ai = 0; ai < 2; ++ai)
#pragma unroll
            for (int m = 0; m < 4; ++m) { const size_t row = (size_t)(row0 + ai * 128 + m * 16);
                const float rstd = rs[ai][m]; float hv[8];
#pragma unroll
                for (int n = 0; n < 2; ++n)
#pragma unroll
                    for (int e = 0; e < 4; ++e) { const float g = acc[ai][0][m][n][e] * rstd, up = acc[ai][1][m][n][e] * rstd; hv[4 * n + e] = g * sigmoidf_(g) * up; }
                *(u32x4*)(H + row * DFF + col0) = pack8f(hv); }
    }
};
struct EpiDown {
    static constexpr bool PERM = false, MID = false, FP8 = false;
    LAS unsigned char* lds;
    __device__ __forceinline__ void operator()(const f32x4 (&acc)[2][2][4][2], const pg8::Unit& u, int wr, int wc, int fr, int fq) const {
        const float* X1 = (const float*)(e_ws(lds) + WS_X1); float* Y = e_out(lds);
        const int row0 = u.pm * 256 + wr * 64 + fr, col0 = u.pn * 256 + wc * 32 + 4 * fq;
#pragma unroll
        for (int ai = 0; ai < 2; ++ai) { f32x4 xv[4][2][2];
#pragma unroll
            for (int m = 0; m < 4; ++m)
#pragma unroll
                for (int bj = 0; bj < 2; ++bj)
#pragma unroll
                    for (int n = 0; n < 2; ++n) xv[m][bj][n] = *(const f32x4*)(X1 + (size_t)(row0 + ai * 128 + m * 16) * DM + col0 + bj * 128 + n * 16);
            asm volatile("" ::: "memory");
#pragma unroll
            for (int m = 0; m < 4; ++m)
#pragma unroll
                for (int bj = 0; bj < 2; ++bj)
#pragma unroll
                    for (int n = 0; n < 2; ++n) *(f32x4*)(Y + (size_t)(row0 + ai * 128 + m * 16) * DM + col0 + bj * 128 + n * 16) = xv[m][bj][n] + acc[ai][bj][m][n];
            asm volatile("" ::: "memory"); }
    }
};

__device__ __forceinline__ f32x4 part_sum(const float* PART, int tile, int s0, int s1, int rr, int cc) {
    f32x4 a = {0.f, 0.f, 0.f, 0.f};
#pragma unroll
    for (int s = 0; s < 8; ++s) if (s >= s0 && s < s1) a += *(const f32x4*)(PART + ((size_t)(tile * 8 + s) * 65536 + (size_t)rr * 256 + cc));
    return a;
}
__device__ __forceinline__ void reduce_mix(Frame& F) {
    unsigned char* const ws = ws_ptr(F); const float* PART = (const float*)(ws + WS_PART);
    const bf16_t* SGA = (const bf16_t*)(ws + WS_SGA); const bf16_t* SGL = (const bf16_t*)(ws + WS_SGL); unsigned char* MIX = ws + WS_MIX;
    for (int it = F.gw * 64 + F.lane; it < NTOK_S * 1024; it += F.NGW * 64) { const int r = it >> 10, col = 4 * (it & 1023), tile = (r >> 8) * 16 + (col >> 8), rr = r & 255, cc = col & 255;
        const f32x4 sA = part_sum(PART, tile, 0, 4, rr, cc), sL = part_sum(PART, tile, 4, 8, rr, cc);
        const size_t off = (size_t)(NTOK_P + r) * DM + col; const u32x2 ga = *(const u32x2*)(SGA + off), gl = *(const u32x2*)(SGL + off);
        constexpr float CA = (P9_FP8 ? S_MIX : 1.0f) / (SA_ATT * SW8), CL = (P9_FP8 ? S_MIX : 1.0f) / (SA_LRU * SW8);
        const float m0 = bflo(ga.x) * sA[0] * CA + bflo(gl.x) * sL[0] * CL, m1 = bfhi(ga.x) * sA[1] * CA + bfhi(gl.x) * sL[1] * CL, m2 = bflo(ga.y) * sA[2] * CA + bflo(gl.y) * sL[2] * CL, m3 = bfhi(ga.y) * sA[3] * CA + bfhi(gl.y) * sL[3] * CL;
        if (P9_FP8) *(unsigned*)(MIX + off) = pk4_fp8(m0, m1, m2, m3); else *(u32x2*)((bf16_t*)MIX + off) = (u32x2){pk2(m0, m1), pk2(m2, m3)}; }
}
__device__ __forceinline__ void reduce_out(Frame& F, bool tail) {
    unsigned char* const ws = ws_ptr(F); const float* PART = (const float*)(ws + WS_PART); const float* xs = in_ptr(F, 1); const float* gf = in_ptr(F, 21);
    float* X1 = (float*)(ws + WS_X1); bf16_t* A2 = (bf16_t*)(ws + WS_A2); float* RSTD = (float*)(ctl_ptr(F) + CW_SSQ); const float* PSSQ = (const float*)(ws + WS_PSSQ);
    for (int r = F.gw * 64 + F.lane; r < (tail ? NTOK_P : MTOK); r += F.NGW * 64) { float ss = 0.f;
#pragma unroll
        for (int j = 0; j < 16; ++j) ss += PSSQ[(size_t)j * MTOK + r];
        RSTD[r] = 1.0f / sqrtf(ss * (1.0f / DM) + EPS); }
    if (tail) for (int r = F.gw; r < NTOK_S; r += F.NGW) { float ss = 0.f;
#pragma unroll 4
        for (int j = 0; j < 16; ++j) { const int col = 4 * F.lane + 256 * j, tile = (r >> 8) * 16 + j, rr = r & 255, cc = 4 * F.lane;
            const f32x4 x1 = *(const f32x4*)(xs + (size_t)r * DM + col) + part_sum(PART, tile, 0, 8, rr, cc) * (P9_FP8 ? 1.0f / (S_MIX * SW8) : 1.0f); const f32x4 gg = *(const f32x4*)(gf + col);
            const size_t off = (size_t)(NTOK_P + r) * DM + col; *(f32x4*)(X1 + off) = x1; ss += (x1[0] * x1[0] + x1[1] * x1[1]) + (x1[2] * x1[2] + x1[3] * x1[3]);
            u32x2 o; o.x = pk2(x1[0] * gg[0], x1[1] * gg[1]); o.y = pk2(x1[2] * gg[2], x1[3] * gg[3]); *(u32x2*)(A2 + off) = o; }
        ss = wave_sum(ss);
        if (F.lane == 0) RSTD[NTOK_P + r] = 1.0f / sqrtf(ss * (1.0f / DM) + EPS); }
}
__device__ __forceinline__ void reduce_down(Frame& F) {
    unsigned char* const ws = ws_ptr(F); const float* PART = (const float*)(ws + WS_PART); const float* X1 = (const float*)(ws + WS_X1); float* Y = out_ptr(F);
    for (int it = F.gw * 64 + F.lane; it < NTOK_S * 1024; it += F.NGW * 64) { const int r = it >> 10, col = 4 * (it & 1023), tile = (r >> 8) * 16 + (col >> 8), rr = r & 255, cc = col & 255;
        const size_t off = (size_t)(NTOK_P + r) * DM + col;
        *(f32x4*)(Y + off) = *(const f32x4*)(X1 + off) + part_sum(PART, tile, 0, 8, rr, cc); }
}

__device__ __forceinline__ void reduce_gu(Frame& F) {
    unsigned char* const ws = ws_ptr(F); const float* PART = (const float*)(ws + WS_PART); const float* RSTD = (const float*)(ws + WS_CTL) + CW_SSQ; bf16_t* H = (bf16_t*)(ws + WS_H);
    constexpr int nM = MTOK / 256, nN = 2 * DFF / 256, NW = nM * nN, RF = NW / 256, REM = NW - RF * 256;
    for (int it = F.gw * 64 + F.lane; it < REM * 256 * 32; it += F.NGW * 64) { const int t = it >> 13, rr = (it >> 5) & 255, cc = 4 * (it & 31);
        int pm, pn; pg8::map_unit(RF * 256 + t, nM, nN, pm, pn);
        const float* p0 = PART + (size_t)(2 * t) * 65536 + (size_t)rr * 256 + cc; const float* p1 = p0 + 65536;
        const f32x4 g = *(const f32x4*)p0 + *(const f32x4*)p1, u = *(const f32x4*)(p0 + 128) + *(const f32x4*)(p1 + 128);
        const size_t row = (size_t)pm * 256 + rr; const float rstd = RSTD[row];
        float h[4];
#pragma unroll
        for (int e = 0; e < 4; ++e) { const float gg = g[e] * rstd; h[e] = gg * sigmoidf_(gg) * (u[e] * rstd); }
        *(u32x2*)(H + row * DFF + pn * 128 + cc) = (u32x2){pk2(h[0], h[1]), pk2(h[2], h[3])}; }
}

__global__ void __launch_bounds__(NTHR, 2) fwd_kernel(Args args) {
    extern __shared__ __attribute__((aligned(16))) unsigned char lds_raw[];
    LAS unsigned char* const ldsb = (LAS unsigned char*)lds_raw;
    int wv0 = __builtin_amdgcn_readfirstlane((int)(threadIdx.x >> 6)); asm volatile("" : "+s"(wv0));
    Frame F = make_frame(ldsb, wv0);
    for (int u = F.tid; u < (LDS_BYTES - LDSCTL_OFF) / 4; u += NTHR) ((LAS unsigned*)(F.lds + LDSCTL_OFF))[u] = 0u;
    __syncthreads();
    if (F.tid == 0) { volatile LAS unsigned* p = (volatile LAS unsigned*)(F.lds + PTR_OFF);
#pragma unroll
        for (int i = 0; i < 25; ++i) { const unsigned long long v = (unsigned long long)args.in[i]; p[2 * i] = (unsigned)v; p[2 * i + 1] = (unsigned)(v >> 32); }
        { const unsigned long long v = (unsigned long long)args.out; p[50] = (unsigned)v; p[51] = (unsigned)(v >> 32); }
        { const unsigned long long v = (unsigned long long)args.ws; p[52] = (unsigned)v; p[53] = (unsigned)(v >> 32); } }
    __syncthreads();
    XcdBarrier bar = xcd_barrier_post(ctl_ptr(F) + CW_BAR, F.MISC + 8, wv0);

#define REP(n, ...) do { __VA_ARGS__; if constexpr ((DBL >> (n)) & 1) { xcd_barrier(bar); __VA_ARGS__; } } while (0)
#define GEMM_PHASE_C(EPI, AOFF, BOFF, LDA, LDB, KK, NN, BD, TAIL, CIDX) do { F = make_frame(ldsb, wv0); unsigned char* const ws = ws_ptr(F); \
        pg8::Gemm g{ws, (AOFF), (BOFF), (LDA), (LDB), (KK)}; pg8::StaticOrder S; S.init(MTOK, (NN), (KK), F.G, (CIDX), (BD), (TAIL)); \
        EPI E{F.lds}; pg8::gemm_phase<EPI, pg8::StaticOrder>(F.lds + RING_OFF, g, S, E, F.wave); } while (0)
#define GEMM_PHASE(EPI, AOFF, BOFF, LDA, LDB, KK, NN, BD, TAIL) GEMM_PHASE_C(EPI, AOFF, BOFF, LDA, LDB, KK, NN, BD, TAIL, (int)blockIdx.x)
    REP(0, F = make_frame(ldsb, wv0); p0_prologue(F));
    xcd_barrier(bar);
    REP(1, GEMM_PHASE(EpiProjA, WS_XN, WS_WI, DM, DM, DM, 41 * 256, 0, 0));
    REP(13, GEMM_PHASE_C(EpiProjB, WS_XN8, WS_WI8, DM / 2, DM / 2, DM / 2, 64 * 256, 0, 0, (int)(gridDim.x - 1 - blockIdx.x)));
    xcd_barrier(bar);
    REP(2, F = make_frame(ldsb, wv0); p2_phase(F));
    xcd_barrier(bar);
    REP(3, GEMM_PHASE(EpiGates, WS_U, WS_WG, DM, 256, 256, 32 * 256, 1, 0));
    REP(10, F = make_frame(ldsb, wv0); idx_phase(F));
    xcd_barrier(bar);
    REP(4, F = make_frame(ldsb, wv0); scan_summaries(F));
    REP(11, F = make_frame(ldsb, wv0); select_phase(F));
    xcd_barrier(bar);
    REP(5, F = make_frame(ldsb, wv0); scan_apply(F));
    REP(12, F = make_frame(ldsb, wv0); attn_phase(F, (char*)lds_raw + RING_OFF));
    xcd_barrier(bar);
    REP(6, GEMM_PHASE(EpiMix, WS_OAL, WS_WB, DM, DM, DM, DM, 0, 1));
    xcd_barrier(bar);
    if (gridDim.x == 256) { F = make_frame(ldsb, wv0); reduce_mix(F); xcd_barrier(bar); }
    GEMM_PHASE(EpiOut, WS_MIX, WS_WO, (P9_FP8 ? DM / 2 : DM), (P9_FP8 ? DM / 2 : DM), (P9_FP8 ? DM / 2 : DM), DM, 0, 1);
    xcd_barrier(bar);
    F = make_frame(ldsb, wv0); reduce_out(F, gridDim.x == 256); xcd_barrier(bar);
    REP(8, GEMM_PHASE(EpiGU, WS_A2, WS_WGU, DM, DM, DM, 2 * DFF, 0, 2));
    xcd_barrier(bar);
    if (gridDim.x == 256) { F = make_frame(ldsb, wv0); reduce_gu(F); xcd_barrier(bar); }
    REP(9, GEMM_PHASE(EpiDown, WS_H, WS_WD, DFF, DFF, DFF, DM, 0, 1));
    if (gridDim.x == 256) { xcd_barrier(bar); F = make_frame(ldsb, wv0); reduce_down(F); }
#undef REP
#undef GEMM_PHASE
#undef GEMM_PHASE_C
}

extern "C" void kernel_launch(void* const* d_in, const int* in_sizes, int n_in, void* d_out, int out_size, void* d_ws, size_t ws_size, hipStream_t stream) {
    static int grid = 0;
    if (grid == 0) {
        if (n_in != 25 || out_size != (int)O_END || ws_size < WS_END) { fprintf(stderr, "kernel_launch: unexpected shapes (n_in %d, out %d, ws %zu; need ws >= %zu); nothing launched\n", n_in, out_size, ws_size, (size_t)WS_END); grid = -1; return; }
        int dev = 0, cus = 0, per_cu = 0;
        if (hipGetDevice(&dev) != hipSuccess || hipDeviceGetAttribute(&cus, hipDeviceAttributeMultiprocessorCount, dev) != hipSuccess) { fprintf(stderr, "kernel_launch: device query failed\n"); grid = -1; return; }
        if (hipFuncSetAttribute((const void*)fwd_kernel, hipFuncAttributeMaxDynamicSharedMemorySize, LDS_BYTES) != hipSuccess) { fprintf(stderr, "kernel_launch: hipFuncSetAttribute failed\n"); grid = -1; return; }
        if (hipOccupancyMaxActiveBlocksPerMultiprocessor(&per_cu, (const void*)fwd_kernel, NTHR, LDS_BYTES) != hipSuccess || per_cu < 1) { fprintf(stderr, "kernel_launch: occupancy query reports %d blocks per CU\n", per_cu); }
        (void)hipGetLastError();
        grid = cus;
    }
    if (grid < 0) return;
    if (hipMemsetAsync((char*)d_ws + WS_CTL, 0, CTL_BYTES, stream) != hipSuccess) { fprintf(stderr, "kernel_launch: memset failed\n"); return; }
    Args a{};
    for (int i = 0; i < 25; ++i) a.in[i] = (const float*)d_in[i];
    a.out = (float*)d_out; a.ws = (unsigned char*)d_ws;
    hipLaunchKernelGGL(fwd_kernel, dim3(grid), dim3(NTHR), LDS_BYTES, stream, a);
    const hipError_t le = hipPeekAtLastError();
    if (le != hipSuccess) fprintf(stderr, "kernel_launch: launch failed: %s\n", hipGetErrorName(le));
}
```
